# Optimizing an MI355X kernel written in HIP

```python
import functools
import jax, jax.numpy as jnp
from jax import lax
import numpy as np

D_MODEL = 2048
BATCH = 4
SEQ = 2048
DEPTH = 1
DEC_BATCH = 32
DEC_SEQ = 4
PAST_LEN = 8192
PAGE_SIZE = 128

RWKV_HEAD_DIM = 64
RWKV_WIDTH = D_MODEL // 2
RWKV_HEADS = RWKV_WIDTH // RWKV_HEAD_DIM
DECAY_LORA = 64
ICLR_LORA = 64
GN_EPS = 64e-5
SHIFT_WIDTH = 3 * RWKV_WIDTH + DECAY_LORA + ICLR_LORA

ATT_HEADS = 4
ATT_WIDTH = D_MODEL // 4
ATT_HEAD_DIM = ATT_WIDTH // ATT_HEADS
IDX_HEADS = 16
IDX_DIM = 64
TOPK_MAX = 256
Q_BLOCK = 128
ROPE_THETA = 10000.0

MEM_TOKENS = 256
MEM_HEADS = 4
MEM_WIDTH = D_MODEL // 4
MEM_HEAD_DIM = MEM_WIDTH // MEM_HEADS

MIX_WIDTH = RWKV_WIDTH + ATT_WIDTH + MEM_WIDTH
RMS_EPS = 1e-6
IN_SPLITS = (SHIFT_WIDTH, RWKV_WIDTH,
             ATT_WIDTH, ATT_WIDTH, ATT_WIDTH, ATT_WIDTH,
             IDX_HEADS * IDX_DIM, IDX_HEADS, IDX_DIM,
             MEM_WIDTH, MEM_WIDTH)
IN_WIDTH = sum(IN_SPLITS)

kernel_name = 'hymba_rwkv7_dsa_memory_step'


def rmsnorm(x, w):
    xf = x.astype(jnp.float32)
    y = xf * lax.rsqrt(jnp.mean(xf * xf, axis=-1, keepdims=True) + RMS_EPS)
    return (y * w.astype(jnp.float32)).astype(x.dtype)


def rope(x, pos):
    d = x.shape[-1]
    half = d // 2
    inv_freq = ROPE_THETA ** (-jnp.arange(half, dtype=jnp.float32) * (2.0 / d))
    ang = pos.astype(jnp.float32)[:, None] * inv_freq[None, :]
    cos = jnp.cos(ang)[:, None, :]
    sin = jnp.sin(ang)[:, None, :]
    xf = x.astype(jnp.float32)
    x1, x2 = xf[..., :half], xf[..., half:]
    return jnp.concatenate([x1 * cos - x2 * sin, x2 * cos + x1 * sin], axis=-1).astype(x.dtype)


def rwkv_time_mix(sh, prev_shift, wkv0, mu, w0, w2, a0, a2, k_k, k_a, r_k, gn_w, gn_b):
    Bh, Th, _ = sh.shape
    C = RWKV_WIDTH
    f32 = jnp.float32
    prev = jnp.concatenate([prev_shift[:, None, :].astype(sh.dtype), sh[:, :-1]], axis=1)
    xs = sh + (prev - sh) * mu
    r, k, v, cw, ca = jnp.split(xs, [C, 2 * C, 3 * C, 3 * C + DECAY_LORA], axis=-1)
    w_log = -jax.nn.softplus(-(w0 + jnp.tanh(cw) @ w2).astype(f32)) - 0.5
    decay = jnp.exp(-jnp.exp(w_log))
    a = jax.nn.sigmoid((a0 + ca @ a2).astype(f32))
    hd = lambda t: t.astype(f32).reshape(Bh, Th, RWKV_HEADS, RWKV_HEAD_DIM)
    kk = hd(k * k_k)
    kk = kk / jnp.maximum(jnp.sqrt(jnp.sum(kk * kk, axis=-1, keepdims=True)), 1e-12)
    k = hd(k * (1.0 + (a - 1.0) * k_a))
    r, v, decay, a = hd(r), hd(v), hd(decay), hd(a)

    def step(S, inp):
        r_t, k_t, v_t, w_t, kk_t, a_t = inp
        sa = jnp.einsum('bhvk,bhk->bhv', S, -kk_t)
        S = (S * w_t[:, :, None, :] + sa[..., None] * (kk_t * a_t)[:, :, None, :]
             + v_t[..., None] * k_t[:, :, None, :])
        return S, jnp.einsum('bhvk,bhk->bhv', S, r_t)

    tm = lambda t: jnp.swapaxes(t, 0, 1)
    S_fin, y = lax.scan(step, wkv0.astype(f32), (tm(r), tm(k), tm(v), tm(decay), tm(kk), tm(a)))
    y = tm(y)
    mean = jnp.mean(y, axis=-1, keepdims=True)
    var = jnp.mean(jnp.square(y - mean), axis=-1, keepdims=True)
    y = ((y - mean) * lax.rsqrt(var + GN_EPS) * gn_w.reshape(RWKV_HEADS, RWKV_HEAD_DIM)
         + gn_b.reshape(RWKV_HEADS, RWKV_HEAD_DIM))
    y = y + jnp.sum(r * k * r_k, axis=-1, keepdims=True) * v
    return y.reshape(Bh, Th, C).astype(sh.dtype), S_fin.astype(sh.dtype), sh[:, -1]


def indexer_scores(qi, wi, ki):
    dots = jnp.einsum('bqhd,bld->bqhl', qi, ki).astype(jnp.float32) * IDX_DIM ** -0.5
    return jnp.einsum('bqhl,bqh->bql', jax.nn.relu(dots), wi.astype(jnp.float32) * IDX_HEADS ** -0.5)


def sparse_attend(q, ks, vs, valid):
    s = jnp.einsum('bqhd,bqkhd->bqhk', q, ks).astype(jnp.float32) * ATT_HEAD_DIM ** -0.5
    s = jnp.where(valid[:, :, None, :], s, -jnp.inf)
    p = jax.nn.softmax(s, axis=-1).astype(vs.dtype)
    return jnp.einsum('bqhk,bqkhd->bqhd', p, vs)


_take_rows = jax.vmap(lambda rows, idx: rows[idx])


def dsa_prompt(q, k, v, qi, wi, ki, topk):
    S = q.shape[1]
    key_pos = jnp.arange(S)

    def block(start):
        sl = lambda t: lax.dynamic_slice_in_dim(t, start, Q_BLOCK, axis=1)
        qpos = start + jnp.arange(Q_BLOCK)
        score = indexer_scores(sl(qi), sl(wi), ki)
        score = jnp.where(key_pos[None, None, :] <= qpos[None, :, None], score, -jnp.inf)
        _, idx = lax.top_k(score, topk)
        valid = idx <= qpos[None, :, None]
        return sparse_attend(sl(q), _take_rows(k, idx), _take_rows(v, idx), valid)

    out = lax.map(block, jnp.arange(0, S, Q_BLOCK))
    return jnp.moveaxis(out, 0, 1).reshape(q.shape)


def dsa_sample(q, k, v, qi, wi, ki, cache_k, cache_v, cache_kidx, page_table, topk):
    DB, T = q.shape[:2]
    past = page_table.shape[1] * PAGE_SIZE
    ki_past = cache_kidx[page_table].reshape(DB, past, IDX_DIM).astype(ki.dtype)
    ki_all = jnp.concatenate([ki_past, ki], axis=1)
    qpos = past + jnp.arange(T)
    score = indexer_scores(qi, wi, ki_all)
    score = jnp.where(jnp.arange(past + T)[None, None, :] <= qpos[None, :, None], score, -jnp.inf)
    _, idx = lax.top_k(score, topk)
    valid = idx <= qpos[None, :, None]
    is_past = idx < past
    pidx = jnp.minimum(idx, past - 1)
    phys = _take_rows(page_table, pidx // PAGE_SIZE) * PAGE_SIZE + pidx % PAGE_SIZE
    nidx = jnp.clip(idx - past, 0, T - 1)

    def gather(pool, new):
        from_pool = pool.reshape(-1, ATT_HEADS, ATT_HEAD_DIM)[phys].astype(new.dtype)
        return jnp.where(is_past[..., None, None], from_pool, _take_rows(new, nidx))

    return sparse_attend(q, gather(cache_k, k), gather(cache_v, v), valid)


def memory_kv(mem, mem_norm_w, w_mem_kv):
    Bm, M, _ = mem.shape
    mk, mv = jnp.split(rmsnorm(mem, mem_norm_w) @ w_mem_kv, 2, axis=-1)
    return (mk.reshape(Bm, M, MEM_HEADS, MEM_HEAD_DIM), mv.reshape(Bm, M, MEM_HEADS, MEM_HEAD_DIM))


def mem_attend(q, mk, mv):
    s = jnp.einsum('bthd,bmhd->bhtm', q, mk.astype(q.dtype)).astype(jnp.float32) * MEM_HEAD_DIM ** -0.5
    p = jax.nn.softmax(s, axis=-1).astype(q.dtype)
    return jnp.einsum('bhtm,bmhd->bthd', p, mv.astype(q.dtype))


def mixer_layer(h, pos, prev_shift, wkv0, attend, mem_k, mem_v, norm_w, w_in, w_out, rwkv_params):
    Bh, Th, _ = h.shape
    xn = rmsnorm(h, norm_w)
    offsets = np.cumsum(IN_SPLITS)[:-1].tolist()
    (sh, g_r, q, k, v, g_a, qi, wi, ki, qm, g_m) = jnp.split(xn @ w_in, offsets, axis=-1)
    y_r, wkv, shift = rwkv_time_mix(sh, prev_shift, wkv0, *rwkv_params)
    y_r = y_r * jax.nn.silu(g_r)
    q = rope(q.reshape(Bh, Th, ATT_HEADS, ATT_HEAD_DIM), pos)
    k = rope(k.reshape(Bh, Th, ATT_HEADS, ATT_HEAD_DIM), pos)
    v = v.reshape(Bh, Th, ATT_HEADS, ATT_HEAD_DIM)
    qi = rope(qi.reshape(Bh, Th, IDX_HEADS, IDX_DIM), pos)
    ki = rope(ki[:, :, None, :], pos)[:, :, 0, :]
    y_a = attend(q, k, v, qi, wi, ki).reshape(Bh, Th, ATT_WIDTH) * jax.nn.silu(g_a)
    y_m = mem_attend(qm.reshape(Bh, Th, MEM_HEADS, MEM_HEAD_DIM), mem_k, mem_v).reshape(Bh, Th, MEM_WIDTH)
    y_m = y_m * jax.nn.silu(g_m)
    y = jnp.concatenate([y_r, y_a, y_m], axis=-1) @ w_out
    return h + y.astype(h.dtype), wkv, shift, k, v, ki


def setup_inputs(seed: int = 0) -> dict:
    key = jax.random.key(seed)
    ks = jax.random.split(key, 32)
    f32 = jnp.float32
    n_pages = PAST_LEN // PAGE_SIZE
    n_pool = (DEC_BATCH * n_pages * 5) // 4
    C = RWKV_WIDTH
    nrm = lambda k, shape, s=1.0: s * jax.random.normal(k, shape, f32)
    perm = jax.random.permutation(ks[0], n_pool)
    page_table = perm[:DEC_BATCH * n_pages].reshape(DEC_BATCH, n_pages).astype(jnp.int32)
    return {
        'x_prompt': nrm(ks[1], (BATCH, SEQ, D_MODEL)),
        'x_sample': nrm(ks[2], (DEC_BATCH, DEC_SEQ, D_MODEL)),
        'state_wkv': nrm(ks[3], (DEPTH, DEC_BATCH, RWKV_HEADS, RWKV_HEAD_DIM, RWKV_HEAD_DIM), 0.5),
        'state_shift': nrm(ks[4], (DEPTH, DEC_BATCH, SHIFT_WIDTH)),
        'cache_k': nrm(ks[5], (DEPTH, n_pool, PAGE_SIZE, ATT_HEADS, ATT_HEAD_DIM)),
        'cache_v': nrm(ks[6], (DEPTH, n_pool, PAGE_SIZE, ATT_HEADS, ATT_HEAD_DIM)),
        'cache_kidx': nrm(ks[7], (DEPTH, n_pool, PAGE_SIZE, IDX_DIM)),
        'cache_mem_k': nrm(ks[8], (DEPTH, DEC_BATCH, MEM_TOKENS, MEM_HEADS, MEM_HEAD_DIM)),
        'cache_mem_v': nrm(ks[9], (DEPTH, DEC_BATCH, MEM_TOKENS, MEM_HEADS, MEM_HEAD_DIM)),
        'page_table': page_table,
        'mem_prompt': nrm(ks[10], (BATCH, MEM_TOKENS, D_MODEL)),
        'norm_w': 1.0 + nrm(ks[11], (DEPTH, D_MODEL), 0.02),
        'w_in': nrm(ks[12], (DEPTH, D_MODEL, IN_WIDTH), D_MODEL ** -0.5),
        'shift_mu': jax.random.uniform(ks[13], (DEPTH, SHIFT_WIDTH), f32),
        'w0': jax.random.uniform(ks[14], (DEPTH, C), f32, -6.0, 0.0),
        'w2': nrm(ks[15], (DEPTH, DECAY_LORA, C), 0.1),
        'a0': nrm(ks[16], (DEPTH, C), 0.1),
        'a2': nrm(ks[17], (DEPTH, ICLR_LORA, C), 0.1),
        'k_k': 0.85 + nrm(ks[18], (DEPTH, C), 0.02),
        'k_a': 1.0 + nrm(ks[19], (DEPTH, C), 0.02),
        'r_k': nrm(ks[20], (DEPTH, RWKV_HEADS, RWKV_HEAD_DIM), 0.1),
        'gn_w': 1.0 + nrm(ks[21], (DEPTH, C), 0.02),
        'gn_b': nrm(ks[22], (DEPTH, C), 0.02),
        'mem_norm_w': 1.0 + nrm(ks[23], (DEPTH, D_MODEL), 0.02),
        'w_mem_kv': nrm(ks[24], (DEPTH, D_MODEL, 2 * MEM_WIDTH), D_MODEL ** -0.5),
        'w_out': nrm(ks[25], (DEPTH, MIX_WIDTH, D_MODEL), MIX_WIDTH ** -0.5),
        'final_norm_w': 1.0 + nrm(ks[26], (D_MODEL,), 0.02),
    }


def reference(x_prompt, x_sample, state_wkv, state_shift, cache_k, cache_v, cache_kidx,
              cache_mem_k, cache_mem_v, page_table, mem_prompt, norm_w, w_in, shift_mu,
              w0, w2, a0, a2, k_k, k_a, r_k, gn_w, gn_b, mem_norm_w, w_mem_kv, w_out,
              final_norm_w):
    B, S, _ = x_prompt.shape
    DB, T, _ = x_sample.shape
    past = page_table.shape[1] * PAGE_SIZE
    pos_p = jnp.arange(S)
    pos_s = past + jnp.arange(T)
    topk_p = min(TOPK_MAX, S // 4)
    topk_s = min(TOPK_MAX, (past + T) // 4)
    hp, hs = x_prompt, x_sample
    wkv_p, shift_p, k_p, v_p, kidx_p, memk_p, memv_p = [], [], [], [], [], [], []
    wkv_s, shift_s, k_s, v_s, kidx_s = [], [], [], [], []
    for l in range(DEPTH):
        rw = (shift_mu[l], w0[l], w2[l], a0[l], a2[l], k_k[l], k_a[l], r_k[l], gn_w[l], gn_b[l])
        mk, mv = memory_kv(mem_prompt, mem_norm_w[l], w_mem_kv[l])
        hp, n_wkv, n_shift, n_k, n_v, n_ki = mixer_layer(
            hp, pos_p, jnp.zeros((B, SHIFT_WIDTH), hp.dtype),
            jnp.zeros((B, RWKV_HEADS, RWKV_HEAD_DIM, RWKV_HEAD_DIM), jnp.float32),
            functools.partial(dsa_prompt, topk=topk_p), mk, mv,
            norm_w[l], w_in[l], w_out[l], rw)
        wkv_p.append(n_wkv); shift_p.append(n_shift); k_p.append(n_k); v_p.append(n_v)
        kidx_p.append(n_ki); memk_p.append(mk); memv_p.append(mv)
        attend_s = functools.partial(dsa_sample, cache_k=cache_k[l], cache_v=cache_v[l],
                                     cache_kidx=cache_kidx[l], page_table=page_table, topk=topk_s)
        hs, n_wkv, n_shift, n_k, n_v, n_ki = mixer_layer(
            hs, pos_s, state_shift[l], state_wkv[l], attend_s, cache_mem_k[l], cache_mem_v[l],
            norm_w[l], w_in[l], w_out[l], rw)
        wkv_s.append(n_wkv); shift_s.append(n_shift); k_s.append(n_k); v_s.append(n_v)
        kidx_s.append(n_ki)
    y_prompt = rmsnorm(hp, final_norm_w)
    y_sample = rmsnorm(hs, final_norm_w)
    new_wkv_prompt = jnp.stack(wkv_p)
    new_shift_prompt = jnp.stack(shift_p)
    new_k_prompt = jnp.stack(k_p)
    new_v_prompt = jnp.stack(v_p)
    new_kidx_prompt = jnp.stack(kidx_p)
    new_mem_k_prompt = jnp.stack(memk_p)
    new_mem_v_prompt = jnp.stack(memv_p)
    new_wkv_sample = jnp.stack(wkv_s)
    new_shift_sample = jnp.stack(shift_s)
    new_k_sample = jnp.stack(k_s)
    new_v_sample = jnp.stack(v_s)
    new_kidx_sample = jnp.stack(kidx_s)
    return (y_prompt, y_sample, new_wkv_prompt, new_shift_prompt, new_k_prompt, new_v_prompt,
            new_kidx_prompt, new_mem_k_prompt, new_mem_v_prompt, new_wkv_sample,
            new_shift_sample, new_k_sample, new_v_sample, new_kidx_sample)
```

```cpp
#include <hip/hip_runtime.h>
#include <cstdio>
#include <cstdint>

#ifndef MK_SPLIT
#define MK_SPLIT 0
#endif

namespace pg8 {
#define PG8_LAS __attribute__((address_space(3)))
typedef unsigned short bf16_t;
typedef short bf16x8 __attribute__((ext_vector_type(8)));
typedef float f32x4 __attribute__((ext_vector_type(4)));
typedef unsigned u32x4 __attribute__((ext_vector_type(4)));
constexpr int BM = 256, BK = 64, HALF = 128, HTB = HALF * BK * 2, STAGE_BYTES = 8 * HTB, NXCD = 8, WGM = 8;

__host__ __device__ __forceinline__ int lds_byte(int r, int c) { const int st = (r >> 4) * 2 + (c >> 5), rr = r & 15, cc = c & 31, ob = rr * 64 + cc * 2; return st * 1024 + (ob ^ (((ob >> 9) & 1) << 5)); }
__host__ __device__ __forceinline__ void stage_rc(int b, int& R, int& C) { const int st = b / 1024, sb = b % 1024, swz = sb ^ (((sb >> 9) & 1) << 5); R = (st >> 1) * 16 + swz / 64; C = (st & 1) * 32 + (swz % 64) / 2; }

struct Unit { int pm, pn, koff; };
struct Gemm { const bf16_t* A; const bf16_t* Bt; int M, N, K, ld; };

struct StaticOrder {
    int nM, nN, nwg, G, c;
    __host__ __device__ void init(int M, int N, int G_, int c_) { nM = M / BM; nN = N / BM; nwg = nM * nN; G = G_; c = c_; }
    __host__ __device__ bool next(int i, Unit& u) const {
        const long L = (long)i * G + c; if (L >= nwg) return false;
        int wgid = (int)L; { const int q = nwg / NXCD, r = nwg % NXCD, xcd = wgid % NXCD, off = wgid / NXCD; wgid = (xcd < r ? xcd * (q + 1) : r * (q + 1) + (xcd - r) * q) + off; }
        const int nig = WGM * nN, gid = wgid / nig, fm = gid * WGM, gsz = (nM - fm) < WGM ? (nM - fm) : WGM;
        u.pm = fm + ((wgid % nig) % gsz); u.pn = (wgid % nig) / gsz; u.koff = 0; return true;
    }
    __device__ __forceinline__ void a_ready(const Unit&) const {}
    __device__ __forceinline__ void done(const Unit&) const {}
};

struct ListOrder {
    int G, c, mode;
    __device__ __forceinline__ bool next(int i, Unit& u) const {
        const int L = i * G + c;
        if (mode == 0) { if (L >= 260) return false; const int q = L & 3, uu = L >> 2; if (uu < 33) { u.pm = 32; u.pn = uu; } else { u.pm = uu - 33; u.pn = 32; } u.koff = q * 512; return true; }
        if (mode == 1) { if (L >= 64) return false; const int q = L & 3, uu = L >> 2; u.pm = uu >> 2; u.pn = uu & 3; u.koff = q * 512; return true; }
        if (L >= 64) return false; u.pm = 32; u.pn = L >> 3; u.koff = (L & 7) * 256; return true;
    }
    __device__ __forceinline__ void a_ready(const Unit&) const {}
    __device__ __forceinline__ void done(const Unit&) const {}
};
template <class Epi, class Sched, bool ALIGN_EPI = false, bool SP2 = false>
__device__ __forceinline__ void gemm_phase(PG8_LAS unsigned char* lds, const Gemm g, const Sched& S, const Epi& E) {
    const int tid = threadIdx.x, wid = __builtin_amdgcn_readfirstlane(tid >> 6), lane = tid & 63, wr = wid >> 2, wc = wid & 3, fr = lane & 15, fq = lane >> 4;
    const int K = g.K, nt = K / BK;
    unsigned voffA[2], voffB[2];
    const int ld = g.ld;
#pragma unroll
    for (int i = 0; i < 2; ++i) { int R, C; stage_rc(tid * 16 + i * 8192, R, C); voffA[i] = (unsigned)(R * ld + C) * 2u; voffB[i] = (unsigned)(R * ld + C) * 2u; }
    const size_t kstep = (size_t)(BK * 2);
    const size_t hstep = (size_t)HALF * ld * 2;
    const size_t tstep = 2 * hstep;
    const unsigned ldsw = (unsigned)wid * 1024u;
    const int aoff = lds_byte(wr * 64 + fr, fq * 8), boff = lds_byte(wc * 32 + fr, fq * 8);
#define PG8_SA(b, h) (((b) * 2 + (h)) * HTB)
#define PG8_SB(b, h) ((4 + (b) * 2 + (h)) * HTB)
#define PG8_STAGE(bufoff, gbase, voff) do { _Pragma("unroll") for (int _i = 0; _i < 2; ++_i) \
        __builtin_amdgcn_global_load_lds((const unsigned*)((const char*)(gbase) + (voff)[_i]), (PG8_LAS unsigned*)(lds + (bufoff) + ldsw + _i * 8192), 16, 0, 0); } while (0)
#define PG8_LDA(dst, b, h) do { _Pragma("unroll") for (int m = 0; m < 4; ++m) _Pragma("unroll") for (int k = 0; k < 2; ++k) dst[m][k] = *(const PG8_LAS bf16x8*)(lds + PG8_SA(b, h) + aoff + m * 2048 + k * 1024); } while (0)
#define PG8_LDB(dst, b, h) do { _Pragma("unroll") for (int n = 0; n < 2; ++n) _Pragma("unroll") for (int k = 0; k < 2; ++k) dst[n][k] = *(const PG8_LAS bf16x8*)(lds + PG8_SB(b, h) + boff + n * 2048 + k * 1024); } while (0)
#define PG8_MMA(ai, bj, At, Bt) do { __builtin_amdgcn_s_setprio(1); _Pragma("unroll") for (int m = 0; m < 4; ++m) _Pragma("unroll") for (int n = 0; n < 2; ++n) _Pragma("unroll") for (int k = 0; k < 2; ++k) \
        acc[ai][bj][m][n] = __builtin_amdgcn_mfma_f32_16x16x32_bf16(Bt[n][k], At[m][k], acc[ai][bj][m][n], 0, 0, 0); __builtin_amdgcn_s_setprio(0); } while (0)
#define PG8_WAIT_V(n) asm volatile("s_waitcnt vmcnt(" #n ")" ::: "memory")
#define PG8_WAIT_L(n) asm volatile("s_waitcnt lgkmcnt(" #n ")" ::: "memory")
#define PG8_BAR __builtin_amdgcn_s_barrier()
#define PG8_SCHED __builtin_amdgcn_sched_barrier(0)
    Unit cur, nxt; int ui = 0;
    if (!S.next(0, cur)) return;
    f32x4 acc[2][2][4][2];
#pragma unroll
    for (int a = 0; a < 2; ++a)
#pragma unroll
        for (int b = 0; b < 2; ++b)
#pragma unroll
            for (int m = 0; m < 4; ++m)
#pragma unroll
                for (int n = 0; n < 2; ++n) acc[a][b][m][n] = (f32x4){0.f, 0.f, 0.f, 0.f};
    bf16x8 At[4][2], B0[2][2], B1[2][2];
    const char* cA = (const char*)g.A + (size_t)cur.pm * tstep + (size_t)cur.koff * 2; const char* cB = (const char*)g.Bt + (size_t)cur.pn * tstep + (size_t)cur.koff * 2;
    S.a_ready(cur);
    if constexpr (SP2) {
        PG8_STAGE(PG8_SB(0, 0), cB, voffB); PG8_STAGE(PG8_SB(0, 1), cB + hstep, voffB); PG8_STAGE(PG8_SA(0, 0), cA, voffA); PG8_STAGE(PG8_SA(0, 1), cA + hstep, voffA);
        if (wr == 1) PG8_BAR;
        PG8_WAIT_V(2); PG8_BAR;
        PG8_STAGE(PG8_SB(1, 0), cB + kstep, voffB); PG8_STAGE(PG8_SA(1, 0), cA + kstep, voffA); PG8_STAGE(PG8_SB(1, 1), cB + hstep + kstep, voffB);
        PG8_WAIT_V(6); PG8_BAR;
    } else {
        PG8_STAGE(PG8_SB(0, 0), cB, voffB); PG8_STAGE(PG8_SA(0, 0), cA, voffA); PG8_STAGE(PG8_SB(0, 1), cB + hstep, voffB); PG8_STAGE(PG8_SA(0, 1), cA + hstep, voffA);
        if (wr == 1) PG8_BAR;
        PG8_WAIT_V(4); PG8_BAR;
        PG8_STAGE(PG8_SB(1, 0), cB + kstep, voffB); PG8_STAGE(PG8_SA(1, 0), cA + kstep, voffA); PG8_STAGE(PG8_SB(1, 1), cB + hstep + kstep, voffB);
        PG8_WAIT_V(6); PG8_BAR;
    }
    for (;;) {
        const bool has_next = S.next(ui + 1, nxt);
        const char* nA = has_next ? (const char*)g.A + (size_t)nxt.pm * tstep + (size_t)nxt.koff * 2 : cA; const char* nB = has_next ? (const char*)g.Bt + (size_t)nxt.pn * tstep + (size_t)nxt.koff * 2 : cB;
        for (int t = 0; t < nt; t += 2) {
            const bool last = (t == nt - 2);
            const char* a1 = cA + (size_t)(t + 1) * kstep;
            const char* a2 = last ? nA : cA + (size_t)(t + 2) * kstep; const char* b2 = last ? nB : cB + (size_t)(t + 2) * kstep;
            const char* a3 = a2 + kstep; const char* b3 = b2 + kstep;
            if (last && has_next) S.a_ready(nxt);
            if constexpr (SP2) {
            PG8_LDB(B0, 0, 0); PG8_LDB(B1, 0, 1); PG8_SCHED; PG8_LDA(At, 0, 0); PG8_STAGE(PG8_SA(1, 1), a1 + hstep, voffA);
            PG8_WAIT_V(8); PG8_WAIT_L(0); PG8_BAR; PG8_MMA(0, 0, At, B0); PG8_MMA(0, 1, At, B1); PG8_BAR; PG8_SCHED;
            PG8_LDA(At, 0, 1); PG8_STAGE(PG8_SB(0, 0), b2, voffB); PG8_STAGE(PG8_SB(0, 1), b2 + hstep, voffB); PG8_STAGE(PG8_SA(0, 0), a2, voffA);
            PG8_WAIT_V(8); PG8_WAIT_L(0); PG8_BAR; PG8_MMA(1, 0, At, B0); PG8_MMA(1, 1, At, B1); PG8_BAR; PG8_SCHED;
            PG8_LDB(B0, 1, 0); PG8_LDB(B1, 1, 1); PG8_SCHED; PG8_LDA(At, 1, 0); PG8_STAGE(PG8_SA(0, 1), a2 + hstep, voffA);
            PG8_WAIT_V(8); PG8_WAIT_L(0); PG8_BAR; PG8_MMA(0, 0, At, B0); PG8_MMA(0, 1, At, B1); PG8_BAR; PG8_SCHED;
            PG8_LDA(At, 1, 1); PG8_STAGE(PG8_SB(1, 0), b3, voffB); PG8_STAGE(PG8_SB(1, 1), b3 + hstep, voffB); PG8_STAGE(PG8_SA(1, 0), a3, voffA);
            PG8_WAIT_V(8); PG8_WAIT_L(0); PG8_BAR; PG8_MMA(1, 0, At, B0); PG8_MMA(1, 1, At, B1); PG8_BAR; PG8_SCHED;
            } else {
            PG8_LDB(B0, 0, 0); PG8_SCHED; PG8_LDA(At, 0, 0); PG8_STAGE(PG8_SA(1, 1), a1 + hstep, voffA);
            PG8_WAIT_L(8); PG8_BAR; PG8_WAIT_L(0); PG8_MMA(0, 0, At, B0); PG8_BAR; PG8_SCHED;
            PG8_LDB(B1, 0, 1); PG8_STAGE(PG8_SB(0, 0), b2, voffB);
            PG8_BAR; PG8_WAIT_L(0); PG8_MMA(0, 1, At, B1); PG8_BAR;
            PG8_LDA(At, 0, 1); PG8_STAGE(PG8_SA(0, 0), a2, voffA);
            PG8_BAR; PG8_WAIT_L(0); PG8_MMA(1, 0, At, B0); PG8_BAR; PG8_SCHED;
            PG8_STAGE(PG8_SB(0, 1), b2 + hstep, voffB);
            PG8_WAIT_V(6); PG8_BAR; PG8_MMA(1, 1, At, B1); PG8_BAR;
            PG8_LDB(B0, 1, 0); PG8_SCHED; PG8_LDA(At, 1, 0); PG8_STAGE(PG8_SA(0, 1), a2 + hstep, voffA);
            PG8_WAIT_L(8); PG8_BAR; PG8_WAIT_L(0); PG8_MMA(0, 0, At, B0); PG8_BAR; PG8_SCHED;
            PG8_LDB(B1, 1, 1); PG8_STAGE(PG8_SB(1, 0), b3, voffB);
            PG8_BAR; PG8_WAIT_L(0); PG8_MMA(0, 1, At, B1); PG8_BAR;
            PG8_LDA(At, 1, 1); PG8_STAGE(PG8_SA(1, 0), a3, voffA);
            PG8_BAR; PG8_WAIT_L(0); PG8_MMA(1, 0, At, B0); PG8_BAR; PG8_SCHED;
            PG8_STAGE(PG8_SB(1, 1), b3 + hstep, voffB);
            PG8_WAIT_V(6); PG8_BAR; PG8_MMA(1, 1, At, B1); PG8_BAR;
            }
        }
        if constexpr (ALIGN_EPI) { if (wr == 0) PG8_BAR; }
        E(acc, cur, wr, wc, fr, fq); S.done(cur);
        if (!has_next) break;
#pragma unroll
        for (int a = 0; a < 2; ++a)
#pragma unroll
            for (int b = 0; b < 2; ++b)
#pragma unroll
                for (int m = 0; m < 4; ++m)
#pragma unroll
                    for (int n = 0; n < 2; ++n) acc[a][b][m][n] = (f32x4){0.f, 0.f, 0.f, 0.f};
        cur = nxt; cA = nA; cB = nB; ++ui;
        if constexpr (ALIGN_EPI) { if (wr == 1) PG8_BAR; }
    }
    PG8_WAIT_V(0);
    if constexpr (!ALIGN_EPI) { if (wr == 0) PG8_BAR; }
    PG8_BAR;
#undef PG8_SA
#undef PG8_SB
#undef PG8_STAGE
#undef PG8_LDA
#undef PG8_LDB
#undef PG8_MMA
#undef PG8_WAIT_V
#undef PG8_WAIT_L
#undef PG8_BAR
#undef PG8_SCHED
}
}

constexpr int NWAVES = 8, NTHR = 512;
constexpr int DM = 2048, NB = 4, SEQ = 2048, DB = 32, DT = 4, PAST = 8192, PAGE = 128, NPAGES = 64;
constexpr int NTOKP = NB * SEQ;
constexpr int NTOKS = DB * DT;
constexpr int NTOK = NTOKP + NTOKS;
constexpr int MPAD = 8448;
constexpr int INW = 8400, INWP = 8448;
constexpr int RW = 1024, RH = 16, RD = 64, SHW = 3200;
constexpr int C_R = 0, C_K = 1024, C_V = 2048, C_CW = 3072, C_CA = 3136, C_GR = 3200, C_Q = 4224, C_AK = 4736, C_AV = 5248, C_GA = 5760, C_QI = 6272, C_WI = 7296, C_KI = 7312, C_QM = 7376, C_GM = 7888;
constexpr int MEMT = 256;
constexpr int TOPK = 256;
constexpr int SCS_LD = 8256;
constexpr float RMS_EPS = 1e-6f, GN_EPS = 64e-5f;
constexpr float QSCALE = 0.08838834764831845f * 1.4426950408889634f;
constexpr size_t O_YP = 0, O_YS = 16777216, O_WKVP = 17039360, O_SHP = 17301504, O_KP = 17314304, O_VP = 21508608, O_KIP = 25702912, O_MKP = 26227200, O_MVP = 26751488,
                 O_WKVS = 27275776, O_SHS = 29372928, O_KS = 29475328, O_VS = 29540864, O_KIS = 29606400, O_END = 29614592;
enum { I_XP = 0, I_XS, I_SWKV, I_SSH, I_CK, I_CV, I_CKI, I_CMK, I_CMV, I_PT, I_MEM, I_NW, I_WIN, I_MU, I_W0, I_W2, I_A0, I_A2, I_KK, I_KA, I_RK, I_GNW, I_GNB, I_MNW, I_WMEM, I_WOUT, I_FNW, N_IN };

constexpr size_t MiB = 1u << 20;
constexpr size_t al1m(size_t x) { return (x + MiB - 1) / MiB * MiB; }
constexpr size_t WS_CTL = 0, CTL_ZERO_BYTES = 1 * MiB;
constexpr size_t WS_WINT = 1 * MiB;
constexpr size_t WS_WOUTT = WS_WINT + al1m((size_t)INWP * DM * 2);
constexpr size_t WS_WMEMT = WS_WOUTT + al1m((size_t)DM * DM * 2);
constexpr size_t WS_W2T = WS_WMEMT + al1m((size_t)1024 * DM * 2);
constexpr size_t WS_A2T = WS_W2T + al1m((size_t)1024 * 64 * 2);
constexpr size_t WS_ROPE128 = WS_A2T + al1m((size_t)1024 * 64 * 2);
constexpr size_t WS_ROPE64 = WS_ROPE128 + al1m((size_t)2052 * 64 * 8);
constexpr size_t WS_XN = WS_ROPE64 + al1m((size_t)2052 * 32 * 8);
constexpr size_t WS_XM = WS_XN + al1m((size_t)MPAD * DM * 2);
constexpr size_t WS_PROJ = WS_XM + al1m((size_t)1024 * DM * 2);
constexpr size_t WS_SCANIN = WS_PROJ + al1m((size_t)MPAD * INWP * 4);
constexpr size_t WS_SCAL = WS_SCANIN + al1m((size_t)NTOK * RH * 384 * 4);
constexpr size_t WS_Y = WS_SCAL + al1m((size_t)NTOK * RH * 4 * 4);
constexpr size_t WS_QB = WS_Y + al1m((size_t)NTOK * RW * 4);
constexpr size_t WS_KB = WS_QB + al1m((size_t)NTOK * 512 * 2);
constexpr size_t WS_VT = WS_KB + al1m((size_t)NTOK * 512 * 2);
constexpr size_t WS_QIB = WS_VT + al1m((size_t)NB * 4 * 128 * SEQ * 2);
constexpr size_t WS_KIB = WS_QIB + al1m((size_t)NTOK * 1024 * 2);
constexpr size_t WS_WIS = WS_KIB + al1m((size_t)NTOK * 64 * 2);
constexpr size_t WS_QMB = WS_WIS + al1m((size_t)NTOK * 16 * 4);
constexpr size_t WS_MKB = WS_QMB + al1m((size_t)NTOK * 512 * 2);
constexpr size_t WS_MVT = WS_MKB + al1m((size_t)1024 * 512 * 2);
constexpr size_t WS_SC = WS_MVT + al1m((size_t)1024 * 512 * 2);
constexpr size_t WS_SCS = WS_SC + al1m((size_t)NTOKP * SEQ * 4);
constexpr size_t WS_THR = WS_SCS + al1m((size_t)NTOKS * SCS_LD * 4);
constexpr size_t WS_IDX = WS_THR + al1m((size_t)NTOK * 8);
constexpr size_t WS_YMIX = WS_IDX + al1m((size_t)NTOKS * TOPK * 4);
constexpr size_t WS_END = WS_YMIX + al1m((size_t)MPAD * DM * 2);
constexpr int CW_BAR = 4096;

constexpr int RING_OFF = 0, RING_BYTES = 131072;
constexpr int LDSCTL_OFF = 143360, MISC_OFF = LDSCTL_OFF + 320;
constexpr int LDS_BYTES = 147456;

#define GAS __attribute__((address_space(1)))
#define LAS __attribute__((address_space(3)))
typedef unsigned short bf16;
typedef unsigned v4u __attribute__((ext_vector_type(4)));
typedef unsigned v2u __attribute__((ext_vector_type(2)));
typedef float f32x4 __attribute__((ext_vector_type(4)));
typedef float f32x2 __attribute__((ext_vector_type(2)));
typedef float f32x16 __attribute__((ext_vector_type(16)));
typedef short bf16x8 __attribute__((ext_vector_type(8)));
typedef short bf16x4 __attribute__((ext_vector_type(4)));
#define LDS_WAIT() asm volatile("s_waitcnt lgkmcnt(0)" ::: "memory")
#define VM_WAIT() asm volatile("s_waitcnt vmcnt(0)" ::: "memory")
__device__ __forceinline__ unsigned cvt_pk_bf16(float lo, float hi) { unsigned r; asm volatile("v_cvt_pk_bf16_f32 %0, %1, %2" : "=v"(r) : "v"(lo), "v"(hi)); return r; }
__device__ __forceinline__ float bf2f(unsigned short b) { return __uint_as_float(((unsigned)b) << 16); }
template <int CTRL> __device__ __forceinline__ float dpp(float x) { return __builtin_bit_cast(float, __builtin_amdgcn_mov_dpp(__builtin_bit_cast(int, x), CTRL, 0xf, 0xf, true)); }
__device__ __forceinline__ float row16_sum(float x) {
    x += dpp<0xB1>(x); x += dpp<0x4E>(x); x += dpp<0x141>(x); x += dpp<0x140>(x); return x;
}
__device__ __forceinline__ float wave_sum(float v) {
#pragma unroll
    for (int o = 1; o < 64; o <<= 1) v += __shfl_xor(v, o);
    return v;
}
__device__ __forceinline__ float xhalf_max(float x) { auto rr = __builtin_amdgcn_permlane32_swap(__float_as_uint(x), __float_as_uint(x), false, false); return fmaxf(__uint_as_float(rr[0]), __uint_as_float(rr[1])); }
__device__ __forceinline__ float xhalf_sum(float x) { auto rr = __builtin_amdgcn_permlane32_swap(__float_as_uint(x), __float_as_uint(x), false, false); return __uint_as_float(rr[0]) + __uint_as_float(rr[1]); }
__device__ __forceinline__ unsigned sort_key(float f) { const unsigned u = __float_as_uint(f); return (u & 0x80000000u) ? ~u : (u | 0x80000000u); }
__device__ __forceinline__ float silu(float g) { return g / (1.f + __expf(-g)); }

#define XB_TMO      128
#define XB_XCNT(j)  (256  + 64 * (j))
#define XB_XSUB(j)  (1280 + 64 * (j))
#define XB_XGEN(j)  (2304 + 64 * (j))
#define XB_TOP      3328
#define XB_TOPGEN   3392
#define XCD_BAR_WORDS 3456
#define XB_SPIN_CAP (1u << 18)
__device__ __forceinline__ unsigned xb_ld(unsigned* p)              { return __hip_atomic_load(p, __ATOMIC_RELAXED, __HIP_MEMORY_SCOPE_AGENT); }
__device__ __forceinline__ unsigned xb_add(unsigned* p, unsigned v) { return __hip_atomic_fetch_add(p, v, __ATOMIC_RELAXED, __HIP_MEMORY_SCOPE_AGENT); }
__device__ __forceinline__ unsigned xb_xcc_id() { return (unsigned)__builtin_amdgcn_s_getreg((3 << 11) | 20) & 0xFu; }
#define XB_SPIN(cond, bar) do { unsigned _sp = 0; while (cond) { __builtin_amdgcn_s_sleep(1); \
    if ((++_sp & 255u) == 0u) { if (xb_ld(&(bar)[XB_TMO])) break; if (_sp > XB_SPIN_CAP) { atomicAdd(&(bar)[XB_TMO], 1u); break; } } } } while (0)
struct XcdBarrier { unsigned* bar; unsigned x; volatile LAS unsigned* st; };
__device__ __forceinline__ XcdBarrier xcd_barrier_post(unsigned* bar, volatile LAS unsigned* st) {
    XcdBarrier b; b.bar = bar; b.x = xb_xcc_id(); b.st = st;
    if (threadIdx.x == 0) (void)xb_add(&bar[XB_XCNT(b.x)], 1u);
    return b;
}
__device__ __forceinline__ void xcd_barrier_complete(unsigned* bar, unsigned x, unsigned& nloc, unsigned& nx) {
    const unsigned G = gridDim.x * gridDim.y * gridDim.z;
    unsigned sum, cnt, mine, sp = 0u;
    for (;;) {
        sum = 0u; cnt = 0u; mine = 0u;
#pragma unroll
        for (unsigned j = 0; j < 16; ++j) { const unsigned c = xb_ld(&bar[XB_XCNT(j)]); sum += c; cnt += (c > 0u) ? 1u : 0u; mine = (j == x) ? c : mine; }
        if (sum == G) break;
        __builtin_amdgcn_s_sleep(1);
        if ((++sp & 255u) == 0u) { if (xb_ld(&bar[XB_TMO])) break; if (sp > XB_SPIN_CAP) { atomicAdd(&bar[XB_TMO], 1u); break; } }
    }
    nloc = mine > 0u ? mine : 1u; nx = cnt > 0u ? cnt : 1u;
}
__device__ __forceinline__ void xcd_barrier(const XcdBarrier& b) {
    asm volatile("s_waitcnt vmcnt(0)" ::: "memory");
    __syncthreads();
    if (threadIdx.x == 0) {
        unsigned* bar = b.bar;
        __builtin_amdgcn_s_waitcnt(0);
        unsigned nloc = b.st[0], nx = b.st[1];
        if (nloc == 0u) { xcd_barrier_complete(bar, b.x, nloc, nx); b.st[0] = nloc; b.st[1] = nx; }
        const unsigned old = xb_add(&bar[XB_XSUB(b.x)], 1u);
        const unsigned gen = old / nloc;
        if (old + 1u == (gen + 1u) * nloc) {
            __builtin_amdgcn_fence(__ATOMIC_RELEASE, "agent");
            asm volatile("s_waitcnt vmcnt(0)" ::: "memory");
            const unsigned og = xb_add(&bar[XB_TOP], 1u);
            const unsigned tg = og / nx;
            if (og + 1u == (tg + 1u) * nx) xb_add(&bar[XB_TOPGEN], 1u);
            else XB_SPIN(xb_ld(&bar[XB_TOPGEN]) == tg, bar);
            __builtin_amdgcn_fence(__ATOMIC_ACQUIRE, "agent");
            xb_add(&bar[XB_XGEN(b.x)], 1u);
            asm volatile("s_waitcnt vmcnt(0)" ::: "memory");
        } else {
            XB_SPIN(xb_ld(&bar[XB_XGEN(b.x)]) == gen, bar);
            __builtin_amdgcn_fence(__ATOMIC_ACQUIRE, "agent");
            asm volatile("s_waitcnt vmcnt(0)" ::: "memory");
        }
    }
    __syncthreads();
}

struct Frame {
    LAS unsigned char* lds;
    int tid, lane, wave, G, bid;
    const float* in[N_IN];
    float* out;
    unsigned char* ws;
};
#define WSP(T, off) ((T*)(F.ws + (off)))

__device__ __forceinline__ void p0_transpose_item(const float* W, int K, int N, int Npad, bf16* WT, LAS float* scr, int item, int lane) {
    const int nblk = Npad / 32, kb = item / nblk, nb = item % nblk, k0 = 64 * kb, n0 = 32 * nb;
    const int nn = n0 + (lane & 31);
    float tv[32];
#pragma unroll
    for (int i = 0; i < 32; ++i) { const int kk = 2 * i + (lane >> 5); tv[i] = (nn < N) ? W[(size_t)(k0 + kk) * N + nn] : 0.f; }
#pragma unroll
    for (int i = 0; i < 32; ++i) { const int kk = 2 * i + (lane >> 5); scr[kk * 33 + (lane & 31)] = tv[i]; }
    LDS_WAIT(); asm volatile("" ::: "memory");
    const int c = lane & 7;
#pragma unroll
    for (int j = 0; j < 4; ++j) { const int n = (lane >> 3) + 8 * j; const LAS float* s = scr + (8 * c) * 33 + n;
        v4u o; o.x = cvt_pk_bf16(s[0 * 33], s[1 * 33]); o.y = cvt_pk_bf16(s[2 * 33], s[3 * 33]); o.z = cvt_pk_bf16(s[4 * 33], s[5 * 33]); o.w = cvt_pk_bf16(s[6 * 33], s[7 * 33]);
        *(v4u*)(WT + (size_t)(n0 + n) * K + k0 + 8 * c) = o; }
    LDS_WAIT(); asm volatile("" ::: "memory");
}
__device__ __forceinline__ void rms_row_to_bf16(const float* xrow, const float* w, bf16* orow, int lane) {
    const f32x4* xr = (const f32x4*)xrow + lane; const f32x4* wr = (const f32x4*)w + lane;
    f32x4 v[8]; float s = 0.f;
#pragma unroll
    for (int j = 0; j < 8; ++j) { v[j] = xr[64 * j]; s += (v[j].x * v[j].x + v[j].y * v[j].y) + (v[j].z * v[j].z + v[j].w * v[j].w); }
    const float rs = 1.f / sqrtf(wave_sum(s) * (1.f / DM) + RMS_EPS);
    v2u* o8 = (v2u*)orow + lane;
#pragma unroll
    for (int j = 0; j < 8; ++j) { const f32x4 ww = wr[64 * j]; v2u o; o.x = cvt_pk_bf16(v[j].x * rs * ww.x, v[j].y * rs * ww.y); o.y = cvt_pk_bf16(v[j].z * rs * ww.z, v[j].w * rs * ww.w); o8[64 * j] = o; }
}
__device__ __forceinline__ void rope_cs(int pos, int i, double ratio, float& c, float& s) {
    double f = 1.0, b = ratio; int e = i;
    while (e) { if (e & 1) f *= b; b *= b; e >>= 1; }
    const double th = (double)pos * f;
    const double TWO_OVER_PI = 0.63661977236758134308, PIO2_HI = 1.57079632679489655800e+00, PIO2_LO = 6.12323399573676603587e-17;
    const double kq = rint(th * TWO_OVER_PI);
    double r = fma(-kq, PIO2_HI, th); r = fma(-kq, PIO2_LO, r);
    const int q = ((int)kq) & 3;
    const double z = r * r;
    const double sp = r + r * z * (-1.66666666666666324348e-01 + z * (8.33333333332248946124e-03 + z * (-1.98412698298579493134e-04 + z * (2.75573137070700676789e-06 + z * (-2.50507602534068634195e-08 + z * 1.58969099521155010221e-10)))));
    const double cp = 1.0 - 0.5 * z + z * z * (4.16666666666666019037e-02 + z * (-1.38888888888741095749e-03 + z * (2.48015872894767294178e-05 + z * (-2.75573143513906633035e-07 + z * (2.08757232129817482790e-09 + z * -1.13596475577881948265e-11)))));
    double cc, ss;
    if (q == 0) { cc = cp; ss = sp; } else if (q == 1) { cc = -sp; ss = cp; } else if (q == 2) { cc = -cp; ss = -sp; } else { cc = sp; ss = -cp; }
    c = (float)cc; s = (float)ss;
}
__device__ __forceinline__ void p0_prologue(Frame& F) {
    LAS float* scr = (LAS float*)(F.lds + RING_OFF + F.wave * 16384);
    const int gw = F.bid * NWAVES + F.wave, NGW = F.G * NWAVES;
    constexpr int T_IN = (DM / 64) * (INWP / 32), T_OUT = (DM / 64) * (DM / 32), T_MEM = (DM / 64) * (1024 / 32), T_L = 1024 / 32;
    constexpr int NITEMS = T_IN + T_OUT + T_MEM + 2 * T_L;
    for (int it = gw; it < NITEMS; it += NGW) {
        int r = it;
        if (r < T_IN) { p0_transpose_item(F.in[I_WIN], DM, INW, INWP, WSP(bf16, WS_WINT), scr, r, F.lane); continue; } r -= T_IN;
        if (r < T_OUT) { p0_transpose_item(F.in[I_WOUT], DM, DM, DM, WSP(bf16, WS_WOUTT), scr, r, F.lane); continue; } r -= T_OUT;
        if (r < T_MEM) { p0_transpose_item(F.in[I_WMEM], DM, 1024, 1024, WSP(bf16, WS_WMEMT), scr, r, F.lane); continue; } r -= T_MEM;
        if (r < T_L) { p0_transpose_item(F.in[I_W2], 64, 1024, 1024, WSP(bf16, WS_W2T), scr, r, F.lane); continue; } r -= T_L;
        p0_transpose_item(F.in[I_A2], 64, 1024, 1024, WSP(bf16, WS_A2T), scr, r, F.lane);
    }
    for (int m = gw; m < MPAD + 1024; m += NGW) {
        if (m < NTOKP) rms_row_to_bf16(F.in[I_XP] + (size_t)m * DM, F.in[I_NW], WSP(bf16, WS_XN) + (size_t)m * DM, F.lane);
        else if (m < NTOK) rms_row_to_bf16(F.in[I_XS] + (size_t)(m - NTOKP) * DM, F.in[I_NW], WSP(bf16, WS_XN) + (size_t)m * DM, F.lane);
        else if (m < MPAD) { v4u z = {0u, 0u, 0u, 0u}; v4u* o = (v4u*)(WSP(bf16, WS_XN) + (size_t)m * DM) + F.lane;
#pragma unroll
            for (int j = 0; j < 4; ++j) o[64 * j] = z; }
        else rms_row_to_bf16(F.in[I_MEM] + (size_t)(m - MPAD) * DM, F.in[I_MNW], WSP(bf16, WS_XM) + (size_t)(m - MPAD) * DM, F.lane);
    }
    const int gt = F.bid * NTHR + F.tid, NGT = F.G * NTHR;
    for (int e = gt; e < 2052 * 96; e += NGT) {
        const int p = e / 96, i = e % 96; const int pos = p < 2048 ? p : PAST + (p - 2048);
        float c, s;
        if (i < 64) { rope_cs(pos, i, 0.8659643233600653, c, s); WSP(f32x2, WS_ROPE128)[p * 64 + i] = (f32x2){c, s}; }
        else { rope_cs(pos, i - 64, 0.7498942093324559, c, s); WSP(f32x2, WS_ROPE64)[p * 32 + (i - 64)] = (f32x2){c, s}; }
    }
}

struct EpiProj {
    float* C;
    __device__ __forceinline__ void operator()(const f32x4 (&acc)[2][2][4][2], const pg8::Unit& u, int wr, int wc, int fr, int fq) const {
        const int row0 = u.pm * 256 + wr * 64 + fr, col0 = u.pn * 256 + wc * 32 + 4 * fq;
#pragma unroll
        for (int ai = 0; ai < 2; ++ai)
#pragma unroll
            for (int m = 0; m < 4; ++m) { float* rowp = C + (size_t)(row0 + ai * 128 + m * 16) * INWP + col0;
#pragma unroll
                for (int bj = 0; bj < 2; ++bj)
#pragma unroll
                    for (int n = 0; n < 2; ++n) *(f32x4*)(rowp + bj * 128 + n * 16) = acc[ai][bj][m][n]; }
    }
};
struct EpiMem {
    float* out;
    __device__ __forceinline__ void operator()(const f32x4 (&acc)[2][2][4][2], const pg8::Unit& u, int wr, int wc, int fr, int fq) const {
        const int row0 = u.pm * 256 + wr * 64 + fr; int colt = u.pn * 256;
        float* base = out + (colt < 512 ? O_MKP : O_MVP); if (colt >= 512) colt -= 512;
        const int col0 = colt + wc * 32 + 4 * fq;
#pragma unroll
        for (int ai = 0; ai < 2; ++ai)
#pragma unroll
            for (int m = 0; m < 4; ++m) { float* rowp = base + (size_t)(row0 + ai * 128 + m * 16) * 512 + col0;
#pragma unroll
                for (int bj = 0; bj < 2; ++bj)
#pragma unroll
                    for (int n = 0; n < 2; ++n) *(f32x4*)(rowp + bj * 128 + n * 16) = acc[ai][bj][m][n]; }
    }
};
__device__ __forceinline__ void atomic_add4(float* p, const f32x4& v) { unsafeAtomicAdd(p, v.x); unsafeAtomicAdd(p + 1, v.y); unsafeAtomicAdd(p + 2, v.z); unsafeAtomicAdd(p + 3, v.w); }
struct EpiProjAtomic {
    float* C;
    __device__ __forceinline__ void operator()(const f32x4 (&acc)[2][2][4][2], const pg8::Unit& u, int wr, int wc, int fr, int fq) const {
        const int row0 = u.pm * 256 + wr * 64 + fr, col0 = u.pn * 256 + wc * 32 + 4 * fq;
#pragma unroll
        for (int ai = 0; ai < 2; ++ai)
#pragma unroll
            for (int m = 0; m < 4; ++m) { const int row = row0 + ai * 128 + m * 16; float* rowp = C + (size_t)row * INWP + col0;
                if (row < NTOK) {
#pragma unroll
                    for (int bj = 0; bj < 2; ++bj)
#pragma unroll
                        for (int n = 0; n < 2; ++n) atomic_add4(rowp + bj * 128 + n * 16, acc[ai][bj][m][n]); } }
    }
};
struct EpiMemAtomic {
    float* out;
    __device__ __forceinline__ void operator()(const f32x4 (&acc)[2][2][4][2], const pg8::Unit& u, int wr, int wc, int fr, int fq) const {
        const int row0 = u.pm * 256 + wr * 64 + fr; int colt = u.pn * 256;
        float* base = out + (colt < 512 ? O_MKP : O_MVP); if (colt >= 512) colt -= 512;
        const int col0 = colt + wc * 32 + 4 * fq;
#pragma unroll
        for (int ai = 0; ai < 2; ++ai)
#pragma unroll
            for (int m = 0; m < 4; ++m) { float* rowp = base + (size_t)(row0 + ai * 128 + m * 16) * 512 + col0;
#pragma unroll
                for (int bj = 0; bj < 2; ++bj)
#pragma unroll
                    for (int n = 0; n < 2; ++n) atomic_add4(rowp + bj * 128 + n * 16, acc[ai][bj][m][n]); }
    }
};
struct EpiOutAtomic {
    float* out;
    __device__ __forceinline__ void operator()(const f32x4 (&acc)[2][2][4][2], const pg8::Unit& u, int wr, int wc, int fr, int fq) const {
        const int row0 = u.pm * 256 + wr * 64 + fr, col0 = u.pn * 256 + wc * 32 + 4 * fq;
#pragma unroll
        for (int ai = 0; ai < 2; ++ai)
#pragma unroll
            for (int m = 0; m < 4; ++m) { const int row = row0 + ai * 128 + m * 16;
                if (row >= NTOKP && row < NTOK) { float* orow = out + O_YS + (size_t)(row - NTOKP) * DM + col0;
#pragma unroll
                    for (int bj = 0; bj < 2; ++bj)
#pragma unroll
                        for (int n = 0; n < 2; ++n) atomic_add4(orow + bj * 128 + n * 16, acc[ai][bj][m][n]); } }
    }
};
struct EpiOut {
    const float* xp; const float* xs; float* out;
    __device__ __forceinline__ void operator()(const f32x4 (&acc)[2][2][4][2], const pg8::Unit& u, int wr, int wc, int fr, int fq) const {
        const int row0 = u.pm * 256 + wr * 64 + fr, col0 = u.pn * 256 + wc * 32 + 4 * fq;
#pragma unroll
        for (int ai = 0; ai < 2; ++ai)
#pragma unroll
            for (int m = 0; m < 4; ++m) { const int row = row0 + ai * 128 + m * 16;
                if (row < NTOK) {
                    const float* xr = (row < NTOKP ? xp + (size_t)row * DM : xs + (size_t)(row - NTOKP) * DM) + col0;
                    float* orow = out + (row < NTOKP ? O_YP + (size_t)row * DM : O_YS + (size_t)(row - NTOKP) * DM) + col0;
#pragma unroll
                    for (int bj = 0; bj < 2; ++bj)
#pragma unroll
                        for (int n = 0; n < 2; ++n) *(f32x4*)(orow + bj * 128 + n * 16) = acc[ai][bj][m][n] + *(const f32x4*)(xr + bj * 128 + n * 16); } }
    }
};

__device__ __forceinline__ float prev_val(const Frame& F, const float* P, int row, int col) {
    if (row < NTOKP) { return (row & (SEQ - 1)) == 0 ? 0.f : P[(size_t)(row - 1) * INWP + col]; }
    const int s = row - NTOKP; return (s & 3) == 0 ? F.in[I_SSH][(size_t)(s >> 2) * SHW + col] : P[(size_t)(row - 1) * INWP + col];
}
__device__ __forceinline__ size_t scan_seq_off(int row, int h) {
    if (row < NTOKP) { const int b = row >> 11, t = row & 2047; return ((size_t)(b * RH + h) * SEQ + t); }
    const int s = row - NTOKP, db = s >> 2, t = s & 3; return (size_t)NB * RH * SEQ + ((size_t)(db * RH + h) * DT + t);
}
__device__ __forceinline__ size_t kf_off(int NT, int h, int s, int dim) { return ((size_t)((h * NT + (s >> 5)) * 8 + (dim >> 4))) * 512 + (((dim >> 3) & 1) * 32 + (s & 31)) * 8 + (dim & 7); }
__device__ __forceinline__ size_t kif_off(int s, int dim) { return ((size_t)((s >> 5) * 4 + (dim >> 4))) * 512 + (((dim >> 3) & 1) * 32 + (s & 31)) * 8 + (dim & 7); }
__device__ __forceinline__ f32x4 ld4(const float* p) { return *(const f32x4*)p; }
__device__ __forceinline__ f32x4 prev4(const Frame& F, const float* P, int row, int col) {
    if (row < NTOKP) { if ((row & (SEQ - 1)) == 0) return (f32x4){0.f, 0.f, 0.f, 0.f}; return ld4(P + (size_t)(row - 1) * INWP + col); }
    const int s = row - NTOKP; if ((s & 3) == 0) return ld4(F.in[I_SSH] + (size_t)(s >> 2) * SHW + col); return ld4(P + (size_t)(row - 1) * INWP + col);
}
__device__ __forceinline__ void p2_rwkv_witem(Frame& F, int item) {
    const float* P = WSP(float, WS_PROJ);
    const int tile = item >> 3, hp = item & 7, row0 = tile * 16;
    const int lane = F.lane, tk = lane & 15, kq = lane >> 4, row = row0 + tk;
    const float* mu = F.in[I_MU];
    bf16x8 bw[2], ba[2];
#pragma unroll
    for (int ks = 0; ks < 2; ++ks) {
        const int c0 = 32 * ks + 8 * kq;
        float xw[8], xa[8];
#pragma unroll
        for (int hf = 0; hf < 2; ++hf) {
            const f32x4 cw = ld4(P + (size_t)row * INWP + C_CW + c0 + 4 * hf), pw = prev4(F, P, row, C_CW + c0 + 4 * hf), mw = ld4(mu + C_CW + c0 + 4 * hf);
            const f32x4 ca = ld4(P + (size_t)row * INWP + C_CA + c0 + 4 * hf), pa = prev4(F, P, row, C_CA + c0 + 4 * hf), ma = ld4(mu + C_CA + c0 + 4 * hf);
#pragma unroll
            for (int e = 0; e < 4; ++e) { const float x = cw[e] + (pw[e] - cw[e]) * mw[e];
                const float t = __builtin_amdgcn_exp2f(x * 2.8853900817779268f); xw[4 * hf + e] = 1.f - 2.f * __builtin_amdgcn_rcpf(t + 1.f);
                xa[4 * hf + e] = ca[e] + (pa[e] - ca[e]) * ma[e]; }
        }
        v4u uw, ua; uw.x = cvt_pk_bf16(xw[0], xw[1]); uw.y = cvt_pk_bf16(xw[2], xw[3]); uw.z = cvt_pk_bf16(xw[4], xw[5]); uw.w = cvt_pk_bf16(xw[6], xw[7]);
        ua.x = cvt_pk_bf16(xa[0], xa[1]); ua.y = cvt_pk_bf16(xa[2], xa[3]); ua.z = cvt_pk_bf16(xa[4], xa[5]); ua.w = cvt_pk_bf16(xa[6], xa[7]);
        bw[ks] = __builtin_bit_cast(bf16x8, uw); ba[ks] = __builtin_bit_cast(bf16x8, ua);
    }
    const bf16* W2T = WSP(bf16, WS_W2T); const bf16* A2T = WSP(bf16, WS_A2T);
    float* SI = WSP(float, WS_SCANIN); float* SL = WSP(float, WS_SCAL);
    const float* pr = P + (size_t)row * INWP;
    for (int hh = 0; hh < 2; ++hh) {
        const int h = hp * 2 + hh;
        f32x4 wl[4], al[4];
#pragma unroll
        for (int n = 0; n < 4; ++n) {
            const int chA = h * 64 + n * 16 + tk;
            wl[n] = (f32x4){0.f, 0.f, 0.f, 0.f}; al[n] = (f32x4){0.f, 0.f, 0.f, 0.f};
#pragma unroll
            for (int ks = 0; ks < 2; ++ks) {
                const bf16x8 aw = *(const bf16x8*)(W2T + (size_t)chA * 64 + 32 * ks + 8 * kq);
                const bf16x8 aa = *(const bf16x8*)(A2T + (size_t)chA * 64 + 32 * ks + 8 * kq);
                wl[n] = __builtin_amdgcn_mfma_f32_16x16x32_bf16(aw, bw[ks], wl[n], 0, 0, 0);
                al[n] = __builtin_amdgcn_mfma_f32_16x16x32_bf16(aa, ba[ks], al[n], 0, 0, 0);
            }
        }
        f32x4 Lxk[4], Lqk[4], Lxr[4], Lqr[4], Lxv[4], Lqv[4];
#pragma unroll
        for (int n = 0; n < 4; ++n) { const int ch = h * 64 + n * 16 + 4 * kq;
            Lxk[n] = ld4(pr + C_K + ch); Lqk[n] = prev4(F, P, row, C_K + ch); Lxr[n] = ld4(pr + C_R + ch); Lqr[n] = prev4(F, P, row, C_R + ch); Lxv[n] = ld4(pr + C_V + ch); Lqv[n] = prev4(F, P, row, C_V + ch); }
        __builtin_amdgcn_sched_barrier(0);
        f32x4 k4[4];
        float ss = 0.f;
#pragma unroll
        for (int n = 0; n < 4; ++n) {
            const int ch = h * 64 + n * 16 + 4 * kq;
            const f32x4 xk = Lxk[n], qk = Lqk[n], mk = ld4(mu + C_K + ch), kkw = ld4(F.in[I_KK] + ch);
#pragma unroll
            for (int j = 0; j < 4; ++j) { k4[n][j] = xk[j] + (qk[j] - xk[j]) * mk[j]; const float t = k4[n][j] * kkw[j]; ss += t * t; }
        }
        ss += __shfl_xor(ss, 16); ss += __shfl_xor(ss, 32);
        const float inv = 1.f / fmaxf(sqrtf(ss), 1e-12f);
        float s_nbr = 0.f, s_kr = 0.f, s_bon = 0.f;
        const size_t so = scan_seq_off(row, h);
        float* dst = SI + so * 384 + 4 * kq;
#pragma unroll
        for (int n = 0; n < 4; ++n) {
            const int ch = h * 64 + n * 16 + 4 * kq;
            const f32x4 xr = Lxr[n], xv = Lxv[n], qr = Lqr[n], qv = Lqv[n];
            const f32x4 mr = ld4(mu + C_R + ch), mv = ld4(mu + C_V + ch);
            const f32x4 w0 = ld4(F.in[I_W0] + ch), a0 = ld4(F.in[I_A0] + ch), kkw = ld4(F.in[I_KK] + ch), ka = ld4(F.in[I_KA] + ch), rk = ld4(F.in[I_RK] + ch);
            f32x4 kk, kp, nb, wr, wv, vv;
#pragma unroll
            for (int j = 0; j < 4; ++j) {
                const float r = xr[j] + (qr[j] - xr[j]) * mr[j]; vv[j] = xv[j] + (qv[j] - xv[j]) * mv[j];
                const float wlin = w0[j] + wl[n][j];
                const float sg = __builtin_amdgcn_rcpf(1.f + __builtin_amdgcn_exp2f(-wlin * 1.4426950408889634f));
                wv[j] = __builtin_amdgcn_exp2f(-0.8750338f * sg);
                const float alin = a0[j] + al[n][j];
                const float a = __builtin_amdgcn_rcpf(1.f + __builtin_amdgcn_exp2f(-alin * 1.4426950408889634f));
                kk[j] = k4[n][j] * kkw[j] * inv;
                kp[j] = k4[n][j] * (1.f + (a - 1.f) * ka[j]);
                nb[j] = -kk[j] * a;
                wr[j] = wv[j] * r;
                s_nbr += nb[j] * r; s_kr += kp[j] * r; s_bon += r * kp[j] * rk[j];
            }
            *(f32x4*)(dst + 0 * 64 + 16 * n) = kk; *(f32x4*)(dst + 1 * 64 + 16 * n) = wv; *(f32x4*)(dst + 2 * 64 + 16 * n) = nb;
            *(f32x4*)(dst + 3 * 64 + 16 * n) = kp; *(f32x4*)(dst + 4 * 64 + 16 * n) = wr; *(f32x4*)(dst + 5 * 64 + 16 * n) = vv;
        }
        s_nbr += __shfl_xor(s_nbr, 16); s_nbr += __shfl_xor(s_nbr, 32);
        s_kr += __shfl_xor(s_kr, 16); s_kr += __shfl_xor(s_kr, 32);
        s_bon += __shfl_xor(s_bon, 16); s_bon += __shfl_xor(s_bon, 32);
        if (kq == 0) *(f32x4*)(SL + so * 4) = (f32x4){s_nbr, s_kr, s_bon, 0.f};
    }
}
__device__ __forceinline__ void p2_row_item(Frame& F, int row) {
    const float* P = WSP(float, WS_PROJ) + (size_t)row * INWP;
    const int lane = F.lane;
    const bool prm = row < NTOKP; const int srow = row - NTOKP;
    const int p = prm ? (row & 2047) : 2048 + (srow & 3);
    const f32x2* T128 = WSP(f32x2, WS_ROPE128) + p * 64; const f32x2* T64 = WSP(f32x2, WS_ROPE64) + p * 32;
    bf16* QB = WSP(bf16, WS_QB) + (size_t)row * 512; bf16* KF = WSP(bf16, WS_KB) + (size_t)(row >> 11) * SEQ * 512; const int sq = row & 2047;
    float* ko = F.out + (prm ? O_KP + (size_t)row * 512 : O_KS + (size_t)srow * 512);
    float* vo = F.out + (prm ? O_VP + (size_t)row * 512 : O_VS + (size_t)srow * 512);
    const f32x2 cs = T128[lane];
    float Lq1[4], Lq2[4], Lk1[4], Lk2[4];
#pragma unroll
    for (int h = 0; h < 4; ++h) { Lq1[h] = P[C_Q + h * 128 + lane]; Lq2[h] = P[C_Q + h * 128 + 64 + lane]; Lk1[h] = P[C_AK + h * 128 + lane]; Lk2[h] = P[C_AK + h * 128 + 64 + lane]; }
    float Li1[8], Li2[8]; f32x2 Lc[8];
#pragma unroll
    for (int j = 0; j < 8; ++j) { const int pi = lane + 64 * j, hd = pi >> 5, i = pi & 31; Li1[j] = P[C_QI + hd * 64 + i]; Li2[j] = P[C_QI + hd * 64 + 32 + i]; Lc[j] = T64[i]; }
    const f32x4 Lv0 = *(const f32x4*)(P + C_AV + 4 * lane), Lv1 = *(const f32x4*)(P + C_AV + 256 + 4 * lane);
    const f32x4 Lm0 = *(const f32x4*)(P + C_QM + 8 * lane), Lm1 = *(const f32x4*)(P + C_QM + 8 * lane + 4);
    __builtin_amdgcn_sched_barrier(0);
#pragma unroll
    for (int h = 0; h < 4; ++h) {
        { const float x1 = Lq1[h], x2 = Lq2[h];
          const float o1 = (x1 * cs.x - x2 * cs.y) * QSCALE, o2 = (x2 * cs.x + x1 * cs.y) * QSCALE;
          QB[h * 128 + lane] = (bf16)(cvt_pk_bf16(o1, 0.f) & 0xffffu); QB[h * 128 + 64 + lane] = (bf16)(cvt_pk_bf16(o2, 0.f) & 0xffffu); }
        { const float x1 = Lk1[h], x2 = Lk2[h];
          const float o1 = x1 * cs.x - x2 * cs.y, o2 = x2 * cs.x + x1 * cs.y;
          ko[h * 128 + lane] = o1; ko[h * 128 + 64 + lane] = o2;
          if (prm) { KF[kf_off(64, h, sq, lane)] = (bf16)(cvt_pk_bf16(o1, 0.f) & 0xffffu); KF[kf_off(64, h, sq, 64 + lane)] = (bf16)(cvt_pk_bf16(o2, 0.f) & 0xffffu); } }
    }
    {
        f32x4* d = (f32x4*)vo;
        d[lane] = Lv0; d[64 + lane] = Lv1;
    }
    {
        bf16* QIB = WSP(bf16, WS_QIB) + (size_t)row * 1024;
#pragma unroll
        for (int j = 0; j < 8; ++j) { const int pi = lane + 64 * j, hd = pi >> 5, i = pi & 31; const f32x2 c2 = Lc[j];
            const float x1 = Li1[j], x2 = Li2[j];
            QIB[hd * 64 + i] = (bf16)(cvt_pk_bf16(x1 * c2.x - x2 * c2.y, 0.f) & 0xffffu); QIB[hd * 64 + 32 + i] = (bf16)(cvt_pk_bf16(x2 * c2.x + x1 * c2.y, 0.f) & 0xffffu); }
    }
    if (lane < 32) {
        const f32x2 c2 = T64[lane]; const float x1 = P[C_KI + lane], x2 = P[C_KI + 32 + lane];
        const float o1 = x1 * c2.x - x2 * c2.y, o2 = x2 * c2.x + x1 * c2.y;
        float* kio = F.out + (prm ? O_KIP + (size_t)row * 64 : O_KIS + (size_t)srow * 64);
        kio[lane] = o1; kio[32 + lane] = o2;
        bf16* KIB = WSP(bf16, WS_KIB) + (size_t)row * 64;
        KIB[lane] = (bf16)(cvt_pk_bf16(o1, 0.f) & 0xffffu); KIB[32 + lane] = (bf16)(cvt_pk_bf16(o2, 0.f) & 0xffffu);
        if (prm) { bf16* KIF = WSP(bf16, WS_SC) + (size_t)(row >> 11) * SEQ * 64; KIF[kif_off(sq, lane)] = (bf16)(cvt_pk_bf16(o1, 0.f) & 0xffffu); KIF[kif_off(sq, 32 + lane)] = (bf16)(cvt_pk_bf16(o2, 0.f) & 0xffffu); }
    }
    if (lane < 16) WSP(float, WS_WIS)[(size_t)row * 16 + lane] = P[C_WI + lane] * (1.f / 32.f);
    {
        bf16* QMB = WSP(bf16, WS_QMB) + (size_t)row * 512;
        const f32x4 a = Lm0, b = Lm1;
        v4u o; o.x = cvt_pk_bf16(a.x * QSCALE, a.y * QSCALE); o.y = cvt_pk_bf16(a.z * QSCALE, a.w * QSCALE); o.z = cvt_pk_bf16(b.x * QSCALE, b.y * QSCALE); o.w = cvt_pk_bf16(b.z * QSCALE, b.w * QSCALE);
        *(v4u*)(QMB + 8 * lane) = o;
    }
    if (prm ? ((row & 2047) == 2047) : ((srow & 3) == 3)) {
        float* so = F.out + (prm ? O_SHP + (size_t)(row >> 11) * SHW : O_SHS + (size_t)(srow >> 2) * SHW);
        for (int c = lane; c < SHW; c += 64) so[c] = P[c];
    }
}
__device__ __forceinline__ void p2_vt_item(Frame& F, const float* src, size_t ld_src, bf16* dstb, int NT, int ts) {
    LAS bf16* tile = (LAS bf16*)(F.lds + RING_OFF);
    { f32x4 tv[16];
#pragma unroll
      for (int i = 0; i < 16; ++i) { const int e = F.tid + i * NTHR, tok = e >> 7, c4 = (e & 127) * 4; tv[i] = *(const f32x4*)(src + (size_t)tok * ld_src + c4); }
#pragma unroll
      for (int i = 0; i < 16; ++i) { const int e = F.tid + i * NTHR, tok = e >> 7, c4 = (e & 127) * 4;
        v2u o; o.x = cvt_pk_bf16(tv[i].x, tv[i].y); o.y = cvt_pk_bf16(tv[i].z, tv[i].w); *(LAS v2u*)(tile + tok * 520 + c4) = o; } }
    __syncthreads();
    const int rsub = F.lane >> 3, chunk = F.lane & 7;
    for (int it = 0; it < 8; ++it) { const int hd = (it * 8 + F.wave) * 8 + rsub, h = hd >> 7, d = hd & 127;
        unsigned short e[8];
#pragma unroll
        for (int k = 0; k < 8; ++k) e[k] = tile[(chunk * 8 + k) * 520 + hd];
        const int kt = ts * 2 + (chunk >> 2), s2 = (chunk >> 1) & 1, g = chunk & 1;
        bf16* p = dstb + ((size_t)((h * NT + kt) * 8 + (d >> 5) * 2 + s2)) * 512 + (d & 31) * 8 + g * 4;
        v2u lo, hi; lo.x = e[0] | ((unsigned)e[1] << 16); lo.y = e[2] | ((unsigned)e[3] << 16); hi.x = e[4] | ((unsigned)e[5] << 16); hi.y = e[6] | ((unsigned)e[7] << 16);
        *(v2u*)p = lo; *(v2u*)(p + 32 * 8) = hi; }
    __syncthreads();
}
#ifndef PROBE_REPEAT
#define PROBE_REPEAT -1
#endif
__device__ __forceinline__ void p2_phase(Frame& F) {
    const int gw = F.bid * NWAVES + F.wave, NGW = F.G * NWAVES;
    for (int rep = 0; rep < (PROBE_REPEAT == 20 ? 2 : 1); ++rep)
    for (int it = gw; it < (NTOK / 16) * 8; it += NGW) p2_rwkv_witem(F, it);
    for (int rep = 0; rep < (PROBE_REPEAT == 21 ? 2 : 1); ++rep)
    for (int it = F.bid; it < 128 + 16; it += F.G) {
        if (it < 128) { const int b = it >> 5, ts = it & 31;
            p2_vt_item(F, WSP(float, WS_PROJ) + (size_t)(b * SEQ + ts * 64) * INWP + C_AV, INWP, WSP(bf16, WS_VT) + (size_t)b * 512 * SEQ, 64, ts); }
        else { const int j = it - 128, b = j >> 2, ts = j & 3;
            p2_vt_item(F, F.out + O_MVP + (size_t)(b * MEMT + ts * 64) * 512, 512, WSP(bf16, WS_MVT) + (size_t)b * 512 * MEMT, 8, ts); }
    }
    for (int rep = 0; rep < (PROBE_REPEAT == 22 ? 2 : 1); ++rep)
    for (int row = NGW - 1 - gw; row < NTOK; row += NGW) p2_row_item(F, row);
    const int gt = F.bid * NTHR + F.tid, NGT = F.G * NTHR;
    for (int e = gt; e < 1024 * 512 / 4; e += NGT) { const f32x4 v = *(const f32x4*)(F.out + O_MKP + (size_t)e * 4); v2u o; o.x = cvt_pk_bf16(v.x, v.y); o.y = cvt_pk_bf16(v.z, v.w);
        const int rowm = e >> 7, col = (e & 127) * 4, bm = rowm >> 8, m = rowm & 255; *(v2u*)(WSP(bf16, WS_MKB) + (size_t)bm * MEMT * 512 + kf_off(8, col >> 7, m, col & 127)) = o; }
}

constexpr int TC = 32, SBUF_FLOATS = TC * 384;
#define SCAN_STAGE_LOAD(SIN, SCALP) do { \
    _Pragma("unroll") for (int i = 0; i < 10; ++i) { const int e = lt + 256 * i, st = e / 80, r = e % 80; rv[i] = *(const f32x4*)((SIN) + (size_t)st * 384 + r * 4); } \
    _Pragma("unroll") for (int i = 0; i < 2; ++i) { const int e = lt + 256 * i, st = e >> 4, row = e & 15; const float v_ = (SIN)[(size_t)st * 384 + 320 + rg * 16 + row]; const f32x2 sc_ = *(const f32x2*)((SCALP) + (size_t)st * 4); \
        rt[i].x = v_; rt[i].y = sc_.x; rt[i].z = sc_.y; rt[i].w = 0.f; } } while (0)
#define SCAN_STAGE_WRITE(BUF) do { \
    _Pragma("unroll") for (int i = 0; i < 10; ++i) { const int e = lt + 256 * i, st = e / 80, r = e % 80; *(LAS f32x4*)((BUF) + st * 384 + r * 4) = rv[i]; } \
    _Pragma("unroll") for (int i = 0; i < 2; ++i) { const int e = lt + 256 * i, st = e >> 4, row = e & 15; *(LAS f32x4*)((BUF) + st * 384 + 320 + row * 4) = rt[i]; } } while (0)
#define SCAN_STEP(KK, W4, NB, KP, WR, TB, YOUT) do { \
    f32x2 _a = s01 * (f32x2){KK.x, KK.y}; _a = __builtin_elementwise_fma(s23, (f32x2){KK.z, KK.w}, _a); \
    f32x2 _b = s01 * (f32x2){WR.x, WR.y}; _b = __builtin_elementwise_fma(s23, (f32x2){WR.z, WR.w}, _b); \
    float _p1 = _a.x + _a.y, _p2 = _b.x + _b.y; \
    _p1 += dpp<0xB1>(_p1); _p2 += dpp<0xB1>(_p2); _p1 += dpp<0x4E>(_p1); _p2 += dpp<0x4E>(_p2); _p1 += dpp<0x141>(_p1); _p2 += dpp<0x141>(_p2); _p1 += dpp<0x140>(_p1); _p2 += dpp<0x140>(_p2); \
    YOUT = __builtin_fmaf(TB.x, TB.z, __builtin_fmaf(_p1, TB.y, _p2)); \
    const f32x2 _pp = (f32x2){_p1, _p1}, _vv = (f32x2){TB.x, TB.x}; \
    f32x2 _t01 = _vv * (f32x2){KP.x, KP.y}; _t01 = __builtin_elementwise_fma(_pp, (f32x2){NB.x, NB.y}, _t01); s01 = __builtin_elementwise_fma(s01, (f32x2){W4.x, W4.y}, _t01); \
    f32x2 _t23 = _vv * (f32x2){KP.z, KP.w}; _t23 = __builtin_elementwise_fma(_pp, (f32x2){NB.z, NB.w}, _t23); s23 = __builtin_elementwise_fma(s23, (f32x2){W4.z, W4.w}, _t23); \
} while (0)
__device__ __forceinline__ void scan_prompt_item(Frame& F, const float* sin, const float* scal, float* s_out, float* y0, int rg) {
    LAS float* bufs = (LAS float*)(F.lds + RING_OFF);
    constexpr int nchunks = SEQ / TC;
    const bool scanner = F.wave < 4;
    const int ri = F.lane >> 4, kq = F.lane & 15;
    const int lrow = (F.wave & 3) * 4 + ri, vrow = rg * 16 + lrow;
    f32x2 s01 = (f32x2){0.f, 0.f}, s23 = (f32x2){0.f, 0.f};
#define SCAN_BAR() do { asm volatile("s_waitcnt lgkmcnt(0)" ::: "memory"); __builtin_amdgcn_s_barrier(); asm volatile("" ::: "memory"); } while (0)
    if (!scanner) {
        f32x4 rv[10], rt[2]; const int lt = F.tid - 256;
        SCAN_STAGE_LOAD(sin, scal); SCAN_STAGE_WRITE(bufs); SCAN_STAGE_LOAD(sin + (size_t)TC * 384, scal + (size_t)TC * 4);
        SCAN_BAR();
        for (int c = 0; c < nchunks; ++c) {
            if (c + 1 < nchunks) { SCAN_STAGE_WRITE(bufs + ((c + 1) & 1) * SBUF_FLOATS);
                if (c + 2 < nchunks) SCAN_STAGE_LOAD(sin + (size_t)(c + 2) * TC * 384, scal + (size_t)(c + 2) * TC * 4); }
            SCAN_BAR();
        }
    } else {
        SCAN_BAR();
        for (int c = 0; c < nchunks; ++c) {
            LAS float* buf = bufs + (c & 1) * SBUF_FLOATS;
            const LAS float* lb = buf + 4 * kq;
            const LAS float* tbp = buf + 320 + lrow * 4;
            float yacc = 0.f;
            f32x4 kkA = *(const LAS f32x4*)(lb), w4A = *(const LAS f32x4*)(lb + 64), nbA = *(const LAS f32x4*)(lb + 128), kpA = *(const LAS f32x4*)(lb + 192), wrA = *(const LAS f32x4*)(lb + 256), tbA = *(const LAS f32x4*)(tbp);
            f32x4 kkB = *(const LAS f32x4*)(lb + 384), w4B = *(const LAS f32x4*)(lb + 384 + 64), nbB = *(const LAS f32x4*)(lb + 384 + 128), kpB = *(const LAS f32x4*)(lb + 384 + 192), wrB = *(const LAS f32x4*)(lb + 384 + 256), tbB = *(const LAS f32x4*)(tbp + 384);
#pragma unroll
            for (int st = 0; st < TC; st += 2) {
                const int s2 = (st + 2 < TC) ? st + 2 : st, s3 = (st + 3 < TC) ? st + 3 : st + 1;
                float y;
                SCAN_STEP(kkA, w4A, nbA, kpA, wrA, tbA, y);
                yacc = (kq == (st & 15)) ? y : yacc;
                kkA = *(const LAS f32x4*)(lb + s2 * 384); w4A = *(const LAS f32x4*)(lb + s2 * 384 + 64); nbA = *(const LAS f32x4*)(lb + s2 * 384 + 128);
                kpA = *(const LAS f32x4*)(lb + s2 * 384 + 192); wrA = *(const LAS f32x4*)(lb + s2 * 384 + 256); tbA = *(const LAS f32x4*)(tbp + s2 * 384);
                __builtin_amdgcn_sched_barrier(0);
                SCAN_STEP(kkB, w4B, nbB, kpB, wrB, tbB, y);
                yacc = (kq == ((st + 1) & 15)) ? y : yacc;
                if (((st + 1) & 15) == 15) y0[(size_t)(c * TC + st + 1 - 15 + kq) * RW + vrow] = yacc;
                kkB = *(const LAS f32x4*)(lb + s3 * 384); w4B = *(const LAS f32x4*)(lb + s3 * 384 + 64); nbB = *(const LAS f32x4*)(lb + s3 * 384 + 128);
                kpB = *(const LAS f32x4*)(lb + s3 * 384 + 192); wrB = *(const LAS f32x4*)(lb + s3 * 384 + 256); tbB = *(const LAS f32x4*)(tbp + s3 * 384);
                __builtin_amdgcn_sched_barrier(0);
            }
            SCAN_BAR();
        }
    }
    __syncthreads();
    if (scanner) *(f32x4*)(s_out + (size_t)vrow * 64 + 4 * kq) = (f32x4){s01.x, s01.y, s23.x, s23.y};
}
__device__ __forceinline__ void scan_sample_witem(Frame& F, int item) {
    const int dbh = item >> 4, r4 = item & 15, db = dbh >> 4, h = dbh & 15;
    const int ri = F.lane >> 4, kq = F.lane & 15, vrow = r4 * 4 + ri;
    const size_t so = (size_t)NB * RH * SEQ + (size_t)dbh * DT;
    const float* sin = WSP(float, WS_SCANIN) + so * 384; const float* scal = WSP(float, WS_SCAL) + so * 4;
    const f32x4 s0 = *(const f32x4*)(F.in[I_SWKV] + (size_t)dbh * 4096 + (size_t)vrow * 64 + 4 * kq);
    f32x2 s01 = (f32x2){s0.x, s0.y}, s23 = (f32x2){s0.z, s0.w};
    f32x4 kk[DT], w4[DT], nb[DT], kp[DT], wr[DT], tb[DT];
#pragma unroll
    for (int st = 0; st < DT; ++st) { const float* p = sin + st * 384 + 4 * kq;
        kk[st] = *(const f32x4*)(p); w4[st] = *(const f32x4*)(p + 64); nb[st] = *(const f32x4*)(p + 128); kp[st] = *(const f32x4*)(p + 192); wr[st] = *(const f32x4*)(p + 256);
        const f32x2 sc = *(const f32x2*)(scal + st * 4); tb[st] = (f32x4){sin[st * 384 + 320 + vrow], sc.x, sc.y, 0.f}; }
    float* y0 = WSP(float, WS_Y) + (size_t)(NTOKP + db * DT) * RW + h * 64 + vrow;
#pragma unroll
    for (int st = 0; st < DT; ++st) { float y; SCAN_STEP(kk[st], w4[st], nb[st], kp[st], wr[st], tb[st], y); if (kq == 0) y0[(size_t)st * RW] = y; }
    *(f32x4*)(F.out + O_WKVS + (size_t)dbh * 4096 + (size_t)vrow * 64 + 4 * kq) = (f32x4){s01.x, s01.y, s23.x, s23.y};
}
__device__ __forceinline__ void p3_scan_phase(Frame& F) {
    const int gw = F.bid * NWAVES + F.wave, NGW = F.G * NWAVES;
    for (int it = gw; it < DB * RH * 16; it += NGW) scan_sample_witem(F, it);
    const float* SI = WSP(float, WS_SCANIN); const float* SL = WSP(float, WS_SCAL); float* Y = WSP(float, WS_Y);
    for (int it0 = F.bid; it0 < 256; it0 += F.G) { const int it = (F.G == 256) ? ((it0 & 7) * 32 + (it0 >> 3)) : it0;
        const int bh = it >> 2, rg = it & 3, b = bh >> 4, h = bh & 15;
        scan_prompt_item(F, SI + (size_t)bh * SEQ * 384, SL + (size_t)bh * SEQ * 4, F.out + O_WKVP + (size_t)bh * 4096, Y + (size_t)(b * SEQ) * RW + h * 64, rg); }
}

__device__ __forceinline__ void gn_row(Frame& F, int row) {
    const int lane = F.lane, h = lane >> 2, q = lane & 3, c0 = h * 64 + q * 16;
    const float* y = WSP(float, WS_Y) + (size_t)row * RW + c0;
    f32x4 v[4]; float s = 0.f;
#pragma unroll
    for (int j = 0; j < 4; ++j) { v[j] = *(const f32x4*)(y + 4 * j); s += (v[j].x + v[j].y) + (v[j].z + v[j].w); }
    s += dpp<0xB1>(s); s += dpp<0x4E>(s);
    const float mean = s * (1.f / 64.f); float s2 = 0.f;
#pragma unroll
    for (int j = 0; j < 4; ++j) { v[j] = v[j] - mean; s2 += (v[j].x * v[j].x + v[j].y * v[j].y) + (v[j].z * v[j].z + v[j].w * v[j].w); }
    s2 += dpp<0xB1>(s2); s2 += dpp<0x4E>(s2);
    const float rstd = 1.f / sqrtf(s2 * (1.f / 64.f) + GN_EPS);
    const size_t so = scan_seq_off(row, h);
    const float bonus = WSP(float, WS_SCAL)[so * 4 + 2];
    const float* vv = WSP(float, WS_SCANIN) + so * 384 + 5 * 64 + q * 16;
    const float* g = WSP(float, WS_PROJ) + (size_t)row * INWP + C_GR + c0;
    const float* gw = F.in[I_GNW] + c0; const float* gb = F.in[I_GNB] + c0;
    bf16* o = WSP(bf16, WS_YMIX) + (size_t)row * DM + c0;
#pragma unroll
    for (int j = 0; j < 4; ++j) { const f32x4 w4 = *(const f32x4*)(gw + 4 * j), b4 = *(const f32x4*)(gb + 4 * j), v4 = *(const f32x4*)(vv + 4 * j), g4 = *(const f32x4*)(g + 4 * j);
        const float o0 = (v[j].x * rstd * w4.x + b4.x + bonus * v4.x) * silu(g4.x), o1 = (v[j].y * rstd * w4.y + b4.y + bonus * v4.y) * silu(g4.y);
        const float o2 = (v[j].z * rstd * w4.z + b4.z + bonus * v4.z) * silu(g4.z), o3 = (v[j].w * rstd * w4.w + b4.w + bonus * v4.w) * silu(g4.w);
        v2u pk; pk.x = cvt_pk_bf16(o0, o1); pk.y = cvt_pk_bf16(o2, o3); *(v2u*)(o + 4 * j) = pk; }
}
__device__ __forceinline__ void idx_afrag(const bf16* QIB, int row0, int lane, bf16x8 (&af)[4]) {
    const int r = lane & 31, hh = lane >> 5;
    const bf16* p = QIB + (size_t)(row0 + ((r >> 2) & 1)) * 1024 + ((r >> 3) * 4 + (r & 3)) * 64 + 8 * hh;
#pragma unroll
    for (int ks = 0; ks < 4; ++ks) af[ks] = *(const bf16x8*)(p + 16 * ks);
}
__device__ __forceinline__ float idx_reduce(const f32x16& acc, const f32x4 (&w)[4]) {
    float v = 0.f;
#pragma unroll
    for (int j = 0; j < 16; ++j) v += w[j >> 2][j & 3] * fmaxf(acc[j], 0.f);
    return v;
}
__device__ __forceinline__ void d1_prompt_item(Frame& F, int item) {
    const int idx = item & 255, second = item >> 8, b = idx >> 6, qi = idx & 63, qt = second ? 127 - qi : qi;
    const int t0 = qt * 16 + 2 * F.wave, row0 = b * SEQ + t0;
    const int r = F.lane & 31, hh = F.lane >> 5;
    bf16x8 af[4]; idx_afrag(WSP(bf16, WS_QIB), row0, F.lane, af);
    f32x4 w[4];
#pragma unroll
    for (int j = 0; j < 4; ++j) w[j] = *(const f32x4*)(WSP(float, WS_WIS) + (size_t)(row0 + hh) * 16 + 4 * j);
    const int tq = t0 + hh;
    const bf16* KIB = WSP(bf16, WS_KIB) + (size_t)(b * SEQ) * 64;
    float* SC = WSP(float, WS_SC) + (size_t)(b * SEQ + tq) * SEQ;
    for (int s0 = 0; s0 <= t0 + 1; s0 += 32) {
        f32x16 acc;
#pragma unroll
        for (int j = 0; j < 16; ++j) acc[j] = 0.f;
#pragma unroll
        for (int ks = 0; ks < 4; ++ks) { const bf16x8 bfr = *(const bf16x8*)(KIB + (size_t)(s0 + r) * 64 + 16 * ks + 8 * hh);
            acc = __builtin_amdgcn_mfma_f32_32x32x16_bf16(af[ks], bfr, acc, 0, 0, 0); }
        SC[s0 + r] = idx_reduce(acc, w);
    }
}
__device__ __forceinline__ void d1_sample_item(Frame& F, int item) {
    const int r = F.lane & 31, hh = F.lane >> 5;
    int db, p = 0; bool newk = false;
    if (item < DB * NPAGES) { db = item >> 6; p = item & 63; } else { db = item - DB * NPAGES; newk = true; }
    const int row0 = NTOKP + db * DT;
    bf16x8 af0[4], af1[4]; idx_afrag(WSP(bf16, WS_QIB), row0, F.lane, af0); idx_afrag(WSP(bf16, WS_QIB), row0 + 2, F.lane, af1);
    f32x4 w0[4], w1[4];
#pragma unroll
    for (int j = 0; j < 4; ++j) { w0[j] = *(const f32x4*)(WSP(float, WS_WIS) + (size_t)(row0 + hh) * 16 + 4 * j); w1[j] = *(const f32x4*)(WSP(float, WS_WIS) + (size_t)(row0 + 2 + hh) * 16 + 4 * j); }
    float* SCS = WSP(float, WS_SCS);
    if (!newk) {
        const int page = ((const int*)F.in[I_PT])[db * NPAGES + p];
        const float* kp = F.in[I_CKI] + ((size_t)page * PAGE + r) * 64 + 8 * hh;
        f32x4 ka[4][4], kc[4][4];
#pragma unroll
        for (int kt = 0; kt < 4; ++kt)
#pragma unroll
            for (int ks = 0; ks < 4; ++ks) { ka[kt][ks] = *(const f32x4*)(kp + (size_t)kt * 32 * 64 + 16 * ks); kc[kt][ks] = *(const f32x4*)(kp + (size_t)kt * 32 * 64 + 16 * ks + 4); }
#pragma unroll
        for (int kt = 0; kt < 4; ++kt) {
            f32x16 acc0, acc1;
#pragma unroll
            for (int j = 0; j < 16; ++j) { acc0[j] = 0.f; acc1[j] = 0.f; }
#pragma unroll
            for (int ks = 0; ks < 4; ++ks) { const f32x4 a = ka[kt][ks], c = kc[kt][ks];
                v4u u; u.x = cvt_pk_bf16(a.x, a.y); u.y = cvt_pk_bf16(a.z, a.w); u.z = cvt_pk_bf16(c.x, c.y); u.w = cvt_pk_bf16(c.z, c.w);
                const bf16x8 bfr = __builtin_bit_cast(bf16x8, u);
                acc0 = __builtin_amdgcn_mfma_f32_32x32x16_bf16(af0[ks], bfr, acc0, 0, 0, 0); acc1 = __builtin_amdgcn_mfma_f32_32x32x16_bf16(af1[ks], bfr, acc1, 0, 0, 0); }
            SCS[(size_t)(db * DT + hh) * SCS_LD + p * PAGE + kt * 32 + r] = idx_reduce(acc0, w0);
            SCS[(size_t)(db * DT + 2 + hh) * SCS_LD + p * PAGE + kt * 32 + r] = idx_reduce(acc1, w1);
        }
    } else {
        f32x16 acc0, acc1;
#pragma unroll
        for (int j = 0; j < 16; ++j) { acc0[j] = 0.f; acc1[j] = 0.f; }
        const bf16* kp = WSP(bf16, WS_KIB) + (size_t)(row0 + (r & 3)) * 64 + 8 * hh;
#pragma unroll
        for (int ks = 0; ks < 4; ++ks) { bf16x8 bfr = *(const bf16x8*)(kp + 16 * ks);
            acc0 = __builtin_amdgcn_mfma_f32_32x32x16_bf16(af0[ks], bfr, acc0, 0, 0, 0); acc1 = __builtin_amdgcn_mfma_f32_32x32x16_bf16(af1[ks], bfr, acc1, 0, 0, 0); }
        if (r < 4) { SCS[(size_t)(db * DT + hh) * SCS_LD + PAST + r] = idx_reduce(acc0, w0); SCS[(size_t)(db * DT + 2 + hh) * SCS_LD + PAST + r] = idx_reduce(acc1, w1); }
    }
}
__device__ __forceinline__ void p4_phase(Frame& F) {
    const int gw = F.bid * NWAVES + F.wave, NGW = F.G * NWAVES;
    for (int it = gw; it < DB * NPAGES + DB; it += NGW) d1_sample_item(F, it);
    for (int row = gw; row < NTOK; row += NGW) gn_row(F, row);
}

__device__ __forceinline__ unsigned wave_count(unsigned c) {
#pragma unroll
    for (int o = 1; o < 64; o <<= 1) c += __shfl_xor((int)c, o);
    return c;
}
template <int NV>
__device__ __forceinline__ void kth_select(const unsigned (&key)[NV * 4], unsigned xk, int xbase, int lane, unsigned& T_out, unsigned& cut_out) {
    unsigned T = 0u; bool exact = false;
    for (int bit = 31; bit >= 0; --bit) {
        const unsigned cand = T | (1u << bit);
        unsigned c = (xk >= cand) ? 1u : 0u;
#pragma unroll
        for (int i = 0; i < NV * 4; ++i) c += (key[i] >= cand) ? 1u : 0u;
        c = wave_count(c);
        if (c >= (unsigned)TOPK) T = cand;
        if (c == (unsigned)TOPK) { exact = true; break; }
    }
    unsigned cut = 0x7fffffffu;
    if (!exact) {
        unsigned cg = (xk > T) ? 1u : 0u, ce = (xk == T) ? 1u : 0u;
#pragma unroll
        for (int i = 0; i < NV * 4; ++i) { cg += (key[i] > T) ? 1u : 0u; ce += (key[i] == T) ? 1u : 0u; }
        cg = wave_count(cg); ce = wave_count(ce);
        const unsigned need = (unsigned)TOPK - cg;
        if (ce > need) {
            unsigned I = 0u;
            for (int bit = 14; bit >= 0; --bit) {
                const unsigned cand = I | (1u << bit);
                unsigned c = (xk == T && (unsigned)(xbase + lane) < cand && lane < 4) ? 1u : 0u;
#pragma unroll
                for (int i = 0; i < NV * 4; ++i) { const unsigned idx = 256u * (i >> 2) + 4u * lane + (i & 3); c += (key[i] == T && idx < cand) ? 1u : 0u; }
                c = wave_count(c);
                if (c < need) I = cand;
            }
            cut = I;
        }
    }
    T_out = T; cut_out = cut;
}
__device__ __forceinline__ void d2_prompt_row(Frame& F, int row) {
    const int t = row & 2047, lane = F.lane;
    unsigned* THR = WSP(unsigned, WS_THR) + (size_t)row * 2;
    if (t < TOPK) { if (lane == 0) { THR[0] = 0u; THR[1] = 0x7fffffffu; } return; }
    const float* SC = WSP(float, WS_SC) + (size_t)row * SEQ;
    unsigned key[32];
#pragma unroll
    for (int j = 0; j < 8; ++j) { const int i0 = 256 * j + 4 * lane;
        if (i0 <= t) { const f32x4 v = *(const f32x4*)(SC + i0);
            key[4 * j + 0] = sort_key(v.x); key[4 * j + 1] = (i0 + 1 <= t) ? sort_key(v.y) : 0u; key[4 * j + 2] = (i0 + 2 <= t) ? sort_key(v.z) : 0u; key[4 * j + 3] = (i0 + 3 <= t) ? sort_key(v.w) : 0u; }
        else { key[4 * j + 0] = 0u; key[4 * j + 1] = 0u; key[4 * j + 2] = 0u; key[4 * j + 3] = 0u; } }
    unsigned T, cut; kth_select<8>(key, 0u, 1 << 20, lane, T, cut);
    if (lane == 0) { THR[0] = T; THR[1] = cut; }
}
__device__ __forceinline__ void d2_sample_block(Frame& F, int q) {
    const int t = q & 3, tid = F.tid, lane = F.lane;
    const float* SCS = WSP(float, WS_SCS) + (size_t)q * SCS_LD;
    LAS unsigned* red = (LAS unsigned*)(F.lds + RING_OFF);
    unsigned key[16];
#pragma unroll
    for (int j = 0; j < 4; ++j) { const f32x4 v = *(const f32x4*)(SCS + 2048 * j + 4 * tid);
        key[4 * j + 0] = sort_key(v.x); key[4 * j + 1] = sort_key(v.y); key[4 * j + 2] = sort_key(v.z); key[4 * j + 3] = sort_key(v.w); }
    unsigned xk = 0u; if (tid <= t) xk = sort_key(SCS[PAST + tid]);
    if (tid == 0) red[16] = 0u;
    unsigned T = 0u; bool exact = false; int par = 0;
    for (int bit = 31; bit >= 0; --bit) {
        const unsigned cand = T | (1u << bit);
        unsigned c = (xk >= cand) ? 1u : 0u;
#pragma unroll
        for (int i = 0; i < 16; ++i) c += (key[i] >= cand) ? 1u : 0u;
        c = wave_count(c);
        if (lane == 0) red[par * 8 + F.wave] = c;
        __syncthreads();
        unsigned tot = 0u;
#pragma unroll
        for (int w = 0; w < 8; ++w) tot += red[par * 8 + w];
        par ^= 1;
        if (tot >= (unsigned)TOPK) T = cand;
        if (tot == (unsigned)TOPK) { exact = true; break; }
    }
    unsigned cut = 0x7fffffffu;
    if (!exact) {
        unsigned cg = (xk > T) ? 1u : 0u, ce = (xk == T) ? 1u : 0u;
#pragma unroll
        for (int i = 0; i < 16; ++i) { cg += (key[i] > T) ? 1u : 0u; ce += (key[i] == T) ? 1u : 0u; }
        cg = wave_count(cg); ce = wave_count(ce);
        if (lane == 0) red[par * 8 + F.wave] = (cg << 16) | ce;
        __syncthreads();
        unsigned tg = 0u, te = 0u;
#pragma unroll
        for (int w = 0; w < 8; ++w) { const unsigned v = red[par * 8 + w]; tg += v >> 16; te += v & 0xffffu; }
        par ^= 1;
        const unsigned need = (unsigned)TOPK - tg;
        if (te > need) {
            unsigned I = 0u;
            for (int bit = 14; bit >= 0; --bit) {
                const unsigned cand = I | (1u << bit);
                unsigned c = (xk == T && tid < 4 && (unsigned)(PAST + tid) < cand) ? 1u : 0u;
#pragma unroll
                for (int i = 0; i < 16; ++i) { const unsigned idx = 2048u * (i >> 2) + 4u * tid + (i & 3); c += (key[i] == T && idx < cand) ? 1u : 0u; }
                c = wave_count(c);
                if (lane == 0) red[par * 8 + F.wave] = c;
                __syncthreads();
                unsigned tot = 0u;
#pragma unroll
                for (int w = 0; w < 8; ++w) tot += red[par * 8 + w];
                par ^= 1;
                if (tot < need) I = cand;
            }
            cut = I;
        }
    }
    __syncthreads();
    int* IDX = WSP(int, WS_IDX) + (size_t)q * TOPK;
#pragma unroll
    for (int i = 0; i < 16; ++i) { const int idx = 2048 * (i >> 2) + 4 * tid + (i & 3);
        if (key[i] > T || (key[i] == T && (unsigned)idx <= cut)) { const unsigned pos = atomicAdd((unsigned*)&red[16], 1u); if (pos < (unsigned)TOPK) IDX[pos] = idx; } }
    if (tid <= t) { const int idx = PAST + tid; if (xk > T || (xk == T && (unsigned)idx <= cut)) { const unsigned pos = atomicAdd((unsigned*)&red[16], 1u); if (pos < (unsigned)TOPK) IDX[pos] = idx; } }
    __syncthreads();
}
__device__ __forceinline__ void p5_phase(Frame& F) {
    const int gw = F.bid * NWAVES + F.wave, NGW = F.G * NWAVES;
    for (int q = F.bid; q < NTOKS; q += F.G) d2_sample_block(F, q);
}

constexpr int DSA_MASK_OFF = RING_OFF;
constexpr int DSA_MERGE_OFF = RING_OFF + 8192;
__device__ __forceinline__ void cnt_ge(unsigned& c, unsigned k, unsigned cand) { asm volatile("v_cmp_ge_u32 vcc, %1, %2\n\tv_addc_co_u32 %0, vcc, 0, %0, vcc" : "+v"(c) : "v"(k), "v"(cand) : "vcc"); }
template <int CTRL> __device__ __forceinline__ unsigned dppu(unsigned x) { return (unsigned)__builtin_amdgcn_mov_dpp((int)x, CTRL, 0xf, 0xf, true); }
__device__ __forceinline__ unsigned half_sum_u(unsigned c) {
    c += dppu<0xB1>(c); c += dppu<0x4E>(c); c += dppu<0x141>(c); c += dppu<0x140>(c);
    auto s2 = __builtin_amdgcn_permlane16_swap(c, c, false, false);
    return s2[0] + s2[1];
}
template <bool MASKED>
__device__ __forceinline__ void attn_core(Frame& F, int row0, int nkt, int NT, const bf16* Qb, const bf16* Kf  , const bf16* Vf  , int gate_col, int out_col) {
    const int lane = F.lane, r = lane & 31, hh = lane >> 5, h = F.wave & 3, half = F.wave >> 2;
    const LAS unsigned* mask = (const LAS unsigned*)(F.lds + DSA_MASK_OFF) + r * 64;
    bf16x8 qf[8];
#pragma unroll
    for (int ks = 0; ks < 8; ++ks) qf[ks] = *(const bf16x8*)(Qb + (size_t)(row0 + r) * 512 + h * 128 + 16 * ks + 8 * hh);
    f32x16 o[4];
#pragma unroll
    for (int d = 0; d < 4; ++d)
#pragma unroll
        for (int j = 0; j < 16; ++j) o[d][j] = 0.f;
    float m = -INFINITY, lsum = 0.f;
    const bf16* kbase = Kf + (size_t)(h * NT) * 4096 + lane * 8;
    const bf16* vbase = Vf + (size_t)(h * NT) * 4096 + lane * 8;
    bf16x8 kf[8];
    if (half < nkt) {
#pragma unroll
        for (int ks = 0; ks < 8; ++ks) kf[ks] = *(const bf16x8*)(kbase + (size_t)half * 4096 + ks * 512);
    }
    for (int kt = half; kt < nkt; kt += 2) {
        bf16x8 vf[4][2];
#pragma unroll
        for (int d = 0; d < 4; ++d)
#pragma unroll
            for (int s = 0; s < 2; ++s) vf[d][s] = *(const bf16x8*)(vbase + (size_t)kt * 4096 + (d * 2 + s) * 512);
        f32x16 x;
#pragma unroll
        for (int j = 0; j < 16; ++j) x[j] = 0.f;
#pragma unroll
        for (int ks = 0; ks < 8; ++ks) x = __builtin_amdgcn_mfma_f32_32x32x16_bf16(kf[ks], qf[ks], x, 0, 0, 0);
        {
            const int ktn = (kt + 2 < nkt) ? kt + 2 : kt;
#pragma unroll
            for (int ks = 0; ks < 8; ++ks) kf[ks] = *(const bf16x8*)(kbase + (size_t)ktn * 4096 + ks * 512);
        }
        if (MASKED) {
            const unsigned m4 = mask[kt] >> (4 * hh);
#pragma unroll
            for (int g = 0; g < 4; ++g)
#pragma unroll
                for (int e = 0; e < 4; ++e) { const unsigned t = (unsigned)((int)(m4 << (31 - (8 * g + e))) >> 31);
                    x[4 * g + e] = __uint_as_float((__float_as_uint(x[4 * g + e]) & t) | (0xff800000u & ~t)); }
        }
        float mx = x[0];
#pragma unroll
        for (int j = 1; j < 16; ++j) mx = fmaxf(mx, x[j]);
        mx = xhalf_max(mx);
        const float mn = fmaxf(m, mx), mu = (mn == -INFINITY) ? 0.f : mn;
        const float alpha = __builtin_amdgcn_exp2f(m - mu);
        m = mn;
        float ls = 0.f;
#pragma unroll
        for (int j = 0; j < 16; ++j) { x[j] = __builtin_amdgcn_exp2f(x[j] - mu); ls += x[j]; }
        lsum = lsum * alpha + ls;
        if (__any(alpha != 1.f)) {
#pragma unroll
            for (int d = 0; d < 4; ++d)
#pragma unroll
                for (int j = 0; j < 16; ++j) o[d][j] *= alpha;
        }
        bf16x8 pf[2];
#pragma unroll
        for (int s = 0; s < 2; ++s) { v4u u; u.x = cvt_pk_bf16(x[8 * s + 0], x[8 * s + 1]); u.y = cvt_pk_bf16(x[8 * s + 2], x[8 * s + 3]); u.z = cvt_pk_bf16(x[8 * s + 4], x[8 * s + 5]); u.w = cvt_pk_bf16(x[8 * s + 6], x[8 * s + 7]);
            pf[s] = __builtin_bit_cast(bf16x8, u); }
#pragma unroll
        for (int d = 0; d < 4; ++d)
#pragma unroll
            for (int s = 0; s < 2; ++s) o[d] = __builtin_amdgcn_mfma_f32_32x32x16_bf16(vf[d][s], pf[s], o[d], 0, 0, 0);
    }
    lsum = xhalf_sum(lsum);
    LAS float* mg = (LAS float*)(F.lds + DSA_MERGE_OFF) + h * 66 * 64;
    if (half == 1) {
        mg[0 * 64 + lane] = m; mg[1 * 64 + lane] = lsum;
#pragma unroll
        for (int d = 0; d < 4; ++d)
#pragma unroll
            for (int j = 0; j < 16; ++j) mg[(2 + d * 16 + j) * 64 + lane] = o[d][j];
    }
    __syncthreads();
    if (half == 0) {
        const float m1 = mg[0 * 64 + lane], l1 = mg[1 * 64 + lane];
        const float mn = fmaxf(m, m1), mu = (mn == -INFINITY) ? 0.f : mn;
        const float a0 = __builtin_amdgcn_exp2f(m - mu), a1 = __builtin_amdgcn_exp2f(m1 - mu);
        const float l = lsum * a0 + l1 * a1; const float inv = l > 0.f ? 1.f / l : 0.f;
        const float* gp = WSP(float, WS_PROJ) + (size_t)(row0 + r) * INWP + gate_col + h * 128;
        bf16* op = WSP(bf16, WS_YMIX) + (size_t)(row0 + r) * DM + out_col + h * 128;
#pragma unroll
        for (int d = 0; d < 4; ++d)
#pragma unroll
            for (int g = 0; g < 4; ++g) { const int dd = d * 32 + 8 * g + 4 * hh; const f32x4 gv = *(const f32x4*)(gp + dd);
                float v[4];
#pragma unroll
                for (int e = 0; e < 4; ++e) v[e] = (o[d][4 * g + e] * a0 + mg[(2 + d * 16 + 4 * g + e) * 64 + lane] * a1) * inv * silu(gv[e]);
                v2u pk; pk.x = cvt_pk_bf16(v[0], v[1]); pk.y = cvt_pk_bf16(v[2], v[3]); *(v2u*)(op + dd) = pk; }
    }
    __syncthreads();
}
__device__ __forceinline__ void dsa_prompt_item(Frame& F, int b, int qt) {
    const int t0 = qt * 32, row0 = b * SEQ + t0, nkt = qt + 1;
    LAS unsigned* mask = (LAS unsigned*)(F.lds + DSA_MASK_OFF);
    if (t0 + 31 < TOPK) {
        for (int i = F.tid; i < 32 * 64; i += NTHR) { const int q = i >> 6, kt = i & 63; const int nb = t0 + q - 32 * kt + 1;
            mask[i] = nb >= 32 ? 0xffffffffu : (nb <= 0 ? 0u : ((1u << nb) - 1u)); }
    } else {
        const int lane = F.lane, r = lane & 31, hh = lane >> 5;
        int r4 = 4 * r; asm volatile("" : "+v"(r4));
        const bf16* KIB = WSP(bf16, WS_SC) + (size_t)(b * SEQ) * 64 + lane * 8;
        LAS unsigned* skl = (LAS unsigned*)(F.lds + DSA_MASK_OFF + 8192) + F.wave * 4096 + hh * 2048;
        for (int i = F.tid; i < 32 * 64; i += NTHR) mask[i] = 0u;
        __syncthreads();
        for (int pass = 0; pass < 2; ++pass) {
            const int q0 = 16 * pass + 2 * F.wave, tq = t0 + q0 + hh;
            {
                bf16x8 af[4]; idx_afrag(WSP(bf16, WS_QIB), row0 + q0, lane, af);
                f32x4 w[4];
#pragma unroll
                for (int j = 0; j < 4; ++j) w[j] = *(const f32x4*)(WSP(float, WS_WIS) + (size_t)(row0 + q0 + hh) * 16 + 4 * j);
                bf16x8 ring[4][4];
#pragma unroll
                for (int i = 0; i < 3; ++i) { const int ktc = i < nkt ? i : nkt - 1;
#pragma unroll
                    for (int ks = 0; ks < 4; ++ks) ring[i][ks] = *(const bf16x8*)(KIB + (size_t)ktc * 2048 + ks * 512); }
                for (int kt0 = 0; kt0 < nkt; kt0 += 4) {
#pragma unroll
                    for (int i = 0; i < 4; ++i) {
                        const int kt = kt0 + i, ktp = (kt + 3 < nkt) ? kt + 3 : nkt - 1;
#pragma unroll
                        for (int ks = 0; ks < 4; ++ks) ring[(i + 3) & 3][ks] = *(const bf16x8*)(KIB + (size_t)ktp * 2048 + ks * 512);
                        f32x16 acc;
#pragma unroll
                        for (int j = 0; j < 16; ++j) acc[j] = 0.f;
#pragma unroll
                        for (int ks = 0; ks < 4; ++ks) acc = __builtin_amdgcn_mfma_f32_32x32x16_bf16(af[ks], ring[i][ks], acc, 0, 0, 0);
                        if (kt < nkt) skl[kt * 32 + r] = sort_key(idx_reduce(acc, w));
                    }
                }
            }
            asm volatile("s_waitcnt lgkmcnt(0)" ::: "memory");
            unsigned sk[64];
            int tqr = tq - r4; asm volatile("" : "+v"(tqr));
#pragma unroll
            for (int i = 0; i < 16; ++i) { const v4u v = *(const LAS v4u*)(skl + 128 * i + r4);
                sk[4 * i + 0] = (128 * i + 0 <= tqr) ? v.x : 0u; sk[4 * i + 1] = (128 * i + 1 <= tqr) ? v.y : 0u; sk[4 * i + 2] = (128 * i + 2 <= tqr) ? v.z : 0u; sk[4 * i + 3] = (128 * i + 3 <= tqr) ? v.w : 0u; }
            unsigned T = 0u; bool exact = false;
            for (int bit = 31; bit >= 0; --bit) {
                const unsigned cand = T | (1u << bit);
                unsigned c = 0u;
#pragma unroll
                for (int i = 0; i < 64; ++i) cnt_ge(c, sk[i], cand);
                c = half_sum_u(c);
                if (!exact) { if (c >= (unsigned)TOPK) T = cand; if (c == (unsigned)TOPK) exact = true; }
                if (__all(exact)) break;
            }
            unsigned cut = 0x7fffffffu;
            if (__any(!exact)) {
                unsigned cg = 0u, ce = 0u;
                for (int i = 0; i < 16; ++i) { const v4u v = *(const LAS v4u*)(skl + 128 * i + r4); const int i0 = 128 * i + r4;
#pragma unroll
                    for (int e = 0; e < 4; ++e) { const unsigned k = (i0 + e <= tq) ? v[e] : 0u; cg += (k > T) ? 1u : 0u; ce += (k == T) ? 1u : 0u; } }
                cg = half_sum_u(cg); ce = half_sum_u(ce);
                const unsigned need = (unsigned)TOPK - cg;
                const bool tie = !exact && ce > need;
                unsigned I = 0u;
                for (int bit = 11; bit >= 0; --bit) {
                    const unsigned cand = I | (1u << bit);
                    unsigned c = 0u;
                    for (int i = 0; i < 16; ++i) { const v4u v = *(const LAS v4u*)(skl + 128 * i + r4); const int i0 = 128 * i + r4;
#pragma unroll
                        for (int e = 0; e < 4; ++e) { const unsigned k = (i0 + e <= tq) ? v[e] : 0u; c += (k == T && (unsigned)(i0 + e) < cand) ? 1u : 0u; } }
                    c = half_sum_u(c);
                    if (c < need) I = cand;
                }
                if (tie) cut = I;
            }
            int cutr = (int)cut - r4; asm volatile("" : "+v"(cutr));
#pragma unroll
            for (int i = 0; i < 16; ++i) {
                unsigned nib = 0u;
#pragma unroll
                for (int e = 0; e < 4; ++e) { const unsigned k = sk[4 * i + e]; const bool sel = k != 0u && (k > T || (k == T && (128 * i + e) <= cutr)); nib |= sel ? (1u << e) : 0u; }
                if (nib) __hip_atomic_fetch_or((LAS unsigned*)&mask[(q0 + hh) * 64 + 4 * i + (r >> 3)], nib << (4 * (r & 7)), __ATOMIC_RELAXED, __HIP_MEMORY_SCOPE_WORKGROUP);
            }
        }
    }
    __syncthreads();
#ifndef T_NOCORE
    attn_core<true>(F, row0, nkt, 64, WSP(bf16, WS_QB), WSP(bf16, WS_KB) + (size_t)b * SEQ * 512, WSP(bf16, WS_VT) + (size_t)b * 512 * SEQ, C_GA, 1024);
#endif
}
__device__ __forceinline__ void gather_attn_item(Frame& F, int q, bool dsa) {
    const int lane = F.lane, hd = lane >> 4, d0 = (lane & 15) * 8, db = q >> 2, row = NTOKP + q;
    LAS float* red = (LAS float*)(F.lds + RING_OFF);
    LAS float* racc = red + 64;
    const float* kptr; const float* vptr;
    {
        const int ki = F.wave * 32 + (lane & 31);
        if (dsa) { const int idx = WSP(int, WS_IDX)[(size_t)q * TOPK + ki];
            if (idx < PAST) { const size_t phys = (size_t)((const int*)F.in[I_PT])[db * NPAGES + (idx >> 7)] * PAGE + (idx & 127); kptr = F.in[I_CK] + phys * 512; vptr = F.in[I_CV] + phys * 512; }
            else { const int j = idx - PAST; kptr = F.out + O_KS + (size_t)(db * DT + j) * 512; vptr = F.out + O_VS + (size_t)(db * DT + j) * 512; } }
        else { kptr = F.in[I_CMK] + (size_t)(db * MEMT + ki) * 512; vptr = F.in[I_CMV] + (size_t)(db * MEMT + ki) * 512; }
    }
    const bf16* qb = (dsa ? WSP(bf16, WS_QB) : WSP(bf16, WS_QMB)) + (size_t)row * 512 + hd * 128 + d0;
    float qv[8];
    { const v4u u = *(const v4u*)qb; qv[0] = __uint_as_float(u.x << 16); qv[1] = __uint_as_float(u.x & 0xffff0000u); qv[2] = __uint_as_float(u.y << 16); qv[3] = __uint_as_float(u.y & 0xffff0000u);
      qv[4] = __uint_as_float(u.z << 16); qv[5] = __uint_as_float(u.z & 0xffff0000u); qv[6] = __uint_as_float(u.w << 16); qv[7] = __uint_as_float(u.w & 0xffff0000u); }
    LAS float* sl = racc + 8 * 8 * 64 + F.wave * 128;
    float mx = -INFINITY;
#pragma unroll 16
    for (int i = 0; i < 32; ++i) {
        const unsigned long long pk = (unsigned long long)kptr;
        const unsigned lo = __shfl((int)(unsigned)pk, i), hi = __shfl((int)(unsigned)(pk >> 32), i);
        const float* kr = (const float*)(((unsigned long long)hi << 32) | lo) + hd * 128 + d0;
        const f32x4 a = *(const f32x4*)kr, c = *(const f32x4*)(kr + 4);
        float s = (a.x * qv[0] + a.y * qv[1]) + (a.z * qv[2] + a.w * qv[3]) + (c.x * qv[4] + c.y * qv[5]) + (c.z * qv[6] + c.w * qv[7]);
        s = row16_sum(s); mx = fmaxf(mx, s);
        if ((lane & 15) == 0) sl[i * 4 + hd] = s;
    }
    if ((lane & 15) == 0) red[F.wave * 4 + hd] = mx;
    __syncthreads();
    float gm = red[hd];
#pragma unroll
    for (int w = 1; w < 8; ++w) gm = fmaxf(gm, red[w * 4 + hd]);
    __syncthreads();
    float acc[8]; float ls = 0.f;
#pragma unroll
    for (int e = 0; e < 8; ++e) acc[e] = 0.f;
#pragma unroll 16
    for (int i = 0; i < 32; ++i) {
        const unsigned long long pv = (unsigned long long)vptr;
        const unsigned lo = __shfl((int)(unsigned)pv, i), hi = __shfl((int)(unsigned)(pv >> 32), i);
        const float* vr = (const float*)(((unsigned long long)hi << 32) | lo) + hd * 128 + d0;
        const f32x4 a = *(const f32x4*)vr, c = *(const f32x4*)(vr + 4);
        const float p = exp2f(sl[i * 4 + hd] - gm); ls += p;
        acc[0] += p * a.x; acc[1] += p * a.y; acc[2] += p * a.z; acc[3] += p * a.w; acc[4] += p * c.x; acc[5] += p * c.y; acc[6] += p * c.z; acc[7] += p * c.w;
    }
    if ((lane & 15) == 0) red[F.wave * 4 + hd] = ls;
#pragma unroll
    for (int e = 0; e < 8; ++e) racc[(F.wave * 8 + e) * 64 + lane] = acc[e];
    __syncthreads();
    if (F.wave == 0) {
        float l = 0.f;
#pragma unroll
        for (int w = 0; w < 8; ++w) l += red[w * 4 + hd];
        const float inv = 1.f / l;
        const float* gp = WSP(float, WS_PROJ) + (size_t)row * INWP + (dsa ? C_GA : C_GM) + hd * 128 + d0;
        float v[8];
#pragma unroll
        for (int e = 0; e < 8; ++e) { float a = 0.f;
#pragma unroll
            for (int w = 0; w < 8; ++w) a += racc[(w * 8 + e) * 64 + lane];
            v[e] = a * inv * silu(gp[e]); }
        v4u pk; pk.x = cvt_pk_bf16(v[0], v[1]); pk.y = cvt_pk_bf16(v[2], v[3]); pk.z = cvt_pk_bf16(v[4], v[5]); pk.w = cvt_pk_bf16(v[6], v[7]);
        *(v4u*)(WSP(bf16, WS_YMIX) + (size_t)row * DM + (dsa ? 1024 : 1536) + hd * 128 + d0) = pk;
    }
    __syncthreads();
}
__device__ __forceinline__ void p6_phase(Frame& F) {
    { const int gt = F.bid * NTHR + F.tid, NGT = F.G * NTHR;
      for (int e = gt; e < NTOKS * DM / 4; e += NGT) *(f32x4*)(F.out + O_YS + (size_t)e * 4) = *(const f32x4*)(F.in[I_XS] + (size_t)e * 4); }
    unsigned* qctr = (unsigned*)(F.ws + WS_CTL) + 8192;
    volatile LAS int* slot = (volatile LAS int*)(F.lds + LDSCTL_OFF + 64);
    for (;;) {
        if (F.tid == 0) *slot = (int)__hip_atomic_fetch_add(qctr, 1u, __ATOMIC_RELAXED, __HIP_MEMORY_SCOPE_AGENT);
        __syncthreads();
        const int it = *slot;
        __syncthreads();
        if (it >= 768) break;
        Frame Fi = F; asm volatile("" : "+v"(Fi.lane), "+v"(Fi.tid));
        if (it < 256) { const int b = it & 3, qt = 63 - (it >> 2); dsa_prompt_item(Fi, b, qt); }
        else if (it < 512) { const int j = it - 256; gather_attn_item(Fi, j & 127, j < 128); }
        else { const int j = it - 512, b = j >> 6, qt = j & 63;
            attn_core<false>(Fi, b * SEQ + qt * 32, 8, 8, WSP(bf16, WS_QMB), WSP(bf16, WS_MKB) + (size_t)b * MEMT * 512, WSP(bf16, WS_MVT) + (size_t)b * 512 * MEMT, C_GM, 1536); }
    }
}

__device__ __forceinline__ void p8_phase(Frame& F) {
    const int gw = F.bid * NWAVES + F.wave, NGW = F.G * NWAVES;
    for (int row = gw; row < NTOK; row += NGW) {
        float* y = F.out + (row < NTOKP ? O_YP + (size_t)row * DM : O_YS + (size_t)(row - NTOKP) * DM);
        f32x4* xr = (f32x4*)y + F.lane; const f32x4* wr = (const f32x4*)F.in[I_FNW] + F.lane;
        f32x4 v[8]; float s = 0.f;
#pragma unroll
        for (int j = 0; j < 8; ++j) { v[j] = xr[64 * j]; s += (v[j].x * v[j].x + v[j].y * v[j].y) + (v[j].z * v[j].z + v[j].w * v[j].w); }
        const float rs = 1.f / sqrtf(wave_sum(s) * (1.f / DM) + RMS_EPS);
#pragma unroll
        for (int j = 0; j < 8; ++j) { const f32x4 ww = wr[64 * j]; xr[64 * j] = (f32x4){v[j].x * rs * ww.x, v[j].y * rs * ww.y, v[j].z * rs * ww.z, v[j].w * rs * ww.w}; }
    }
}

constexpr int N_PHASES = 9;
struct Args { const void* in[N_IN]; float* out; unsigned char* ws; int ph_lo, ph_hi; };
__global__ void __launch_bounds__(NTHR, 2) hymba_fwd(Args args) {
    extern __shared__ __attribute__((aligned(16))) unsigned char lds[];
    Frame F;
    F.lds = (LAS unsigned char*)lds;
    F.tid = threadIdx.x; F.lane = F.tid & 63; F.wave = __builtin_amdgcn_readfirstlane(F.tid >> 6);
    F.G = gridDim.x; F.bid = blockIdx.x;
#pragma unroll
    for (int i = 0; i < N_IN; ++i) F.in[i] = (const float*)args.in[i];
    F.out = args.out; F.ws = args.ws;
    for (int u = F.tid; u < (LDS_BYTES - LDSCTL_OFF) / 4; u += NTHR) ((LAS unsigned*)(F.lds + LDSCTL_OFF))[u] = 0u;
    __syncthreads();
#if MK_SPLIT
#define GRID_BAR() do { } while (0)
#else
    XcdBarrier bar = xcd_barrier_post((unsigned*)(F.ws + WS_CTL) + CW_BAR, (volatile LAS unsigned*)(F.lds + MISC_OFF) + 8);
#define GRID_BAR() xcd_barrier(bar)
#endif
    const int lo = args.ph_lo, hi = args.ph_hi;
#ifndef PH_MASK
#define PH_MASK 0x1FF
#endif
#define IN(k) (((PH_MASK >> (k)) & 1) && lo <= (k) && (k) < hi)
#define BOTH(k) (IN(k) && IN((k) + 1))

#define RUNPH(k, ...) do { if (IN(k)) { __VA_ARGS__; if (PROBE_REPEAT == (k)) { GRID_BAR(); __VA_ARGS__; } if (BOTH(k)) GRID_BAR(); } } while (0)
    RUNPH(0, p0_prologue(F));
    RUNPH(1, {
        { pg8::Gemm g{WSP(bf16, WS_XN), WSP(bf16, WS_WINT), MPAD, INWP, DM, DM}; pg8::StaticOrder S; S.init(MPAD, INWP, F.G, F.bid);
          EpiProj E{WSP(float, WS_PROJ)};
          pg8::gemm_phase<EpiProj, pg8::StaticOrder, true, true>(F.lds + RING_OFF, g, S, E); }
        { pg8::Gemm g{WSP(bf16, WS_XM), WSP(bf16, WS_WMEMT), 1024, 1024, DM, DM}; pg8::StaticOrder S; S.init(1024, 1024, F.G, F.G - 1 - F.bid);
          EpiMem E{F.out};
          pg8::gemm_phase<EpiMem, pg8::StaticOrder, true, true>(F.lds + RING_OFF, g, S, E); }
    });
    RUNPH(2, p2_phase(F));
    RUNPH(3, p3_scan_phase(F));
    RUNPH(4, p4_phase(F));
    RUNPH(5, p5_phase(F));
    RUNPH(6, p6_phase(F));
    RUNPH(7, {
        { pg8::Gemm g{WSP(bf16, WS_YMIX), WSP(bf16, WS_WOUTT), NTOKP, DM, DM, DM}; pg8::StaticOrder S; S.init(NTOKP, DM, F.G, F.bid);
          EpiOut E{F.in[I_XP], F.in[I_XS], F.out};
          pg8::gemm_phase<EpiOut, pg8::StaticOrder, true, true>(F.lds + RING_OFF, g, S, E); }
        { pg8::Gemm g{WSP(bf16, WS_YMIX), WSP(bf16, WS_WOUTT), MPAD, DM, 256, DM}; pg8::ListOrder S{F.G, F.bid, 2};
          EpiOutAtomic E{F.out};
          pg8::gemm_phase<EpiOutAtomic, pg8::ListOrder, true, true>(F.lds + RING_OFF, g, S, E); }
    });
    if (IN(8)) { p8_phase(F); }
#undef IN
#undef BOTH
}

extern "C" void kernel_launch(void* const* d_in, const int* in_sizes, int n_in, void* d_out, int out_size, void* d_ws, size_t ws_size, hipStream_t stream) {
    static int grid = 0;
    if (grid == 0) {
        if (n_in != N_IN || out_size != (int)O_END || ws_size < WS_END) { fprintf(stderr, "kernel_launch: unexpected shapes: n_in %d out %d ws %zu (need %zu)\n", n_in, out_size, ws_size, (size_t)WS_END); grid = -1; return; }
        int dev = 0, cus = 0, per_cu = 0;
        if (hipGetDevice(&dev) != hipSuccess || hipDeviceGetAttribute(&cus, hipDeviceAttributeMultiprocessorCount, dev) != hipSuccess) { grid = -1; return; }
        if (hipFuncSetAttribute((const void*)hymba_fwd, hipFuncAttributeMaxDynamicSharedMemorySize, LDS_BYTES) != hipSuccess) { fprintf(stderr, "kernel_launch: hipFuncSetAttribute failed\n"); grid = -1; return; }
        if (hipOccupancyMaxActiveBlocksPerMultiprocessor(&per_cu, (const void*)hymba_fwd, NTHR, LDS_BYTES) != hipSuccess || per_cu < 1) { fprintf(stderr, "kernel_launch: occupancy query says %d\n", per_cu); }
        (void)hipGetLastError();
        grid = cus;
    }
    if (grid < 0) return;
    if (hipMemsetAsync((char*)d_ws + WS_CTL, 0, CTL_ZERO_BYTES, stream) != hipSuccess) { fprintf(stderr, "kernel_launch: memset failed\n"); return; }
    Args a{};
    for (int i = 0; i < N_IN; ++i) a.in[i] = d_in[i];
    a.out = (float*)d_out; a.ws = (unsigned char*)d_ws;
#if MK_SPLIT
    for (int p = 0; p < N_PHASES; ++p) { a.ph_lo = p; a.ph_hi = p + 1; hipLaunchKernelGGL(hymba_fwd, dim3(grid), dim3(NTHR), LDS_BYTES, stream, a); }
#else
    a.ph_lo = 0; a.ph_hi = N_PHASES;
    hipLaunchKernelGGL(hymba_fwd, dim3(grid), dim3(NTHR), LDS_BYTES, stream, a);
#endif
    const hipError_t le = hipPeekAtLastError();
    if (le != hipSuccess) fprintf(stderr, "kernel_launch: launch failed: %s\n", hipGetErrorName(le));
}
```

```cpp
#include <hip/hip_runtime.h>
#include <cstdio>
#include <cstdint>

#ifndef MK_SPLIT
#define MK_SPLIT 0
#endif

namespace pg8 {
#define PG8_LAS __attribute__((address_space(3)))
typedef unsigned short bf16_t;
typedef short bf16x8 __attribute__((ext_vector_type(8)));
typedef float f32x4 __attribute__((ext_vector_type(4)));
typedef unsigned u32x4 __attribute__((ext_vector_type(4)));
constexpr int BM = 256, BK = 64, HALF = 128, HTB = HALF * BK * 2, STAGE_BYTES = 8 * HTB, NXCD = 8, WGM = 8;

__host__ __device__ __forceinline__ int lds_byte(int r, int c) { const int st = (r >> 4) * 2 + (c >> 5), rr = r & 15, cc = c & 31, ob = rr * 64 + cc * 2; return st * 1024 + (ob ^ (((ob >> 9) & 1) << 5)); }
__host__ __device__ __forceinline__ void stage_rc(int b, int& R, int& C) { const int st = b / 1024, sb = b % 1024, swz = sb ^ (((sb >> 9) & 1) << 5); R = (st >> 1) * 16 + swz / 64; C = (st & 1) * 32 + (swz % 64) / 2; }

struct Unit { int pm, pn, koff; };
struct Gemm { const bf16_t* A; const bf16_t* Bt; int M, N, K, ld; };

struct StaticOrder {
    int nM, nN, nwg, G, c;
    __host__ __device__ void init(int M, int N, int G_, int c_) { nM = M / BM; nN = N / BM; nwg = nM * nN; G = G_; c = c_; }
    __host__ __device__ bool next(int i, Unit& u) const {
        const long L = (long)i * G + c; if (L >= nwg) return false;
        int wgid = (int)L; { const int q = nwg / NXCD, r = nwg % NXCD, xcd = wgid % NXCD, off = wgid / NXCD; wgid = (xcd < r ? xcd * (q + 1) : r * (q + 1) + (xcd - r) * q) + off; }
        const int nig = WGM * nN, gid = wgid / nig, fm = gid * WGM, gsz = (nM - fm) < WGM ? (nM - fm) : WGM;
        u.pm = fm + ((wgid % nig) % gsz); u.pn = (wgid % nig) / gsz; u.koff = 0; return true;
    }
    __device__ __forceinline__ void a_ready(const Unit&) const {}
    __device__ __forceinline__ void done(const Unit&) const {}
};

struct ListOrder {
    int G, c, mode;
    __device__ __forceinline__ bool next(int i, Unit& u) const {
        const int L = i * G + c;
        if (mode == 0) { if (L >= 260) return false; const int q = L & 3, uu = L >> 2; if (uu < 33) { u.pm = 32; u.pn = uu; } else { u.pm = uu - 33; u.pn = 32; } u.koff = q * 512; return true; }
        if (mode == 1) { if (L >= 64) return false; const int q = L & 3, uu = L >> 2; u.pm = uu >> 2; u.pn = uu & 3; u.koff = q * 512; return true; }
        if (L >= 64) return false; u.pm = 32; u.pn = L >> 3; u.koff = (L & 7) * 256; return true;
    }
    __device__ __forceinline__ void a_ready(const Unit&) const {}
    __device__ __forceinline__ void done(const Unit&) const {}
};
template <class Epi, class Sched, bool ALIGN_EPI = false, bool SP2 = false>
__device__ __forceinline__ void gemm_phase(PG8_LAS unsigned char* lds, const Gemm g, const Sched& S, const Epi& E) {
    const int tid = threadIdx.x, wid = __builtin_amdgcn_readfirstlane(tid >> 6), lane = tid & 63, wr = wid >> 2, wc = wid & 3, fr = lane & 15, fq = lane >> 4;
    const int K = g.K, nt = K / BK;
    unsigned voffA[2], voffB[2];
    const int ld = g.ld;
#pragma unroll
    for (int i = 0; i < 2; ++i) { int R, C; stage_rc(tid * 16 + i * 8192, R, C); voffA[i] = (unsigned)(R * ld + C) * 2u; voffB[i] = (unsigned)(R * ld + C) * 2u; }
    const size_t kstep = (size_t)(BK * 2);
    const size_t hstep = (size_t)HALF * ld * 2;
    const size_t tstep = 2 * hstep;
    const unsigned ldsw = (unsigned)wid * 1024u;
    const int aoff = lds_byte(wr * 64 + fr, fq * 8), boff = lds_byte(wc * 32 + fr, fq * 8);
#define PG8_SA(b, h) (((b) * 2 + (h)) * HTB)
#define PG8_SB(b, h) ((4 + (b) * 2 + (h)) * HTB)
#define PG8_STAGE(bufoff, gbase, voff) do { _Pragma("unroll") for (int _i = 0; _i < 2; ++_i) \
        __builtin_amdgcn_global_load_lds((const unsigned*)((const char*)(gbase) + (voff)[_i]), (PG8_LAS unsigned*)(lds + (bufoff) + ldsw + _i * 8192), 16, 0, 0); } while (0)
#define PG8_LDA(dst, b, h) do { _Pragma("unroll") for (int m = 0; m < 4; ++m) _Pragma("unroll") for (int k = 0; k < 2; ++k) dst[m][k] = *(const PG8_LAS bf16x8*)(lds + PG8_SA(b, h) + aoff + m * 2048 + k * 1024); } while (0)
#define PG8_LDB(dst, b, h) do { _Pragma("unroll") for (int n = 0; n < 2; ++n) _Pragma("unroll") for (int k = 0; k < 2; ++k) dst[n][k] = *(const PG8_LAS bf16x8*)(lds + PG8_SB(b, h) + boff + n * 2048 + k * 1024); } while (0)
#define PG8_MMA(ai, bj, At, Bt) do { __builtin_amdgcn_s_setprio(1); _Pragma("unroll") for (int m = 0; m < 4; ++m) _Pragma("unroll") for (int n = 0; n < 2; ++n) _Pragma("unroll") for (int k = 0; k < 2; ++k) \
        acc[ai][bj][m][n] = __builtin_amdgcn_mfma_f32_16x16x32_bf16(Bt[n][k], At[m][k], acc[ai][bj][m][n], 0, 0, 0); __builtin_amdgcn_s_setprio(0); } while (0)
#define PG8_WAIT_V(n) asm volatile("s_waitcnt vmcnt(" #n ")" ::: "memory")
#define PG8_WAIT_L(n) asm volatile("s_waitcnt lgkmcnt(" #n ")" ::: "memory")
#define PG8_BAR __builtin_amdgcn_s_barrier()
#define PG8_SCHED __builtin_amdgcn_sched_barrier(0)
    Unit cur, nxt; int ui = 0;
    if (!S.next(0, cur)) return;
    f32x4 acc[2][2][4][2];
#pragma unroll
    for (int a = 0; a < 2; ++a)
#pragma unroll
        for (int b = 0; b < 2; ++b)
#pragma unroll
            for (int m = 0; m < 4; ++m)
#pragma unroll
                for (int n = 0; n < 2; ++n) acc[a][b][m][n] = (f32x4){0.f, 0.f, 0.f, 0.f};
    bf16x8 At[4][2], B0[2][2], B1[2][2];
    const char* cA = (const char*)g.A + (size_t)cur.pm * tstep + (size_t)cur.koff * 2; const char* cB = (const char*)g.Bt + (size_t)cur.pn * tstep + (size_t)cur.koff * 2;
    S.a_ready(cur);
    if constexpr (SP2) {
        PG8_STAGE(PG8_SB(0, 0), cB, voffB); PG8_STAGE(PG8_SB(0, 1), cB + hstep, voffB); PG8_STAGE(PG8_SA(0, 0), cA, voffA); PG8_STAGE(PG8_SA(0, 1), cA + hstep, voffA);
        if (wr == 1) PG8_BAR;
        PG8_WAIT_V(2); PG8_BAR;
        PG8_STAGE(PG8_SB(1, 0), cB + kstep, voffB); PG8_STAGE(PG8_SA(1, 0), cA + kstep, voffA); PG8_STAGE(PG8_SB(1, 1), cB + hstep + kstep, voffB);
        PG8_WAIT_V(6); PG8_BAR;
    } else {
        PG8_STAGE(PG8_SB(0, 0), cB, voffB); PG8_STAGE(PG8_SA(0, 0), cA, voffA); PG8_STAGE(PG8_SB(0, 1), cB + hstep, voffB); PG8_STAGE(PG8_SA(0, 1), cA + hstep, voffA);
        if (wr == 1) PG8_BAR;
        PG8_WAIT_V(4); PG8_BAR;
        PG8_STAGE(PG8_SB(1, 0), cB + kstep, voffB); PG8_STAGE(PG8_SA(1, 0), cA + kstep, voffA); PG8_STAGE(PG8_SB(1, 1), cB + hstep + kstep, voffB);
        PG8_WAIT_V(6); PG8_BAR;
    }
    for (;;) {
        const bool has_next = S.next(ui + 1, nxt);
        const char* nA = has_next ? (const char*)g.A + (size_t)nxt.pm * tstep + (size_t)nxt.koff * 2 : cA; const char* nB = has_next ? (const char*)g.Bt + (size_t)nxt.pn * tstep + (size_t)nxt.koff * 2 : cB;
        for (int t = 0; t < nt; t += 2) {
            const bool last = (t == nt - 2);
            const char* a1 = cA + (size_t)(t + 1) * kstep;
            const char* a2 = last ? nA : cA + (size_t)(t + 2) * kstep; const char* b2 = last ? nB : cB + (size_t)(t + 2) * kstep;
            const char* a3 = a2 + kstep; const char* b3 = b2 + kstep;
            if (last && has_next) S.a_ready(nxt);
            if constexpr (SP2) {
            PG8_LDB(B0, 0, 0); PG8_LDB(B1, 0, 1); PG8_SCHED; PG8_LDA(At, 0, 0); PG8_STAGE(PG8_SA(1, 1), a1 + hstep, voffA);
            PG8_WAIT_V(8); PG8_WAIT_L(0); PG8_BAR; PG8_MMA(0, 0, At, B0); PG8_MMA(0, 1, At, B1); PG8_BAR; PG8_SCHED;
            PG8_LDA(At, 0, 1); PG8_STAGE(PG8_SB(0, 0), b2, voffB); PG8_STAGE(PG8_SB(0, 1), b2 + hstep, voffB); PG8_STAGE(PG8_SA(0, 0), a2, voffA);
            PG8_WAIT_V(8); PG8_WAIT_L(0); PG8_BAR; PG8_MMA(1, 0, At, B0); PG8_MMA(1, 1, At, B1); PG8_BAR; PG8_SCHED;
            PG8_LDB(B0, 1, 0); PG8_LDB(B1, 1, 1); PG8_SCHED; PG8_LDA(At, 1, 0); PG8_STAGE(PG8_SA(0, 1), a2 + hstep, voffA);
            PG8_WAIT_V(8); PG8_WAIT_L(0); PG8_BAR; PG8_MMA(0, 0, At, B0); PG8_MMA(0, 1, At, B1); PG8_BAR; PG8_SCHED;
            PG8_LDA(At, 1, 1); PG8_STAGE(PG8_SB(1, 0), b3, voffB); PG8_STAGE(PG8_SB(1, 1), b3 + hstep, voffB); PG8_STAGE(PG8_SA(1, 0), a3, voffA);
            PG8_WAIT_V(8); PG8_WAIT_L(0); PG8_BAR; PG8_MMA(1, 0, At, B0); PG8_MMA(1, 1, At, B1); PG8_BAR; PG8_SCHED;
            } else {
            PG8_LDB(B0, 0, 0); PG8_SCHED; PG8_LDA(At, 0, 0); PG8_STAGE(PG8_SA(1, 1), a1 + hstep, voffA);
            PG8_WAIT_L(8); PG8_BAR; PG8_WAIT_L(0); PG8_MMA(0, 0, At, B0); PG8_BAR; PG8_SCHED;
            PG8_LDB(B1, 0, 1); PG8_STAGE(PG8_SB(0, 0), b2, voffB);
            PG8_BAR; PG8_WAIT_L(0); PG8_MMA(0, 1, At, B1); PG8_BAR;
            PG8_LDA(At, 0, 1); PG8_STAGE(PG8_SA(0, 0), a2, voffA);
            PG8_BAR; PG8_WAIT_L(0); PG8_MMA(1, 0, At, B0); PG8_BAR; PG8_SCHED;
            PG8_STAGE(PG8_SB(0, 1), b2 + hstep, voffB);
            PG8_WAIT_V(6); PG8_BAR; PG8_MMA(1, 1, At, B1); PG8_BAR;
            PG8_LDB(B0, 1, 0); PG8_SCHED; PG8_LDA(At, 1, 0); PG8_STAGE(PG8_SA(0, 1), a2 + hstep, voffA);
            PG8_WAIT_L(8); PG8_BAR; PG8_WAIT_L(0); PG8_MMA(0, 0, At, B0); PG8_BAR; PG8_SCHED;
            PG8_LDB(B1, 1, 1); PG8_STAGE(PG8_SB(1, 0), b3, voffB);
            PG8_BAR; PG8_WAIT_L(0); PG8_MMA(0, 1, At, B1); PG8_BAR;
            PG8_LDA(At, 1, 1); PG8_STAGE(PG8_SA(1, 0), a3, voffA);
            PG8_BAR; PG8_WAIT_L(0); PG8_MMA(1, 0, At, B0); PG8_BAR; PG8_SCHED;
            PG8_STAGE(PG8_SB(1, 1), b3 + hstep, voffB);
            PG8_WAIT_V(6); PG8_BAR; PG8_MMA(1, 1, At, B1); PG8_BAR;
            }
        }
        if constexpr (ALIGN_EPI) { if (wr == 0) PG8_BAR; }
        E(acc, cur, wr, wc, fr, fq); S.done(cur);
        if (!has_next) break;
#pragma unroll
        for (int a = 0; a < 2; ++a)
#pragma unroll
            for (int b = 0; b < 2; ++b)
#pragma unroll
                for (int m = 0; m < 4; ++m)
#pragma unroll
                    for (int n = 0; n < 2; ++n) acc[a][b][m][n] = (f32x4){0.f, 0.f, 0.f, 0.f};
        cur = nxt; cA = nA; cB = nB; ++ui;
        if constexpr (ALIGN_EPI) { if (wr == 1) PG8_BAR; }
    }
    PG8_WAIT_V(0);
    if constexpr (!ALIGN_EPI) { if (wr == 0) PG8_BAR; }
    PG8_BAR;
#undef PG8_SA
#undef PG8_SB
#undef PG8_STAGE
#undef PG8_LDA
#undef PG8_LDB
#undef PG8_MMA
#undef PG8_WAIT_V
#undef PG8_WAIT_L
#undef PG8_BAR
#undef PG8_SCHED
}
}

constexpr int NWAVES = 8, NTHR = 512;
constexpr int DM = 2048, NB = 4, SEQ = 2048, DB = 32, DT = 4, PAST = 8192, PAGE = 128, NPAGES = 64;
constexpr int NTOKP = NB * SEQ;
constexpr int NTOKS = DB * DT;
constexpr int NTOK = NTOKP + NTOKS;
constexpr int MPAD = 8448;
constexpr int INW = 8400, INWP = 8448;
constexpr int RW = 1024, RH = 16, RD = 64, SHW = 3200;
constexpr int C_R = 0, C_K = 1024, C_V = 2048, C_CW = 3072, C_CA = 3136, C_GR = 3200, C_Q = 4224, C_AK = 4736, C_AV = 5248, C_GA = 5760, C_QI = 6272, C_WI = 7296, C_KI = 7312, C_QM = 7376, C_GM = 7888;
constexpr int MEMT = 256;
constexpr int TOPK = 256;
constexpr int SCS_LD = 8256;
constexpr float RMS_EPS = 1e-6f, GN_EPS = 64e-5f;
constexpr float QSCALE = 0.08838834764831845f * 1.4426950408889634f;
constexpr size_t O_YP = 0, O_YS = 16777216, O_WKVP = 17039360, O_SHP = 17301504, O_KP = 17314304, O_VP = 21508608, O_KIP = 25702912, O_MKP = 26227200, O_MVP = 26751488,
                 O_WKVS = 27275776, O_SHS = 29372928, O_KS = 29475328, O_VS = 29540864, O_KIS = 29606400, O_END = 29614592;
enum { I_XP = 0, I_XS, I_SWKV, I_SSH, I_CK, I_CV, I_CKI, I_CMK, I_CMV, I_PT, I_MEM, I_NW, I_WIN, I_MU, I_W0, I_W2, I_A0, I_A2, I_KK, I_KA, I_RK, I_GNW, I_GNB, I_MNW, I_WMEM, I_WOUT, I_FNW, N_IN };

constexpr size_t MiB = 1u << 20;
constexpr size_t al1m(size_t x) { return (x + MiB - 1) / MiB * MiB; }
constexpr size_t WS_CTL = 0, CTL_ZERO_BYTES = 1 * MiB;
constexpr size_t WS_WINT = 1 * MiB;
constexpr size_t WS_WOUTT = WS_WINT + al1m((size_t)INWP * DM * 2);
constexpr size_t WS_WMEMT = WS_WOUTT + al1m((size_t)DM * DM * 2);
constexpr size_t WS_W2T = WS_WMEMT + al1m((size_t)1024 * DM * 2);
constexpr size_t WS_A2T = WS_W2T + al1m((size_t)1024 * 64 * 2);
constexpr size_t WS_ROPE128 = WS_A2T + al1m((size_t)1024 * 64 * 2);
constexpr size_t WS_ROPE64 = WS_ROPE128 + al1m((size_t)2052 * 64 * 8);
constexpr size_t WS_XN = WS_ROPE64 + al1m((size_t)2052 * 32 * 8);
constexpr size_t WS_XM = WS_XN + al1m((size_t)MPAD * DM * 2);
constexpr size_t WS_PROJ = WS_XM + al1m((size_t)1024 * DM * 2);
constexpr size_t WS_SCANIN = WS_PROJ + al1m((size_t)MPAD * INWP * 4);
constexpr size_t WS_SCAL = WS_SCANIN + al1m((size_t)NTOK * RH * 384 * 4);
constexpr size_t WS_Y = WS_SCAL + al1m((size_t)NTOK * RH * 16 * 4 + 65536);
constexpr size_t WS_QB = WS_Y + al1m((size_t)NTOK * RW * 4);
constexpr size_t WS_KB = WS_QB + al1m((size_t)NTOK * 512 * 2);
constexpr size_t WS_VT = WS_KB + al1m((size_t)NTOK * 512 * 2);
constexpr size_t WS_QIB = WS_VT + al1m((size_t)NB * 4 * 128 * SEQ * 2);
constexpr size_t WS_KIB = WS_QIB + al1m((size_t)NTOK * 1024 * 2);
constexpr size_t WS_WIS = WS_KIB + al1m((size_t)NTOK * 64 * 2);
constexpr size_t WS_QMB = WS_WIS + al1m((size_t)NTOK * 16 * 4);
constexpr size_t WS_MKB = WS_QMB + al1m((size_t)NTOK * 512 * 2);
constexpr size_t WS_MVT = WS_MKB + al1m((size_t)1024 * 512 * 2);
constexpr size_t WS_SC = WS_MVT + al1m((size_t)1024 * 512 * 2);
constexpr size_t WS_SCS = WS_SC + al1m((size_t)NTOKP * SEQ * 4);
constexpr size_t WS_THR = WS_SCS + al1m((size_t)NTOKS * SCS_LD * 4);
constexpr size_t WS_IDX = WS_THR + al1m((size_t)NTOK * 8);
constexpr size_t WS_YMIX = WS_IDX + al1m((size_t)NTOKS * TOPK * 4);
constexpr size_t WS_END = WS_YMIX + al1m((size_t)MPAD * DM * 2);
constexpr int CW_BAR = 4096;

constexpr int RING_OFF = 0, RING_BYTES = 131072;
constexpr int LDSCTL_OFF = 159744, MISC_OFF = LDSCTL_OFF + 320;
constexpr int LDS_BYTES = 163840;

#define GAS __attribute__((address_space(1)))
#define LAS __attribute__((address_space(3)))
typedef unsigned short bf16;
typedef unsigned v4u __attribute__((ext_vector_type(4)));
typedef unsigned v2u __attribute__((ext_vector_type(2)));
typedef float f32x4 __attribute__((ext_vector_type(4)));
typedef float f32x2 __attribute__((ext_vector_type(2)));
typedef float f32x16 __attribute__((ext_vector_type(16)));
typedef short bf16x8 __attribute__((ext_vector_type(8)));
typedef short bf16x4 __attribute__((ext_vector_type(4)));
#define LDS_WAIT() asm volatile("s_waitcnt lgkmcnt(0)" ::: "memory")
#define VM_WAIT() asm volatile("s_waitcnt vmcnt(0)" ::: "memory")
__device__ __forceinline__ unsigned cvt_pk_bf16(float lo, float hi) { unsigned r; asm volatile("v_cvt_pk_bf16_f32 %0, %1, %2" : "=v"(r) : "v"(lo), "v"(hi)); return r; }
__device__ __forceinline__ float bf2f(unsigned short b) { return __uint_as_float(((unsigned)b) << 16); }
template <int CTRL> __device__ __forceinline__ float dpp(float x) { return __builtin_bit_cast(float, __builtin_amdgcn_mov_dpp(__builtin_bit_cast(int, x), CTRL, 0xf, 0xf, true)); }
__device__ __forceinline__ float row16_sum(float x) {
    x += dpp<0xB1>(x); x += dpp<0x4E>(x); x += dpp<0x141>(x); x += dpp<0x140>(x); return x;
}
__device__ __forceinline__ float wave_sum(float v) {
#pragma unroll
    for (int o = 1; o < 64; o <<= 1) v += __shfl_xor(v, o);
    return v;
}
__device__ __forceinline__ float xhalf_max(float x) { auto rr = __builtin_amdgcn_permlane32_swap(__float_as_uint(x), __float_as_uint(x), false, false); return fmaxf(__uint_as_float(rr[0]), __uint_as_float(rr[1])); }
__device__ __forceinline__ float xhalf_sum(float x) { auto rr = __builtin_amdgcn_permlane32_swap(__float_as_uint(x), __float_as_uint(x), false, false); return __uint_as_float(rr[0]) + __uint_as_float(rr[1]); }
__device__ __forceinline__ unsigned sort_key(float f) { const unsigned u = __float_as_uint(f); return (u & 0x80000000u) ? ~u : (u | 0x80000000u); }
__device__ __forceinline__ float silu(float g) { return g / (1.f + __expf(-g)); }

#define XB_TMO      128
#define XB_XCNT(j)  (256  + 64 * (j))
#define XB_XSUB(j)  (1280 + 64 * (j))
#define XB_XGEN(j)  (2304 + 64 * (j))
#define XB_TOP      3328
#define XB_TOPGEN   3392
#define XCD_BAR_WORDS 3456
#define XB_SPIN_CAP (1u << 18)
__device__ __forceinline__ unsigned xb_ld(unsigned* p)              { return __hip_atomic_load(p, __ATOMIC_RELAXED, __HIP_MEMORY_SCOPE_AGENT); }
__device__ __forceinline__ unsigned xb_add(unsigned* p, unsigned v) { return __hip_atomic_fetch_add(p, v, __ATOMIC_RELAXED, __HIP_MEMORY_SCOPE_AGENT); }
__device__ __forceinline__ unsigned xb_xcc_id() { return (unsigned)__builtin_amdgcn_s_getreg((3 << 11) | 20) & 0xFu; }
#define XB_SPIN(cond, bar) do { unsigned _sp = 0; while (cond) { __builtin_amdgcn_s_sleep(1); \
    if ((++_sp & 255u) == 0u) { if (xb_ld(&(bar)[XB_TMO])) break; if (_sp > XB_SPIN_CAP) { atomicAdd(&(bar)[XB_TMO], 1u); break; } } } } while (0)
struct XcdBarrier { unsigned* bar; unsigned x; volatile LAS unsigned* st; };
__device__ __forceinline__ XcdBarrier xcd_barrier_post(unsigned* bar, volatile LAS unsigned* st) {
    XcdBarrier b; b.bar = bar; b.x = xb_xcc_id(); b.st = st;
    if (threadIdx.x == 0) (void)xb_add(&bar[XB_XCNT(b.x)], 1u);
    return b;
}
__device__ __forceinline__ void xcd_barrier_complete(unsigned* bar, unsigned x, unsigned& nloc, unsigned& nx) {
    const unsigned G = gridDim.x * gridDim.y * gridDim.z;
    unsigned sum, cnt, mine, sp = 0u;
    for (;;) {
        sum = 0u; cnt = 0u; mine = 0u;
#pragma unroll
        for (unsigned j = 0; j < 16; ++j) { const unsigned c = xb_ld(&bar[XB_XCNT(j)]); sum += c; cnt += (c > 0u) ? 1u : 0u; mine = (j == x) ? c : mine; }
        if (sum == G) break;
        __builtin_amdgcn_s_sleep(1);
        if ((++sp & 255u) == 0u) { if (xb_ld(&bar[XB_TMO])) break; if (sp > XB_SPIN_CAP) { atomicAdd(&bar[XB_TMO], 1u); break; } }
    }
    nloc = mine > 0u ? mine : 1u; nx = cnt > 0u ? cnt : 1u;
}
__device__ __forceinline__ void xcd_barrier(const XcdBarrier& b) {
    asm volatile("s_waitcnt vmcnt(0)" ::: "memory");
    __syncthreads();
    if (threadIdx.x == 0) {
        unsigned* bar = b.bar;
        __builtin_amdgcn_s_waitcnt(0);
        unsigned nloc = b.st[0], nx = b.st[1];
        if (nloc == 0u) { xcd_barrier_complete(bar, b.x, nloc, nx); b.st[0] = nloc; b.st[1] = nx; }
        const unsigned old = xb_add(&bar[XB_XSUB(b.x)], 1u);
        const unsigned gen = old / nloc;
        if (old + 1u == (gen + 1u) * nloc) {
            __builtin_amdgcn_fence(__ATOMIC_RELEASE, "agent");
            asm volatile("s_waitcnt vmcnt(0)" ::: "memory");
            const unsigned og = xb_add(&bar[XB_TOP], 1u);
            const unsigned tg = og / nx;
            if (og + 1u == (tg + 1u) * nx) xb_add(&bar[XB_TOPGEN], 1u);
            else XB_SPIN(xb_ld(&bar[XB_TOPGEN]) == tg, bar);
            __builtin_amdgcn_fence(__ATOMIC_ACQUIRE, "agent");
            xb_add(&bar[XB_XGEN(b.x)], 1u);
            asm volatile("s_waitcnt vmcnt(0)" ::: "memory");
        } else {
            XB_SPIN(xb_ld(&bar[XB_XGEN(b.x)]) == gen, bar);
            __builtin_amdgcn_fence(__ATOMIC_ACQUIRE, "agent");
            asm volatile("s_waitcnt vmcnt(0)" ::: "memory");
        }
    }
    __syncthreads();
}

struct Frame {
    LAS unsigned char* lds;
    int tid, lane, wave, G, bid;
    const float* in[N_IN];
    float* out;
    unsigned char* ws;
};
#define WSP(T, off) ((T*)(F.ws + (off)))

__device__ __forceinline__ void p0_transpose_item(const float* W, int K, int N, int Npad, bf16* WT, LAS float* scr, int item, int lane) {
    const int nblk = Npad / 32, kb = item / nblk, nb = item % nblk, k0 = 64 * kb, n0 = 32 * nb;
    const int nn = n0 + (lane & 31);
    float tv[32];
#pragma unroll
    for (int i = 0; i < 32; ++i) { const int kk = 2 * i + (lane >> 5); tv[i] = (nn < N) ? W[(size_t)(k0 + kk) * N + nn] : 0.f; }
#pragma unroll
    for (int i = 0; i < 32; ++i) { const int kk = 2 * i + (lane >> 5); scr[kk * 33 + (lane & 31)] = tv[i]; }
    LDS_WAIT(); asm volatile("" ::: "memory");
    const int c = lane & 7;
#pragma unroll
    for (int j = 0; j < 4; ++j) { const int n = (lane >> 3) + 8 * j; const LAS float* s = scr + (8 * c) * 33 + n;
        v4u o; o.x = cvt_pk_bf16(s[0 * 33], s[1 * 33]); o.y = cvt_pk_bf16(s[2 * 33], s[3 * 33]); o.z = cvt_pk_bf16(s[4 * 33], s[5 * 33]); o.w = cvt_pk_bf16(s[6 * 33], s[7 * 33]);
        *(v4u*)(WT + (size_t)(n0 + n) * K + k0 + 8 * c) = o; }
    LDS_WAIT(); asm volatile("" ::: "memory");
}
__device__ __forceinline__ void rms_row_to_bf16(const float* xrow, const float* w, bf16* orow, int lane) {
    const f32x4* xr = (const f32x4*)xrow + lane; const f32x4* wr = (const f32x4*)w + lane;
    f32x4 v[8]; float s = 0.f;
#pragma unroll
    for (int j = 0; j < 8; ++j) { v[j] = xr[64 * j]; s += (v[j].x * v[j].x + v[j].y * v[j].y) + (v[j].z * v[j].z + v[j].w * v[j].w); }
    const float rs = 1.f / sqrtf(wave_sum(s) * (1.f / DM) + RMS_EPS);
    v2u* o8 = (v2u*)orow + lane;
#pragma unroll
    for (int j = 0; j < 8; ++j) { const f32x4 ww = wr[64 * j]; v2u o; o.x = cvt_pk_bf16(v[j].x * rs * ww.x, v[j].y * rs * ww.y); o.y = cvt_pk_bf16(v[j].z * rs * ww.z, v[j].w * rs * ww.w); o8[64 * j] = o; }
}
__device__ __forceinline__ void rope_cs(int pos, int i, double ratio, float& c, float& s) {
    double f = 1.0, b = ratio; int e = i;
    while (e) { if (e & 1) f *= b; b *= b; e >>= 1; }
    const double th = (double)pos * f;
    const double TWO_OVER_PI = 0.63661977236758134308, PIO2_HI = 1.57079632679489655800e+00, PIO2_LO = 6.12323399573676603587e-17;
    const double kq = rint(th * TWO_OVER_PI);
    double r = fma(-kq, PIO2_HI, th); r = fma(-kq, PIO2_LO, r);
    const int q = ((int)kq) & 3;
    const double z = r * r;
    const double sp = r + r * z * (-1.66666666666666324348e-01 + z * (8.33333333332248946124e-03 + z * (-1.98412698298579493134e-04 + z * (2.75573137070700676789e-06 + z * (-2.50507602534068634195e-08 + z * 1.58969099521155010221e-10)))));
    const double cp = 1.0 - 0.5 * z + z * z * (4.16666666666666019037e-02 + z * (-1.38888888888741095749e-03 + z * (2.48015872894767294178e-05 + z * (-2.75573143513906633035e-07 + z * (2.08757232129817482790e-09 + z * -1.13596475577881948265e-11)))));
    double cc, ss;
    if (q == 0) { cc = cp; ss = sp; } else if (q == 1) { cc = -sp; ss = cp; } else if (q == 2) { cc = -cp; ss = -sp; } else { cc = sp; ss = -cp; }
    c = (float)cc; s = (float)ss;
}
__device__ __forceinline__ void p0_prologue(Frame& F) {
    LAS float* scr = (LAS float*)(F.lds + RING_OFF + F.wave * 16384);
    const int gw = F.bid * NWAVES + F.wave, NGW = F.G * NWAVES;
    constexpr int T_IN = (DM / 64) * (INWP / 32), T_OUT = (DM / 64) * (DM / 32), T_MEM = (DM / 64) * (1024 / 32), T_L = 1024 / 32;
    constexpr int NITEMS = T_IN + T_OUT + T_MEM + 2 * T_L;
    for (int it = gw; it < NITEMS; it += NGW) {
        int r = it;
        if (r < T_IN) { p0_transpose_item(F.in[I_WIN], DM, INW, INWP, WSP(bf16, WS_WINT), scr, r, F.lane); continue; } r -= T_IN;
        if (r < T_OUT) { p0_transpose_item(F.in[I_WOUT], DM, DM, DM, WSP(bf16, WS_WOUTT), scr, r, F.lane); continue; } r -= T_OUT;
        if (r < T_MEM) { p0_transpose_item(F.in[I_WMEM], DM, 1024, 1024, WSP(bf16, WS_WMEMT), scr, r, F.lane); continue; } r -= T_MEM;
        if (r < T_L) { p0_transpose_item(F.in[I_W2], 64, 1024, 1024, WSP(bf16, WS_W2T), scr, r, F.lane); continue; } r -= T_L;
        p0_transpose_item(F.in[I_A2], 64, 1024, 1024, WSP(bf16, WS_A2T), scr, r, F.lane);
    }
    for (int m = gw; m < MPAD + 1024; m += NGW) {
        if (m < NTOKP) rms_row_to_bf16(F.in[I_XP] + (size_t)m * DM, F.in[I_NW], WSP(bf16, WS_XN) + (size_t)m * DM, F.lane);
        else if (m < NTOK) rms_row_to_bf16(F.in[I_XS] + (size_t)(m - NTOKP) * DM, F.in[I_NW], WSP(bf16, WS_XN) + (size_t)m * DM, F.lane);
        else if (m < MPAD) { v4u z = {0u, 0u, 0u, 0u}; v4u* o = (v4u*)(WSP(bf16, WS_XN) + (size_t)m * DM) + F.lane;
#pragma unroll
            for (int j = 0; j < 4; ++j) o[64 * j] = z; }
        else rms_row_to_bf16(F.in[I_MEM] + (size_t)(m - MPAD) * DM, F.in[I_MNW], WSP(bf16, WS_XM) + (size_t)(m - MPAD) * DM, F.lane);
    }
    const int gt = F.bid * NTHR + F.tid, NGT = F.G * NTHR;
    for (int e = gt; e < 2052 * 96; e += NGT) {
        const int p = e / 96, i = e % 96; const int pos = p < 2048 ? p : PAST + (p - 2048);
        float c, s;
        if (i < 64) { rope_cs(pos, i, 0.8659643233600653, c, s); WSP(f32x2, WS_ROPE128)[p * 64 + i] = (f32x2){c, s}; }
        else { rope_cs(pos, i - 64, 0.7498942093324559, c, s); WSP(f32x2, WS_ROPE64)[p * 32 + (i - 64)] = (f32x2){c, s}; }
    }
}

struct EpiProj {
    float* C;
    __device__ __forceinline__ void operator()(const f32x4 (&acc)[2][2][4][2], const pg8::Unit& u, int wr, int wc, int fr, int fq) const {
        const int row0 = u.pm * 256 + wr * 64 + fr, col0 = u.pn * 256 + wc * 32 + 4 * fq;
#pragma unroll
        for (int ai = 0; ai < 2; ++ai)
#pragma unroll
            for (int m = 0; m < 4; ++m) { float* rowp = C + (size_t)(row0 + ai * 128 + m * 16) * INWP + col0;
#pragma unroll
                for (int bj = 0; bj < 2; ++bj)
#pragma unroll
                    for (int n = 0; n < 2; ++n) *(f32x4*)(rowp + bj * 128 + n * 16) = acc[ai][bj][m][n]; }
    }
};
struct EpiMem {
    float* out;
    __device__ __forceinline__ void operator()(const f32x4 (&acc)[2][2][4][2], const pg8::Unit& u, int wr, int wc, int fr, int fq) const {
        const int row0 = u.pm * 256 + wr * 64 + fr; int colt = u.pn * 256;
        float* base = out + (colt < 512 ? O_MKP : O_MVP); if (colt >= 512) colt -= 512;
        const int col0 = colt + wc * 32 + 4 * fq;
#pragma unroll
        for (int ai = 0; ai < 2; ++ai)
#pragma unroll
            for (int m = 0; m < 4; ++m) { float* rowp = base + (size_t)(row0 + ai * 128 + m * 16) * 512 + col0;
#pragma unroll
                for (int bj = 0; bj < 2; ++bj)
#pragma unroll
                    for (int n = 0; n < 2; ++n) *(f32x4*)(rowp + bj * 128 + n * 16) = acc[ai][bj][m][n]; }
    }
};
__device__ __forceinline__ void atomic_add4(float* p, const f32x4& v) { unsafeAtomicAdd(p, v.x); unsafeAtomicAdd(p + 1, v.y); unsafeAtomicAdd(p + 2, v.z); unsafeAtomicAdd(p + 3, v.w); }
struct EpiProjAtomic {
    float* C;
    __device__ __forceinline__ void operator()(const f32x4 (&acc)[2][2][4][2], const pg8::Unit& u, int wr, int wc, int fr, int fq) const {
        const int row0 = u.pm * 256 + wr * 64 + fr, col0 = u.pn * 256 + wc * 32 + 4 * fq;
#pragma unroll
        for (int ai = 0; ai < 2; ++ai)
#pragma unroll
            for (int m = 0; m < 4; ++m) { const int row = row0 + ai * 128 + m * 16; float* rowp = C + (size_t)row * INWP + col0;
                if (row < NTOK) {
#pragma unroll
                    for (int bj = 0; bj < 2; ++bj)
#pragma unroll
                        for (int n = 0; n < 2; ++n) atomic_add4(rowp + bj * 128 + n * 16, acc[ai][bj][m][n]); } }
    }
};
struct EpiMemAtomic {
    float* out;
    __device__ __forceinline__ void operator()(const f32x4 (&acc)[2][2][4][2], const pg8::Unit& u, int wr, int wc, int fr, int fq) const {
        const int row0 = u.pm * 256 + wr * 64 + fr; int colt = u.pn * 256;
        float* base = out + (colt < 512 ? O_MKP : O_MVP); if (colt >= 512) colt -= 512;
        const int col0 = colt + wc * 32 + 4 * fq;
#pragma unroll
        for (int ai = 0; ai < 2; ++ai)
#pragma unroll
            for (int m = 0; m < 4; ++m) { float* rowp = base + (size_t)(row0 + ai * 128 + m * 16) * 512 + col0;
#pragma unroll
                for (int bj = 0; bj < 2; ++bj)
#pragma unroll
                    for (int n = 0; n < 2; ++n) atomic_add4(rowp + bj * 128 + n * 16, acc[ai][bj][m][n]); }
    }
};
struct EpiOutAtomic {
    float* out;
    __device__ __forceinline__ void operator()(const f32x4 (&acc)[2][2][4][2], const pg8::Unit& u, int wr, int wc, int fr, int fq) const {
        const int row0 = u.pm * 256 + wr * 64 + fr, col0 = u.pn * 256 + wc * 32 + 4 * fq;
#pragma unroll
        for (int ai = 0; ai < 2; ++ai)
#pragma unroll
            for (int m = 0; m < 4; ++m) { const int row = row0 + ai * 128 + m * 16;
                if (row >= NTOKP && row < NTOK) { float* orow = out + O_YS + (size_t)(row - NTOKP) * DM + col0;
#pragma unroll
                    for (int bj = 0; bj < 2; ++bj)
#pragma unroll
                        for (int n = 0; n < 2; ++n) atomic_add4(orow + bj * 128 + n * 16, acc[ai][bj][m][n]); } }
    }
};
struct EpiOut {
    const float* xp; const float* xs; float* out;
    __device__ __forceinline__ void operator()(const f32x4 (&acc)[2][2][4][2], const pg8::Unit& u, int wr, int wc, int fr, int fq) const {
        const int row0 = u.pm * 256 + wr * 64 + fr, col0 = u.pn * 256 + wc * 32 + 4 * fq;
#pragma unroll
        for (int ai = 0; ai < 2; ++ai)
#pragma unroll
            for (int m = 0; m < 4; ++m) { const int row = row0 + ai * 128 + m * 16;
                if (row < NTOK) {
                    const float* xr = (row < NTOKP ? xp + (size_t)row * DM : xs + (size_t)(row - NTOKP) * DM) + col0;
                    float* orow = out + (row < NTOKP ? O_YP + (size_t)row * DM : O_YS + (size_t)(row - NTOKP) * DM) + col0;
#pragma unroll
                    for (int bj = 0; bj < 2; ++bj)
#pragma unroll
                        for (int n = 0; n < 2; ++n) *(f32x4*)(orow + bj * 128 + n * 16) = acc[ai][bj][m][n] + *(const f32x4*)(xr + bj * 128 + n * 16); } }
    }
};

__device__ __forceinline__ float prev_val(const Frame& F, const float* P, int row, int col) {
    if (row < NTOKP) { return (row & (SEQ - 1)) == 0 ? 0.f : P[(size_t)(row - 1) * INWP + col]; }
    const int s = row - NTOKP; return (s & 3) == 0 ? F.in[I_SSH][(size_t)(s >> 2) * SHW + col] : P[(size_t)(row - 1) * INWP + col];
}
__device__ __forceinline__ size_t scan_seq_off(int row, int h) {
    if (row < NTOKP) { const int b = row >> 11, t = row & 2047; return ((size_t)(b * RH + h) * SEQ + t); }
    const int s = row - NTOKP, db = s >> 2, t = s & 3; return (size_t)NB * RH * SEQ + ((size_t)(db * RH + h) * DT + t);
}
__device__ __forceinline__ size_t kf_off(int NT, int h, int s, int dim) { return ((size_t)((h * NT + (s >> 5)) * 8 + (dim >> 4))) * 512 + (((dim >> 3) & 1) * 32 + (s & 31)) * 8 + (dim & 7); }
__device__ __forceinline__ size_t kif_off(int s, int dim) { return ((size_t)((s >> 5) * 4 + (dim >> 4))) * 512 + (((dim >> 3) & 1) * 32 + (s & 31)) * 8 + (dim & 7); }
__device__ __forceinline__ f32x4 ld4(const float* p) { return *(const f32x4*)p; }
__device__ __forceinline__ f32x4 prev4(const Frame& F, const float* P, int row, int col) {
    if (row < NTOKP) { if ((row & (SEQ - 1)) == 0) return (f32x4){0.f, 0.f, 0.f, 0.f}; return ld4(P + (size_t)(row - 1) * INWP + col); }
    const int s = row - NTOKP; if ((s & 3) == 0) return ld4(F.in[I_SSH] + (size_t)(s >> 2) * SHW + col); return ld4(P + (size_t)(row - 1) * INWP + col);
}
__device__ __forceinline__ void p2_rwkv_witem(Frame& F, int tile, int h0, int nh) {
    const float* P = WSP(float, WS_PROJ);
    const int row0 = tile * 16;
    const int lane = F.lane, tk = lane & 15, kq = lane >> 4, row = row0 + tk;
    const float* mu = F.in[I_MU];
    bf16x8 bw[2], ba[2];
#pragma unroll
    for (int ks = 0; ks < 2; ++ks) {
        const int c0 = 32 * ks + 8 * kq;
        float xw[8], xa[8];
#pragma unroll
        for (int hf = 0; hf < 2; ++hf) {
            const f32x4 cw = ld4(P + (size_t)row * INWP + C_CW + c0 + 4 * hf), pw = prev4(F, P, row, C_CW + c0 + 4 * hf), mw = ld4(mu + C_CW + c0 + 4 * hf);
            const f32x4 ca = ld4(P + (size_t)row * INWP + C_CA + c0 + 4 * hf), pa = prev4(F, P, row, C_CA + c0 + 4 * hf), ma = ld4(mu + C_CA + c0 + 4 * hf);
#pragma unroll
            for (int e = 0; e < 4; ++e) { const float x = cw[e] + (pw[e] - cw[e]) * mw[e];
                const float t = __builtin_amdgcn_exp2f(x * 2.8853900817779268f); xw[4 * hf + e] = 1.f - 2.f * __builtin_amdgcn_rcpf(t + 1.f);
                xa[4 * hf + e] = ca[e] + (pa[e] - ca[e]) * ma[e]; }
        }
        v4u uw, ua; uw.x = cvt_pk_bf16(xw[0], xw[1]); uw.y = cvt_pk_bf16(xw[2], xw[3]); uw.z = cvt_pk_bf16(xw[4], xw[5]); uw.w = cvt_pk_bf16(xw[6], xw[7]);
        ua.x = cvt_pk_bf16(xa[0], xa[1]); ua.y = cvt_pk_bf16(xa[2], xa[3]); ua.z = cvt_pk_bf16(xa[4], xa[5]); ua.w = cvt_pk_bf16(xa[6], xa[7]);
        bw[ks] = __builtin_bit_cast(bf16x8, uw); ba[ks] = __builtin_bit_cast(bf16x8, ua);
    }
    const bf16* W2T = WSP(bf16, WS_W2T); const bf16* A2T = WSP(bf16, WS_A2T);
    float* SI = WSP(float, WS_SCANIN); float* SL = WSP(float, WS_SCAL);
    const float* pr = P + (size_t)row * INWP;
    for (int hh = 0; hh < nh; ++hh) {
        const int h = h0 + hh;
        f32x4 wl[4], al[4];
#pragma unroll
        for (int n = 0; n < 4; ++n) {
            const int chA = h * 64 + n * 16 + tk;
            wl[n] = (f32x4){0.f, 0.f, 0.f, 0.f}; al[n] = (f32x4){0.f, 0.f, 0.f, 0.f};
#pragma unroll
            for (int ks = 0; ks < 2; ++ks) {
                const bf16x8 aw = *(const bf16x8*)(W2T + (size_t)chA * 64 + 32 * ks + 8 * kq);
                const bf16x8 aa = *(const bf16x8*)(A2T + (size_t)chA * 64 + 32 * ks + 8 * kq);
                wl[n] = __builtin_amdgcn_mfma_f32_16x16x32_bf16(aw, bw[ks], wl[n], 0, 0, 0);
                al[n] = __builtin_amdgcn_mfma_f32_16x16x32_bf16(aa, ba[ks], al[n], 0, 0, 0);
            }
        }
        f32x4 Lxk[4], Lqk[4], Lxr[4], Lqr[4], Lxv[4], Lqv[4];
#pragma unroll
        for (int n = 0; n < 4; ++n) { const int ch = h * 64 + n * 16 + 4 * kq;
            Lxk[n] = ld4(pr + C_K + ch); Lqk[n] = prev4(F, P, row, C_K + ch); Lxr[n] = ld4(pr + C_R + ch); Lqr[n] = prev4(F, P, row, C_R + ch); Lxv[n] = ld4(pr + C_V + ch); Lqv[n] = prev4(F, P, row, C_V + ch); }
        __builtin_amdgcn_sched_barrier(0);
        f32x4 k4[4];
        float ss = 0.f;
#pragma unroll
        for (int n = 0; n < 4; ++n) {
            const int ch = h * 64 + n * 16 + 4 * kq;
            const f32x4 xk = Lxk[n], qk = Lqk[n], mk = ld4(mu + C_K + ch), kkw = ld4(F.in[I_KK] + ch);
#pragma unroll
            for (int j = 0; j < 4; ++j) { k4[n][j] = xk[j] + (qk[j] - xk[j]) * mk[j]; const float t = k4[n][j] * kkw[j]; ss += t * t; }
        }
        ss += __shfl_xor(ss, 16); ss += __shfl_xor(ss, 32);
        const float inv = 1.f / fmaxf(sqrtf(ss), 1e-12f);
        float s_nbr = 0.f, s_kr = 0.f, s_bon = 0.f;
        const size_t so = scan_seq_off(row, h);
        float* dst = SI + so * 384 + 4 * kq;
#pragma unroll
        for (int n = 0; n < 4; ++n) {
            const int ch = h * 64 + n * 16 + 4 * kq;
            const f32x4 xr = Lxr[n], xv = Lxv[n], qr = Lqr[n], qv = Lqv[n];
            const f32x4 mr = ld4(mu + C_R + ch), mv = ld4(mu + C_V + ch);
            const f32x4 w0 = ld4(F.in[I_W0] + ch), a0 = ld4(F.in[I_A0] + ch), kkw = ld4(F.in[I_KK] + ch), ka = ld4(F.in[I_KA] + ch), rk = ld4(F.in[I_RK] + ch);
            f32x4 kk, kp, nb, wr, wv, vv;
#pragma unroll
            for (int j = 0; j < 4; ++j) {
                const float r = xr[j] + (qr[j] - xr[j]) * mr[j]; vv[j] = xv[j] + (qv[j] - xv[j]) * mv[j];
                const float wlin = w0[j] + wl[n][j];
                const float sg = __builtin_amdgcn_rcpf(1.f + __builtin_amdgcn_exp2f(-wlin * 1.4426950408889634f));
                wv[j] = __builtin_amdgcn_exp2f(-0.8750338f * sg);
                const float alin = a0[j] + al[n][j];
                const float a = __builtin_amdgcn_rcpf(1.f + __builtin_amdgcn_exp2f(-alin * 1.4426950408889634f));
                kk[j] = k4[n][j] * kkw[j] * inv;
                kp[j] = k4[n][j] * (1.f + (a - 1.f) * ka[j]);
                nb[j] = -kk[j] * a;
                wr[j] = wv[j] * r;
                s_nbr += nb[j] * r; s_kr += kp[j] * r; s_bon += r * kp[j] * rk[j];
            }
            *(f32x4*)(dst + 0 * 64 + 16 * n) = kk; *(f32x4*)(dst + 1 * 64 + 16 * n) = wv; *(f32x4*)(dst + 2 * 64 + 16 * n) = nb;
            *(f32x4*)(dst + 3 * 64 + 16 * n) = kp; *(f32x4*)(dst + 4 * 64 + 16 * n) = wr; *(f32x4*)(dst + 5 * 64 + 16 * n) = vv;
        }
        s_nbr += __shfl_xor(s_nbr, 16); s_nbr += __shfl_xor(s_nbr, 32);
        s_kr += __shfl_xor(s_kr, 16); s_kr += __shfl_xor(s_kr, 32);
        s_bon += __shfl_xor(s_bon, 16); s_bon += __shfl_xor(s_bon, 32);
        if (kq == 0) *(f32x4*)(SL + so * 16) = (f32x4){s_nbr, s_kr, s_bon, 0.f};
    }
}
__device__ __forceinline__ void p2_row_item(Frame& F, int row) {
    const float* P = WSP(float, WS_PROJ) + (size_t)row * INWP;
    const int lane = F.lane;
    const bool prm = row < NTOKP; const int srow = row - NTOKP;
    const int p = prm ? (row & 2047) : 2048 + (srow & 3);
    const f32x2* T128 = WSP(f32x2, WS_ROPE128) + p * 64; const f32x2* T64 = WSP(f32x2, WS_ROPE64) + p * 32;
    bf16* QB = WSP(bf16, WS_QB) + (size_t)row * 512; bf16* KF = WSP(bf16, WS_KB) + (size_t)(row >> 11) * SEQ * 512; const int sq = row & 2047;
    float* ko = F.out + (prm ? O_KP + (size_t)row * 512 : O_KS + (size_t)srow * 512);
    float* vo = F.out + (prm ? O_VP + (size_t)row * 512 : O_VS + (size_t)srow * 512);
    const f32x2 cs = T128[lane];
    float Lq1[4], Lq2[4], Lk1[4], Lk2[4];
#pragma unroll
    for (int h = 0; h < 4; ++h) { Lq1[h] = P[C_Q + h * 128 + lane]; Lq2[h] = P[C_Q + h * 128 + 64 + lane]; Lk1[h] = P[C_AK + h * 128 + lane]; Lk2[h] = P[C_AK + h * 128 + 64 + lane]; }
    float Li1[8], Li2[8]; f32x2 Lc[8];
#pragma unroll
    for (int j = 0; j < 8; ++j) { const int pi = lane + 64 * j, hd = pi >> 5, i = pi & 31; Li1[j] = P[C_QI + hd * 64 + i]; Li2[j] = P[C_QI + hd * 64 + 32 + i]; Lc[j] = T64[i]; }
    const f32x4 Lv0 = *(const f32x4*)(P + C_AV + 4 * lane), Lv1 = *(const f32x4*)(P + C_AV + 256 + 4 * lane);
    const f32x4 Lm0 = *(const f32x4*)(P + C_QM + 8 * lane), Lm1 = *(const f32x4*)(P + C_QM + 8 * lane + 4);
    __builtin_amdgcn_sched_barrier(0);
#pragma unroll
    for (int h = 0; h < 4; ++h) {
        { const float x1 = Lq1[h], x2 = Lq2[h];
          const float o1 = (x1 * cs.x - x2 * cs.y) * QSCALE, o2 = (x2 * cs.x + x1 * cs.y) * QSCALE;
          QB[h * 128 + lane] = (bf16)(cvt_pk_bf16(o1, 0.f) & 0xffffu); QB[h * 128 + 64 + lane] = (bf16)(cvt_pk_bf16(o2, 0.f) & 0xffffu); }
        { const float x1 = Lk1[h], x2 = Lk2[h];
          const float o1 = x1 * cs.x - x2 * cs.y, o2 = x2 * cs.x + x1 * cs.y;
          ko[h * 128 + lane] = o1; ko[h * 128 + 64 + lane] = o2;
          if (prm) { KF[kf_off(64, h, sq, lane)] = (bf16)(cvt_pk_bf16(o1, 0.f) & 0xffffu); KF[kf_off(64, h, sq, 64 + lane)] = (bf16)(cvt_pk_bf16(o2, 0.f) & 0xffffu); } }
    }
    {
        f32x4* d = (f32x4*)vo;
        d[lane] = Lv0; d[64 + lane] = Lv1;
    }
    {
        bf16* QIB = WSP(bf16, WS_QIB) + (size_t)row * 1024;
#pragma unroll
        for (int j = 0; j < 8; ++j) { const int pi = lane + 64 * j, hd = pi >> 5, i = pi & 31; const f32x2 c2 = Lc[j];
            const float x1 = Li1[j], x2 = Li2[j];
            QIB[hd * 64 + i] = (bf16)(cvt_pk_bf16(x1 * c2.x - x2 * c2.y, 0.f) & 0xffffu); QIB[hd * 64 + 32 + i] = (bf16)(cvt_pk_bf16(x2 * c2.x + x1 * c2.y, 0.f) & 0xffffu); }
    }
    if (lane < 32) {
        const f32x2 c2 = T64[lane]; const float x1 = P[C_KI + lane], x2 = P[C_KI + 32 + lane];
        const float o1 = x1 * c2.x - x2 * c2.y, o2 = x2 * c2.x + x1 * c2.y;
        float* kio = F.out + (prm ? O_KIP + (size_t)row * 64 : O_KIS + (size_t)srow * 64);
        kio[lane] = o1; kio[32 + lane] = o2;
        bf16* KIB = WSP(bf16, WS_KIB) + (size_t)row * 64;
        KIB[lane] = (bf16)(cvt_pk_bf16(o1, 0.f) & 0xffffu); KIB[32 + lane] = (bf16)(cvt_pk_bf16(o2, 0.f) & 0xffffu);
        if (prm) { bf16* KIF = WSP(bf16, WS_SC) + (size_t)(row >> 11) * SEQ * 64; KIF[kif_off(sq, lane)] = (bf16)(cvt_pk_bf16(o1, 0.f) & 0xffffu); KIF[kif_off(sq, 32 + lane)] = (bf16)(cvt_pk_bf16(o2, 0.f) & 0xffffu); }
    }
    if (lane < 16) WSP(float, WS_WIS)[(size_t)row * 16 + lane] = P[C_WI + lane] * (1.f / 32.f);
    {
        bf16* QMB = WSP(bf16, WS_QMB) + (size_t)row * 512;
        const f32x4 a = Lm0, b = Lm1;
        v4u o; o.x = cvt_pk_bf16(a.x * QSCALE, a.y * QSCALE); o.y = cvt_pk_bf16(a.z * QSCALE, a.w * QSCALE); o.z = cvt_pk_bf16(b.x * QSCALE, b.y * QSCALE); o.w = cvt_pk_bf16(b.z * QSCALE, b.w * QSCALE);
        *(v4u*)(QMB + 8 * lane) = o;
    }
    if (prm ? ((row & 2047) == 2047) : ((srow & 3) == 3)) {
        float* so = F.out + (prm ? O_SHP + (size_t)(row >> 11) * SHW : O_SHS + (size_t)(srow >> 2) * SHW);
        for (int c = lane; c < SHW; c += 64) so[c] = P[c];
    }
}
__device__ __forceinline__ void p2_vt_item(Frame& F, const float* src, size_t ld_src, bf16* dstb, int NT, int ts) {
    LAS bf16* tile = (LAS bf16*)(F.lds + RING_OFF);
    { f32x4 tv[16];
#pragma unroll
      for (int i = 0; i < 16; ++i) { const int e = F.tid + i * NTHR, tok = e >> 7, c4 = (e & 127) * 4; tv[i] = *(const f32x4*)(src + (size_t)tok * ld_src + c4); }
#pragma unroll
      for (int i = 0; i < 16; ++i) { const int e = F.tid + i * NTHR, tok = e >> 7, c4 = (e & 127) * 4;
        v2u o; o.x = cvt_pk_bf16(tv[i].x, tv[i].y); o.y = cvt_pk_bf16(tv[i].z, tv[i].w); *(LAS v2u*)(tile + tok * 520 + c4) = o; } }
    __syncthreads();
    const int rsub = F.lane >> 3, chunk = F.lane & 7;
    for (int it = 0; it < 8; ++it) { const int hd = (it * 8 + F.wave) * 8 + rsub, h = hd >> 7, d = hd & 127;
        unsigned short e[8];
#pragma unroll
        for (int k = 0; k < 8; ++k) e[k] = tile[(chunk * 8 + k) * 520 + hd];
        const int kt = ts * 2 + (chunk >> 2), s2 = (chunk >> 1) & 1, g = chunk & 1;
        bf16* p = dstb + ((size_t)((h * NT + kt) * 8 + (d >> 5) * 2 + s2)) * 512 + (d & 31) * 8 + g * 4;
        v2u lo, hi; lo.x = e[0] | ((unsigned)e[1] << 16); lo.y = e[2] | ((unsigned)e[3] << 16); hi.x = e[4] | ((unsigned)e[5] << 16); hi.y = e[6] | ((unsigned)e[7] << 16);
        *(v2u*)p = lo; *(v2u*)(p + 32 * 8) = hi; }
    __syncthreads();
}
#ifndef PROBE_REPEAT
#define PROBE_REPEAT -1
#endif
__device__ __forceinline__ void p2_phase(Frame& F) {
    const int gw = F.bid * NWAVES + F.wave, NGW = F.G * NWAVES;
    for (int rep = 0; rep < (PROBE_REPEAT == 20 ? 2 : 1); ++rep)
    for (int it = gw; it < (NTOKP / 16) * 8; it += NGW) p2_rwkv_witem(F, it >> 3, (it & 7) * 2, 2);
    for (int it = NGW - 1 - gw; it < (NTOKS / 16) * 16; it += NGW) p2_rwkv_witem(F, NTOKP / 16 + (it >> 4), it & 15, 1);
    for (int rep = 0; rep < (PROBE_REPEAT == 21 ? 2 : 1); ++rep)
    for (int it = F.bid; it < 128 + 16; it += F.G) {
        if (it < 128) { const int b = it >> 5, ts = it & 31;
            p2_vt_item(F, WSP(float, WS_PROJ) + (size_t)(b * SEQ + ts * 64) * INWP + C_AV, INWP, WSP(bf16, WS_VT) + (size_t)b * 512 * SEQ, 64, ts); }
        else { const int j = it - 128, b = j >> 2, ts = j & 3;
            p2_vt_item(F, F.out + O_MVP + (size_t)(b * MEMT + ts * 64) * 512, 512, WSP(bf16, WS_MVT) + (size_t)b * 512 * MEMT, 8, ts); }
    }
    for (int rep = 0; rep < (PROBE_REPEAT == 22 ? 2 : 1); ++rep)
    for (int row = NGW - 1 - gw; row < NTOK; row += NGW) p2_row_item(F, row);
    const int gt = F.bid * NTHR + F.tid, NGT = F.G * NTHR;
    for (int e = gt; e < 1024 * 512 / 4; e += NGT) { const f32x4 v = *(const f32x4*)(F.out + O_MKP + (size_t)e * 4); v2u o; o.x = cvt_pk_bf16(v.x, v.y); o.y = cvt_pk_bf16(v.z, v.w);
        const int rowm = e >> 7, col = (e & 127) * 4, bm = rowm >> 8, m = rowm & 255; *(v2u*)(WSP(bf16, WS_MKB) + (size_t)bm * MEMT * 512 + kf_off(8, col >> 7, m, col & 127)) = o; }
}

constexpr int TC = 32, SBUF_FLOATS = TC * 384;
#define SCAN_STAGE_LOAD(SIN, SCALP) do { \
    _Pragma("unroll") for (int i = 0; i < 10; ++i) { const int e = lt + 256 * i, st = e / 80, r = e % 80; rv[i] = *(const f32x4*)((SIN) + (size_t)st * 384 + r * 4); } \
    _Pragma("unroll") for (int i = 0; i < 2; ++i) { const int e = lt + 256 * i, st = e >> 4, row = e & 15; const float v_ = (SIN)[(size_t)st * 384 + 320 + rg * 16 + row]; const f32x2 sc_ = *(const f32x2*)((SCALP) + (size_t)st * 16); \
        rt[i].x = v_; rt[i].y = sc_.x; rt[i].z = sc_.y; rt[i].w = 0.f; } } while (0)
#define SCAN_STAGE_WRITE(BUF) do { \
    _Pragma("unroll") for (int i = 0; i < 10; ++i) { const int e = lt + 256 * i, st = e / 80, r = e % 80; *(LAS f32x4*)((BUF) + st * 384 + r * 4) = rv[i]; } \
    _Pragma("unroll") for (int i = 0; i < 2; ++i) { const int e = lt + 256 * i, st = e >> 4, row = e & 15; *(LAS f32x4*)((BUF) + st * 384 + 320 + row * 4) = rt[i]; } } while (0)
#define SCAN_STEP(KK, W4, NB, KP, WR, TB, YOUT) do { \
    f32x2 _a = s01 * (f32x2){KK.x, KK.y}; _a = __builtin_elementwise_fma(s23, (f32x2){KK.z, KK.w}, _a); \
    f32x2 _b = s01 * (f32x2){WR.x, WR.y}; _b = __builtin_elementwise_fma(s23, (f32x2){WR.z, WR.w}, _b); \
    float _p1 = _a.x + _a.y, _p2 = _b.x + _b.y; \
    _p1 += dpp<0xB1>(_p1); _p2 += dpp<0xB1>(_p2); _p1 += dpp<0x4E>(_p1); _p2 += dpp<0x4E>(_p2); _p1 += dpp<0x141>(_p1); _p2 += dpp<0x141>(_p2); _p1 += dpp<0x140>(_p1); _p2 += dpp<0x140>(_p2); \
    YOUT = __builtin_fmaf(TB.x, TB.z, __builtin_fmaf(_p1, TB.y, _p2)); \
    const f32x2 _pp = (f32x2){_p1, _p1}, _vv = (f32x2){TB.x, TB.x}; \
    f32x2 _t01 = _vv * (f32x2){KP.x, KP.y}; _t01 = __builtin_elementwise_fma(_pp, (f32x2){NB.x, NB.y}, _t01); s01 = __builtin_elementwise_fma(s01, (f32x2){W4.x, W4.y}, _t01); \
    f32x2 _t23 = _vv * (f32x2){KP.z, KP.w}; _t23 = __builtin_elementwise_fma(_pp, (f32x2){NB.z, NB.w}, _t23); s23 = __builtin_elementwise_fma(s23, (f32x2){W4.z, W4.w}, _t23); \
} while (0)
__device__ __forceinline__ void scan_prompt_item(Frame& F, const float* sin, const float* scal, float* s_out, float* y0, int rg) {
    LAS float* bufs = (LAS float*)(F.lds + RING_OFF);
    constexpr int nchunks = SEQ / TC;
    const bool scanner = F.wave < 4;
    const int ri = F.lane >> 4, kq = F.lane & 15;
    const int lrow = (F.wave & 3) * 4 + ri, vrow = rg * 16 + lrow;
    f32x2 s01 = (f32x2){0.f, 0.f}, s23 = (f32x2){0.f, 0.f};
#define SCAN_BAR() do { asm volatile("s_waitcnt lgkmcnt(0)" ::: "memory"); __builtin_amdgcn_s_barrier(); asm volatile("" ::: "memory"); } while (0)
    if (!scanner) {
        f32x4 rv[10], rt[2]; const int lt = F.tid - 256;
        SCAN_STAGE_LOAD(sin, scal); SCAN_STAGE_WRITE(bufs); SCAN_STAGE_LOAD(sin + (size_t)TC * 384, scal + (size_t)TC * 16);
        SCAN_BAR();
        for (int c = 0; c < nchunks; ++c) {
            if (c + 1 < nchunks) { SCAN_STAGE_WRITE(bufs + ((c + 1) & 1) * SBUF_FLOATS);
                if (c + 2 < nchunks) SCAN_STAGE_LOAD(sin + (size_t)(c + 2) * TC * 384, scal + (size_t)(c + 2) * TC * 16); }
            SCAN_BAR();
        }
    } else {
        SCAN_BAR();
        for (int c = 0; c < nchunks; ++c) {
            LAS float* buf = bufs + (c & 1) * SBUF_FLOATS;
            const LAS float* lb = buf + 4 * kq;
            const LAS float* tbp = buf + 320 + lrow * 4;
            float yacc = 0.f;
            f32x4 kkA = *(const LAS f32x4*)(lb), w4A = *(const LAS f32x4*)(lb + 64), nbA = *(const LAS f32x4*)(lb + 128), kpA = *(const LAS f32x4*)(lb + 192), wrA = *(const LAS f32x4*)(lb + 256), tbA = *(const LAS f32x4*)(tbp);
            f32x4 kkB = *(const LAS f32x4*)(lb + 384), w4B = *(const LAS f32x4*)(lb + 384 + 64), nbB = *(const LAS f32x4*)(lb + 384 + 128), kpB = *(const LAS f32x4*)(lb + 384 + 192), wrB = *(const LAS f32x4*)(lb + 384 + 256), tbB = *(const LAS f32x4*)(tbp + 384);
#pragma unroll
            for (int st = 0; st < TC; st += 2) {
                const int s2 = (st + 2 < TC) ? st + 2 : st, s3 = (st + 3 < TC) ? st + 3 : st + 1;
                float y;
                SCAN_STEP(kkA, w4A, nbA, kpA, wrA, tbA, y);
                yacc = (kq == (st & 15)) ? y : yacc;
                kkA = *(const LAS f32x4*)(lb + s2 * 384); w4A = *(const LAS f32x4*)(lb + s2 * 384 + 64); nbA = *(const LAS f32x4*)(lb + s2 * 384 + 128);
                kpA = *(const LAS f32x4*)(lb + s2 * 384 + 192); wrA = *(const LAS f32x4*)(lb + s2 * 384 + 256); tbA = *(const LAS f32x4*)(tbp + s2 * 384);
                __builtin_amdgcn_sched_barrier(0);
                SCAN_STEP(kkB, w4B, nbB, kpB, wrB, tbB, y);
                yacc = (kq == ((st + 1) & 15)) ? y : yacc;
                if (((st + 1) & 15) == 15) y0[(size_t)(c * TC + st + 1 - 15 + kq) * RW + vrow] = yacc;
                kkB = *(const LAS f32x4*)(lb + s3 * 384); w4B = *(const LAS f32x4*)(lb + s3 * 384 + 64); nbB = *(const LAS f32x4*)(lb + s3 * 384 + 128);
                kpB = *(const LAS f32x4*)(lb + s3 * 384 + 192); wrB = *(const LAS f32x4*)(lb + s3 * 384 + 256); tbB = *(const LAS f32x4*)(tbp + s3 * 384);
                __builtin_amdgcn_sched_barrier(0);
            }
            SCAN_BAR();
        }
    }
    __syncthreads();
    if (scanner) *(f32x4*)(s_out + (size_t)vrow * 64 + 4 * kq) = (f32x4){s01.x, s01.y, s23.x, s23.y};
}
__device__ __forceinline__ void scan_sample_witem(Frame& F, int item) {
    const int dbh = item >> 4, r4 = item & 15, db = dbh >> 4, h = dbh & 15;
    const int ri = F.lane >> 4, kq = F.lane & 15, vrow = r4 * 4 + ri;
    const size_t so = (size_t)NB * RH * SEQ + (size_t)dbh * DT;
    const float* sin = WSP(float, WS_SCANIN) + so * 384; const float* scal = WSP(float, WS_SCAL) + so * 16;
    const f32x4 s0 = *(const f32x4*)(F.in[I_SWKV] + (size_t)dbh * 4096 + (size_t)vrow * 64 + 4 * kq);
    f32x2 s01 = (f32x2){s0.x, s0.y}, s23 = (f32x2){s0.z, s0.w};
    f32x4 kk[DT], w4[DT], nb[DT], kp[DT], wr[DT], tb[DT];
#pragma unroll
    for (int st = 0; st < DT; ++st) { const float* p = sin + st * 384 + 4 * kq;
        kk[st] = *(const f32x4*)(p); w4[st] = *(const f32x4*)(p + 64); nb[st] = *(const f32x4*)(p + 128); kp[st] = *(const f32x4*)(p + 192); wr[st] = *(const f32x4*)(p + 256);
        const f32x2 sc = *(const f32x2*)(scal + st * 16); tb[st] = (f32x4){sin[st * 384 + 320 + vrow], sc.x, sc.y, 0.f}; }
    float* y0 = WSP(float, WS_Y) + (size_t)(NTOKP + db * DT) * RW + h * 64 + vrow;
#pragma unroll
    for (int st = 0; st < DT; ++st) { float y; SCAN_STEP(kk[st], w4[st], nb[st], kp[st], wr[st], tb[st], y); if (kq == 0) y0[(size_t)st * RW] = y; }
    *(f32x4*)(F.out + O_WKVS + (size_t)dbh * 4096 + (size_t)vrow * 64 + 4 * kq) = (f32x4){s01.x, s01.y, s23.x, s23.y};
}
__device__ __forceinline__ void p3_scan_phase(Frame& F) {
    const int gw = F.bid * NWAVES + F.wave, NGW = F.G * NWAVES;
    for (int it = gw; it < DB * RH * 16; it += NGW) scan_sample_witem(F, it);
    const float* SI = WSP(float, WS_SCANIN); const float* SL = WSP(float, WS_SCAL); float* Y = WSP(float, WS_Y);
    for (int it0 = F.bid; it0 < 256; it0 += F.G) { const int it = (F.G == 256) ? ((it0 & 7) * 32 + (it0 >> 3)) : it0;
        const int bh = it >> 2, rg = it & 3, b = bh >> 4, h = bh & 15;
        scan_prompt_item(F, SI + (size_t)bh * SEQ * 384, SL + (size_t)bh * SEQ * 16, F.out + O_WKVP + (size_t)bh * 4096, Y + (size_t)(b * SEQ) * RW + h * 64, rg); }
}

__device__ __forceinline__ void gn_row(Frame& F, int row) {
    const int lane = F.lane, h = lane >> 2, q = lane & 3, c0 = h * 64 + q * 16;
    const float* y = WSP(float, WS_Y) + (size_t)row * RW + c0;
    f32x4 v[4]; float s = 0.f;
#pragma unroll
    for (int j = 0; j < 4; ++j) { v[j] = *(const f32x4*)(y + 4 * j); s += (v[j].x + v[j].y) + (v[j].z + v[j].w); }
    s += dpp<0xB1>(s); s += dpp<0x4E>(s);
    const float mean = s * (1.f / 64.f); float s2 = 0.f;
#pragma unroll
    for (int j = 0; j < 4; ++j) { v[j] = v[j] - mean; s2 += (v[j].x * v[j].x + v[j].y * v[j].y) + (v[j].z * v[j].z + v[j].w * v[j].w); }
    s2 += dpp<0xB1>(s2); s2 += dpp<0x4E>(s2);
    const float rstd = 1.f / sqrtf(s2 * (1.f / 64.f) + GN_EPS);
    const size_t so = scan_seq_off(row, h);
    const float bonus = WSP(float, WS_SCAL)[so * 16 + 2];
    const float* vv = WSP(float, WS_SCANIN) + so * 384 + 5 * 64 + q * 16;
    const float* g = WSP(float, WS_PROJ) + (size_t)row * INWP + C_GR + c0;
    const float* gw = F.in[I_GNW] + c0; const float* gb = F.in[I_GNB] + c0;
    bf16* o = WSP(bf16, WS_YMIX) + (size_t)row * DM + c0;
#pragma unroll
    for (int j = 0; j < 4; ++j) { const f32x4 w4 = *(const f32x4*)(gw + 4 * j), b4 = *(const f32x4*)(gb + 4 * j), v4 = *(const f32x4*)(vv + 4 * j), g4 = *(const f32x4*)(g + 4 * j);
        const float o0 = (v[j].x * rstd * w4.x + b4.x + bonus * v4.x) * silu(g4.x), o1 = (v[j].y * rstd * w4.y + b4.y + bonus * v4.y) * silu(g4.y);
        const float o2 = (v[j].z * rstd * w4.z + b4.z + bonus * v4.z) * silu(g4.z), o3 = (v[j].w * rstd * w4.w + b4.w + bonus * v4.w) * silu(g4.w);
        v2u pk; pk.x = cvt_pk_bf16(o0, o1); pk.y = cvt_pk_bf16(o2, o3); *(v2u*)(o + 4 * j) = pk; }
}
__device__ __forceinline__ void idx_afrag(const bf16* QIB, int row0, int lane, bf16x8 (&af)[4]) {
    const int r = lane & 31, hh = lane >> 5;
    const bf16* p = QIB + (size_t)(row0 + ((r >> 2) & 1)) * 1024 + ((r >> 3) * 4 + (r & 3)) * 64 + 8 * hh;
#pragma unroll
    for (int ks = 0; ks < 4; ++ks) af[ks] = *(const bf16x8*)(p + 16 * ks);
}
__device__ __forceinline__ float idx_reduce(const f32x16& acc, const f32x4 (&w)[4]) {
    float v = 0.f;
#pragma unroll
    for (int j = 0; j < 16; ++j) v += w[j >> 2][j & 3] * fmaxf(acc[j], 0.f);
    return v;
}
__device__ __forceinline__ void d1_prompt_item(Frame& F, int item) {
    const int idx = item & 255, second = item >> 8, b = idx >> 6, qi = idx & 63, qt = second ? 127 - qi : qi;
    const int t0 = qt * 16 + 2 * F.wave, row0 = b * SEQ + t0;
    const int r = F.lane & 31, hh = F.lane >> 5;
    bf16x8 af[4]; idx_afrag(WSP(bf16, WS_QIB), row0, F.lane, af);
    f32x4 w[4];
#pragma unroll
    for (int j = 0; j < 4; ++j) w[j] = *(const f32x4*)(WSP(float, WS_WIS) + (size_t)(row0 + hh) * 16 + 4 * j);
    const int tq = t0 + hh;
    const bf16* KIB = WSP(bf16, WS_KIB) + (size_t)(b * SEQ) * 64;
    float* SC = WSP(float, WS_SC) + (size_t)(b * SEQ + tq) * SEQ;
    for (int s0 = 0; s0 <= t0 + 1; s0 += 32) {
        f32x16 acc;
#pragma unroll
        for (int j = 0; j < 16; ++j) acc[j] = 0.f;
#pragma unroll
        for (int ks = 0; ks < 4; ++ks) { const bf16x8 bfr = *(const bf16x8*)(KIB + (size_t)(s0 + r) * 64 + 16 * ks + 8 * hh);
            acc = __builtin_amdgcn_mfma_f32_32x32x16_bf16(af[ks], bfr, acc, 0, 0, 0); }
        SC[s0 + r] = idx_reduce(acc, w);
    }
}
__device__ __forceinline__ void d1_sample_item(Frame& F, int item) {
    const int r = F.lane & 31, hh = F.lane >> 5;
    int db, p = 0; bool newk = false;
    if (item < DB * NPAGES) { db = item >> 6; p = item & 63; } else { db = item - DB * NPAGES; newk = true; }
    const int row0 = NTOKP + db * DT;
    bf16x8 af0[4], af1[4]; idx_afrag(WSP(bf16, WS_QIB), row0, F.lane, af0); idx_afrag(WSP(bf16, WS_QIB), row0 + 2, F.lane, af1);
    f32x4 w0[4], w1[4];
#pragma unroll
    for (int j = 0; j < 4; ++j) { w0[j] = *(const f32x4*)(WSP(float, WS_WIS) + (size_t)(row0 + hh) * 16 + 4 * j); w1[j] = *(const f32x4*)(WSP(float, WS_WIS) + (size_t)(row0 + 2 + hh) * 16 + 4 * j); }
    float* SCS = WSP(float, WS_SCS);
    if (!newk) {
        const int page = ((const int*)F.in[I_PT])[db * NPAGES + p];
        const float* kp = F.in[I_CKI] + ((size_t)page * PAGE + r) * 64 + 8 * hh;
        f32x4 ka[4][4], kc[4][4];
#pragma unroll
        for (int kt = 0; kt < 4; ++kt)
#pragma unroll
            for (int ks = 0; ks < 4; ++ks) { ka[kt][ks] = *(const f32x4*)(kp + (size_t)kt * 32 * 64 + 16 * ks); kc[kt][ks] = *(const f32x4*)(kp + (size_t)kt * 32 * 64 + 16 * ks + 4); }
#pragma unroll
        for (int kt = 0; kt < 4; ++kt) {
            f32x16 acc0, acc1;
#pragma unroll
            for (int j = 0; j < 16; ++j) { acc0[j] = 0.f; acc1[j] = 0.f; }
#pragma unroll
            for (int ks = 0; ks < 4; ++ks) { const f32x4 a = ka[kt][ks], c = kc[kt][ks];
                v4u u; u.x = cvt_pk_bf16(a.x, a.y); u.y = cvt_pk_bf16(a.z, a.w); u.z = cvt_pk_bf16(c.x, c.y); u.w = cvt_pk_bf16(c.z, c.w);
                const bf16x8 bfr = __builtin_bit_cast(bf16x8, u);
                acc0 = __builtin_amdgcn_mfma_f32_32x32x16_bf16(af0[ks], bfr, acc0, 0, 0, 0); acc1 = __builtin_amdgcn_mfma_f32_32x32x16_bf16(af1[ks], bfr, acc1, 0, 0, 0); }
            SCS[(size_t)(db * DT + hh) * SCS_LD + p * PAGE + kt * 32 + r] = idx_reduce(acc0, w0);
            SCS[(size_t)(db * DT + 2 + hh) * SCS_LD + p * PAGE + kt * 32 + r] = idx_reduce(acc1, w1);
        }
    } else {
        f32x16 acc0, acc1;
#pragma unroll
        for (int j = 0; j < 16; ++j) { acc0[j] = 0.f; acc1[j] = 0.f; }
        const bf16* kp = WSP(bf16, WS_KIB) + (size_t)(row0 + (r & 3)) * 64 + 8 * hh;
#pragma unroll
        for (int ks = 0; ks < 4; ++ks) { bf16x8 bfr = *(const bf16x8*)(kp + 16 * ks);
            acc0 = __builtin_amdgcn_mfma_f32_32x32x16_bf16(af0[ks], bfr, acc0, 0, 0, 0); acc1 = __builtin_amdgcn_mfma_f32_32x32x16_bf16(af1[ks], bfr, acc1, 0, 0, 0); }
        if (r < 4) { SCS[(size_t)(db * DT + hh) * SCS_LD + PAST + r] = idx_reduce(acc0, w0); SCS[(size_t)(db * DT + 2 + hh) * SCS_LD + PAST + r] = idx_reduce(acc1, w1); }
    }
}
__device__ __forceinline__ void p4_phase(Frame& F) {
    const int gw = F.bid * NWAVES + F.wave, NGW = F.G * NWAVES;
    for (int it = gw; it < DB * NPAGES + DB; it += NGW) d1_sample_item(F, it);
    for (int row = gw; row < NTOK; row += NGW) gn_row(F, row);
}

__device__ __forceinline__ unsigned wave_count(unsigned c) {
#pragma unroll
    for (int o = 1; o < 64; o <<= 1) c += __shfl_xor((int)c, o);
    return c;
}
template <int NV>
__device__ __forceinline__ void kth_select(const unsigned (&key)[NV * 4], unsigned xk, int xbase, int lane, unsigned& T_out, unsigned& cut_out) {
    unsigned T = 0u; bool exact = false;
    for (int bit = 31; bit >= 0; --bit) {
        const unsigned cand = T | (1u << bit);
        unsigned c = (xk >= cand) ? 1u : 0u;
#pragma unroll
        for (int i = 0; i < NV * 4; ++i) c += (key[i] >= cand) ? 1u : 0u;
        c = wave_count(c);
        if (c >= (unsigned)TOPK) T = cand;
        if (c == (unsigned)TOPK) { exact = true; break; }
    }
    unsigned cut = 0x7fffffffu;
    if (!exact) {
        unsigned cg = (xk > T) ? 1u : 0u, ce = (xk == T) ? 1u : 0u;
#pragma unroll
        for (int i = 0; i < NV * 4; ++i) { cg += (key[i] > T) ? 1u : 0u; ce += (key[i] == T) ? 1u : 0u; }
        cg = wave_count(cg); ce = wave_count(ce);
        const unsigned need = (unsigned)TOPK - cg;
        if (ce > need) {
            unsigned I = 0u;
            for (int bit = 14; bit >= 0; --bit) {
                const unsigned cand = I | (1u << bit);
                unsigned c = (xk == T && (unsigned)(xbase + lane) < cand && lane < 4) ? 1u : 0u;
#pragma unroll
                for (int i = 0; i < NV * 4; ++i) { const unsigned idx = 256u * (i >> 2) + 4u * lane + (i & 3); c += (key[i] == T && idx < cand) ? 1u : 0u; }
                c = wave_count(c);
                if (c < need) I = cand;
            }
            cut = I;
        }
    }
    T_out = T; cut_out = cut;
}
__device__ __forceinline__ void d2_prompt_row(Frame& F, int row) {
    const int t = row & 2047, lane = F.lane;
    unsigned* THR = WSP(unsigned, WS_THR) + (size_t)row * 2;
    if (t < TOPK) { if (lane == 0) { THR[0] = 0u; THR[1] = 0x7fffffffu; } return; }
    const float* SC = WSP(float, WS_SC) + (size_t)row * SEQ;
    unsigned key[32];
#pragma unroll
    for (int j = 0; j < 8; ++j) { const int i0 = 256 * j + 4 * lane;
        if (i0 <= t) { const f32x4 v = *(const f32x4*)(SC + i0);
            key[4 * j + 0] = sort_key(v.x); key[4 * j + 1] = (i0 + 1 <= t) ? sort_key(v.y) : 0u; key[4 * j + 2] = (i0 + 2 <= t) ? sort_key(v.z) : 0u; key[4 * j + 3] = (i0 + 3 <= t) ? sort_key(v.w) : 0u; }
        else { key[4 * j + 0] = 0u; key[4 * j + 1] = 0u; key[4 * j + 2] = 0u; key[4 * j + 3] = 0u; } }
    unsigned T, cut; kth_select<8>(key, 0u, 1 << 20, lane, T, cut);
    if (lane == 0) { THR[0] = T; THR[1] = cut; }
}
__device__ __forceinline__ void d2_sample_block(Frame& F, int q) {
    const int t = q & 3, tid = F.tid, lane = F.lane;
    const float* SCS = WSP(float, WS_SCS) + (size_t)q * SCS_LD;
    LAS unsigned* red = (LAS unsigned*)(F.lds + RING_OFF);
    unsigned key[16];
#pragma unroll
    for (int j = 0; j < 4; ++j) { const f32x4 v = *(const f32x4*)(SCS + 2048 * j + 4 * tid);
        key[4 * j + 0] = sort_key(v.x); key[4 * j + 1] = sort_key(v.y); key[4 * j + 2] = sort_key(v.z); key[4 * j + 3] = sort_key(v.w); }
    unsigned xk = 0u; if (tid <= t) xk = sort_key(SCS[PAST + tid]);
    if (tid == 0) red[16] = 0u;
    unsigned T = 0u; bool exact = false; int par = 0;
    for (int bit = 31; bit >= 0; --bit) {
        const unsigned cand = T | (1u << bit);
        unsigned c = (xk >= cand) ? 1u : 0u;
#pragma unroll
        for (int i = 0; i < 16; ++i) c += (key[i] >= cand) ? 1u : 0u;
        c = wave_count(c);
        if (lane == 0) red[par * 8 + F.wave] = c;
        __syncthreads();
        unsigned tot = 0u;
#pragma unroll
        for (int w = 0; w < 8; ++w) tot += red[par * 8 + w];
        par ^= 1;
        if (tot >= (unsigned)TOPK) T = cand;
        if (tot == (unsigned)TOPK) { exact = true; break; }
    }
    unsigned cut = 0x7fffffffu;
    if (!exact) {
        unsigned cg = (xk > T) ? 1u : 0u, ce = (xk == T) ? 1u : 0u;
#pragma unroll
        for (int i = 0; i < 16; ++i) { cg += (key[i] > T) ? 1u : 0u; ce += (key[i] == T) ? 1u : 0u; }
        cg = wave_count(cg); ce = wave_count(ce);
        if (lane == 0) red[par * 8 + F.wave] = (cg << 16) | ce;
        __syncthreads();
        unsigned tg = 0u, te = 0u;
#pragma unroll
        for (int w = 0; w < 8; ++w) { const unsigned v = red[par * 8 + w]; tg += v >> 16; te += v & 0xffffu; }
        par ^= 1;
        const unsigned need = (unsigned)TOPK - tg;
        if (te > need) {
            unsigned I = 0u;
            for (int bit = 14; bit >= 0; --bit) {
                const unsigned cand = I | (1u << bit);
                unsigned c = (xk == T && tid < 4 && (unsigned)(PAST + tid) < cand) ? 1u : 0u;
#pragma unroll
                for (int i = 0; i < 16; ++i) { const unsigned idx = 2048u * (i >> 2) + 4u * tid + (i & 3); c += (key[i] == T && idx < cand) ? 1u : 0u; }
                c = wave_count(c);
                if (lane == 0) red[par * 8 + F.wave] = c;
                __syncthreads();
                unsigned tot = 0u;
#pragma unroll
                for (int w = 0; w < 8; ++w) tot += red[par * 8 + w];
                par ^= 1;
                if (tot < need) I = cand;
            }
            cut = I;
        }
    }
    __syncthreads();
    int* IDX = WSP(int, WS_IDX) + (size_t)q * TOPK;
#pragma unroll
    for (int i = 0; i < 16; ++i) { const int idx = 2048 * (i >> 2) + 4 * tid + (i & 3);
        if (key[i] > T || (key[i] == T && (unsigned)idx <= cut)) { const unsigned pos = atomicAdd((unsigned*)&red[16], 1u); if (pos < (unsigned)TOPK) IDX[pos] = idx; } }
    if (tid <= t) { const int idx = PAST + tid; if (xk > T || (xk == T && (unsigned)idx <= cut)) { const unsigned pos = atomicAdd((unsigned*)&red[16], 1u); if (pos < (unsigned)TOPK) IDX[pos] = idx; } }
    __syncthreads();
}
__device__ __forceinline__ void p5_phase(Frame& F) {
    const int gw = F.bid * NWAVES + F.wave, NGW = F.G * NWAVES;
    for (int q = F.bid; q < NTOKS; q += F.G) d2_sample_block(F, q);
}

constexpr int DSA_MASK_OFF = RING_OFF;
constexpr int DSA_MERGE_OFF = RING_OFF + 8192;
__device__ __forceinline__ void cnt_ge(unsigned& c, unsigned k, unsigned cand) { asm volatile("v_cmp_ge_u32 vcc, %1, %2\n\tv_addc_co_u32 %0, vcc, 0, %0, vcc" : "+v"(c) : "v"(k), "v"(cand) : "vcc"); }
template <int CTRL> __device__ __forceinline__ unsigned dppu(unsigned x) { return (unsigned)__builtin_amdgcn_mov_dpp((int)x, CTRL, 0xf, 0xf, true); }
__device__ __forceinline__ unsigned half_sum_u(unsigned c) {
    c += dppu<0xB1>(c); c += dppu<0x4E>(c); c += dppu<0x141>(c); c += dppu<0x140>(c);
    auto s2 = __builtin_amdgcn_permlane16_swap(c, c, false, false);
    return s2[0] + s2[1];
}
template <bool MASKED>
__device__ __forceinline__ void attn_core(Frame& F, int row0, int nkt, int NT, const bf16* Qb, const bf16* Kf  , const bf16* Vf  , int gate_col, int out_col) {
    const int lane = F.lane, r = lane & 31, hh = lane >> 5, h = F.wave & 3, half = F.wave >> 2;
    const LAS unsigned* mask = (const LAS unsigned*)(F.lds + DSA_MASK_OFF) + r * 64;
    bf16x8 qf[8];
#pragma unroll
    for (int ks = 0; ks < 8; ++ks) qf[ks] = *(const bf16x8*)(Qb + (size_t)(row0 + r) * 512 + h * 128 + 16 * ks + 8 * hh);
    f32x16 o[4];
#pragma unroll
    for (int d = 0; d < 4; ++d)
#pragma unroll
        for (int j = 0; j < 16; ++j) o[d][j] = 0.f;
    float m = -INFINITY, lsum = 0.f;
    const bf16* kbase = Kf + (size_t)(h * NT) * 4096 + lane * 8;
    const bf16* vbase = Vf + (size_t)(h * NT) * 4096 + lane * 8;
    bf16x8 kf[8];
    if (half < nkt) {
#pragma unroll
        for (int ks = 0; ks < 8; ++ks) kf[ks] = *(const bf16x8*)(kbase + (size_t)half * 4096 + ks * 512);
    }
    for (int kt = half; kt < nkt; kt += 2) {
        bf16x8 vf[4][2];
#pragma unroll
        for (int d = 0; d < 4; ++d)
#pragma unroll
            for (int s = 0; s < 2; ++s) vf[d][s] = *(const bf16x8*)(vbase + (size_t)kt * 4096 + (d * 2 + s) * 512);
        f32x16 x;
#pragma unroll
        for (int j = 0; j < 16; ++j) x[j] = 0.f;
#pragma unroll
        for (int ks = 0; ks < 8; ++ks) x = __builtin_amdgcn_mfma_f32_32x32x16_bf16(kf[ks], qf[ks], x, 0, 0, 0);
        {
            const int ktn = (kt + 2 < nkt) ? kt + 2 : kt;
#pragma unroll
            for (int ks = 0; ks < 8; ++ks) kf[ks] = *(const bf16x8*)(kbase + (size_t)ktn * 4096 + ks * 512);
        }
        if (MASKED) {
            const unsigned m4 = mask[kt] >> (4 * hh);
#pragma unroll
            for (int g = 0; g < 4; ++g)
#pragma unroll
                for (int e = 0; e < 4; ++e) { const unsigned t = (unsigned)((int)(m4 << (31 - (8 * g + e))) >> 31);
                    x[4 * g + e] = __uint_as_float((__float_as_uint(x[4 * g + e]) & t) | (0xff800000u & ~t)); }
        }
        float mx = x[0];
#pragma unroll
        for (int j = 1; j < 16; ++j) mx = fmaxf(mx, x[j]);
        mx = xhalf_max(mx);
        const float mn = fmaxf(m, mx), mu = (mn == -INFINITY) ? 0.f : mn;
        const float alpha = __builtin_amdgcn_exp2f(m - mu);
        m = mn;
        float ls = 0.f;
#pragma unroll
        for (int j = 0; j < 16; ++j) { x[j] = __builtin_amdgcn_exp2f(x[j] - mu); ls += x[j]; }
        lsum = lsum * alpha + ls;
        if (__any(alpha != 1.f)) {
#pragma unroll
            for (int d = 0; d < 4; ++d)
#pragma unroll
                for (int j = 0; j < 16; ++j) o[d][j] *= alpha;
        }
        bf16x8 pf[2];
#pragma unroll
        for (int s = 0; s < 2; ++s) { v4u u; u.x = cvt_pk_bf16(x[8 * s + 0], x[8 * s + 1]); u.y = cvt_pk_bf16(x[8 * s + 2], x[8 * s + 3]); u.z = cvt_pk_bf16(x[8 * s + 4], x[8 * s + 5]); u.w = cvt_pk_bf16(x[8 * s + 6], x[8 * s + 7]);
            pf[s] = __builtin_bit_cast(bf16x8, u); }
#pragma unroll
        for (int d = 0; d < 4; ++d)
#pragma unroll
            for (int s = 0; s < 2; ++s) o[d] = __builtin_amdgcn_mfma_f32_32x32x16_bf16(vf[d][s], pf[s], o[d], 0, 0, 0);
    }
    lsum = xhalf_sum(lsum);
    LAS float* mg = (LAS float*)(F.lds + DSA_MERGE_OFF) + h * 66 * 64;
    if (half == 1) {
        mg[0 * 64 + lane] = m; mg[1 * 64 + lane] = lsum;
#pragma unroll
        for (int d = 0; d < 4; ++d)
#pragma unroll
            for (int j = 0; j < 16; ++j) mg[(2 + d * 16 + j) * 64 + lane] = o[d][j];
    }
    __syncthreads();
    if (half == 0) {
        const float m1 = mg[0 * 64 + lane], l1 = mg[1 * 64 + lane];
        const float mn = fmaxf(m, m1), mu = (mn == -INFINITY) ? 0.f : mn;
        const float a0 = __builtin_amdgcn_exp2f(m - mu), a1 = __builtin_amdgcn_exp2f(m1 - mu);
        const float l = lsum * a0 + l1 * a1; const float inv = l > 0.f ? 1.f / l : 0.f;
        const float* gp = WSP(float, WS_PROJ) + (size_t)(row0 + r) * INWP + gate_col + h * 128;
        bf16* op = WSP(bf16, WS_YMIX) + (size_t)(row0 + r) * DM + out_col + h * 128;
#pragma unroll
        for (int d = 0; d < 4; ++d)
#pragma unroll
            for (int g = 0; g < 4; ++g) { const int dd = d * 32 + 8 * g + 4 * hh; const f32x4 gv = *(const f32x4*)(gp + dd);
                float v[4];
#pragma unroll
                for (int e = 0; e < 4; ++e) v[e] = (o[d][4 * g + e] * a0 + mg[(2 + d * 16 + 4 * g + e) * 64 + lane] * a1) * inv * silu(gv[e]);
                v2u pk; pk.x = cvt_pk_bf16(v[0], v[1]); pk.y = cvt_pk_bf16(v[2], v[3]); *(v2u*)(op + dd) = pk; }
    }
    __syncthreads();
}
__device__ __forceinline__ void dsa_prompt_item(Frame& F, int b, int qt) {
    const int t0 = qt * 32, row0 = b * SEQ + t0, nkt = qt + 1;
    LAS unsigned* mask = (LAS unsigned*)(F.lds + DSA_MASK_OFF);
    if (t0 + 31 < TOPK) {
        for (int i = F.tid; i < 32 * 64; i += NTHR) { const int q = i >> 6, kt = i & 63; const int nb = t0 + q - 32 * kt + 1;
            mask[i] = nb >= 32 ? 0xffffffffu : (nb <= 0 ? 0u : ((1u << nb) - 1u)); }
    } else {
        const int lane = F.lane, r = lane & 31, hh = lane >> 5;
        int r4 = 4 * r; asm volatile("" : "+v"(r4));
        const bf16* KIB = WSP(bf16, WS_SC) + (size_t)(b * SEQ) * 64 + lane * 8;
        LAS unsigned* skl = (LAS unsigned*)(F.lds + DSA_MASK_OFF + 8192) + F.wave * 4096 + hh * 2048;
        for (int i = F.tid; i < 32 * 64; i += NTHR) mask[i] = 0u;
        __syncthreads();
        for (int pass = 0; pass < 2; ++pass) {
            const int q0 = 16 * pass + 2 * F.wave, tq = t0 + q0 + hh;
            {
                bf16x8 af[4]; idx_afrag(WSP(bf16, WS_QIB), row0 + q0, lane, af);
                f32x4 w[4];
#pragma unroll
                for (int j = 0; j < 4; ++j) w[j] = *(const f32x4*)(WSP(float, WS_WIS) + (size_t)(row0 + q0 + hh) * 16 + 4 * j);
                bf16x8 ring[4][4];
#pragma unroll
                for (int i = 0; i < 3; ++i) { const int ktc = i < nkt ? i : nkt - 1;
#pragma unroll
                    for (int ks = 0; ks < 4; ++ks) ring[i][ks] = *(const bf16x8*)(KIB + (size_t)ktc * 2048 + ks * 512); }
                for (int kt0 = 0; kt0 < nkt; kt0 += 4) {
#pragma unroll
                    for (int i = 0; i < 4; ++i) {
                        const int kt = kt0 + i, ktp = (kt + 3 < nkt) ? kt + 3 : nkt - 1;
#pragma unroll
                        for (int ks = 0; ks < 4; ++ks) ring[(i + 3) & 3][ks] = *(const bf16x8*)(KIB + (size_t)ktp * 2048 + ks * 512);
                        f32x16 acc;
#pragma unroll
                        for (int j = 0; j < 16; ++j) acc[j] = 0.f;
#pragma unroll
                        for (int ks = 0; ks < 4; ++ks) acc = __builtin_amdgcn_mfma_f32_32x32x16_bf16(af[ks], ring[i][ks], acc, 0, 0, 0);
                        if (kt < nkt) skl[kt * 32 + r] = sort_key(idx_reduce(acc, w));
                    }
                }
            }
            asm volatile("s_waitcnt lgkmcnt(0)" ::: "memory");
            unsigned sk[64];
            int tqr = tq - r4; asm volatile("" : "+v"(tqr));
#pragma unroll
            for (int i = 0; i < 16; ++i) { const v4u v = *(const LAS v4u*)(skl + 128 * i + r4);
                sk[4 * i + 0] = (128 * i + 0 <= tqr) ? v.x : 0u; sk[4 * i + 1] = (128 * i + 1 <= tqr) ? v.y : 0u; sk[4 * i + 2] = (128 * i + 2 <= tqr) ? v.z : 0u; sk[4 * i + 3] = (128 * i + 3 <= tqr) ? v.w : 0u; }
            unsigned T = 0u; bool exact = false;
            for (int bit = 31; bit >= 0; --bit) {
                const unsigned cand = T | (1u << bit);
                unsigned c = 0u;
#pragma unroll
                for (int i = 0; i < 64; ++i) cnt_ge(c, sk[i], cand);
                c = half_sum_u(c);
                if (!exact) { if (c >= (unsigned)TOPK) T = cand; if (c == (unsigned)TOPK) exact = true; }
                if (__all(exact)) break;
            }
            unsigned cut = 0x7fffffffu;
            if (__any(!exact)) {
                unsigned cg = 0u, ce = 0u;
                for (int i = 0; i < 16; ++i) { const v4u v = *(const LAS v4u*)(skl + 128 * i + r4); const int i0 = 128 * i + r4;
#pragma unroll
                    for (int e = 0; e < 4; ++e) { const unsigned k = (i0 + e <= tq) ? v[e] : 0u; cg += (k > T) ? 1u : 0u; ce += (k == T) ? 1u : 0u; } }
                cg = half_sum_u(cg); ce = half_sum_u(ce);
                const unsigned need = (unsigned)TOPK - cg;
                const bool tie = !exact && ce > need;
                unsigned I = 0u;
                for (int bit = 11; bit >= 0; --bit) {
                    const unsigned cand = I | (1u << bit);
                    unsigned c = 0u;
                    for (int i = 0; i < 16; ++i) { const v4u v = *(const LAS v4u*)(skl + 128 * i + r4); const int i0 = 128 * i + r4;
#pragma unroll
                        for (int e = 0; e < 4; ++e) { const unsigned k = (i0 + e <= tq) ? v[e] : 0u; c += (k == T && (unsigned)(i0 + e) < cand) ? 1u : 0u; } }
                    c = half_sum_u(c);
                    if (c < need) I = cand;
                }
                if (tie) cut = I;
            }
            int cutr = (int)cut - r4; asm volatile("" : "+v"(cutr));
#pragma unroll
            for (int i = 0; i < 16; ++i) {
                unsigned nib = 0u;
#pragma unroll
                for (int e = 0; e < 4; ++e) { const unsigned k = sk[4 * i + e]; const bool sel = k != 0u && (k > T || (k == T && (128 * i + e) <= cutr)); nib |= sel ? (1u << e) : 0u; }
                if (nib) __hip_atomic_fetch_or((LAS unsigned*)&mask[(q0 + hh) * 64 + 4 * i + (r >> 3)], nib << (4 * (r & 7)), __ATOMIC_RELAXED, __HIP_MEMORY_SCOPE_WORKGROUP);
            }
        }
    }
    __syncthreads();
#ifndef T_NOCORE
    attn_core<true>(F, row0, nkt, 64, WSP(bf16, WS_QB), WSP(bf16, WS_KB) + (size_t)b * SEQ * 512, WSP(bf16, WS_VT) + (size_t)b * 512 * SEQ, C_GA, 1024);
#endif
}
__device__ __forceinline__ void gather_attn_item(Frame& F, int q, bool dsa) {
    const int lane = F.lane, hd = lane >> 4, d0 = (lane & 15) * 8, db = q >> 2, row = NTOKP + q;
    LAS float* red = (LAS float*)(F.lds + RING_OFF);
    LAS float* racc = red + 64;
    const float* kptr; const float* vptr;
    {
        const int ki = F.wave * 32 + (lane & 31);
        if (dsa) { const int idx = WSP(int, WS_IDX)[(size_t)q * TOPK + ki];
            if (idx < PAST) { const size_t phys = (size_t)((const int*)F.in[I_PT])[db * NPAGES + (idx >> 7)] * PAGE + (idx & 127); kptr = F.in[I_CK] + phys * 512; vptr = F.in[I_CV] + phys * 512; }
            else { const int j = idx - PAST; kptr = F.out + O_KS + (size_t)(db * DT + j) * 512; vptr = F.out + O_VS + (size_t)(db * DT + j) * 512; } }
        else { kptr = F.in[I_CMK] + (size_t)(db * MEMT + ki) * 512; vptr = F.in[I_CMV] + (size_t)(db * MEMT + ki) * 512; }
    }
    const bf16* qb = (dsa ? WSP(bf16, WS_QB) : WSP(bf16, WS_QMB)) + (size_t)row * 512 + hd * 128 + d0;
    float qv[8];
    { const v4u u = *(const v4u*)qb; qv[0] = __uint_as_float(u.x << 16); qv[1] = __uint_as_float(u.x & 0xffff0000u); qv[2] = __uint_as_float(u.y << 16); qv[3] = __uint_as_float(u.y & 0xffff0000u);
      qv[4] = __uint_as_float(u.z << 16); qv[5] = __uint_as_float(u.z & 0xffff0000u); qv[6] = __uint_as_float(u.w << 16); qv[7] = __uint_as_float(u.w & 0xffff0000u); }
    LAS float* sl = racc + 8 * 8 * 64 + F.wave * 128;
    float mx = -INFINITY;
#pragma unroll 16
    for (int i = 0; i < 32; ++i) {
        const unsigned long long pk = (unsigned long long)kptr;
        const unsigned lo = __shfl((int)(unsigned)pk, i), hi = __shfl((int)(unsigned)(pk >> 32), i);
        const float* kr = (const float*)(((unsigned long long)hi << 32) | lo) + hd * 128 + d0;
        const f32x4 a = *(const f32x4*)kr, c = *(const f32x4*)(kr + 4);
        float s = (a.x * qv[0] + a.y * qv[1]) + (a.z * qv[2] + a.w * qv[3]) + (c.x * qv[4] + c.y * qv[5]) + (c.z * qv[6] + c.w * qv[7]);
        s = row16_sum(s); mx = fmaxf(mx, s);
        if ((lane & 15) == 0) sl[i * 4 + hd] = s;
    }
    if ((lane & 15) == 0) red[F.wave * 4 + hd] = mx;
    __syncthreads();
    float gm = red[hd];
#pragma unroll
    for (int w = 1; w < 8; ++w) gm = fmaxf(gm, red[w * 4 + hd]);
    __syncthreads();
    float acc[8]; float ls = 0.f;
#pragma unroll
    for (int e = 0; e < 8; ++e) acc[e] = 0.f;
#pragma unroll 16
    for (int i = 0; i < 32; ++i) {
        const unsigned long long pv = (unsigned long long)vptr;
        const unsigned lo = __shfl((int)(unsigned)pv, i), hi = __shfl((int)(unsigned)(pv >> 32), i);
        const float* vr = (const float*)(((unsigned long long)hi << 32) | lo) + hd * 128 + d0;
        const f32x4 a = *(const f32x4*)vr, c = *(const f32x4*)(vr + 4);
        const float p = exp2f(sl[i * 4 + hd] - gm); ls += p;
        acc[0] += p * a.x; acc[1] += p * a.y; acc[2] += p * a.z; acc[3] += p * a.w; acc[4] += p * c.x; acc[5] += p * c.y; acc[6] += p * c.z; acc[7] += p * c.w;
    }
    if ((lane & 15) == 0) red[F.wave * 4 + hd] = ls;
#pragma unroll
    for (int e = 0; e < 8; ++e) racc[(F.wave * 8 + e) * 64 + lane] = acc[e];
    __syncthreads();
    if (F.wave == 0) {
        float l = 0.f;
#pragma unroll
        for (int w = 0; w < 8; ++w) l += red[w * 4 + hd];
        const float inv = 1.f / l;
        const float* gp = WSP(float, WS_PROJ) + (size_t)row * INWP + (dsa ? C_GA : C_GM) + hd * 128 + d0;
        float v[8];
#pragma unroll
        for (int e = 0; e < 8; ++e) { float a = 0.f;
#pragma unroll
            for (int w = 0; w < 8; ++w) a += racc[(w * 8 + e) * 64 + lane];
            v[e] = a * inv * silu(gp[e]); }
        v4u pk; pk.x = cvt_pk_bf16(v[0], v[1]); pk.y = cvt_pk_bf16(v[2], v[3]); pk.z = cvt_pk_bf16(v[4], v[5]); pk.w = cvt_pk_bf16(v[6], v[7]);
        *(v4u*)(WSP(bf16, WS_YMIX) + (size_t)row * DM + (dsa ? 1024 : 1536) + hd * 128 + d0) = pk;
    }
    __syncthreads();
}
__device__ __forceinline__ void p6_phase(Frame& F) {
    { const int gt = F.bid * NTHR + F.tid, NGT = F.G * NTHR;
      for (int e = gt; e < NTOKS * DM / 4; e += NGT) *(f32x4*)(F.out + O_YS + (size_t)e * 4) = *(const f32x4*)(F.in[I_XS] + (size_t)e * 4); }
    if (F.G >= 64) { for (int it = F.bid; it < 256; it += F.G) gather_attn_item(F, it & 127, it < 128); return; }
    unsigned* qctr = (unsigned*)(F.ws + WS_CTL) + 8192;
    volatile LAS int* slot = (volatile LAS int*)(F.lds + LDSCTL_OFF + 64);
    for (;;) {
        if (F.tid == 0) *slot = (int)__hip_atomic_fetch_add(qctr, 1u, __ATOMIC_RELAXED, __HIP_MEMORY_SCOPE_AGENT);
        __syncthreads();
        const int it = *slot;
        __syncthreads();
        if (it >= 768) break;
        Frame Fi = F; asm volatile("" : "+v"(Fi.lane), "+v"(Fi.tid));
        if (it < 256) { const int b = it & 3, qt = 63 - (it >> 2); dsa_prompt_item(Fi, b, qt); }
        else if (it < 512) { const int j = it - 256; gather_attn_item(Fi, j & 127, j < 128); }
        else { const int j = it - 512, b = j >> 6, qt = j & 63;
            attn_core<false>(Fi, b * SEQ + qt * 32, 8, 8, WSP(bf16, WS_QMB), WSP(bf16, WS_MKB) + (size_t)b * MEMT * 512, WSP(bf16, WS_MVT) + (size_t)b * 512 * MEMT, C_GM, 1536); }
    }
}

constexpr int G4_RING_BYTES = 3 * (16 * 384 + 16 * 16) * 4;
constexpr int G4_MASK_OFF = 77824, G4_SKL_OFF = G4_MASK_OFF + 8192;
constexpr int G4_SLOT_OFF = LDSCTL_OFF + 128;
struct GBar { volatile LAS unsigned* cnt; unsigned target; };
__device__ __forceinline__ void gbar(GBar& g, int lane) {
    g.target += 4u;
    asm volatile("s_waitcnt lgkmcnt(0)" ::: "memory");
    if (lane == 0) __hip_atomic_fetch_add((LAS unsigned*)g.cnt, 1u, __ATOMIC_RELAXED, __HIP_MEMORY_SCOPE_WORKGROUP);
    unsigned sp = 0; while (*g.cnt < g.target) { __builtin_amdgcn_s_sleep(1); if (++sp > (1u << 24)) break; }
    asm volatile("" ::: "memory");
}
constexpr int S4_TC = 16, S4_NB = 3, S4_BUF_FLOATS = S4_TC * 384 + S4_TC * 16, S4_NCH = SEQ / S4_TC;
__device__ __forceinline__ void scan4_issue(LAS unsigned char* lds, const float* sin, const float* scal, int c, int sw, int lane) {
    LAS float* buf = (LAS float*)(lds + RING_OFF) + (c % S4_NB) * S4_BUF_FLOATS;
    const float* src = sin + (size_t)c * S4_TC * 384;
#pragma unroll
    for (int i = 0; i < 6; ++i) { const int piece = sw + 4 * i;
        __builtin_amdgcn_global_load_lds((const unsigned*)(src + piece * 256 + lane * 4), (LAS unsigned*)(buf + piece * 256), 16, 0, 0); }
    __builtin_amdgcn_global_load_lds((const unsigned*)(scal + (size_t)c * S4_TC * 16 + lane * 4), (LAS unsigned*)(buf + S4_TC * 384), 16, 0, 0);
}
__device__ __forceinline__ void scan4_item(Frame& F, GBar& gb, int b, int h, int rg, float* s_out, float* y0) {
    const int bh = b * RH + h, lane = F.lane, sw = F.wave;
    const float* sin = WSP(float, WS_SCANIN) + (size_t)bh * SEQ * 384; const float* scal = WSP(float, WS_SCAL) + (size_t)bh * SEQ * 16;
    const int ri = lane >> 4, kq = lane & 15, vrow = rg * 16 + sw * 4 + ri;
    f32x2 s01 = (f32x2){0.f, 0.f}, s23 = (f32x2){0.f, 0.f};
    scan4_issue(F.lds, sin, scal, 0, sw, lane); scan4_issue(F.lds, sin, scal, 1, sw, lane);
    for (int c = 0; c < S4_NCH; ++c) {
        if (c < 2 || c + 2 >= S4_NCH) asm volatile("s_waitcnt vmcnt(0)" ::: "memory");
        else asm volatile("s_waitcnt vmcnt(9)" ::: "memory");
        gbar(gb, lane);
        if (c + 2 < S4_NCH) scan4_issue(F.lds, sin, scal, c + 2, sw, lane);
        const LAS float* buf = (const LAS float*)(F.lds + RING_OFF) + (c % S4_NB) * S4_BUF_FLOATS;
        const LAS float* lb = buf + 4 * kq;
        const LAS float* vb = buf + 320 + vrow;
        const LAS float* sb = buf + S4_TC * 384;
        float yacc = 0.f;
#define S4_LOAD(ST, KK, W4, NB, KP, WR, TB) do { KK = *(const LAS f32x4*)(lb + (ST) * 384); W4 = *(const LAS f32x4*)(lb + (ST) * 384 + 64); NB = *(const LAS f32x4*)(lb + (ST) * 384 + 128); \
            KP = *(const LAS f32x4*)(lb + (ST) * 384 + 192); WR = *(const LAS f32x4*)(lb + (ST) * 384 + 256); const float _v = vb[(ST) * 384]; const f32x2 _s = *(const LAS f32x2*)(sb + (ST) * 16); \
            TB.x = _v; TB.y = _s.x; TB.z = _s.y; TB.w = 0.f; } while (0)
        f32x4 kkA, w4A, nbA, kpA, wrA, tbA, kkB, w4B, nbB, kpB, wrB, tbB;
        S4_LOAD(0, kkA, w4A, nbA, kpA, wrA, tbA); S4_LOAD(1, kkB, w4B, nbB, kpB, wrB, tbB);
#pragma unroll
        for (int st = 0; st < S4_TC; st += 2) {
            const int s2 = (st + 2 < S4_TC) ? st + 2 : st, s3 = (st + 3 < S4_TC) ? st + 3 : st + 1;
            float y;
            SCAN_STEP(kkA, w4A, nbA, kpA, wrA, tbA, y);
            yacc = (kq == st) ? y : yacc;
            S4_LOAD(s2, kkA, w4A, nbA, kpA, wrA, tbA);
            __builtin_amdgcn_sched_barrier(0);
            SCAN_STEP(kkB, w4B, nbB, kpB, wrB, tbB, y);
            yacc = (kq == st + 1) ? y : yacc;
            S4_LOAD(s3, kkB, w4B, nbB, kpB, wrB, tbB);
            __builtin_amdgcn_sched_barrier(0);
        }
#undef S4_LOAD
        y0[(size_t)(c * S4_TC + kq) * RW + vrow] = yacc;
    }
    *(f32x4*)(s_out + (size_t)vrow * 64 + 4 * kq) = (f32x4){s01.x, s01.y, s23.x, s23.y};
}
template <bool MASKED>
__device__ __forceinline__ void attn4(Frame& F, int gw, int row0, int nkt, int NT, const bf16* Qb, const bf16* Kf, const bf16* Vf, int gate_col, int out_col) {
    const int lane = F.lane, r = lane & 31, hh = lane >> 5, h = gw;
    const LAS unsigned* mask = (const LAS unsigned*)(F.lds + G4_MASK_OFF) + r * 64;
    bf16x8 qf[8];
#pragma unroll
    for (int ks = 0; ks < 8; ++ks) qf[ks] = *(const bf16x8*)(Qb + (size_t)(row0 + r) * 512 + h * 128 + 16 * ks + 8 * hh);
    f32x16 o[4];
#pragma unroll
    for (int d = 0; d < 4; ++d)
#pragma unroll
        for (int j = 0; j < 16; ++j) o[d][j] = 0.f;
    float m = -INFINITY, lsum = 0.f;
    const bf16* kbase = Kf + (size_t)(h * NT) * 4096 + lane * 8;
    const bf16* vbase = Vf + (size_t)(h * NT) * 4096 + lane * 8;
    bf16x8 kf[8];
#pragma unroll
    for (int ks = 0; ks < 8; ++ks) kf[ks] = *(const bf16x8*)(kbase + ks * 512);
#pragma unroll 1
    for (int kt = 0; kt < nkt; ++kt) {
        bf16x8 vf[4][2];
#pragma unroll
        for (int d = 0; d < 4; ++d)
#pragma unroll
            for (int s = 0; s < 2; ++s) vf[d][s] = *(const bf16x8*)(vbase + (size_t)kt * 4096 + (d * 2 + s) * 512);
        f32x16 x;
#pragma unroll
        for (int j = 0; j < 16; ++j) x[j] = 0.f;
#pragma unroll
        for (int ks = 0; ks < 8; ++ks) x = __builtin_amdgcn_mfma_f32_32x32x16_bf16(kf[ks], qf[ks], x, 0, 0, 0);
        {   const int ktn = (kt + 1 < nkt) ? kt + 1 : kt;
#pragma unroll
            for (int ks = 0; ks < 8; ++ks) kf[ks] = *(const bf16x8*)(kbase + (size_t)ktn * 4096 + ks * 512); }
        if (MASKED) {
            const unsigned m4 = mask[kt] >> (4 * hh);
#pragma unroll
            for (int g = 0; g < 4; ++g)
#pragma unroll
                for (int e = 0; e < 4; ++e) { const unsigned t = (unsigned)((int)(m4 << (31 - (8 * g + e))) >> 31);
                    x[4 * g + e] = __uint_as_float((__float_as_uint(x[4 * g + e]) & t) | (0xff800000u & ~t)); }
        }
        float mx = x[0];
#pragma unroll
        for (int j = 1; j < 16; ++j) mx = fmaxf(mx, x[j]);
        mx = xhalf_max(mx);
        const float mn = fmaxf(m, mx), mu = (mn == -INFINITY) ? 0.f : mn;
        const float alpha = __builtin_amdgcn_exp2f(m - mu);
        m = mn;
        float ls = 0.f;
#pragma unroll
        for (int j = 0; j < 16; ++j) { x[j] = __builtin_amdgcn_exp2f(x[j] - mu); ls += x[j]; }
        lsum = lsum * alpha + ls;
        if (__any(alpha != 1.f)) {
#pragma unroll
            for (int d = 0; d < 4; ++d)
#pragma unroll
                for (int j = 0; j < 16; ++j) o[d][j] *= alpha;
        }
        bf16x8 pf[2];
#pragma unroll
        for (int s = 0; s < 2; ++s) { v4u u; u.x = cvt_pk_bf16(x[8 * s + 0], x[8 * s + 1]); u.y = cvt_pk_bf16(x[8 * s + 2], x[8 * s + 3]); u.z = cvt_pk_bf16(x[8 * s + 4], x[8 * s + 5]); u.w = cvt_pk_bf16(x[8 * s + 6], x[8 * s + 7]);
            pf[s] = __builtin_bit_cast(bf16x8, u); }
#pragma unroll
        for (int d = 0; d < 4; ++d)
#pragma unroll
            for (int s = 0; s < 2; ++s) o[d] = __builtin_amdgcn_mfma_f32_32x32x16_bf16(vf[d][s], pf[s], o[d], 0, 0, 0);
    }
    lsum = xhalf_sum(lsum);
    const float inv = lsum > 0.f ? 1.f / lsum : 0.f;
    const float* gp = WSP(float, WS_PROJ) + (size_t)(row0 + r) * INWP + gate_col + h * 128;
    bf16* op = WSP(bf16, WS_YMIX) + (size_t)(row0 + r) * DM + out_col + h * 128;
#pragma unroll
    for (int d = 0; d < 4; ++d)
#pragma unroll
        for (int g = 0; g < 4; ++g) { const int dd = d * 32 + 8 * g + 4 * hh; const f32x4 gv = *(const f32x4*)(gp + dd);
            float v[4];
#pragma unroll
            for (int e = 0; e < 4; ++e) v[e] = o[d][4 * g + e] * inv * silu(gv[e]);
            v2u pk; pk.x = cvt_pk_bf16(v[0], v[1]); pk.y = cvt_pk_bf16(v[2], v[3]); *(v2u*)(op + dd) = pk; }
}
__device__ __forceinline__ void dsa4_item(Frame& F, GBar& gb, int gw, int b, int qt) {
    const int t0 = qt * 32, row0 = b * SEQ + t0, nkt = qt + 1, gt = gw * 64 + F.lane;
    LAS unsigned* mask = (LAS unsigned*)(F.lds + G4_MASK_OFF);
    if (t0 + 31 < TOPK) {
        for (int i = gt; i < 32 * 64; i += 256) { const int q = i >> 6, kt = i & 63; const int nb = t0 + q - 32 * kt + 1;
            mask[i] = nb >= 32 ? 0xffffffffu : (nb <= 0 ? 0u : ((1u << nb) - 1u)); }
    } else {
        const int lane = F.lane, r = lane & 31, hh = lane >> 5;
        int r4 = 4 * r; asm volatile("" : "+v"(r4));
        const bf16* KIB = WSP(bf16, WS_SC) + (size_t)(b * SEQ) * 64 + lane * 8;
        LAS unsigned* skl = (LAS unsigned*)(F.lds + G4_SKL_OFF) + gw * 4096 + hh * 2048;
        for (int i = gt; i < 32 * 64; i += 256) mask[i] = 0u;
        gbar(gb, lane);
        for (int pass = 0; pass < 4; ++pass) {
            const int q0 = 8 * pass + 2 * gw, tq = t0 + q0 + hh;
            {
                bf16x8 af[4]; idx_afrag(WSP(bf16, WS_QIB), row0 + q0, lane, af);
                f32x4 w[4];
#pragma unroll
                for (int j = 0; j < 4; ++j) w[j] = *(const f32x4*)(WSP(float, WS_WIS) + (size_t)(row0 + q0 + hh) * 16 + 4 * j);
                bf16x8 ring[4][4];
#pragma unroll
                for (int i = 0; i < 3; ++i) { const int ktc = i < nkt ? i : nkt - 1;
#pragma unroll
                    for (int ks = 0; ks < 4; ++ks) ring[i][ks] = *(const bf16x8*)(KIB + (size_t)ktc * 2048 + ks * 512); }
                for (int kt0 = 0; kt0 < nkt; kt0 += 4) {
#pragma unroll
                    for (int i = 0; i < 4; ++i) {
                        const int kt = kt0 + i, ktp = (kt + 3 < nkt) ? kt + 3 : nkt - 1;
#pragma unroll
                        for (int ks = 0; ks < 4; ++ks) ring[(i + 3) & 3][ks] = *(const bf16x8*)(KIB + (size_t)ktp * 2048 + ks * 512);
                        f32x16 acc;
#pragma unroll
                        for (int j = 0; j < 16; ++j) acc[j] = 0.f;
#pragma unroll
                        for (int ks = 0; ks < 4; ++ks) acc = __builtin_amdgcn_mfma_f32_32x32x16_bf16(af[ks], ring[i][ks], acc, 0, 0, 0);
                        if (kt < nkt) skl[kt * 32 + r] = sort_key(idx_reduce(acc, w));
                    }
                }
            }
            asm volatile("s_waitcnt lgkmcnt(0)" ::: "memory");
            unsigned sk[64];
            int tqr = tq - r4; asm volatile("" : "+v"(tqr));
#pragma unroll
            for (int i = 0; i < 16; ++i) { const v4u v = *(const LAS v4u*)(skl + 128 * i + r4);
                sk[4 * i + 0] = (128 * i + 0 <= tqr) ? v.x : 0u; sk[4 * i + 1] = (128 * i + 1 <= tqr) ? v.y : 0u; sk[4 * i + 2] = (128 * i + 2 <= tqr) ? v.z : 0u; sk[4 * i + 3] = (128 * i + 3 <= tqr) ? v.w : 0u; }
            unsigned T = 0u; bool exact = false;
            for (int bit = 31; bit >= 0; --bit) {
                const unsigned cand = T | (1u << bit);
                unsigned c = 0u;
#pragma unroll
                for (int i = 0; i < 64; ++i) cnt_ge(c, sk[i], cand);
                c = half_sum_u(c);
                if (!exact) { if (c >= (unsigned)TOPK) T = cand; if (c == (unsigned)TOPK) exact = true; }
                if (__all(exact)) break;
            }
            unsigned cut = 0x7fffffffu;
            if (__any(!exact)) {
                unsigned cg = 0u, ce = 0u;
                for (int i = 0; i < 16; ++i) { const v4u v = *(const LAS v4u*)(skl + 128 * i + r4); const int i0 = 128 * i + r4;
#pragma unroll
                    for (int e = 0; e < 4; ++e) { const unsigned k = (i0 + e <= tq) ? v[e] : 0u; cg += (k > T) ? 1u : 0u; ce += (k == T) ? 1u : 0u; } }
                cg = half_sum_u(cg); ce = half_sum_u(ce);
                const unsigned need = (unsigned)TOPK - cg;
                const bool tie = !exact && ce > need;
                unsigned I = 0u;
                for (int bit = 11; bit >= 0; --bit) {
                    const unsigned cand = I | (1u << bit);
                    unsigned c = 0u;
                    for (int i = 0; i < 16; ++i) { const v4u v = *(const LAS v4u*)(skl + 128 * i + r4); const int i0 = 128 * i + r4;
#pragma unroll
                        for (int e = 0; e < 4; ++e) { const unsigned k = (i0 + e <= tq) ? v[e] : 0u; c += (k == T && (unsigned)(i0 + e) < cand) ? 1u : 0u; } }
                    c = half_sum_u(c);
                    if (c < need) I = cand;
                }
                if (tie) cut = I;
            }
            int cutr = (int)cut - r4; asm volatile("" : "+v"(cutr));
#pragma unroll
            for (int i = 0; i < 16; ++i) {
                unsigned nib = 0u;
#pragma unroll
                for (int e = 0; e < 4; ++e) { const unsigned k = sk[4 * i + e]; const bool sel = k != 0u && (k > T || (k == T && (128 * i + e) <= cutr)); nib |= sel ? (1u << e) : 0u; }
                if (nib) __hip_atomic_fetch_or((LAS unsigned*)&mask[(q0 + hh) * 64 + 4 * i + (r >> 3)], nib << (4 * (r & 7)), __ATOMIC_RELAXED, __HIP_MEMORY_SCOPE_WORKGROUP);
            }
        }
    }
    gbar(gb, F.lane);
    attn4<true>(F, gw, row0, nkt, 64, WSP(bf16, WS_QB), WSP(bf16, WS_KB) + (size_t)b * SEQ * 512, WSP(bf16, WS_VT) + (size_t)b * 512 * SEQ, C_GA, 1024);
    gbar(gb, F.lane);
}
__device__ __forceinline__ void group_queue(Frame& F, GBar& gb, int gw) {
    unsigned* qctr = (unsigned*)(F.ws + WS_CTL) + 8192;
    volatile LAS int* slot = (volatile LAS int*)(F.lds + G4_SLOT_OFF);
    for (int n = 0;; ++n) {
        if (gw == 0 && F.lane == 0) slot[n & 1] = (int)__hip_atomic_fetch_add(qctr, 1u, __ATOMIC_RELAXED, __HIP_MEMORY_SCOPE_AGENT);
        gbar(gb, F.lane);
        const int it = slot[n & 1];
        if (it >= 512) break;
        Frame Fi = F; asm volatile("" : "+v"(Fi.lane), "+v"(Fi.tid));
        if (it < 256) dsa4_item(Fi, gb, gw, it & 3, 63 - (it >> 2));
        else { const int j = it - 256, b = j >> 6, qt = j & 63;
            attn4<false>(Fi, gw, b * SEQ + qt * 32, 8, 8, WSP(bf16, WS_QMB), WSP(bf16, WS_MKB) + (size_t)b * MEMT * 512, WSP(bf16, WS_MVT) + (size_t)b * 512 * MEMT, C_GM, 1536); }
    }
}
__device__ __forceinline__ bool overlap_mode(const Frame& F) { return F.G >= 64; }
__device__ __forceinline__ void p3_overlap(Frame& F) {
    volatile LAS unsigned* ctl = (volatile LAS unsigned*)(F.lds + G4_SLOT_OFF);
    const unsigned c_scan = ctl[4], c_att = ctl[8];
    __syncthreads();
    if (F.wave < 4) {
        GBar gb{ctl + 4, c_scan};
        for (int it0 = F.bid; it0 < 256; it0 += F.G) { const int it = (F.G == 256) ? ((it0 & 7) * 32 + (it0 >> 3)) : it0;
            const int bh = it >> 2, rg = it & 3, b = bh >> 4, h = bh & 15;
            scan4_item(F, gb, b, h, rg, F.out + O_WKVP + (size_t)bh * 4096, WSP(float, WS_Y) + (size_t)(b * SEQ) * RW + h * 64);
            asm volatile("s_waitcnt vmcnt(0)" ::: "memory"); gbar(gb, F.lane); }
    } else {
        GBar gb{ctl + 8, c_att};
        const int gw = F.wave - 4;
        const int gwi = F.bid * 4 + gw, NGW = F.G * 4;
        for (int it = gwi; it < DB * RH * 16; it += NGW) scan_sample_witem(F, it);
        group_queue(F, gb, gw);
    }
    __syncthreads();
}
__device__ __forceinline__ void p8_phase(Frame& F) {
    const int gw = F.bid * NWAVES + F.wave, NGW = F.G * NWAVES;
    for (int row = gw; row < NTOK; row += NGW) {
        float* y = F.out + (row < NTOKP ? O_YP + (size_t)row * DM : O_YS + (size_t)(row - NTOKP) * DM);
        f32x4* xr = (f32x4*)y + F.lane; const f32x4* wr = (const f32x4*)F.in[I_FNW] + F.lane;
        f32x4 v[8]; float s = 0.f;
#pragma unroll
        for (int j = 0; j < 8; ++j) { v[j] = xr[64 * j]; s += (v[j].x * v[j].x + v[j].y * v[j].y) + (v[j].z * v[j].z + v[j].w * v[j].w); }
        const float rs = 1.f / sqrtf(wave_sum(s) * (1.f / DM) + RMS_EPS);
#pragma unroll
        for (int j = 0; j < 8; ++j) { const f32x4 ww = wr[64 * j]; xr[64 * j] = (f32x4){v[j].x * rs * ww.x, v[j].y * rs * ww.y, v[j].z * rs * ww.z, v[j].w * rs * ww.w}; }
    }
}

constexpr int N_PHASES = 9;
struct Args { const void* in[N_IN]; float* out; unsigned char* ws; int ph_lo, ph_hi; };
__global__ void __launch_bounds__(NTHR, 2) hymba_fwd(Args args) {
    extern __shared__ __attribute__((aligned(16))) unsigned char lds[];
    Frame F;
    F.lds = (LAS unsigned char*)lds;
    F.tid = threadIdx.x; F.lane = F.tid & 63; F.wave = __builtin_amdgcn_readfirstlane(F.tid >> 6);
    F.G = gridDim.x; F.bid = blockIdx.x;
#pragma unroll
    for (int i = 0; i < N_IN; ++i) F.in[i] = (const float*)args.in[i];
    F.out = args.out; F.ws = args.ws;
    for (int u = F.tid; u < (LDS_BYTES - LDSCTL_OFF) / 4; u += NTHR) ((LAS unsigned*)(F.lds + LDSCTL_OFF))[u] = 0u;
    __syncthreads();
#if MK_SPLIT
#define GRID_BAR() do { } while (0)
#else
    XcdBarrier bar = xcd_barrier_post((unsigned*)(F.ws + WS_CTL) + CW_BAR, (volatile LAS unsigned*)(F.lds + MISC_OFF) + 8);
#define GRID_BAR() xcd_barrier(bar)
#endif
    const int lo = args.ph_lo, hi = args.ph_hi;
#ifndef PH_MASK
#define PH_MASK 0x1FF
#endif
#define IN(k) (((PH_MASK >> (k)) & 1) && lo <= (k) && (k) < hi)
#define BOTH(k) (IN(k) && IN((k) + 1))

#define RUNPH(k, ...) do { if (IN(k)) { __VA_ARGS__; if (PROBE_REPEAT == (k)) { GRID_BAR(); __VA_ARGS__; } if (BOTH(k)) GRID_BAR(); } } while (0)
    RUNPH(0, p0_prologue(F));
    RUNPH(1, {
        { pg8::Gemm g{WSP(bf16, WS_XN), WSP(bf16, WS_WINT), MPAD, INWP, DM, DM}; pg8::StaticOrder S; S.init(MPAD, INWP, F.G, F.bid);
          EpiProj E{WSP(float, WS_PROJ)};
          pg8::gemm_phase<EpiProj, pg8::StaticOrder, true, true>(F.lds + RING_OFF, g, S, E); }
        { pg8::Gemm g{WSP(bf16, WS_XM), WSP(bf16, WS_WMEMT), 1024, 1024, DM, DM}; pg8::StaticOrder S; S.init(1024, 1024, F.G, F.G - 1 - F.bid);
          EpiMem E{F.out};
          pg8::gemm_phase<EpiMem, pg8::StaticOrder, true, true>(F.lds + RING_OFF, g, S, E); }
    });
    RUNPH(2, p2_phase(F));
    if (F.G >= 64) { RUNPH(3, p3_overlap(F)); } else { RUNPH(3, p3_scan_phase(F)); }
    RUNPH(4, p4_phase(F));
    RUNPH(5, p5_phase(F));
    RUNPH(6, p6_phase(F));
    RUNPH(7, {
        { pg8::Gemm g{WSP(bf16, WS_YMIX), WSP(bf16, WS_WOUTT), NTOKP, DM, DM, DM}; pg8::StaticOrder S; S.init(NTOKP, DM, F.G, F.bid);
          EpiOut E{F.in[I_XP], F.in[I_XS], F.out};
          pg8::gemm_phase<EpiOut, pg8::StaticOrder, true, true>(F.lds + RING_OFF, g, S, E); }
        { pg8::Gemm g{WSP(bf16, WS_YMIX), WSP(bf16, WS_WOUTT), MPAD, DM, 256, DM}; pg8::ListOrder S{F.G, F.bid, 2};
          EpiOutAtomic E{F.out};
          pg8::gemm_phase<EpiOutAtomic, pg8::ListOrder, true, true>(F.lds + RING_OFF, g, S, E); }
    });
    if (IN(8)) { p8_phase(F); }
#undef IN
#undef BOTH
}

extern "C" void kernel_launch(void* const* d_in, const int* in_sizes, int n_in, void* d_out, int out_size, void* d_ws, size_t ws_size, hipStream_t stream) {
    static int grid = 0;
    if (grid == 0) {
        if (n_in != N_IN || out_size != (int)O_END || ws_size < WS_END) { fprintf(stderr, "kernel_launch: unexpected shapes: n_in %d out %d ws %zu (need %zu)\n", n_in, out_size, ws_size, (size_t)WS_END); grid = -1; return; }
        int dev = 0, cus = 0, per_cu = 0;
        if (hipGetDevice(&dev) != hipSuccess || hipDeviceGetAttribute(&cus, hipDeviceAttributeMultiprocessorCount, dev) != hipSuccess) { grid = -1; return; }
        if (hipFuncSetAttribute((const void*)hymba_fwd, hipFuncAttributeMaxDynamicSharedMemorySize, LDS_BYTES) != hipSuccess) { fprintf(stderr, "kernel_launch: hipFuncSetAttribute failed\n"); grid = -1; return; }
        if (hipOccupancyMaxActiveBlocksPerMultiprocessor(&per_cu, (const void*)hymba_fwd, NTHR, LDS_BYTES) != hipSuccess || per_cu < 1) { fprintf(stderr, "kernel_launch: occupancy query says %d\n", per_cu); }
        (void)hipGetLastError();
        grid = cus;
    }
    if (grid < 0) return;
    if (hipMemsetAsync((char*)d_ws + WS_CTL, 0, CTL_ZERO_BYTES, stream) != hipSuccess) { fprintf(stderr, "kernel_launch: memset failed\n"); return; }
    Args a{};
    for (int i = 0; i < N_IN; ++i) a.in[i] = d_in[i];
    a.out = (float*)d_out; a.ws = (unsigned char*)d_ws;
#if MK_SPLIT
    for (int p = 0; p < N_PHASES; ++p) { a.ph_lo = p; a.ph_hi = p + 1; hipLaunchKernelGGL(hymba_fwd, dim3(grid), dim3(NTHR), LDS_BYTES, stream, a); }
#else
    a.ph_lo = 0; a.ph_hi = N_PHASES;
    hipLaunchKernelGGL(hymba_fwd, dim3(grid), dim3(NTHR), LDS_BYTES, stream, a);
#endif
    const hipError_t le = hipPeekAtLastError();
    if (le != hipSuccess) fprintf(stderr, "kernel_launch: launch failed: %s\n", hipGetErrorName(le));
}
```

```cpp
#include <hip/hip_runtime.h>
#include <cstdio>
#include <cstdint>

#ifndef MK_SPLIT
#define MK_SPLIT 0
#endif

namespace pg8 {
#define PG8_LAS __attribute__((address_space(3)))
typedef unsigned short bf16_t;
typedef short bf16x8 __attribute__((ext_vector_type(8)));
typedef float f32x4 __attribute__((ext_vector_type(4)));
typedef unsigned u32x4 __attribute__((ext_vector_type(4)));
constexpr int BM = 256, BK = 64, HALF = 128, HTB = HALF * BK * 2, STAGE_BYTES = 8 * HTB, NXCD = 8, WGM = 8;

__host__ __device__ __forceinline__ int lds_byte(int r, int c) { const int st = (r >> 4) * 2 + (c >> 5), rr = r & 15, cc = c & 31, ob = rr * 64 + cc * 2; return st * 1024 + (ob ^ (((ob >> 9) & 1) << 5)); }
__host__ __device__ __forceinline__ void stage_rc(int b, int& R, int& C) { const int st = b / 1024, sb = b % 1024, swz = sb ^ (((sb >> 9) & 1) << 5); R = (st >> 1) * 16 + swz / 64; C = (st & 1) * 32 + (swz % 64) / 2; }

struct Unit { int pm, pn, koff; };
struct Gemm { const bf16_t* A; const bf16_t* Bt; int M, N, K, ld; };

struct StaticOrder {
    int nM, nN, nwg, G, c;
    __host__ __device__ void init(int M, int N, int G_, int c_) { nM = M / BM; nN = N / BM; nwg = nM * nN; G = G_; c = c_; }
    __host__ __device__ bool next(int i, Unit& u) const {
        const long L = (long)i * G + c; if (L >= nwg) return false;
        int wgid = (int)L; { const int q = nwg / NXCD, r = nwg % NXCD, xcd = wgid % NXCD, off = wgid / NXCD; wgid = (xcd < r ? xcd * (q + 1) : r * (q + 1) + (xcd - r) * q) + off; }
        const int nig = WGM * nN, gid = wgid / nig, fm = gid * WGM, gsz = (nM - fm) < WGM ? (nM - fm) : WGM;
        u.pm = fm + ((wgid % nig) % gsz); u.pn = (wgid % nig) / gsz; u.koff = 0; return true;
    }
    __device__ __forceinline__ void a_ready(const Unit&) const {}
    __device__ __forceinline__ void done(const Unit&) const {}
};

struct ListOrder {
    int G, c, mode;
    __device__ __forceinline__ bool next(int i, Unit& u) const {
        const int L = i * G + c;
        if (mode == 0) { if (L >= 260) return false; const int q = L & 3, uu = L >> 2; if (uu < 33) { u.pm = 32; u.pn = uu; } else { u.pm = uu - 33; u.pn = 32; } u.koff = q * 512; return true; }
        if (mode == 1) { if (L >= 64) return false; const int q = L & 3, uu = L >> 2; u.pm = uu >> 2; u.pn = uu & 3; u.koff = q * 512; return true; }
        if (L >= 64) return false; u.pm = 32; u.pn = L >> 3; u.koff = (L & 7) * 256; return true;
    }
    __device__ __forceinline__ void a_ready(const Unit&) const {}
    __device__ __forceinline__ void done(const Unit&) const {}
};
template <class Epi, class Sched, bool ALIGN_EPI = false, bool SP2 = false>
__device__ __forceinline__ void gemm_phase(PG8_LAS unsigned char* lds, const Gemm g, const Sched& S, const Epi& E) {
    const int tid = threadIdx.x, wid = __builtin_amdgcn_readfirstlane(tid >> 6), lane = tid & 63, wr = wid >> 2, wc = wid & 3, fr = lane & 15, fq = lane >> 4;
    const int K = g.K, nt = K / BK;
    unsigned voffA[2], voffB[2];
    const int ld = g.ld;
#pragma unroll
    for (int i = 0; i < 2; ++i) { int R, C; stage_rc(tid * 16 + i * 8192, R, C); voffA[i] = (unsigned)(R * ld + C) * 2u; voffB[i] = (unsigned)(R * ld + C) * 2u; }
    const size_t kstep = (size_t)(BK * 2);
    const size_t hstep = (size_t)HALF * ld * 2;
    const size_t tstep = 2 * hstep;
    const unsigned ldsw = (unsigned)wid * 1024u;
    const int aoff = lds_byte(wr * 64 + fr, fq * 8), boff = lds_byte(wc * 32 + fr, fq * 8);
#define PG8_SA(b, h) (((b) * 2 + (h)) * HTB)
#define PG8_SB(b, h) ((4 + (b) * 2 + (h)) * HTB)
#define PG8_STAGE(bufoff, gbase, voff) do { _Pragma("unroll") for (int _i = 0; _i < 2; ++_i) \
        __builtin_amdgcn_global_load_lds((const unsigned*)((const char*)(gbase) + (voff)[_i]), (PG8_LAS unsigned*)(lds + (bufoff) + ldsw + _i * 8192), 16, 0, 0); } while (0)
#define PG8_LDA(dst, b, h) do { _Pragma("unroll") for (int m = 0; m < 4; ++m) _Pragma("unroll") for (int k = 0; k < 2; ++k) dst[m][k] = *(const PG8_LAS bf16x8*)(lds + PG8_SA(b, h) + aoff + m * 2048 + k * 1024); } while (0)
#define PG8_LDB(dst, b, h) do { _Pragma("unroll") for (int n = 0; n < 2; ++n) _Pragma("unroll") for (int k = 0; k < 2; ++k) dst[n][k] = *(const PG8_LAS bf16x8*)(lds + PG8_SB(b, h) + boff + n * 2048 + k * 1024); } while (0)
#define PG8_MMA(ai, bj, At, Bt) do { __builtin_amdgcn_s_setprio(1); _Pragma("unroll") for (int m = 0; m < 4; ++m) _Pragma("unroll") for (int n = 0; n < 2; ++n) _Pragma("unroll") for (int k = 0; k < 2; ++k) \
        acc[ai][bj][m][n] = __builtin_amdgcn_mfma_f32_16x16x32_bf16(Bt[n][k], At[m][k], acc[ai][bj][m][n], 0, 0, 0); __builtin_amdgcn_s_setprio(0); } while (0)
#define PG8_WAIT_V(n) asm volatile("s_waitcnt vmcnt(" #n ")" ::: "memory")
#define PG8_WAIT_L(n) asm volatile("s_waitcnt lgkmcnt(" #n ")" ::: "memory")
#define PG8_BAR __builtin_amdgcn_s_barrier()
#define PG8_SCHED __builtin_amdgcn_sched_barrier(0)
    Unit cur, nxt; int ui = 0;
    if (!S.next(0, cur)) return;
    f32x4 acc[2][2][4][2];
#pragma unroll
    for (int a = 0; a < 2; ++a)
#pragma unroll
        for (int b = 0; b < 2; ++b)
#pragma unroll
            for (int m = 0; m < 4; ++m)
#pragma unroll
                for (int n = 0; n < 2; ++n) acc[a][b][m][n] = (f32x4){0.f, 0.f, 0.f, 0.f};
    bf16x8 At[4][2], B0[2][2], B1[2][2];
    const char* cA = (const char*)g.A + (size_t)cur.pm * tstep + (size_t)cur.koff * 2; const char* cB = (const char*)g.Bt + (size_t)cur.pn * tstep + (size_t)cur.koff * 2;
    S.a_ready(cur);
    if constexpr (SP2) {
        PG8_STAGE(PG8_SB(0, 0), cB, voffB); PG8_STAGE(PG8_SB(0, 1), cB + hstep, voffB); PG8_STAGE(PG8_SA(0, 0), cA, voffA); PG8_STAGE(PG8_SA(0, 1), cA + hstep, voffA);
        if (wr == 1) PG8_BAR;
        PG8_WAIT_V(2); PG8_BAR;
        PG8_STAGE(PG8_SB(1, 0), cB + kstep, voffB); PG8_STAGE(PG8_SA(1, 0), cA + kstep, voffA); PG8_STAGE(PG8_SB(1, 1), cB + hstep + kstep, voffB);
        PG8_WAIT_V(6); PG8_BAR;
    } else {
        PG8_STAGE(PG8_SB(0, 0), cB, voffB); PG8_STAGE(PG8_SA(0, 0), cA, voffA); PG8_STAGE(PG8_SB(0, 1), cB + hstep, voffB); PG8_STAGE(PG8_SA(0, 1), cA + hstep, voffA);
        if (wr == 1) PG8_BAR;
        PG8_WAIT_V(4); PG8_BAR;
        PG8_STAGE(PG8_SB(1, 0), cB + kstep, voffB); PG8_STAGE(PG8_SA(1, 0), cA + kstep, voffA); PG8_STAGE(PG8_SB(1, 1), cB + hstep + kstep, voffB);
        PG8_WAIT_V(6); PG8_BAR;
    }
    for (;;) {
        const bool has_next = S.next(ui + 1, nxt);
        const char* nA = has_next ? (const char*)g.A + (size_t)nxt.pm * tstep + (size_t)nxt.koff * 2 : cA; const char* nB = has_next ? (const char*)g.Bt + (size_t)nxt.pn * tstep + (size_t)nxt.koff * 2 : cB;
        for (int t = 0; t < nt; t += 2) {
            const bool last = (t == nt - 2);
            const char* a1 = cA + (size_t)(t + 1) * kstep;
            const char* a2 = last ? nA : cA + (size_t)(t + 2) * kstep; const char* b2 = last ? nB : cB + (size_t)(t + 2) * kstep;
            const char* a3 = a2 + kstep; const char* b3 = b2 + kstep;
            if (last && has_next) S.a_ready(nxt);
            if constexpr (SP2) {
            PG8_LDB(B0, 0, 0); PG8_LDB(B1, 0, 1); PG8_SCHED; PG8_LDA(At, 0, 0); PG8_STAGE(PG8_SA(1, 1), a1 + hstep, voffA);
            PG8_WAIT_V(8); PG8_WAIT_L(0); PG8_BAR; PG8_MMA(0, 0, At, B0); PG8_MMA(0, 1, At, B1); PG8_BAR; PG8_SCHED;
            PG8_LDA(At, 0, 1); PG8_STAGE(PG8_SB(0, 0), b2, voffB); PG8_STAGE(PG8_SB(0, 1), b2 + hstep, voffB); PG8_STAGE(PG8_SA(0, 0), a2, voffA);
            PG8_WAIT_V(8); PG8_WAIT_L(0); PG8_BAR; PG8_MMA(1, 0, At, B0); PG8_MMA(1, 1, At, B1); PG8_BAR; PG8_SCHED;
            PG8_LDB(B0, 1, 0); PG8_LDB(B1, 1, 1); PG8_SCHED; PG8_LDA(At, 1, 0); PG8_STAGE(PG8_SA(0, 1), a2 + hstep, voffA);
            PG8_WAIT_V(8); PG8_WAIT_L(0); PG8_BAR; PG8_MMA(0, 0, At, B0); PG8_MMA(0, 1, At, B1); PG8_BAR; PG8_SCHED;
            PG8_LDA(At, 1, 1); PG8_STAGE(PG8_SB(1, 0), b3, voffB); PG8_STAGE(PG8_SB(1, 1), b3 + hstep, voffB); PG8_STAGE(PG8_SA(1, 0), a3, voffA);
            PG8_WAIT_V(8); PG8_WAIT_L(0); PG8_BAR; PG8_MMA(1, 0, At, B0); PG8_MMA(1, 1, At, B1); PG8_BAR; PG8_SCHED;
            } else {
            PG8_LDB(B0, 0, 0); PG8_SCHED; PG8_LDA(At, 0, 0); PG8_STAGE(PG8_SA(1, 1), a1 + hstep, voffA);
            PG8_WAIT_L(8); PG8_BAR; PG8_WAIT_L(0); PG8_MMA(0, 0, At, B0); PG8_BAR; PG8_SCHED;
            PG8_LDB(B1, 0, 1); PG8_STAGE(PG8_SB(0, 0), b2, voffB);
            PG8_BAR; PG8_WAIT_L(0); PG8_MMA(0, 1, At, B1); PG8_BAR;
            PG8_LDA(At, 0, 1); PG8_STAGE(PG8_SA(0, 0), a2, voffA);
            PG8_BAR; PG8_WAIT_L(0); PG8_MMA(1, 0, At, B0); PG8_BAR; PG8_SCHED;
            PG8_STAGE(PG8_SB(0, 1), b2 + hstep, voffB);
            PG8_WAIT_V(6); PG8_BAR; PG8_MMA(1, 1, At, B1); PG8_BAR;
            PG8_LDB(B0, 1, 0); PG8_SCHED; PG8_LDA(At, 1, 0); PG8_STAGE(PG8_SA(0, 1), a2 + hstep, voffA);
            PG8_WAIT_L(8); PG8_BAR; PG8_WAIT_L(0); PG8_MMA(0, 0, At, B0); PG8_BAR; PG8_SCHED;
            PG8_LDB(B1, 1, 1); PG8_STAGE(PG8_SB(1, 0), b3, voffB);
            PG8_BAR; PG8_WAIT_L(0); PG8_MMA(0, 1, At, B1); PG8_BAR;
            PG8_LDA(At, 1, 1); PG8_STAGE(PG8_SA(1, 0), a3, voffA);
            PG8_BAR; PG8_WAIT_L(0); PG8_MMA(1, 0, At, B0); PG8_BAR; PG8_SCHED;
            PG8_STAGE(PG8_SB(1, 1), b3 + hstep, voffB);
            PG8_WAIT_V(6); PG8_BAR; PG8_MMA(1, 1, At, B1); PG8_BAR;
            }
        }
        if constexpr (ALIGN_EPI) { if (wr == 0) PG8_BAR; }
        E(acc, cur, wr, wc, fr, fq); S.done(cur);
        if (!has_next) break;
#pragma unroll
        for (int a = 0; a < 2; ++a)
#pragma unroll
            for (int b = 0; b < 2; ++b)
#pragma unroll
                for (int m = 0; m < 4; ++m)
#pragma unroll
                    for (int n = 0; n < 2; ++n) acc[a][b][m][n] = (f32x4){0.f, 0.f, 0.f, 0.f};
        cur = nxt; cA = nA; cB = nB; ++ui;
        if constexpr (ALIGN_EPI) { if (wr == 1) PG8_BAR; }
    }
    PG8_WAIT_V(0);
    if constexpr (!ALIGN_EPI) { if (wr == 0) PG8_BAR; }
    PG8_BAR;
#undef PG8_SA
#undef PG8_SB
#undef PG8_STAGE
#undef PG8_LDA
#undef PG8_LDB
#undef PG8_MMA
#undef PG8_WAIT_V
#undef PG8_WAIT_L
#undef PG8_BAR
#undef PG8_SCHED
}
}

constexpr int NWAVES = 8, NTHR = 512;
constexpr int DM = 2048, NB = 4, SEQ = 2048, DB = 32, DT = 4, PAST = 8192, PAGE = 128, NPAGES = 64;
constexpr int NTOKP = NB * SEQ;
constexpr int NTOKS = DB * DT;
constexpr int NTOK = NTOKP + NTOKS;
constexpr int MPAD = 8448;
constexpr int INW = 8400, INWP = 8448;
constexpr int RW = 1024, RH = 16, RD = 64, SHW = 3200;
constexpr int C_R = 0, C_K = 1024, C_V = 2048, C_CW = 3072, C_CA = 3136, C_GR = 3200, C_Q = 4224, C_AK = 4736, C_AV = 5248, C_GA = 5760, C_QI = 6272, C_WI = 7296, C_KI = 7312, C_QM = 7376, C_GM = 7888;
constexpr int MEMT = 256;
constexpr int TOPK = 256;
constexpr int SCS_LD = 8256;
constexpr float RMS_EPS = 1e-6f, GN_EPS = 64e-5f;
constexpr float QSCALE = 0.08838834764831845f * 1.4426950408889634f;
constexpr size_t O_YP = 0, O_YS = 16777216, O_WKVP = 17039360, O_SHP = 17301504, O_KP = 17314304, O_VP = 21508608, O_KIP = 25702912, O_MKP = 26227200, O_MVP = 26751488,
                 O_WKVS = 27275776, O_SHS = 29372928, O_KS = 29475328, O_VS = 29540864, O_KIS = 29606400, O_END = 29614592;
enum { I_XP = 0, I_XS, I_SWKV, I_SSH, I_CK, I_CV, I_CKI, I_CMK, I_CMV, I_PT, I_MEM, I_NW, I_WIN, I_MU, I_W0, I_W2, I_A0, I_A2, I_KK, I_KA, I_RK, I_GNW, I_GNB, I_MNW, I_WMEM, I_WOUT, I_FNW, N_IN };

constexpr size_t MiB = 1u << 20;
constexpr size_t al1m(size_t x) { return (x + MiB - 1) / MiB * MiB; }
constexpr size_t WS_CTL = 0, CTL_ZERO_BYTES = 1 * MiB;
constexpr size_t WS_WINT = 1 * MiB;
constexpr size_t WS_WOUTT = WS_WINT + al1m((size_t)INWP * DM * 2);
constexpr size_t WS_WMEMT = WS_WOUTT + al1m((size_t)DM * DM * 2);
constexpr size_t WS_W2T = WS_WMEMT + al1m((size_t)1024 * DM * 2);
constexpr size_t WS_A2T = WS_W2T + al1m((size_t)1024 * 64 * 2);
constexpr size_t WS_ROPE128 = WS_A2T + al1m((size_t)1024 * 64 * 2);
constexpr size_t WS_ROPE64 = WS_ROPE128 + al1m((size_t)2052 * 64 * 8);
constexpr size_t WS_XN = WS_ROPE64 + al1m((size_t)2052 * 32 * 8);
constexpr size_t WS_XM = WS_XN + al1m((size_t)MPAD * DM * 2);
constexpr size_t WS_PROJ = WS_XM + al1m((size_t)1024 * DM * 2);
constexpr size_t WS_SCANIN = WS_PROJ + al1m((size_t)MPAD * INWP * 4);
constexpr size_t WS_SCAL = WS_SCANIN + al1m((size_t)NTOK * RH * 384 * 4);
constexpr size_t WS_Y = WS_SCAL + al1m((size_t)NTOK * RH * 16 * 4 + 65536);
constexpr size_t WS_QB = WS_Y + al1m((size_t)NTOK * RW * 4);
constexpr size_t WS_KB = WS_QB + al1m((size_t)NTOK * 512 * 2);
constexpr size_t WS_VT = WS_KB + al1m((size_t)NTOK * 512 * 2);
constexpr size_t WS_QIB = WS_VT + al1m((size_t)NB * 4 * 128 * SEQ * 2);
constexpr size_t WS_KIB = WS_QIB + al1m((size_t)NTOK * 1024 * 2);
constexpr size_t WS_WIS = WS_KIB + al1m((size_t)NTOK * 64 * 2);
constexpr size_t WS_QMB = WS_WIS + al1m((size_t)NTOK * 16 * 4);
constexpr size_t WS_MKB = WS_QMB + al1m((size_t)NTOK * 512 * 2);
constexpr size_t WS_MVT = WS_MKB + al1m((size_t)1024 * 512 * 2);
constexpr size_t WS_SC = WS_MVT + al1m((size_t)1024 * 512 * 2);
constexpr size_t WS_SCS = WS_SC + al1m((size_t)NTOKP * SEQ * 4);
constexpr size_t WS_THR = WS_SCS + al1m((size_t)NTOKS * SCS_LD * 4);
constexpr size_t WS_IDX = WS_THR + al1m((size_t)NTOK * 8);
constexpr size_t WS_YMIX = WS_IDX + al1m((size_t)NTOKS * TOPK * 4);
constexpr size_t WS_END = WS_YMIX + al1m((size_t)MPAD * DM * 2);
constexpr int CW_BAR = 4096;

constexpr int RING_OFF = 0, RING_BYTES = 131072;
constexpr int LDSCTL_OFF = 159744, MISC_OFF = LDSCTL_OFF + 320;
constexpr int LDS_BYTES = 163840;

#define GAS __attribute__((address_space(1)))
#define LAS __attribute__((address_space(3)))
typedef unsigned short bf16;
typedef unsigned v4u __attribute__((ext_vector_type(4)));
typedef unsigned v2u __attribute__((ext_vector_type(2)));
typedef float f32x4 __attribute__((ext_vector_type(4)));
typedef float f32x2 __attribute__((ext_vector_type(2)));
typedef float f32x16 __attribute__((ext_vector_type(16)));
typedef short bf16x8 __attribute__((ext_vector_type(8)));
typedef short bf16x4 __attribute__((ext_vector_type(4)));
#define LDS_WAIT() asm volatile("s_waitcnt lgkmcnt(0)" ::: "memory")
#define VM_WAIT() asm volatile("s_waitcnt vmcnt(0)" ::: "memory")
__device__ __forceinline__ unsigned cvt_pk_bf16(float lo, float hi) { unsigned r; asm volatile("v_cvt_pk_bf16_f32 %0, %1, %2" : "=v"(r) : "v"(lo), "v"(hi)); return r; }
__device__ __forceinline__ float bf2f(unsigned short b) { return __uint_as_float(((unsigned)b) << 16); }
template <int CTRL> __device__ __forceinline__ float dpp(float x) { return __builtin_bit_cast(float, __builtin_amdgcn_mov_dpp(__builtin_bit_cast(int, x), CTRL, 0xf, 0xf, true)); }
__device__ __forceinline__ float row16_sum(float x) {
    x += dpp<0xB1>(x); x += dpp<0x4E>(x); x += dpp<0x141>(x); x += dpp<0x140>(x); return x;
}
__device__ __forceinline__ float wave_sum(float v) {
#pragma unroll
    for (int o = 1; o < 64; o <<= 1) v += __shfl_xor(v, o);
    return v;
}
__device__ __forceinline__ float xhalf_max(float x) { auto rr = __builtin_amdgcn_permlane32_swap(__float_as_uint(x), __float_as_uint(x), false, false); return fmaxf(__uint_as_float(rr[0]), __uint_as_float(rr[1])); }
__device__ __forceinline__ float xhalf_sum(float x) { auto rr = __builtin_amdgcn_permlane32_swap(__float_as_uint(x), __float_as_uint(x), false, false); return __uint_as_float(rr[0]) + __uint_as_float(rr[1]); }
__device__ __forceinline__ unsigned sort_key(float f) { const unsigned u = __float_as_uint(f); return (u & 0x80000000u) ? ~u : (u | 0x80000000u); }
__device__ __forceinline__ float silu(float g) { return g / (1.f + __expf(-g)); }

#define XB_TMO      128
#define XB_XCNT(j)  (256  + 64 * (j))
#define XB_XSUB(j)  (1280 + 64 * (j))
#define XB_XGEN(j)  (2304 + 64 * (j))
#define XB_TOP      3328
#define XB_TOPGEN   3392
#define XCD_BAR_WORDS 3456
#define XB_SPIN_CAP (1u << 18)
__device__ __forceinline__ unsigned xb_ld(unsigned* p)              { return __hip_atomic_load(p, __ATOMIC_RELAXED, __HIP_MEMORY_SCOPE_AGENT); }
__device__ __forceinline__ unsigned xb_add(unsigned* p, unsigned v) { return __hip_atomic_fetch_add(p, v, __ATOMIC_RELAXED, __HIP_MEMORY_SCOPE_AGENT); }
__device__ __forceinline__ unsigned xb_xcc_id() { return (unsigned)__builtin_amdgcn_s_getreg((3 << 11) | 20) & 0xFu; }
#define XB_SPIN(cond, bar) do { unsigned _sp = 0; while (cond) { __builtin_amdgcn_s_sleep(1); \
    if ((++_sp & 255u) == 0u) { if (xb_ld(&(bar)[XB_TMO])) break; if (_sp > XB_SPIN_CAP) { atomicAdd(&(bar)[XB_TMO], 1u); break; } } } } while (0)
struct XcdBarrier { unsigned* bar; unsigned x; volatile LAS unsigned* st; };
__device__ __forceinline__ XcdBarrier xcd_barrier_post(unsigned* bar, volatile LAS unsigned* st) {
    XcdBarrier b; b.bar = bar; b.x = xb_xcc_id(); b.st = st;
    if (threadIdx.x == 0) (void)xb_add(&bar[XB_XCNT(b.x)], 1u);
    return b;
}
__device__ __forceinline__ void xcd_barrier_complete(unsigned* bar, unsigned x, unsigned& nloc, unsigned& nx) {
    const unsigned G = gridDim.x * gridDim.y * gridDim.z;
    unsigned sum, cnt, mine, sp = 0u;
    for (;;) {
        sum = 0u; cnt = 0u; mine = 0u;
#pragma unroll
        for (unsigned j = 0; j < 16; ++j) { const unsigned c = xb_ld(&bar[XB_XCNT(j)]); sum += c; cnt += (c > 0u) ? 1u : 0u; mine = (j == x) ? c : mine; }
        if (sum == G) break;
        __builtin_amdgcn_s_sleep(1);
        if ((++sp & 255u) == 0u) { if (xb_ld(&bar[XB_TMO])) break; if (sp > XB_SPIN_CAP) { atomicAdd(&bar[XB_TMO], 1u); break; } }
    }
    nloc = mine > 0u ? mine : 1u; nx = cnt > 0u ? cnt : 1u;
}
__device__ __forceinline__ void xcd_barrier(const XcdBarrier& b) {
    asm volatile("s_waitcnt vmcnt(0)" ::: "memory");
    __syncthreads();
    if (threadIdx.x == 0) {
        unsigned* bar = b.bar;
        __builtin_amdgcn_s_waitcnt(0);
        unsigned nloc = b.st[0], nx = b.st[1];
        if (nloc == 0u) { xcd_barrier_complete(bar, b.x, nloc, nx); b.st[0] = nloc; b.st[1] = nx; }
        const unsigned old = xb_add(&bar[XB_XSUB(b.x)], 1u);
        const unsigned gen = old / nloc;
        if (old + 1u == (gen + 1u) * nloc) {
            __builtin_amdgcn_fence(__ATOMIC_RELEASE, "agent");
            asm volatile("s_waitcnt vmcnt(0)" ::: "memory");
            const unsigned og = xb_add(&bar[XB_TOP], 1u);
            const unsigned tg = og / nx;
            if (og + 1u == (tg + 1u) * nx) xb_add(&bar[XB_TOPGEN], 1u);
            else XB_SPIN(xb_ld(&bar[XB_TOPGEN]) == tg, bar);
            __builtin_amdgcn_fence(__ATOMIC_ACQUIRE, "agent");
            xb_add(&bar[XB_XGEN(b.x)], 1u);
            asm volatile("s_waitcnt vmcnt(0)" ::: "memory");
        } else {
            XB_SPIN(xb_ld(&bar[XB_XGEN(b.x)]) == gen, bar);
            __builtin_amdgcn_fence(__ATOMIC_ACQUIRE, "agent");
            asm volatile("s_waitcnt vmcnt(0)" ::: "memory");
        }
    }
    __syncthreads();
}

struct Frame {
    LAS unsigned char* lds;
    int tid, lane, wave, G, bid;
    const float* in[N_IN];
    float* out;
    unsigned char* ws;
};
#define WSP(T, off) ((T*)(F.ws + (off)))

__device__ __forceinline__ void p0_transpose_item(const float* W, int K, int N, int Npad, bf16* WT, LAS float* scr, int item, int lane) {
    const int nblk = Npad / 32, kb = item / nblk, nb = item % nblk, k0 = 64 * kb, n0 = 32 * nb;
    const int nn = n0 + (lane & 31);
    float tv[32];
#pragma unroll
    for (int i = 0; i < 32; ++i) { const int kk = 2 * i + (lane >> 5); tv[i] = (nn < N) ? W[(size_t)(k0 + kk) * N + nn] : 0.f; }
#pragma unroll
    for (int i = 0; i < 32; ++i) { const int kk = 2 * i + (lane >> 5); scr[kk * 33 + (lane & 31)] = tv[i]; }
    LDS_WAIT(); asm volatile("" ::: "memory");
    const int c = lane & 7;
#pragma unroll
    for (int j = 0; j < 4; ++j) { const int n = (lane >> 3) + 8 * j; const LAS float* s = scr + (8 * c) * 33 + n;
        v4u o; o.x = cvt_pk_bf16(s[0 * 33], s[1 * 33]); o.y = cvt_pk_bf16(s[2 * 33], s[3 * 33]); o.z = cvt_pk_bf16(s[4 * 33], s[5 * 33]); o.w = cvt_pk_bf16(s[6 * 33], s[7 * 33]);
        *(v4u*)(WT + (size_t)(n0 + n) * K + k0 + 8 * c) = o; }
    LDS_WAIT(); asm volatile("" ::: "memory");
}
__device__ __forceinline__ void rms_row_to_bf16(const float* xrow, const float* w, bf16* orow, int lane) {
    const f32x4* xr = (const f32x4*)xrow + lane; const f32x4* wr = (const f32x4*)w + lane;
    f32x4 v[8]; float s = 0.f;
#pragma unroll
    for (int j = 0; j < 8; ++j) { v[j] = xr[64 * j]; s += (v[j].x * v[j].x + v[j].y * v[j].y) + (v[j].z * v[j].z + v[j].w * v[j].w); }
    const float rs = 1.f / sqrtf(wave_sum(s) * (1.f / DM) + RMS_EPS);
    v2u* o8 = (v2u*)orow + lane;
#pragma unroll
    for (int j = 0; j < 8; ++j) { const f32x4 ww = wr[64 * j]; v2u o; o.x = cvt_pk_bf16(v[j].x * rs * ww.x, v[j].y * rs * ww.y); o.y = cvt_pk_bf16(v[j].z * rs * ww.z, v[j].w * rs * ww.w); o8[64 * j] = o; }
}
__device__ __forceinline__ void rope_cs(int pos, int i, double ratio, float& c, float& s) {
    double f = 1.0, b = ratio; int e = i;
    while (e) { if (e & 1) f *= b; b *= b; e >>= 1; }
    const double th = (double)pos * f;
    const double TWO_OVER_PI = 0.63661977236758134308, PIO2_HI = 1.57079632679489655800e+00, PIO2_LO = 6.12323399573676603587e-17;
    const double kq = rint(th * TWO_OVER_PI);
    double r = fma(-kq, PIO2_HI, th); r = fma(-kq, PIO2_LO, r);
    const int q = ((int)kq) & 3;
    const double z = r * r;
    const double sp = r + r * z * (-1.66666666666666324348e-01 + z * (8.33333333332248946124e-03 + z * (-1.98412698298579493134e-04 + z * (2.75573137070700676789e-06 + z * (-2.50507602534068634195e-08 + z * 1.58969099521155010221e-10)))));
    const double cp = 1.0 - 0.5 * z + z * z * (4.16666666666666019037e-02 + z * (-1.38888888888741095749e-03 + z * (2.48015872894767294178e-05 + z * (-2.75573143513906633035e-07 + z * (2.08757232129817482790e-09 + z * -1.13596475577881948265e-11)))));
    double cc, ss;
    if (q == 0) { cc = cp; ss = sp; } else if (q == 1) { cc = -sp; ss = cp; } else if (q == 2) { cc = -cp; ss = -sp; } else { cc = sp; ss = -cp; }
    c = (float)cc; s = (float)ss;
}
__device__ __forceinline__ void p0_prologue(Frame& F) {
    LAS float* scr = (LAS float*)(F.lds + RING_OFF + F.wave * 16384);
    const int gw = F.bid * NWAVES + F.wave, NGW = F.G * NWAVES;
    constexpr int T_IN = (DM / 64) * (INWP / 32), T_OUT = (DM / 64) * (DM / 32), T_MEM = (DM / 64) * (1024 / 32), T_L = 1024 / 32;
    constexpr int NITEMS = T_IN + T_OUT + T_MEM + 2 * T_L;
    for (int it = gw; it < NITEMS; it += NGW) {
        int r = it;
        if (r < T_IN) { p0_transpose_item(F.in[I_WIN], DM, INW, INWP, WSP(bf16, WS_WINT), scr, r, F.lane); continue; } r -= T_IN;
        if (r < T_OUT) { p0_transpose_item(F.in[I_WOUT], DM, DM, DM, WSP(bf16, WS_WOUTT), scr, r, F.lane); continue; } r -= T_OUT;
        if (r < T_MEM) { p0_transpose_item(F.in[I_WMEM], DM, 1024, 1024, WSP(bf16, WS_WMEMT), scr, r, F.lane); continue; } r -= T_MEM;
        if (r < T_L) { p0_transpose_item(F.in[I_W2], 64, 1024, 1024, WSP(bf16, WS_W2T), scr, r, F.lane); continue; } r -= T_L;
        p0_transpose_item(F.in[I_A2], 64, 1024, 1024, WSP(bf16, WS_A2T), scr, r, F.lane);
    }
    for (int m = gw; m < MPAD + 1024; m += NGW) {
        if (m < NTOKP) rms_row_to_bf16(F.in[I_XP] + (size_t)m * DM, F.in[I_NW], WSP(bf16, WS_XN) + (size_t)m * DM, F.lane);
        else if (m < NTOK) rms_row_to_bf16(F.in[I_XS] + (size_t)(m - NTOKP) * DM, F.in[I_NW], WSP(bf16, WS_XN) + (size_t)m * DM, F.lane);
        else if (m < MPAD) { v4u z = {0u, 0u, 0u, 0u}; v4u* o = (v4u*)(WSP(bf16, WS_XN) + (size_t)m * DM) + F.lane;
#pragma unroll
            for (int j = 0; j < 4; ++j) o[64 * j] = z; }
        else rms_row_to_bf16(F.in[I_MEM] + (size_t)(m - MPAD) * DM, F.in[I_MNW], WSP(bf16, WS_XM) + (size_t)(m - MPAD) * DM, F.lane);
    }
    const int gt = F.bid * NTHR + F.tid, NGT = F.G * NTHR;
    for (int e = gt; e < 2052 * 96; e += NGT) {
        const int p = e / 96, i = e % 96; const int pos = p < 2048 ? p : PAST + (p - 2048);
        float c, s;
        if (i < 64) { rope_cs(pos, i, 0.8659643233600653, c, s); WSP(f32x2, WS_ROPE128)[p * 64 + i] = (f32x2){c, s}; }
        else { rope_cs(pos, i - 64, 0.7498942093324559, c, s); WSP(f32x2, WS_ROPE64)[p * 32 + (i - 64)] = (f32x2){c, s}; }
    }
}

struct EpiProj {
    float* C;
    __device__ __forceinline__ void operator()(const f32x4 (&acc)[2][2][4][2], const pg8::Unit& u, int wr, int wc, int fr, int fq) const {
        const int row0 = u.pm * 256 + wr * 64 + fr, col0 = u.pn * 256 + wc * 32 + 4 * fq;
#pragma unroll
        for (int ai = 0; ai < 2; ++ai)
#pragma unroll
            for (int m = 0; m < 4; ++m) { float* rowp = C + (size_t)(row0 + ai * 128 + m * 16) * INWP + col0;
#pragma unroll
                for (int bj = 0; bj < 2; ++bj)
#pragma unroll
                    for (int n = 0; n < 2; ++n) *(f32x4*)(rowp + bj * 128 + n * 16) = acc[ai][bj][m][n]; }
    }
};
struct EpiMem {
    float* out;
    __device__ __forceinline__ void operator()(const f32x4 (&acc)[2][2][4][2], const pg8::Unit& u, int wr, int wc, int fr, int fq) const {
        const int row0 = u.pm * 256 + wr * 64 + fr; int colt = u.pn * 256;
        float* base = out + (colt < 512 ? O_MKP : O_MVP); if (colt >= 512) colt -= 512;
        const int col0 = colt + wc * 32 + 4 * fq;
#pragma unroll
        for (int ai = 0; ai < 2; ++ai)
#pragma unroll
            for (int m = 0; m < 4; ++m) { float* rowp = base + (size_t)(row0 + ai * 128 + m * 16) * 512 + col0;
#pragma unroll
                for (int bj = 0; bj < 2; ++bj)
#pragma unroll
                    for (int n = 0; n < 2; ++n) *(f32x4*)(rowp + bj * 128 + n * 16) = acc[ai][bj][m][n]; }
    }
};
__device__ __forceinline__ void atomic_add4(float* p, const f32x4& v) { unsafeAtomicAdd(p, v.x); unsafeAtomicAdd(p + 1, v.y); unsafeAtomicAdd(p + 2, v.z); unsafeAtomicAdd(p + 3, v.w); }
struct EpiProjAtomic {
    float* C;
    __device__ __forceinline__ void operator()(const f32x4 (&acc)[2][2][4][2], const pg8::Unit& u, int wr, int wc, int fr, int fq) const {
        const int row0 = u.pm * 256 + wr * 64 + fr, col0 = u.pn * 256 + wc * 32 + 4 * fq;
#pragma unroll
        for (int ai = 0; ai < 2; ++ai)
#pragma unroll
            for (int m = 0; m < 4; ++m) { const int row = row0 + ai * 128 + m * 16; float* rowp = C + (size_t)row * INWP + col0;
                if (row < NTOK) {
#pragma unroll
                    for (int bj = 0; bj < 2; ++bj)
#pragma unroll
                        for (int n = 0; n < 2; ++n) atomic_add4(rowp + bj * 128 + n * 16, acc[ai][bj][m][n]); } }
    }
};
struct EpiMemAtomic {
    float* out;
    __device__ __forceinline__ void operator()(const f32x4 (&acc)[2][2][4][2], const pg8::Unit& u, int wr, int wc, int fr, int fq) const {
        const int row0 = u.pm * 256 + wr * 64 + fr; int colt = u.pn * 256;
        float* base = out + (colt < 512 ? O_MKP : O_MVP); if (colt >= 512) colt -= 512;
        const int col0 = colt + wc * 32 + 4 * fq;
#pragma unroll
        for (int ai = 0; ai < 2; ++ai)
#pragma unroll
            for (int m = 0; m < 4; ++m) { float* rowp = base + (size_t)(row0 + ai * 128 + m * 16) * 512 + col0;
#pragma unroll
                for (int bj = 0; bj < 2; ++bj)
#pragma unroll
                    for (int n = 0; n < 2; ++n) atomic_add4(rowp + bj * 128 + n * 16, acc[ai][bj][m][n]); }
    }
};
struct EpiOutAtomic {
    float* out;
    __device__ __forceinline__ void operator()(const f32x4 (&acc)[2][2][4][2], const pg8::Unit& u, int wr, int wc, int fr, int fq) const {
        const int row0 = u.pm * 256 + wr * 64 + fr, col0 = u.pn * 256 + wc * 32 + 4 * fq;
#pragma unroll
        for (int ai = 0; ai < 2; ++ai)
#pragma unroll
            for (int m = 0; m < 4; ++m) { const int row = row0 + ai * 128 + m * 16;
                if (row >= NTOKP && row < NTOK) { float* orow = out + O_YS + (size_t)(row - NTOKP) * DM + col0;
#pragma unroll
                    for (int bj = 0; bj < 2; ++bj)
#pragma unroll
                        for (int n = 0; n < 2; ++n) atomic_add4(orow + bj * 128 + n * 16, acc[ai][bj][m][n]); } }
    }
};
struct EpiOut {
    const float* xp; const float* xs; float* out;
    __device__ __forceinline__ void operator()(const f32x4 (&acc)[2][2][4][2], const pg8::Unit& u, int wr, int wc, int fr, int fq) const {
        const int row0 = u.pm * 256 + wr * 64 + fr, col0 = u.pn * 256 + wc * 32 + 4 * fq;
#pragma unroll
        for (int ai = 0; ai < 2; ++ai)
#pragma unroll
            for (int m = 0; m < 4; ++m) { const int row = row0 + ai * 128 + m * 16;
                if (row < NTOK) {
                    const float* xr = (row < NTOKP ? xp + (size_t)row * DM : xs + (size_t)(row - NTOKP) * DM) + col0;
                    float* orow = out + (row < NTOKP ? O_YP + (size_t)row * DM : O_YS + (size_t)(row - NTOKP) * DM) + col0;
#pragma unroll
                    for (int bj = 0; bj < 2; ++bj)
#pragma unroll
                        for (int n = 0; n < 2; ++n) *(f32x4*)(orow + bj * 128 + n * 16) = acc[ai][bj][m][n] + *(const f32x4*)(xr + bj * 128 + n * 16); } }
    }
};

__device__ __forceinline__ float prev_val(const Frame& F, const float* P, int row, int col) {
    if (row < NTOKP) { return (row & (SEQ - 1)) == 0 ? 0.f : P[(size_t)(row - 1) * INWP + col]; }
    const int s = row - NTOKP; return (s & 3) == 0 ? F.in[I_SSH][(size_t)(s >> 2) * SHW + col] : P[(size_t)(row - 1) * INWP + col];
}
__device__ __forceinline__ size_t scan_seq_off(int row, int h) {
    if (row < NTOKP) { const int b = row >> 11, t = row & 2047; return ((size_t)(b * RH + h) * SEQ + t); }
    const int s = row - NTOKP, db = s >> 2, t = s & 3; return (size_t)NB * RH * SEQ + ((size_t)(db * RH + h) * DT + t);
}
__device__ __forceinline__ size_t kf_off(int NT, int h, int s, int dim) { return ((size_t)((h * NT + (s >> 5)) * 8 + (dim >> 4))) * 512 + (((dim >> 3) & 1) * 32 + (s & 31)) * 8 + (dim & 7); }
__device__ __forceinline__ size_t kif_off(int s, int dim) { return ((size_t)((s >> 5) * 4 + (dim >> 4))) * 512 + (((dim >> 3) & 1) * 32 + (s & 31)) * 8 + (dim & 7); }
__device__ __forceinline__ f32x4 ld4(const float* p) { return *(const f32x4*)p; }
__device__ __forceinline__ f32x4 prev4(const Frame& F, const float* P, int row, int col) {
    if (row < NTOKP) { if ((row & (SEQ - 1)) == 0) return (f32x4){0.f, 0.f, 0.f, 0.f}; return ld4(P + (size_t)(row - 1) * INWP + col); }
    const int s = row - NTOKP; if ((s & 3) == 0) return ld4(F.in[I_SSH] + (size_t)(s >> 2) * SHW + col); return ld4(P + (size_t)(row - 1) * INWP + col);
}
__device__ __forceinline__ void p2_rwkv_witem(Frame& F, int tile, int h0, int nh) {
    const float* P = WSP(float, WS_PROJ);
    const int row0 = tile * 16;
    const int lane = F.lane, tk = lane & 15, kq = lane >> 4, row = row0 + tk;
    const float* mu = F.in[I_MU];
    bf16x8 bw[2], ba[2];
#pragma unroll
    for (int ks = 0; ks < 2; ++ks) {
        const int c0 = 32 * ks + 8 * kq;
        float xw[8], xa[8];
#pragma unroll
        for (int hf = 0; hf < 2; ++hf) {
            const f32x4 cw = ld4(P + (size_t)row * INWP + C_CW + c0 + 4 * hf), pw = prev4(F, P, row, C_CW + c0 + 4 * hf), mw = ld4(mu + C_CW + c0 + 4 * hf);
            const f32x4 ca = ld4(P + (size_t)row * INWP + C_CA + c0 + 4 * hf), pa = prev4(F, P, row, C_CA + c0 + 4 * hf), ma = ld4(mu + C_CA + c0 + 4 * hf);
#pragma unroll
            for (int e = 0; e < 4; ++e) { const float x = cw[e] + (pw[e] - cw[e]) * mw[e];
                const float t = __builtin_amdgcn_exp2f(x * 2.8853900817779268f); xw[4 * hf + e] = 1.f - 2.f * __builtin_amdgcn_rcpf(t + 1.f);
                xa[4 * hf + e] = ca[e] + (pa[e] - ca[e]) * ma[e]; }
        }
        v4u uw, ua; uw.x = cvt_pk_bf16(xw[0], xw[1]); uw.y = cvt_pk_bf16(xw[2], xw[3]); uw.z = cvt_pk_bf16(xw[4], xw[5]); uw.w = cvt_pk_bf16(xw[6], xw[7]);
        ua.x = cvt_pk_bf16(xa[0], xa[1]); ua.y = cvt_pk_bf16(xa[2], xa[3]); ua.z = cvt_pk_bf16(xa[4], xa[5]); ua.w = cvt_pk_bf16(xa[6], xa[7]);
        bw[ks] = __builtin_bit_cast(bf16x8, uw); ba[ks] = __builtin_bit_cast(bf16x8, ua);
    }
    const bf16* W2T = WSP(bf16, WS_W2T); const bf16* A2T = WSP(bf16, WS_A2T);
    float* SI = WSP(float, WS_SCANIN); float* SL = WSP(float, WS_SCAL);
    const float* pr = P + (size_t)row * INWP;
    for (int hh = 0; hh < nh; ++hh) {
        const int h = h0 + hh;
        f32x4 wl[4], al[4];
#pragma unroll
        for (int n = 0; n < 4; ++n) {
            const int chA = h * 64 + n * 16 + tk;
            wl[n] = (f32x4){0.f, 0.f, 0.f, 0.f}; al[n] = (f32x4){0.f, 0.f, 0.f, 0.f};
#pragma unroll
            for (int ks = 0; ks < 2; ++ks) {
                const bf16x8 aw = *(const bf16x8*)(W2T + (size_t)chA * 64 + 32 * ks + 8 * kq);
                const bf16x8 aa = *(const bf16x8*)(A2T + (size_t)chA * 64 + 32 * ks + 8 * kq);
                wl[n] = __builtin_amdgcn_mfma_f32_16x16x32_bf16(aw, bw[ks], wl[n], 0, 0, 0);
                al[n] = __builtin_amdgcn_mfma_f32_16x16x32_bf16(aa, ba[ks], al[n], 0, 0, 0);
            }
        }
        f32x4 Lxk[4], Lqk[4], Lxr[4], Lqr[4], Lxv[4], Lqv[4];
#pragma unroll
        for (int n = 0; n < 4; ++n) { const int ch = h * 64 + n * 16 + 4 * kq;
            Lxk[n] = ld4(pr + C_K + ch); Lqk[n] = prev4(F, P, row, C_K + ch); Lxr[n] = ld4(pr + C_R + ch); Lqr[n] = prev4(F, P, row, C_R + ch); Lxv[n] = ld4(pr + C_V + ch); Lqv[n] = prev4(F, P, row, C_V + ch); }
        __builtin_amdgcn_sched_barrier(0);
        f32x4 k4[4];
        float ss = 0.f;
#pragma unroll
        for (int n = 0; n < 4; ++n) {
            const int ch = h * 64 + n * 16 + 4 * kq;
            const f32x4 xk = Lxk[n], qk = Lqk[n], mk = ld4(mu + C_K + ch), kkw = ld4(F.in[I_KK] + ch);
#pragma unroll
            for (int j = 0; j < 4; ++j) { k4[n][j] = xk[j] + (qk[j] - xk[j]) * mk[j]; const float t = k4[n][j] * kkw[j]; ss += t * t; }
        }
        ss += __shfl_xor(ss, 16); ss += __shfl_xor(ss, 32);
        const float inv = 1.f / fmaxf(sqrtf(ss), 1e-12f);
        float s_nbr = 0.f, s_kr = 0.f, s_bon = 0.f;
        const size_t so = scan_seq_off(row, h);
        float* dst = SI + so * 384 + 4 * kq;
#pragma unroll
        for (int n = 0; n < 4; ++n) {
            const int ch = h * 64 + n * 16 + 4 * kq;
            const f32x4 xr = Lxr[n], xv = Lxv[n], qr = Lqr[n], qv = Lqv[n];
            const f32x4 mr = ld4(mu + C_R + ch), mv = ld4(mu + C_V + ch);
            const f32x4 w0 = ld4(F.in[I_W0] + ch), a0 = ld4(F.in[I_A0] + ch), kkw = ld4(F.in[I_KK] + ch), ka = ld4(F.in[I_KA] + ch), rk = ld4(F.in[I_RK] + ch);
            f32x4 kk, kp, nb, wr, wv, vv;
#pragma unroll
            for (int j = 0; j < 4; ++j) {
                const float r = xr[j] + (qr[j] - xr[j]) * mr[j]; vv[j] = xv[j] + (qv[j] - xv[j]) * mv[j];
                const float wlin = w0[j] + wl[n][j];
                const float sg = __builtin_amdgcn_rcpf(1.f + __builtin_amdgcn_exp2f(-wlin * 1.4426950408889634f));
                wv[j] = __builtin_amdgcn_exp2f(-0.8750338f * sg);
                const float alin = a0[j] + al[n][j];
                const float a = __builtin_amdgcn_rcpf(1.f + __builtin_amdgcn_exp2f(-alin * 1.4426950408889634f));
                kk[j] = k4[n][j] * kkw[j] * inv;
                kp[j] = k4[n][j] * (1.f + (a - 1.f) * ka[j]);
                nb[j] = -kk[j] * a;
                wr[j] = wv[j] * r;
                s_nbr += nb[j] * r; s_kr += kp[j] * r; s_bon += r * kp[j] * rk[j];
            }
            *(f32x4*)(dst + 0 * 64 + 16 * n) = kk; *(f32x4*)(dst + 1 * 64 + 16 * n) = wv; *(f32x4*)(dst + 2 * 64 + 16 * n) = nb;
            *(f32x4*)(dst + 3 * 64 + 16 * n) = kp; *(f32x4*)(dst + 4 * 64 + 16 * n) = wr; *(f32x4*)(dst + 5 * 64 + 16 * n) = vv;
        }
        s_nbr += __shfl_xor(s_nbr, 16); s_nbr += __shfl_xor(s_nbr, 32);
        s_kr += __shfl_xor(s_kr, 16); s_kr += __shfl_xor(s_kr, 32);
        s_bon += __shfl_xor(s_bon, 16); s_bon += __shfl_xor(s_bon, 32);
        if (kq == 0) *(f32x4*)(SL + so * 16) = (f32x4){s_nbr, s_kr, s_bon, 0.f};
    }
}
__device__ __forceinline__ void p2_row_item(Frame& F, int row) {
    const float* P = WSP(float, WS_PROJ) + (size_t)row * INWP;
    const int lane = F.lane;
    const bool prm = row < NTOKP; const int srow = row - NTOKP;
    const int p = prm ? (row & 2047) : 2048 + (srow & 3);
    const f32x2* T128 = WSP(f32x2, WS_ROPE128) + p * 64; const f32x2* T64 = WSP(f32x2, WS_ROPE64) + p * 32;
    bf16* QB = WSP(bf16, WS_QB) + (size_t)row * 512; bf16* KF = WSP(bf16, WS_KB) + (size_t)(row >> 11) * SEQ * 512; const int sq = row & 2047;
    float* ko = F.out + (prm ? O_KP + (size_t)row * 512 : O_KS + (size_t)srow * 512);
    float* vo = F.out + (prm ? O_VP + (size_t)row * 512 : O_VS + (size_t)srow * 512);
    const f32x2 cs = T128[lane];
    float Lq1[4], Lq2[4], Lk1[4], Lk2[4];
#pragma unroll
    for (int h = 0; h < 4; ++h) { Lq1[h] = P[C_Q + h * 128 + lane]; Lq2[h] = P[C_Q + h * 128 + 64 + lane]; Lk1[h] = P[C_AK + h * 128 + lane]; Lk2[h] = P[C_AK + h * 128 + 64 + lane]; }
    float Li1[8], Li2[8]; f32x2 Lc[8];
#pragma unroll
    for (int j = 0; j < 8; ++j) { const int pi = lane + 64 * j, hd = pi >> 5, i = pi & 31; Li1[j] = P[C_QI + hd * 64 + i]; Li2[j] = P[C_QI + hd * 64 + 32 + i]; Lc[j] = T64[i]; }
    const f32x4 Lv0 = *(const f32x4*)(P + C_AV + 4 * lane), Lv1 = *(const f32x4*)(P + C_AV + 256 + 4 * lane);
    const f32x4 Lm0 = *(const f32x4*)(P + C_QM + 8 * lane), Lm1 = *(const f32x4*)(P + C_QM + 8 * lane + 4);
    __builtin_amdgcn_sched_barrier(0);
#pragma unroll
    for (int h = 0; h < 4; ++h) {
        { const float x1 = Lq1[h], x2 = Lq2[h];
          const float o1 = (x1 * cs.x - x2 * cs.y) * QSCALE, o2 = (x2 * cs.x + x1 * cs.y) * QSCALE;
          QB[h * 128 + lane] = (bf16)(cvt_pk_bf16(o1, 0.f) & 0xffffu); QB[h * 128 + 64 + lane] = (bf16)(cvt_pk_bf16(o2, 0.f) & 0xffffu); }
        { const float x1 = Lk1[h], x2 = Lk2[h];
          const float o1 = x1 * cs.x - x2 * cs.y, o2 = x2 * cs.x + x1 * cs.y;
          ko[h * 128 + lane] = o1; ko[h * 128 + 64 + lane] = o2;
          if (prm) { KF[kf_off(64, h, sq, lane)] = (bf16)(cvt_pk_bf16(o1, 0.f) & 0xffffu); KF[kf_off(64, h, sq, 64 + lane)] = (bf16)(cvt_pk_bf16(o2, 0.f) & 0xffffu); } }
    }
    {
        f32x4* d = (f32x4*)vo;
        d[lane] = Lv0; d[64 + lane] = Lv1;
    }
    {
        bf16* QIB = WSP(bf16, WS_QIB) + (size_t)row * 1024;
#pragma unroll
        for (int j = 0; j < 8; ++j) { const int pi = lane + 64 * j, hd = pi >> 5, i = pi & 31; const f32x2 c2 = Lc[j];
            const float x1 = Li1[j], x2 = Li2[j];
            QIB[hd * 64 + i] = (bf16)(cvt_pk_bf16(x1 * c2.x - x2 * c2.y, 0.f) & 0xffffu); QIB[hd * 64 + 32 + i] = (bf16)(cvt_pk_bf16(x2 * c2.x + x1 * c2.y, 0.f) & 0xffffu); }
    }
    if (lane < 32) {
        const f32x2 c2 = T64[lane]; const float x1 = P[C_KI + lane], x2 = P[C_KI + 32 + lane];
        const float o1 = x1 * c2.x - x2 * c2.y, o2 = x2 * c2.x + x1 * c2.y;
        float* kio = F.out + (prm ? O_KIP + (size_t)row * 64 : O_KIS + (size_t)srow * 64);
        kio[lane] = o1; kio[32 + lane] = o2;
        bf16* KIB = WSP(bf16, WS_KIB) + (size_t)row * 64;
        KIB[lane] = (bf16)(cvt_pk_bf16(o1, 0.f) & 0xffffu); KIB[32 + lane] = (bf16)(cvt_pk_bf16(o2, 0.f) & 0xffffu);
        if (prm) { bf16* KIF = WSP(bf16, WS_SC) + (size_t)(row >> 11) * SEQ * 64; KIF[kif_off(sq, lane)] = (bf16)(cvt_pk_bf16(o1, 0.f) & 0xffffu); KIF[kif_off(sq, 32 + lane)] = (bf16)(cvt_pk_bf16(o2, 0.f) & 0xffffu); }
    }
    if (lane < 16) WSP(float, WS_WIS)[(size_t)row * 16 + lane] = P[C_WI + lane] * (1.f / 32.f);
    {
        bf16* QMB = WSP(bf16, WS_QMB) + (size_t)row * 512;
        const f32x4 a = Lm0, b = Lm1;
        v4u o; o.x = cvt_pk_bf16(a.x * QSCALE, a.y * QSCALE); o.y = cvt_pk_bf16(a.z * QSCALE, a.w * QSCALE); o.z = cvt_pk_bf16(b.x * QSCALE, b.y * QSCALE); o.w = cvt_pk_bf16(b.z * QSCALE, b.w * QSCALE);
        *(v4u*)(QMB + 8 * lane) = o;
    }
    if (prm ? ((row & 2047) == 2047) : ((srow & 3) == 3)) {
        float* so = F.out + (prm ? O_SHP + (size_t)(row >> 11) * SHW : O_SHS + (size_t)(srow >> 2) * SHW);
        for (int c = lane; c < SHW; c += 64) so[c] = P[c];
    }
}
__device__ __forceinline__ void p2_vt_item(Frame& F, const float* src, size_t ld_src, bf16* dstb, int NT, int ts) {
    LAS bf16* tile = (LAS bf16*)(F.lds + RING_OFF);
    { f32x4 tv[16];
#pragma unroll
      for (int i = 0; i < 16; ++i) { const int e = F.tid + i * NTHR, tok = e >> 7, c4 = (e & 127) * 4; tv[i] = *(const f32x4*)(src + (size_t)tok * ld_src + c4); }
#pragma unroll
      for (int i = 0; i < 16; ++i) { const int e = F.tid + i * NTHR, tok = e >> 7, c4 = (e & 127) * 4;
        v2u o; o.x = cvt_pk_bf16(tv[i].x, tv[i].y); o.y = cvt_pk_bf16(tv[i].z, tv[i].w); *(LAS v2u*)(tile + tok * 520 + c4) = o; } }
    __syncthreads();
    const int rsub = F.lane >> 3, chunk = F.lane & 7;
    for (int it = 0; it < 8; ++it) { const int hd = (it * 8 + F.wave) * 8 + rsub, h = hd >> 7, d = hd & 127;
        unsigned short e[8];
#pragma unroll
        for (int k = 0; k < 8; ++k) e[k] = tile[(chunk * 8 + k) * 520 + hd];
        const int kt = ts * 2 + (chunk >> 2), s2 = (chunk >> 1) & 1, g = chunk & 1;
        bf16* p = dstb + ((size_t)((h * NT + kt) * 8 + (d >> 5) * 2 + s2)) * 512 + (d & 31) * 8 + g * 4;
        v2u lo, hi; lo.x = e[0] | ((unsigned)e[1] << 16); lo.y = e[2] | ((unsigned)e[3] << 16); hi.x = e[4] | ((unsigned)e[5] << 16); hi.y = e[6] | ((unsigned)e[7] << 16);
        *(v2u*)p = lo; *(v2u*)(p + 32 * 8) = hi; }
    __syncthreads();
}
#ifndef PROBE_REPEAT
#define PROBE_REPEAT -1
#endif
__device__ __forceinline__ void p2_phase(Frame& F) {
    const int gw = F.bid * NWAVES + F.wave, NGW = F.G * NWAVES;
    for (int rep = 0; rep < (PROBE_REPEAT == 20 ? 2 : 1); ++rep)
    for (int it = gw; it < (NTOKP / 16) * 8; it += NGW) p2_rwkv_witem(F, it >> 3, (it & 7) * 2, 2);
    for (int it = NGW - 1 - gw; it < (NTOKS / 16) * 16; it += NGW) p2_rwkv_witem(F, NTOKP / 16 + (it >> 4), it & 15, 1);
    for (int rep = 0; rep < (PROBE_REPEAT == 21 ? 2 : 1); ++rep)
    for (int it = F.bid; it < 128 + 16; it += F.G) {
        if (it < 128) { const int b = it >> 5, ts = it & 31;
            p2_vt_item(F, WSP(float, WS_PROJ) + (size_t)(b * SEQ + ts * 64) * INWP + C_AV, INWP, WSP(bf16, WS_VT) + (size_t)b * 512 * SEQ, 64, ts); }
        else { const int j = it - 128, b = j >> 2, ts = j & 3;
            p2_vt_item(F, F.out + O_MVP + (size_t)(b * MEMT + ts * 64) * 512, 512, WSP(bf16, WS_MVT) + (size_t)b * 512 * MEMT, 8, ts); }
    }
    for (int rep = 0; rep < (PROBE_REPEAT == 22 ? 2 : 1); ++rep)
    for (int row = NGW - 1 - gw; row < NTOK; row += NGW) p2_row_item(F, row);
    const int gt = F.bid * NTHR + F.tid, NGT = F.G * NTHR;
    for (int e = gt; e < 1024 * 512 / 4; e += NGT) { const f32x4 v = *(const f32x4*)(F.out + O_MKP + (size_t)e * 4); v2u o; o.x = cvt_pk_bf16(v.x, v.y); o.y = cvt_pk_bf16(v.z, v.w);
        const int rowm = e >> 7, col = (e & 127) * 4, bm = rowm >> 8, m = rowm & 255; *(v2u*)(WSP(bf16, WS_MKB) + (size_t)bm * MEMT * 512 + kf_off(8, col >> 7, m, col & 127)) = o; }
}

constexpr int TC = 32, SBUF_FLOATS = TC * 384;
#define SCAN_STAGE_LOAD(SIN, SCALP) do { \
    _Pragma("unroll") for (int i = 0; i < 10; ++i) { const int e = lt + 256 * i, st = e / 80, r = e % 80; rv[i] = *(const f32x4*)((SIN) + (size_t)st * 384 + r * 4); } \
    _Pragma("unroll") for (int i = 0; i < 2; ++i) { const int e = lt + 256 * i, st = e >> 4, row = e & 15; const float v_ = (SIN)[(size_t)st * 384 + 320 + rg * 16 + row]; const f32x2 sc_ = *(const f32x2*)((SCALP) + (size_t)st * 16); \
        rt[i].x = v_; rt[i].y = sc_.x; rt[i].z = sc_.y; rt[i].w = 0.f; } } while (0)
#define SCAN_STAGE_WRITE(BUF) do { \
    _Pragma("unroll") for (int i = 0; i < 10; ++i) { const int e = lt + 256 * i, st = e / 80, r = e % 80; *(LAS f32x4*)((BUF) + st * 384 + r * 4) = rv[i]; } \
    _Pragma("unroll") for (int i = 0; i < 2; ++i) { const int e = lt + 256 * i, st = e >> 4, row = e & 15; *(LAS f32x4*)((BUF) + st * 384 + 320 + row * 4) = rt[i]; } } while (0)
#define SCAN_STEP(KK, W4, NB, KP, WR, TB, YOUT) do { \
    f32x2 _a = s01 * (f32x2){KK.x, KK.y}; _a = __builtin_elementwise_fma(s23, (f32x2){KK.z, KK.w}, _a); \
    f32x2 _b = s01 * (f32x2){WR.x, WR.y}; _b = __builtin_elementwise_fma(s23, (f32x2){WR.z, WR.w}, _b); \
    float _p1 = _a.x + _a.y, _p2 = _b.x + _b.y; \
    _p1 += dpp<0xB1>(_p1); _p2 += dpp<0xB1>(_p2); _p1 += dpp<0x4E>(_p1); _p2 += dpp<0x4E>(_p2); _p1 += dpp<0x141>(_p1); _p2 += dpp<0x141>(_p2); _p1 += dpp<0x140>(_p1); _p2 += dpp<0x140>(_p2); \
    YOUT = __builtin_fmaf(TB.x, TB.z, __builtin_fmaf(_p1, TB.y, _p2)); \
    const f32x2 _pp = (f32x2){_p1, _p1}, _vv = (f32x2){TB.x, TB.x}; \
    f32x2 _t01 = _vv * (f32x2){KP.x, KP.y}; _t01 = __builtin_elementwise_fma(_pp, (f32x2){NB.x, NB.y}, _t01); s01 = __builtin_elementwise_fma(s01, (f32x2){W4.x, W4.y}, _t01); \
    f32x2 _t23 = _vv * (f32x2){KP.z, KP.w}; _t23 = __builtin_elementwise_fma(_pp, (f32x2){NB.z, NB.w}, _t23); s23 = __builtin_elementwise_fma(s23, (f32x2){W4.z, W4.w}, _t23); \
} while (0)
__device__ __forceinline__ void scan_prompt_item(Frame& F, const float* sin, const float* scal, float* s_out, float* y0, int rg) {
    LAS float* bufs = (LAS float*)(F.lds + RING_OFF);
    constexpr int nchunks = SEQ / TC;
    const bool scanner = F.wave < 4;
    const int ri = F.lane >> 4, kq = F.lane & 15;
    const int lrow = (F.wave & 3) * 4 + ri, vrow = rg * 16 + lrow;
    f32x2 s01 = (f32x2){0.f, 0.f}, s23 = (f32x2){0.f, 0.f};
#define SCAN_BAR() do { asm volatile("s_waitcnt lgkmcnt(0)" ::: "memory"); __builtin_amdgcn_s_barrier(); asm volatile("" ::: "memory"); } while (0)
    if (!scanner) {
        f32x4 rv[10], rt[2]; const int lt = F.tid - 256;
        SCAN_STAGE_LOAD(sin, scal); SCAN_STAGE_WRITE(bufs); SCAN_STAGE_LOAD(sin + (size_t)TC * 384, scal + (size_t)TC * 16);
        SCAN_BAR();
        for (int c = 0; c < nchunks; ++c) {
            if (c + 1 < nchunks) { SCAN_STAGE_WRITE(bufs + ((c + 1) & 1) * SBUF_FLOATS);
                if (c + 2 < nchunks) SCAN_STAGE_LOAD(sin + (size_t)(c + 2) * TC * 384, scal + (size_t)(c + 2) * TC * 16); }
            SCAN_BAR();
        }
    } else {
        SCAN_BAR();
        for (int c = 0; c < nchunks; ++c) {
            LAS float* buf = bufs + (c & 1) * SBUF_FLOATS;
            const LAS float* lb = buf + 4 * kq;
            const LAS float* tbp = buf + 320 + lrow * 4;
            float yacc = 0.f;
            f32x4 kkA = *(const LAS f32x4*)(lb), w4A = *(const LAS f32x4*)(lb + 64), nbA = *(const LAS f32x4*)(lb + 128), kpA = *(const LAS f32x4*)(lb + 192), wrA = *(const LAS f32x4*)(lb + 256), tbA = *(const LAS f32x4*)(tbp);
            f32x4 kkB = *(const LAS f32x4*)(lb + 384), w4B = *(const LAS f32x4*)(lb + 384 + 64), nbB = *(const LAS f32x4*)(lb + 384 + 128), kpB = *(const LAS f32x4*)(lb + 384 + 192), wrB = *(const LAS f32x4*)(lb + 384 + 256), tbB = *(const LAS f32x4*)(tbp + 384);
#pragma unroll
            for (int st = 0; st < TC; st += 2) {
                const int s2 = (st + 2 < TC) ? st + 2 : st, s3 = (st + 3 < TC) ? st + 3 : st + 1;
                float y;
                SCAN_STEP(kkA, w4A, nbA, kpA, wrA, tbA, y);
                yacc = (kq == (st & 15)) ? y : yacc;
                kkA = *(const LAS f32x4*)(lb + s2 * 384); w4A = *(const LAS f32x4*)(lb + s2 * 384 + 64); nbA = *(const LAS f32x4*)(lb + s2 * 384 + 128);
                kpA = *(const LAS f32x4*)(lb + s2 * 384 + 192); wrA = *(const LAS f32x4*)(lb + s2 * 384 + 256); tbA = *(const LAS f32x4*)(tbp + s2 * 384);
                __builtin_amdgcn_sched_barrier(0);
                SCAN_STEP(kkB, w4B, nbB, kpB, wrB, tbB, y);
                yacc = (kq == ((st + 1) & 15)) ? y : yacc;
                if (((st + 1) & 15) == 15) y0[(size_t)(c * TC + st + 1 - 15 + kq) * RW + vrow] = yacc;
                kkB = *(const LAS f32x4*)(lb + s3 * 384); w4B = *(const LAS f32x4*)(lb + s3 * 384 + 64); nbB = *(const LAS f32x4*)(lb + s3 * 384 + 128);
                kpB = *(const LAS f32x4*)(lb + s3 * 384 + 192); wrB = *(const LAS f32x4*)(lb + s3 * 384 + 256); tbB = *(const LAS f32x4*)(tbp + s3 * 384);
                __builtin_amdgcn_sched_barrier(0);
            }
            SCAN_BAR();
        }
    }
    __syncthreads();
    if (scanner) *(f32x4*)(s_out + (size_t)vrow * 64 + 4 * kq) = (f32x4){s01.x, s01.y, s23.x, s23.y};
}
__device__ __forceinline__ void scan_sample_witem(Frame& F, int item) {
    const int dbh = item >> 4, r4 = item & 15, db = dbh >> 4, h = dbh & 15;
    const int ri = F.lane >> 4, kq = F.lane & 15, vrow = r4 * 4 + ri;
    const size_t so = (size_t)NB * RH * SEQ + (size_t)dbh * DT;
    const float* sin = WSP(float, WS_SCANIN) + so * 384; const float* scal = WSP(float, WS_SCAL) + so * 16;
    const f32x4 s0 = *(const f32x4*)(F.in[I_SWKV] + (size_t)dbh * 4096 + (size_t)vrow * 64 + 4 * kq);
    f32x2 s01 = (f32x2){s0.x, s0.y}, s23 = (f32x2){s0.z, s0.w};
    f32x4 kk[DT], w4[DT], nb[DT], kp[DT], wr[DT], tb[DT];
#pragma unroll
    for (int st = 0; st < DT; ++st) { const float* p = sin + st * 384 + 4 * kq;
        kk[st] = *(const f32x4*)(p); w4[st] = *(const f32x4*)(p + 64); nb[st] = *(const f32x4*)(p + 128); kp[st] = *(const f32x4*)(p + 192); wr[st] = *(const f32x4*)(p + 256);
        const f32x2 sc = *(const f32x2*)(scal + st * 16); tb[st] = (f32x4){sin[st * 384 + 320 + vrow], sc.x, sc.y, 0.f}; }
    float* y0 = WSP(float, WS_Y) + (size_t)(NTOKP + db * DT) * RW + h * 64 + vrow;
#pragma unroll
    for (int st = 0; st < DT; ++st) { float y; SCAN_STEP(kk[st], w4[st], nb[st], kp[st], wr[st], tb[st], y); if (kq == 0) y0[(size_t)st * RW] = y; }
    *(f32x4*)(F.out + O_WKVS + (size_t)dbh * 4096 + (size_t)vrow * 64 + 4 * kq) = (f32x4){s01.x, s01.y, s23.x, s23.y};
}
__device__ __forceinline__ void p3_scan_phase(Frame& F) {
    const int gw = F.bid * NWAVES + F.wave, NGW = F.G * NWAVES;
    for (int it = gw; it < DB * RH * 16; it += NGW) scan_sample_witem(F, it);
    const float* SI = WSP(float, WS_SCANIN); const float* SL = WSP(float, WS_SCAL); float* Y = WSP(float, WS_Y);
    for (int it0 = F.bid; it0 < 256; it0 += F.G) { const int it = (F.G == 256) ? ((it0 & 7) * 32 + (it0 >> 3)) : it0;
        const int bh = it >> 2, rg = it & 3, b = bh >> 4, h = bh & 15;
        scan_prompt_item(F, SI + (size_t)bh * SEQ * 384, SL + (size_t)bh * SEQ * 16, F.out + O_WKVP + (size_t)bh * 4096, Y + (size_t)(b * SEQ) * RW + h * 64, rg); }
}

__device__ __forceinline__ void gn_row(Frame& F, int row) {
    const int lane = F.lane, h = lane >> 2, q = lane & 3, c0 = h * 64 + q * 16;
    const float* y = WSP(float, WS_Y) + (size_t)row * RW + c0;
    f32x4 v[4]; float s = 0.f;
#pragma unroll
    for (int j = 0; j < 4; ++j) { v[j] = *(const f32x4*)(y + 4 * j); s += (v[j].x + v[j].y) + (v[j].z + v[j].w); }
    s += dpp<0xB1>(s); s += dpp<0x4E>(s);
    const float mean = s * (1.f / 64.f); float s2 = 0.f;
#pragma unroll
    for (int j = 0; j < 4; ++j) { v[j] = v[j] - mean; s2 += (v[j].x * v[j].x + v[j].y * v[j].y) + (v[j].z * v[j].z + v[j].w * v[j].w); }
    s2 += dpp<0xB1>(s2); s2 += dpp<0x4E>(s2);
    const float rstd = 1.f / sqrtf(s2 * (1.f / 64.f) + GN_EPS);
    const size_t so = scan_seq_off(row, h);
    const float bonus = WSP(float, WS_SCAL)[so * 16 + 2];
    const float* vv = WSP(float, WS_SCANIN) + so * 384 + 5 * 64 + q * 16;
    const float* g = WSP(float, WS_PROJ) + (size_t)row * INWP + C_GR + c0;
    const float* gw = F.in[I_GNW] + c0; const float* gb = F.in[I_GNB] + c0;
    bf16* o = WSP(bf16, WS_YMIX) + (size_t)row * DM + c0;
#pragma unroll
    for (int j = 0; j < 4; ++j) { const f32x4 w4 = *(const f32x4*)(gw + 4 * j), b4 = *(const f32x4*)(gb + 4 * j), v4 = *(const f32x4*)(vv + 4 * j), g4 = *(const f32x4*)(g + 4 * j);
        const float o0 = (v[j].x * rstd * w4.x + b4.x + bonus * v4.x) * silu(g4.x), o1 = (v[j].y * rstd * w4.y + b4.y + bonus * v4.y) * silu(g4.y);
        const float o2 = (v[j].z * rstd * w4.z + b4.z + bonus * v4.z) * silu(g4.z), o3 = (v[j].w * rstd * w4.w + b4.w + bonus * v4.w) * silu(g4.w);
        v2u pk; pk.x = cvt_pk_bf16(o0, o1); pk.y = cvt_pk_bf16(o2, o3); *(v2u*)(o + 4 * j) = pk; }
}
__device__ __forceinline__ void idx_afrag(const bf16* QIB, int row0, int lane, bf16x8 (&af)[4]) {
    const int r = lane & 31, hh = lane >> 5;
    const bf16* p = QIB + (size_t)(row0 + ((r >> 2) & 1)) * 1024 + ((r >> 3) * 4 + (r & 3)) * 64 + 8 * hh;
#pragma unroll
    for (int ks = 0; ks < 4; ++ks) af[ks] = *(const bf16x8*)(p + 16 * ks);
}
__device__ __forceinline__ float idx_reduce(const f32x16& acc, const f32x4 (&w)[4]) {
    float v = 0.f;
#pragma unroll
    for (int j = 0; j < 16; ++j) v += w[j >> 2][j & 3] * fmaxf(acc[j], 0.f);
    return v;
}
__device__ __forceinline__ void d1_prompt_item(Frame& F, int item) {
    const int idx = item & 255, second = item >> 8, b = idx >> 6, qi = idx & 63, qt = second ? 127 - qi : qi;
    const int t0 = qt * 16 + 2 * F.wave, row0 = b * SEQ + t0;
    const int r = F.lane & 31, hh = F.lane >> 5;
    bf16x8 af[4]; idx_afrag(WSP(bf16, WS_QIB), row0, F.lane, af);
    f32x4 w[4];
#pragma unroll
    for (int j = 0; j < 4; ++j) w[j] = *(const f32x4*)(WSP(float, WS_WIS) + (size_t)(row0 + hh) * 16 + 4 * j);
    const int tq = t0 + hh;
    const bf16* KIB = WSP(bf16, WS_KIB) + (size_t)(b * SEQ) * 64;
    float* SC = WSP(float, WS_SC) + (size_t)(b * SEQ + tq) * SEQ;
    for (int s0 = 0; s0 <= t0 + 1; s0 += 32) {
        f32x16 acc;
#pragma unroll
        for (int j = 0; j < 16; ++j) acc[j] = 0.f;
#pragma unroll
        for (int ks = 0; ks < 4; ++ks) { const bf16x8 bfr = *(const bf16x8*)(KIB + (size_t)(s0 + r) * 64 + 16 * ks + 8 * hh);
            acc = __builtin_amdgcn_mfma_f32_32x32x16_bf16(af[ks], bfr, acc, 0, 0, 0); }
        SC[s0 + r] = idx_reduce(acc, w);
    }
}
__device__ __forceinline__ void d1_sample_item(Frame& F, int item) {
    const int r = F.lane & 31, hh = F.lane >> 5;
    int db, p = 0; bool newk = false;
    if (item < DB * NPAGES) { db = item >> 6; p = item & 63; } else { db = item - DB * NPAGES; newk = true; }
    const int row0 = NTOKP + db * DT;
    bf16x8 af0[4], af1[4]; idx_afrag(WSP(bf16, WS_QIB), row0, F.lane, af0); idx_afrag(WSP(bf16, WS_QIB), row0 + 2, F.lane, af1);
    f32x4 w0[4], w1[4];
#pragma unroll
    for (int j = 0; j < 4; ++j) { w0[j] = *(const f32x4*)(WSP(float, WS_WIS) + (size_t)(row0 + hh) * 16 + 4 * j); w1[j] = *(const f32x4*)(WSP(float, WS_WIS) + (size_t)(row0 + 2 + hh) * 16 + 4 * j); }
    float* SCS = WSP(float, WS_SCS);
    if (!newk) {
        const int page = ((const int*)F.in[I_PT])[db * NPAGES + p];
        const float* kp = F.in[I_CKI] + ((size_t)page * PAGE + r) * 64 + 8 * hh;
        f32x4 ka[4][4], kc[4][4];
#pragma unroll
        for (int kt = 0; kt < 4; ++kt)
#pragma unroll
            for (int ks = 0; ks < 4; ++ks) { ka[kt][ks] = *(const f32x4*)(kp + (size_t)kt * 32 * 64 + 16 * ks); kc[kt][ks] = *(const f32x4*)(kp + (size_t)kt * 32 * 64 + 16 * ks + 4); }
#pragma unroll
        for (int kt = 0; kt < 4; ++kt) {
            f32x16 acc0, acc1;
#pragma unroll
            for (int j = 0; j < 16; ++j) { acc0[j] = 0.f; acc1[j] = 0.f; }
#pragma unroll
            for (int ks = 0; ks < 4; ++ks) { const f32x4 a = ka[kt][ks], c = kc[kt][ks];
                v4u u; u.x = cvt_pk_bf16(a.x, a.y); u.y = cvt_pk_bf16(a.z, a.w); u.z = cvt_pk_bf16(c.x, c.y); u.w = cvt_pk_bf16(c.z, c.w);
                const bf16x8 bfr = __builtin_bit_cast(bf16x8, u);
                acc0 = __builtin_amdgcn_mfma_f32_32x32x16_bf16(af0[ks], bfr, acc0, 0, 0, 0); acc1 = __builtin_amdgcn_mfma_f32_32x32x16_bf16(af1[ks], bfr, acc1, 0, 0, 0); }
            SCS[(size_t)(db * DT + hh) * SCS_LD + p * PAGE + kt * 32 + r] = idx_reduce(acc0, w0);
            SCS[(size_t)(db * DT + 2 + hh) * SCS_LD + p * PAGE + kt * 32 + r] = idx_reduce(acc1, w1);
        }
    } else {
        f32x16 acc0, acc1;
#pragma unroll
        for (int j = 0; j < 16; ++j) { acc0[j] = 0.f; acc1[j] = 0.f; }
        const bf16* kp = WSP(bf16, WS_KIB) + (size_t)(row0 + (r & 3)) * 64 + 8 * hh;
#pragma unroll
        for (int ks = 0; ks < 4; ++ks) { bf16x8 bfr = *(const bf16x8*)(kp + 16 * ks);
            acc0 = __builtin_amdgcn_mfma_f32_32x32x16_bf16(af0[ks], bfr, acc0, 0, 0, 0); acc1 = __builtin_amdgcn_mfma_f32_32x32x16_bf16(af1[ks], bfr, acc1, 0, 0, 0); }
        if (r < 4) { SCS[(size_t)(db * DT + hh) * SCS_LD + PAST + r] = idx_reduce(acc0, w0); SCS[(size_t)(db * DT + 2 + hh) * SCS_LD + PAST + r] = idx_reduce(acc1, w1); }
    }
}
__device__ __forceinline__ void d2_sample_block(Frame& F, int q);
__device__ __forceinline__ void p4_phase(Frame& F) {
    const int gw = F.bid * NWAVES + F.wave, NGW = F.G * NWAVES;
    if (F.G >= 64) {
        for (int q = F.bid; q < NTOKS; q += F.G) d2_sample_block(F, q);
    } else {
        for (int it = gw; it < DB * NPAGES + DB; it += NGW) d1_sample_item(F, it);
    }
    for (int row = gw; row < NTOK; row += NGW) gn_row(F, row);
}

__device__ __forceinline__ unsigned wave_count(unsigned c) {
#pragma unroll
    for (int o = 1; o < 64; o <<= 1) c += __shfl_xor((int)c, o);
    return c;
}
template <int NV>
__device__ __forceinline__ void kth_select(const unsigned (&key)[NV * 4], unsigned xk, int xbase, int lane, unsigned& T_out, unsigned& cut_out) {
    unsigned T = 0u; bool exact = false;
    for (int bit = 31; bit >= 0; --bit) {
        const unsigned cand = T | (1u << bit);
        unsigned c = (xk >= cand) ? 1u : 0u;
#pragma unroll
        for (int i = 0; i < NV * 4; ++i) c += (key[i] >= cand) ? 1u : 0u;
        c = wave_count(c);
        if (c >= (unsigned)TOPK) T = cand;
        if (c == (unsigned)TOPK) { exact = true; break; }
    }
    unsigned cut = 0x7fffffffu;
    if (!exact) {
        unsigned cg = (xk > T) ? 1u : 0u, ce = (xk == T) ? 1u : 0u;
#pragma unroll
        for (int i = 0; i < NV * 4; ++i) { cg += (key[i] > T) ? 1u : 0u; ce += (key[i] == T) ? 1u : 0u; }
        cg = wave_count(cg); ce = wave_count(ce);
        const unsigned need = (unsigned)TOPK - cg;
        if (ce > need) {
            unsigned I = 0u;
            for (int bit = 14; bit >= 0; --bit) {
                const unsigned cand = I | (1u << bit);
                unsigned c = (xk == T && (unsigned)(xbase + lane) < cand && lane < 4) ? 1u : 0u;
#pragma unroll
                for (int i = 0; i < NV * 4; ++i) { const unsigned idx = 256u * (i >> 2) + 4u * lane + (i & 3); c += (key[i] == T && idx < cand) ? 1u : 0u; }
                c = wave_count(c);
                if (c < need) I = cand;
            }
            cut = I;
        }
    }
    T_out = T; cut_out = cut;
}
__device__ __forceinline__ void d2_prompt_row(Frame& F, int row) {
    const int t = row & 2047, lane = F.lane;
    unsigned* THR = WSP(unsigned, WS_THR) + (size_t)row * 2;
    if (t < TOPK) { if (lane == 0) { THR[0] = 0u; THR[1] = 0x7fffffffu; } return; }
    const float* SC = WSP(float, WS_SC) + (size_t)row * SEQ;
    unsigned key[32];
#pragma unroll
    for (int j = 0; j < 8; ++j) { const int i0 = 256 * j + 4 * lane;
        if (i0 <= t) { const f32x4 v = *(const f32x4*)(SC + i0);
            key[4 * j + 0] = sort_key(v.x); key[4 * j + 1] = (i0 + 1 <= t) ? sort_key(v.y) : 0u; key[4 * j + 2] = (i0 + 2 <= t) ? sort_key(v.z) : 0u; key[4 * j + 3] = (i0 + 3 <= t) ? sort_key(v.w) : 0u; }
        else { key[4 * j + 0] = 0u; key[4 * j + 1] = 0u; key[4 * j + 2] = 0u; key[4 * j + 3] = 0u; } }
    unsigned T, cut; kth_select<8>(key, 0u, 1 << 20, lane, T, cut);
    if (lane == 0) { THR[0] = T; THR[1] = cut; }
}
__device__ __forceinline__ void d2_sample_block(Frame& F, int q) {
    const int t = q & 3, tid = F.tid, lane = F.lane;
    const float* SCS = WSP(float, WS_SCS) + (size_t)q * SCS_LD;
    LAS unsigned* red = (LAS unsigned*)(F.lds + RING_OFF);
    unsigned key[16];
#pragma unroll
    for (int j = 0; j < 4; ++j) { const f32x4 v = *(const f32x4*)(SCS + 2048 * j + 4 * tid);
        key[4 * j + 0] = sort_key(v.x); key[4 * j + 1] = sort_key(v.y); key[4 * j + 2] = sort_key(v.z); key[4 * j + 3] = sort_key(v.w); }
    unsigned xk = 0u; if (tid <= t) xk = sort_key(SCS[PAST + tid]);
    if (tid == 0) red[16] = 0u;
    unsigned T = 0u; bool exact = false; int par = 0;
    for (int bit = 31; bit >= 0; --bit) {
        const unsigned cand = T | (1u << bit);
        unsigned c = (xk >= cand) ? 1u : 0u;
#pragma unroll
        for (int i = 0; i < 16; ++i) c += (key[i] >= cand) ? 1u : 0u;
        c = wave_count(c);
        if (lane == 0) red[par * 8 + F.wave] = c;
        __syncthreads();
        unsigned tot = 0u;
#pragma unroll
        for (int w = 0; w < 8; ++w) tot += red[par * 8 + w];
        par ^= 1;
        if (tot >= (unsigned)TOPK) T = cand;
        if (tot == (unsigned)TOPK) { exact = true; break; }
    }
    unsigned cut = 0x7fffffffu;
    if (!exact) {
        unsigned cg = (xk > T) ? 1u : 0u, ce = (xk == T) ? 1u : 0u;
#pragma unroll
        for (int i = 0; i < 16; ++i) { cg += (key[i] > T) ? 1u : 0u; ce += (key[i] == T) ? 1u : 0u; }
        cg = wave_count(cg); ce = wave_count(ce);
        if (lane == 0) red[par * 8 + F.wave] = (cg << 16) | ce;
        __syncthreads();
        unsigned tg = 0u, te = 0u;
#pragma unroll
        for (int w = 0; w < 8; ++w) { const unsigned v = red[par * 8 + w]; tg += v >> 16; te += v & 0xffffu; }
        par ^= 1;
        const unsigned need = (unsigned)TOPK - tg;
        if (te > need) {
            unsigned I = 0u;
            for (int bit = 14; bit >= 0; --bit) {
                const unsigned cand = I | (1u << bit);
                unsigned c = (xk == T && tid < 4 && (unsigned)(PAST + tid) < cand) ? 1u : 0u;
#pragma unroll
                for (int i = 0; i < 16; ++i) { const unsigned idx = 2048u * (i >> 2) + 4u * tid + (i & 3); c += (key[i] == T && idx < cand) ? 1u : 0u; }
                c = wave_count(c);
                if (lane == 0) red[par * 8 + F.wave] = c;
                __syncthreads();
                unsigned tot = 0u;
#pragma unroll
                for (int w = 0; w < 8; ++w) tot += red[par * 8 + w];
                par ^= 1;
                if (tot < need) I = cand;
            }
            cut = I;
        }
    }
    __syncthreads();
    int* IDX = WSP(int, WS_IDX) + (size_t)q * TOPK;
#pragma unroll
    for (int i = 0; i < 16; ++i) { const int idx = 2048 * (i >> 2) + 4 * tid + (i & 3);
        if (key[i] > T || (key[i] == T && (unsigned)idx <= cut)) { const unsigned pos = atomicAdd((unsigned*)&red[16], 1u); if (pos < (unsigned)TOPK) IDX[pos] = idx; } }
    if (tid <= t) { const int idx = PAST + tid; if (xk > T || (xk == T && (unsigned)idx <= cut)) { const unsigned pos = atomicAdd((unsigned*)&red[16], 1u); if (pos < (unsigned)TOPK) IDX[pos] = idx; } }
    __syncthreads();
}
__device__ __forceinline__ void p5_phase(Frame& F) {
    const int gw = F.bid * NWAVES + F.wave, NGW = F.G * NWAVES;
    for (int q = F.bid; q < NTOKS; q += F.G) d2_sample_block(F, q);
}

constexpr int DSA_MASK_OFF = RING_OFF;
constexpr int DSA_MERGE_OFF = RING_OFF + 8192;
__device__ __forceinline__ void cnt_ge(unsigned& c, unsigned k, unsigned cand) { asm volatile("v_cmp_ge_u32 vcc, %1, %2\n\tv_addc_co_u32 %0, vcc, 0, %0, vcc" : "+v"(c) : "v"(k), "v"(cand) : "vcc"); }
template <int CTRL> __device__ __forceinline__ unsigned dppu(unsigned x) { return (unsigned)__builtin_amdgcn_mov_dpp((int)x, CTRL, 0xf, 0xf, true); }
__device__ __forceinline__ unsigned half_sum_u(unsigned c) {
    c += dppu<0xB1>(c); c += dppu<0x4E>(c); c += dppu<0x141>(c); c += dppu<0x140>(c);
    auto s2 = __builtin_amdgcn_permlane16_swap(c, c, false, false);
    return s2[0] + s2[1];
}
template <bool MASKED>
__device__ __forceinline__ void attn_core(Frame& F, int row0, int nkt, int NT, const bf16* Qb, const bf16* Kf  , const bf16* Vf  , int gate_col, int out_col) {
    const int lane = F.lane, r = lane & 31, hh = lane >> 5, h = F.wave & 3, half = F.wave >> 2;
    const LAS unsigned* mask = (const LAS unsigned*)(F.lds + DSA_MASK_OFF) + r * 64;
    bf16x8 qf[8];
#pragma unroll
    for (int ks = 0; ks < 8; ++ks) qf[ks] = *(const bf16x8*)(Qb + (size_t)(row0 + r) * 512 + h * 128 + 16 * ks + 8 * hh);
    f32x16 o[4];
#pragma unroll
    for (int d = 0; d < 4; ++d)
#pragma unroll
        for (int j = 0; j < 16; ++j) o[d][j] = 0.f;
    float m = -INFINITY, lsum = 0.f;
    const bf16* kbase = Kf + (size_t)(h * NT) * 4096 + lane * 8;
    const bf16* vbase = Vf + (size_t)(h * NT) * 4096 + lane * 8;
    bf16x8 kf[8];
    if (half < nkt) {
#pragma unroll
        for (int ks = 0; ks < 8; ++ks) kf[ks] = *(const bf16x8*)(kbase + (size_t)half * 4096 + ks * 512);
    }
    for (int kt = half; kt < nkt; kt += 2) {
        bf16x8 vf[4][2];
#pragma unroll
        for (int d = 0; d < 4; ++d)
#pragma unroll
            for (int s = 0; s < 2; ++s) vf[d][s] = *(const bf16x8*)(vbase + (size_t)kt * 4096 + (d * 2 + s) * 512);
        f32x16 x;
#pragma unroll
        for (int j = 0; j < 16; ++j) x[j] = 0.f;
#pragma unroll
        for (int ks = 0; ks < 8; ++ks) x = __builtin_amdgcn_mfma_f32_32x32x16_bf16(kf[ks], qf[ks], x, 0, 0, 0);
        {
            const int ktn = (kt + 2 < nkt) ? kt + 2 : kt;
#pragma unroll
            for (int ks = 0; ks < 8; ++ks) kf[ks] = *(const bf16x8*)(kbase + (size_t)ktn * 4096 + ks * 512);
        }
        if (MASKED) {
            const unsigned m4 = mask[kt] >> (4 * hh);
#pragma unroll
            for (int g = 0; g < 4; ++g)
#pragma unroll
                for (int e = 0; e < 4; ++e) { const unsigned t = (unsigned)((int)(m4 << (31 - (8 * g + e))) >> 31);
                    x[4 * g + e] = __uint_as_float((__float_as_uint(x[4 * g + e]) & t) | (0xff800000u & ~t)); }
        }
        float mx = x[0];
#pragma unroll
        for (int j = 1; j < 16; ++j) mx = fmaxf(mx, x[j]);
        mx = xhalf_max(mx);
        const float mn = fmaxf(m, mx), mu = (mn == -INFINITY) ? 0.f : mn;
        const float alpha = __builtin_amdgcn_exp2f(m - mu);
        m = mn;
        float ls = 0.f;
#pragma unroll
        for (int j = 0; j < 16; ++j) { x[j] = __builtin_amdgcn_exp2f(x[j] - mu); ls += x[j]; }
        lsum = lsum * alpha + ls;
        if (__any(alpha != 1.f)) {
#pragma unroll
            for (int d = 0; d < 4; ++d)
#pragma unroll
                for (int j = 0; j < 16; ++j) o[d][j] *= alpha;
        }
        bf16x8 pf[2];
#pragma unroll
        for (int s = 0; s < 2; ++s) { v4u u; u.x = cvt_pk_bf16(x[8 * s + 0], x[8 * s + 1]); u.y = cvt_pk_bf16(x[8 * s + 2], x[8 * s + 3]); u.z = cvt_pk_bf16(x[8 * s + 4], x[8 * s + 5]); u.w = cvt_pk_bf16(x[8 * s + 6], x[8 * s + 7]);
            pf[s] = __builtin_bit_cast(bf16x8, u); }
#pragma unroll
        for (int d = 0; d < 4; ++d)
#pragma unroll
            for (int s = 0; s < 2; ++s) o[d] = __builtin_amdgcn_mfma_f32_32x32x16_bf16(vf[d][s], pf[s], o[d], 0, 0, 0);
    }
    lsum = xhalf_sum(lsum);
    LAS float* mg = (LAS float*)(F.lds + DSA_MERGE_OFF) + h * 66 * 64;
    if (half == 1) {
        mg[0 * 64 + lane] = m; mg[1 * 64 + lane] = lsum;
#pragma unroll
        for (int d = 0; d < 4; ++d)
#pragma unroll
            for (int j = 0; j < 16; ++j) mg[(2 + d * 16 + j) * 64 + lane] = o[d][j];
    }
    __syncthreads();
    if (half == 0) {
        const float m1 = mg[0 * 64 + lane], l1 = mg[1 * 64 + lane];
        const float mn = fmaxf(m, m1), mu = (mn == -INFINITY) ? 0.f : mn;
        const float a0 = __builtin_amdgcn_exp2f(m - mu), a1 = __builtin_amdgcn_exp2f(m1 - mu);
        const float l = lsum * a0 + l1 * a1; const float inv = l > 0.f ? 1.f / l : 0.f;
        const float* gp = WSP(float, WS_PROJ) + (size_t)(row0 + r) * INWP + gate_col + h * 128;
        bf16* op = WSP(bf16, WS_YMIX) + (size_t)(row0 + r) * DM + out_col + h * 128;
#pragma unroll
        for (int d = 0; d < 4; ++d)
#pragma unroll
            for (int g = 0; g < 4; ++g) { const int dd = d * 32 + 8 * g + 4 * hh; const f32x4 gv = *(const f32x4*)(gp + dd);
                float v[4];
#pragma unroll
                for (int e = 0; e < 4; ++e) v[e] = (o[d][4 * g + e] * a0 + mg[(2 + d * 16 + 4 * g + e) * 64 + lane] * a1) * inv * silu(gv[e]);
                v2u pk; pk.x = cvt_pk_bf16(v[0], v[1]); pk.y = cvt_pk_bf16(v[2], v[3]); *(v2u*)(op + dd) = pk; }
    }
    __syncthreads();
}
__device__ __forceinline__ void dsa_prompt_item(Frame& F, int b, int qt) {
    const int t0 = qt * 32, row0 = b * SEQ + t0, nkt = qt + 1;
    LAS unsigned* mask = (LAS unsigned*)(F.lds + DSA_MASK_OFF);
    if (t0 + 31 < TOPK) {
        for (int i = F.tid; i < 32 * 64; i += NTHR) { const int q = i >> 6, kt = i & 63; const int nb = t0 + q - 32 * kt + 1;
            mask[i] = nb >= 32 ? 0xffffffffu : (nb <= 0 ? 0u : ((1u << nb) - 1u)); }
    } else {
        const int lane = F.lane, r = lane & 31, hh = lane >> 5;
        int r4 = 4 * r; asm volatile("" : "+v"(r4));
        const bf16* KIB = WSP(bf16, WS_SC) + (size_t)(b * SEQ) * 64 + lane * 8;
        LAS unsigned* skl = (LAS unsigned*)(F.lds + DSA_MASK_OFF + 8192) + F.wave * 4096 + hh * 2048;
        for (int i = F.tid; i < 32 * 64; i += NTHR) mask[i] = 0u;
        __syncthreads();
        for (int pass = 0; pass < 2; ++pass) {
            const int q0 = 16 * pass + 2 * F.wave, tq = t0 + q0 + hh;
            {
                bf16x8 af[4]; idx_afrag(WSP(bf16, WS_QIB), row0 + q0, lane, af);
                f32x4 w[4];
#pragma unroll
                for (int j = 0; j < 4; ++j) w[j] = *(const f32x4*)(WSP(float, WS_WIS) + (size_t)(row0 + q0 + hh) * 16 + 4 * j);
                bf16x8 ring[4][4];
#pragma unroll
                for (int i = 0; i < 3; ++i) { const int ktc = i < nkt ? i : nkt - 1;
#pragma unroll
                    for (int ks = 0; ks < 4; ++ks) ring[i][ks] = *(const bf16x8*)(KIB + (size_t)ktc * 2048 + ks * 512); }
                for (int kt0 = 0; kt0 < nkt; kt0 += 4) {
#pragma unroll
                    for (int i = 0; i < 4; ++i) {
                        const int kt = kt0 + i, ktp = (kt + 3 < nkt) ? kt + 3 : nkt - 1;
#pragma unroll
                        for (int ks = 0; ks < 4; ++ks) ring[(i + 3) & 3][ks] = *(const bf16x8*)(KIB + (size_t)ktp * 2048 + ks * 512);
                        f32x16 acc;
#pragma unroll
                        for (int j = 0; j < 16; ++j) acc[j] = 0.f;
#pragma unroll
                        for (int ks = 0; ks < 4; ++ks) acc = __builtin_amdgcn_mfma_f32_32x32x16_bf16(af[ks], ring[i][ks], acc, 0, 0, 0);
                        if (kt < nkt) skl[kt * 32 + r] = sort_key(idx_reduce(acc, w));
                    }
                }
            }
            asm volatile("s_waitcnt lgkmcnt(0)" ::: "memory");
            unsigned sk[64];
            int tqr = tq - r4; asm volatile("" : "+v"(tqr));
#pragma unroll
            for (int i = 0; i < 16; ++i) { const v4u v = *(const LAS v4u*)(skl + 128 * i + r4);
                sk[4 * i + 0] = (128 * i + 0 <= tqr) ? v.x : 0u; sk[4 * i + 1] = (128 * i + 1 <= tqr) ? v.y : 0u; sk[4 * i + 2] = (128 * i + 2 <= tqr) ? v.z : 0u; sk[4 * i + 3] = (128 * i + 3 <= tqr) ? v.w : 0u; }
            unsigned T = 0u; bool exact = false;
            for (int bit = 31; bit >= 0; --bit) {
                const unsigned cand = T | (1u << bit);
                unsigned c = 0u;
#pragma unroll
                for (int i = 0; i < 64; ++i) cnt_ge(c, sk[i], cand);
                c = half_sum_u(c);
                if (!exact) { if (c >= (unsigned)TOPK) T = cand; if (c == (unsigned)TOPK) exact = true; }
                if (__all(exact)) break;
            }
            unsigned cut = 0x7fffffffu;
            if (__any(!exact)) {
                unsigned cg = 0u, ce = 0u;
                for (int i = 0; i < 16; ++i) { const v4u v = *(const LAS v4u*)(skl + 128 * i + r4); const int i0 = 128 * i + r4;
#pragma unroll
                    for (int e = 0; e < 4; ++e) { const unsigned k = (i0 + e <= tq) ? v[e] : 0u; cg += (k > T) ? 1u : 0u; ce += (k == T) ? 1u : 0u; } }
                cg = half_sum_u(cg); ce = half_sum_u(ce);
                const unsigned need = (unsigned)TOPK - cg;
                const bool tie = !exact && ce > need;
                unsigned I = 0u;
                for (int bit = 11; bit >= 0; --bit) {
                    const unsigned cand = I | (1u << bit);
                    unsigned c = 0u;
                    for (int i = 0; i < 16; ++i) { const v4u v = *(const LAS v4u*)(skl + 128 * i + r4); const int i0 = 128 * i + r4;
#pragma unroll
                        for (int e = 0; e < 4; ++e) { const unsigned k = (i0 + e <= tq) ? v[e] : 0u; c += (k == T && (unsigned)(i0 + e) < cand) ? 1u : 0u; } }
                    c = half_sum_u(c);
                    if (c < need) I = cand;
                }
                if (tie) cut = I;
            }
            int cutr = (int)cut - r4; asm volatile("" : "+v"(cutr));
#pragma unroll
            for (int i = 0; i < 16; ++i) {
                unsigned nib = 0u;
#pragma unroll
                for (int e = 0; e < 4; ++e) { const unsigned k = sk[4 * i + e]; const bool sel = k != 0u && (k > T || (k == T && (128 * i + e) <= cutr)); nib |= sel ? (1u << e) : 0u; }
                if (nib) __hip_atomic_fetch_or((LAS unsigned*)&mask[(q0 + hh) * 64 + 4 * i + (r >> 3)], nib << (4 * (r & 7)), __ATOMIC_RELAXED, __HIP_MEMORY_SCOPE_WORKGROUP);
            }
        }
    }
    __syncthreads();
#ifndef T_NOCORE
    attn_core<true>(F, row0, nkt, 64, WSP(bf16, WS_QB), WSP(bf16, WS_KB) + (size_t)b * SEQ * 512, WSP(bf16, WS_VT) + (size_t)b * 512 * SEQ, C_GA, 1024);
#endif
}
__device__ __forceinline__ void gather_attn_item(Frame& F, int q, bool dsa) {
    const int lane = F.lane, hd = lane >> 4, d0 = (lane & 15) * 8, db = q >> 2, row = NTOKP + q;
    LAS float* red = (LAS float*)(F.lds + RING_OFF);
    LAS float* racc = red + 64;
    const float* kptr; const float* vptr;
    {
        const int ki = F.wave * 32 + (lane & 31);
        if (dsa) { const int idx = WSP(int, WS_IDX)[(size_t)q * TOPK + ki];
            if (idx < PAST) { const size_t phys = (size_t)((const int*)F.in[I_PT])[db * NPAGES + (idx >> 7)] * PAGE + (idx & 127); kptr = F.in[I_CK] + phys * 512; vptr = F.in[I_CV] + phys * 512; }
            else { const int j = idx - PAST; kptr = F.out + O_KS + (size_t)(db * DT + j) * 512; vptr = F.out + O_VS + (size_t)(db * DT + j) * 512; } }
        else { kptr = F.in[I_CMK] + (size_t)(db * MEMT + ki) * 512; vptr = F.in[I_CMV] + (size_t)(db * MEMT + ki) * 512; }
    }
    const bf16* qb = (dsa ? WSP(bf16, WS_QB) : WSP(bf16, WS_QMB)) + (size_t)row * 512 + hd * 128 + d0;
    float qv[8];
    { const v4u u = *(const v4u*)qb; qv[0] = __uint_as_float(u.x << 16); qv[1] = __uint_as_float(u.x & 0xffff0000u); qv[2] = __uint_as_float(u.y << 16); qv[3] = __uint_as_float(u.y & 0xffff0000u);
      qv[4] = __uint_as_float(u.z << 16); qv[5] = __uint_as_float(u.z & 0xffff0000u); qv[6] = __uint_as_float(u.w << 16); qv[7] = __uint_as_float(u.w & 0xffff0000u); }
    LAS float* sl = racc + 8 * 8 * 64 + F.wave * 128;
    float mx = -INFINITY;
#pragma unroll 16
    for (int i = 0; i < 32; ++i) {
        const unsigned long long pk = (unsigned long long)kptr;
        const unsigned lo = __shfl((int)(unsigned)pk, i), hi = __shfl((int)(unsigned)(pk >> 32), i);
        const float* kr = (const float*)(((unsigned long long)hi << 32) | lo) + hd * 128 + d0;
        const f32x4 a = *(const f32x4*)kr, c = *(const f32x4*)(kr + 4);
        float s = (a.x * qv[0] + a.y * qv[1]) + (a.z * qv[2] + a.w * qv[3]) + (c.x * qv[4] + c.y * qv[5]) + (c.z * qv[6] + c.w * qv[7]);
        s = row16_sum(s); mx = fmaxf(mx, s);
        if ((lane & 15) == 0) sl[i * 4 + hd] = s;
    }
    if ((lane & 15) == 0) red[F.wave * 4 + hd] = mx;
    __syncthreads();
    float gm = red[hd];
#pragma unroll
    for (int w = 1; w < 8; ++w) gm = fmaxf(gm, red[w * 4 + hd]);
    __syncthreads();
    float acc[8]; float ls = 0.f;
#pragma unroll
    for (int e = 0; e < 8; ++e) acc[e] = 0.f;
#pragma unroll 16
    for (int i = 0; i < 32; ++i) {
        const unsigned long long pv = (unsigned long long)vptr;
        const unsigned lo = __shfl((int)(unsigned)pv, i), hi = __shfl((int)(unsigned)(pv >> 32), i);
        const float* vr = (const float*)(((unsigned long long)hi << 32) | lo) + hd * 128 + d0;
        const f32x4 a = *(const f32x4*)vr, c = *(const f32x4*)(vr + 4);
        const float p = exp2f(sl[i * 4 + hd] - gm); ls += p;
        acc[0] += p * a.x; acc[1] += p * a.y; acc[2] += p * a.z; acc[3] += p * a.w; acc[4] += p * c.x; acc[5] += p * c.y; acc[6] += p * c.z; acc[7] += p * c.w;
    }
    if ((lane & 15) == 0) red[F.wave * 4 + hd] = ls;
#pragma unroll
    for (int e = 0; e < 8; ++e) racc[(F.wave * 8 + e) * 64 + lane] = acc[e];
    __syncthreads();
    if (F.wave == 0) {
        float l = 0.f;
#pragma unroll
        for (int w = 0; w < 8; ++w) l += red[w * 4 + hd];
        const float inv = 1.f / l;
        const float* gp = WSP(float, WS_PROJ) + (size_t)row * INWP + (dsa ? C_GA : C_GM) + hd * 128 + d0;
        float v[8];
#pragma unroll
        for (int e = 0; e < 8; ++e) { float a = 0.f;
#pragma unroll
            for (int w = 0; w < 8; ++w) a += racc[(w * 8 + e) * 64 + lane];
            v[e] = a * inv * silu(gp[e]); }
        v4u pk; pk.x = cvt_pk_bf16(v[0], v[1]); pk.y = cvt_pk_bf16(v[2], v[3]); pk.z = cvt_pk_bf16(v[4], v[5]); pk.w = cvt_pk_bf16(v[6], v[7]);
        *(v4u*)(WSP(bf16, WS_YMIX) + (size_t)row * DM + (dsa ? 1024 : 1536) + hd * 128 + d0) = pk;
    }
    __syncthreads();
}
__device__ __forceinline__ void p6_phase(Frame& F) {
    { const int gt = F.bid * NTHR + F.tid, NGT = F.G * NTHR;
      for (int e = gt; e < NTOKS * DM / 4; e += NGT) *(f32x4*)(F.out + O_YS + (size_t)e * 4) = *(const f32x4*)(F.in[I_XS] + (size_t)e * 4); }
    if (F.G >= 64) { for (int it = F.bid; it < 256; it += F.G) gather_attn_item(F, it & 127, it < 128); return; }
    unsigned* qctr = (unsigned*)(F.ws + WS_CTL) + 8192;
    volatile LAS int* slot = (volatile LAS int*)(F.lds + LDSCTL_OFF + 64);
    for (;;) {
        if (F.tid == 0) *slot = (int)__hip_atomic_fetch_add(qctr, 1u, __ATOMIC_RELAXED, __HIP_MEMORY_SCOPE_AGENT);
        __syncthreads();
        const int it = *slot;
        __syncthreads();
        if (it >= 768) break;
        Frame Fi = F; asm volatile("" : "+v"(Fi.lane), "+v"(Fi.tid));
        if (it < 256) { const int b = it & 3, qt = 63 - (it >> 2); dsa_prompt_item(Fi, b, qt); }
        else if (it < 512) { const int j = it - 256; gather_attn_item(Fi, j & 127, j < 128); }
        else { const int j = it - 512, b = j >> 6, qt = j & 63;
            attn_core<false>(Fi, b * SEQ + qt * 32, 8, 8, WSP(bf16, WS_QMB), WSP(bf16, WS_MKB) + (size_t)b * MEMT * 512, WSP(bf16, WS_MVT) + (size_t)b * 512 * MEMT, C_GM, 1536); }
    }
}

constexpr int G4_RING_BYTES = 3 * (16 * 384 + 16 * 16) * 4;
constexpr int G4_MASK_OFF = 77824, G4_SKL_OFF = G4_MASK_OFF + 8192;
constexpr int G4_SLOT_OFF = LDSCTL_OFF + 128;
struct GBar { volatile LAS unsigned* cnt; unsigned target; };
__device__ __forceinline__ void gbar(GBar& g, int lane) {
    g.target += 4u;
    asm volatile("s_waitcnt lgkmcnt(0)" ::: "memory");
    if (lane == 0) __hip_atomic_fetch_add((LAS unsigned*)g.cnt, 1u, __ATOMIC_RELAXED, __HIP_MEMORY_SCOPE_WORKGROUP);
    unsigned sp = 0; while (*g.cnt < g.target) { __builtin_amdgcn_s_sleep(1); if (++sp > (1u << 24)) break; }
    asm volatile("" ::: "memory");
}
constexpr int S4_TC = 16, S4_NB = 3, S4_BUF_FLOATS = S4_TC * 384 + S4_TC * 16, S4_NCH = SEQ / S4_TC;
__device__ __forceinline__ void scan4_issue(LAS unsigned char* lds, const float* sin, const float* scal, int c, int sw, int lane) {
    LAS float* buf = (LAS float*)(lds + RING_OFF) + (c % S4_NB) * S4_BUF_FLOATS;
    const float* src = sin + (size_t)c * S4_TC * 384;
#pragma unroll
    for (int i = 0; i < 6; ++i) { const int piece = sw + 4 * i;
        __builtin_amdgcn_global_load_lds((const unsigned*)(src + piece * 256 + lane * 4), (LAS unsigned*)(buf + piece * 256), 16, 0, 0); }
    __builtin_amdgcn_global_load_lds((const unsigned*)(scal + (size_t)c * S4_TC * 16 + lane * 4), (LAS unsigned*)(buf + S4_TC * 384), 16, 0, 0);
}
__device__ __forceinline__ void scan4_item(Frame& F, GBar& gb, int b, int h, int rg, float* s_out, float* y0) {
    const int bh = b * RH + h, lane = F.lane, sw = F.wave;
    const float* sin = WSP(float, WS_SCANIN) + (size_t)bh * SEQ * 384; const float* scal = WSP(float, WS_SCAL) + (size_t)bh * SEQ * 16;
    const int ri = lane >> 4, kq = lane & 15, vrow = rg * 16 + sw * 4 + ri;
    f32x2 s01 = (f32x2){0.f, 0.f}, s23 = (f32x2){0.f, 0.f};
    scan4_issue(F.lds, sin, scal, 0, sw, lane); scan4_issue(F.lds, sin, scal, 1, sw, lane);
    for (int c = 0; c < S4_NCH; ++c) {
        if (c < 2 || c + 2 >= S4_NCH) asm volatile("s_waitcnt vmcnt(0)" ::: "memory");
        else asm volatile("s_waitcnt vmcnt(9)" ::: "memory");
        gbar(gb, lane);
        if (c + 2 < S4_NCH) scan4_issue(F.lds, sin, scal, c + 2, sw, lane);
        const LAS float* buf = (const LAS float*)(F.lds + RING_OFF) + (c % S4_NB) * S4_BUF_FLOATS;
        const LAS float* lb = buf + 4 * kq;
        const LAS float* vb = buf + 320 + vrow;
        const LAS float* sb = buf + S4_TC * 384;
        float yacc = 0.f;
#define S4_LOAD(ST, KK, W4, NB, KP, WR, TB) do { KK = *(const LAS f32x4*)(lb + (ST) * 384); W4 = *(const LAS f32x4*)(lb + (ST) * 384 + 64); NB = *(const LAS f32x4*)(lb + (ST) * 384 + 128); \
            KP = *(const LAS f32x4*)(lb + (ST) * 384 + 192); WR = *(const LAS f32x4*)(lb + (ST) * 384 + 256); const float _v = vb[(ST) * 384]; const f32x2 _s = *(const LAS f32x2*)(sb + (ST) * 16); \
            TB.x = _v; TB.y = _s.x; TB.z = _s.y; TB.w = 0.f; } while (0)
        f32x4 kkA, w4A, nbA, kpA, wrA, tbA, kkB, w4B, nbB, kpB, wrB, tbB;
        S4_LOAD(0, kkA, w4A, nbA, kpA, wrA, tbA); S4_LOAD(1, kkB, w4B, nbB, kpB, wrB, tbB);
#pragma unroll
        for (int st = 0; st < S4_TC; st += 2) {
            const int s2 = (st + 2 < S4_TC) ? st + 2 : st, s3 = (st + 3 < S4_TC) ? st + 3 : st + 1;
            float y;
            SCAN_STEP(kkA, w4A, nbA, kpA, wrA, tbA, y);
            yacc = (kq == st) ? y : yacc;
            S4_LOAD(s2, kkA, w4A, nbA, kpA, wrA, tbA);
            __builtin_amdgcn_sched_barrier(0);
            SCAN_STEP(kkB, w4B, nbB, kpB, wrB, tbB, y);
            yacc = (kq == st + 1) ? y : yacc;
            S4_LOAD(s3, kkB, w4B, nbB, kpB, wrB, tbB);
            __builtin_amdgcn_sched_barrier(0);
        }
#undef S4_LOAD
        y0[(size_t)(c * S4_TC + kq) * RW + vrow] = yacc;
    }
    *(f32x4*)(s_out + (size_t)vrow * 64 + 4 * kq) = (f32x4){s01.x, s01.y, s23.x, s23.y};
}
template <bool MASKED>
__device__ __forceinline__ void attn4(Frame& F, int gw, int row0, int nkt, int NT, const bf16* Qb, const bf16* Kf, const bf16* Vf, int gate_col, int out_col) {
    const int lane = F.lane, r = lane & 31, hh = lane >> 5, h = gw;
    const LAS unsigned* mask = (const LAS unsigned*)(F.lds + G4_MASK_OFF) + r * 64;
    bf16x8 qf[8];
#pragma unroll
    for (int ks = 0; ks < 8; ++ks) qf[ks] = *(const bf16x8*)(Qb + (size_t)(row0 + r) * 512 + h * 128 + 16 * ks + 8 * hh);
    f32x16 o[4];
#pragma unroll
    for (int d = 0; d < 4; ++d)
#pragma unroll
        for (int j = 0; j < 16; ++j) o[d][j] = 0.f;
    float m = -INFINITY, lsum = 0.f;
    const bf16* kbase = Kf + (size_t)(h * NT) * 4096 + lane * 8;
    const bf16* vbase = Vf + (size_t)(h * NT) * 4096 + lane * 8;
    bf16x8 kf[8];
#pragma unroll
    for (int ks = 0; ks < 8; ++ks) kf[ks] = *(const bf16x8*)(kbase + ks * 512);
#pragma unroll 1
    for (int kt = 0; kt < nkt; ++kt) {
        bf16x8 vf[4][2];
#pragma unroll
        for (int d = 0; d < 4; ++d)
#pragma unroll
            for (int s = 0; s < 2; ++s) vf[d][s] = *(const bf16x8*)(vbase + (size_t)kt * 4096 + (d * 2 + s) * 512);
        f32x16 x;
#pragma unroll
        for (int j = 0; j < 16; ++j) x[j] = 0.f;
#pragma unroll
        for (int ks = 0; ks < 8; ++ks) x = __builtin_amdgcn_mfma_f32_32x32x16_bf16(kf[ks], qf[ks], x, 0, 0, 0);
        {   const int ktn = (kt + 1 < nkt) ? kt + 1 : kt;
#pragma unroll
            for (int ks = 0; ks < 8; ++ks) kf[ks] = *(const bf16x8*)(kbase + (size_t)ktn * 4096 + ks * 512); }
        if (MASKED) {
            const unsigned m4 = mask[kt] >> (4 * hh);
#pragma unroll
            for (int g = 0; g < 4; ++g)
#pragma unroll
                for (int e = 0; e < 4; ++e) { const unsigned t = (unsigned)((int)(m4 << (31 - (8 * g + e))) >> 31);
                    x[4 * g + e] = __uint_as_float((__float_as_uint(x[4 * g + e]) & t) | (0xff800000u & ~t)); }
        }
        float mx = x[0];
#pragma unroll
        for (int j = 1; j < 16; ++j) mx = fmaxf(mx, x[j]);
        mx = xhalf_max(mx);
        const float mn = fmaxf(m, mx), mu = (mn == -INFINITY) ? 0.f : mn;
        const float alpha = __builtin_amdgcn_exp2f(m - mu);
        m = mn;
        float ls = 0.f;
#pragma unroll
        for (int j = 0; j < 16; ++j) { x[j] = __builtin_amdgcn_exp2f(x[j] - mu); ls += x[j]; }
        lsum = lsum * alpha + ls;
        if (__any(alpha != 1.f)) {
#pragma unroll
            for (int d = 0; d < 4; ++d)
#pragma unroll
                for (int j = 0; j < 16; ++j) o[d][j] *= alpha;
        }
        bf16x8 pf[2];
#pragma unroll
        for (int s = 0; s < 2; ++s) { v4u u; u.x = cvt_pk_bf16(x[8 * s + 0], x[8 * s + 1]); u.y = cvt_pk_bf16(x[8 * s + 2], x[8 * s + 3]); u.z = cvt_pk_bf16(x[8 * s + 4], x[8 * s + 5]); u.w = cvt_pk_bf16(x[8 * s + 6], x[8 * s + 7]);
            pf[s] = __builtin_bit_cast(bf16x8, u); }
#pragma unroll
        for (int d = 0; d < 4; ++d)
#pragma unroll
            for (int s = 0; s < 2; ++s) o[d] = __builtin_amdgcn_mfma_f32_32x32x16_bf16(vf[d][s], pf[s], o[d], 0, 0, 0);
    }
    lsum = xhalf_sum(lsum);
    const float inv = lsum > 0.f ? 1.f / lsum : 0.f;
    const float* gp = WSP(float, WS_PROJ) + (size_t)(row0 + r) * INWP + gate_col + h * 128;
    bf16* op = WSP(bf16, WS_YMIX) + (size_t)(row0 + r) * DM + out_col + h * 128;
#pragma unroll
    for (int d = 0; d < 4; ++d)
#pragma unroll
        for (int g = 0; g < 4; ++g) { const int dd = d * 32 + 8 * g + 4 * hh; const f32x4 gv = *(const f32x4*)(gp + dd);
            float v[4];
#pragma unroll
            for (int e = 0; e < 4; ++e) v[e] = o[d][4 * g + e] * inv * silu(gv[e]);
            v2u pk; pk.x = cvt_pk_bf16(v[0], v[1]); pk.y = cvt_pk_bf16(v[2], v[3]); *(v2u*)(op + dd) = pk; }
}
__device__ __forceinline__ void dsa4_item(Frame& F, GBar& gb, int gw, int b, int qt) {
    const int t0 = qt * 32, row0 = b * SEQ + t0, nkt = qt + 1, gt = gw * 64 + F.lane;
    LAS unsigned* mask = (LAS unsigned*)(F.lds + G4_MASK_OFF);
    if (t0 + 31 < TOPK) {
        for (int i = gt; i < 32 * 64; i += 256) { const int q = i >> 6, kt = i & 63; const int nb = t0 + q - 32 * kt + 1;
            mask[i] = nb >= 32 ? 0xffffffffu : (nb <= 0 ? 0u : ((1u << nb) - 1u)); }
    } else {
        const int lane = F.lane, r = lane & 31, hh = lane >> 5;
        int r4 = 4 * r; asm volatile("" : "+v"(r4));
        const bf16* KIB = WSP(bf16, WS_SC) + (size_t)(b * SEQ) * 64 + lane * 8;
        LAS unsigned* skl = (LAS unsigned*)(F.lds + G4_SKL_OFF) + gw * 4096 + hh * 2048;
        for (int i = gt; i < 32 * 64; i += 256) mask[i] = 0u;
        gbar(gb, lane);
        for (int pass = 0; pass < 4; ++pass) {
            const int q0 = 8 * pass + 2 * gw, tq = t0 + q0 + hh;
            {
                bf16x8 af[4]; idx_afrag(WSP(bf16, WS_QIB), row0 + q0, lane, af);
                f32x4 w[4];
#pragma unroll
                for (int j = 0; j < 4; ++j) w[j] = *(const f32x4*)(WSP(float, WS_WIS) + (size_t)(row0 + q0 + hh) * 16 + 4 * j);
                bf16x8 ring[4][4];
#pragma unroll
                for (int i = 0; i < 3; ++i) { const int ktc = i < nkt ? i : nkt - 1;
#pragma unroll
                    for (int ks = 0; ks < 4; ++ks) ring[i][ks] = *(const bf16x8*)(KIB + (size_t)ktc * 2048 + ks * 512); }
                for (int kt0 = 0; kt0 < nkt; kt0 += 4) {
#pragma unroll
                    for (int i = 0; i < 4; ++i) {
                        const int kt = kt0 + i, ktp = (kt + 3 < nkt) ? kt + 3 : nkt - 1;
#pragma unroll
                        for (int ks = 0; ks < 4; ++ks) ring[(i + 3) & 3][ks] = *(const bf16x8*)(KIB + (size_t)ktp * 2048 + ks * 512);
                        f32x16 acc;
#pragma unroll
                        for (int j = 0; j < 16; ++j) acc[j] = 0.f;
#pragma unroll
                        for (int ks = 0; ks < 4; ++ks) acc = __builtin_amdgcn_mfma_f32_32x32x16_bf16(af[ks], ring[i][ks], acc, 0, 0, 0);
                        if (kt < nkt) skl[kt * 32 + r] = sort_key(idx_reduce(acc, w));
                    }
                }
            }
            asm volatile("s_waitcnt lgkmcnt(0)" ::: "memory");
            unsigned sk[64];
            int tqr = tq - r4; asm volatile("" : "+v"(tqr));
#pragma unroll
            for (int i = 0; i < 16; ++i) { const v4u v = *(const LAS v4u*)(skl + 128 * i + r4);
                sk[4 * i + 0] = (128 * i + 0 <= tqr) ? v.x : 0u; sk[4 * i + 1] = (128 * i + 1 <= tqr) ? v.y : 0u; sk[4 * i + 2] = (128 * i + 2 <= tqr) ? v.z : 0u; sk[4 * i + 3] = (128 * i + 3 <= tqr) ? v.w : 0u; }
            unsigned T = 0u; bool exact = false;
            for (int bit = 31; bit >= 0; --bit) {
                const unsigned cand = T | (1u << bit);
                unsigned c = 0u;
#pragma unroll
                for (int i = 0; i < 64; ++i) cnt_ge(c, sk[i], cand);
                c = half_sum_u(c);
                if (!exact) { if (c >= (unsigned)TOPK) T = cand; if (c == (unsigned)TOPK) exact = true; }
                if (__all(exact)) break;
            }
            unsigned cut = 0x7fffffffu;
            if (__any(!exact)) {
                unsigned cg = 0u, ce = 0u;
                for (int i = 0; i < 16; ++i) { const v4u v = *(const LAS v4u*)(skl + 128 * i + r4); const int i0 = 128 * i + r4;
#pragma unroll
                    for (int e = 0; e < 4; ++e) { const unsigned k = (i0 + e <= tq) ? v[e] : 0u; cg += (k > T) ? 1u : 0u; ce += (k == T) ? 1u : 0u; } }
                cg = half_sum_u(cg); ce = half_sum_u(ce);
                const unsigned need = (unsigned)TOPK - cg;
                const bool tie = !exact && ce > need;
                unsigned I = 0u;
                for (int bit = 11; bit >= 0; --bit) {
                    const unsigned cand = I | (1u << bit);
                    unsigned c = 0u;
                    for (int i = 0; i < 16; ++i) { const v4u v = *(const LAS v4u*)(skl + 128 * i + r4); const int i0 = 128 * i + r4;
#pragma unroll
                        for (int e = 0; e < 4; ++e) { const unsigned k = (i0 + e <= tq) ? v[e] : 0u; c += (k == T && (unsigned)(i0 + e) < cand) ? 1u : 0u; } }
                    c = half_sum_u(c);
                    if (c < need) I = cand;
                }
                if (tie) cut = I;
            }
            int cutr = (int)cut - r4; asm volatile("" : "+v"(cutr));
#pragma unroll
            for (int i = 0; i < 16; ++i) {
                unsigned nib = 0u;
#pragma unroll
                for (int e = 0; e < 4; ++e) { const unsigned k = sk[4 * i + e]; const bool sel = k != 0u && (k > T || (k == T && (128 * i + e) <= cutr)); nib |= sel ? (1u << e) : 0u; }
                if (nib) __hip_atomic_fetch_or((LAS unsigned*)&mask[(q0 + hh) * 64 + 4 * i + (r >> 3)], nib << (4 * (r & 7)), __ATOMIC_RELAXED, __HIP_MEMORY_SCOPE_WORKGROUP);
            }
        }
    }
    gbar(gb, F.lane);
    attn4<true>(F, gw, row0, nkt, 64, WSP(bf16, WS_QB), WSP(bf16, WS_KB) + (size_t)b * SEQ * 512, WSP(bf16, WS_VT) + (size_t)b * 512 * SEQ, C_GA, 1024);
    gbar(gb, F.lane);
}
__device__ __forceinline__ void group_queue(Frame& F, GBar& gb, int gw) {
    unsigned* qctr = (unsigned*)(F.ws + WS_CTL) + 8192;
    volatile LAS int* slot = (volatile LAS int*)(F.lds + G4_SLOT_OFF);
    for (int n = 0;; ++n) {
        if (gw == 0 && F.lane == 0) slot[n & 1] = (int)__hip_atomic_fetch_add(qctr, 1u, __ATOMIC_RELAXED, __HIP_MEMORY_SCOPE_AGENT);
        gbar(gb, F.lane);
        const int it = slot[n & 1];
        if (it >= 512) break;
        Frame Fi = F; asm volatile("" : "+v"(Fi.lane), "+v"(Fi.tid));
        if (it < 256) dsa4_item(Fi, gb, gw, it & 3, 63 - (it >> 2));
        else { const int j = it - 256, b = j >> 6, qt = j & 63;
            attn4<false>(Fi, gw, b * SEQ + qt * 32, 8, 8, WSP(bf16, WS_QMB), WSP(bf16, WS_MKB) + (size_t)b * MEMT * 512, WSP(bf16, WS_MVT) + (size_t)b * 512 * MEMT, C_GM, 1536); }
    }
}
__device__ __forceinline__ bool overlap_mode(const Frame& F) { return F.G >= 64; }
__device__ __forceinline__ void p3_overlap(Frame& F) {
    volatile LAS unsigned* ctl = (volatile LAS unsigned*)(F.lds + G4_SLOT_OFF);
    const unsigned c_scan = ctl[4], c_att = ctl[8];
    __syncthreads();
    if (F.wave < 4) {
        GBar gb{ctl + 4, c_scan};
        for (int it0 = F.bid; it0 < 256; it0 += F.G) { const int it = (F.G == 256) ? ((it0 & 7) * 32 + (it0 >> 3)) : it0;
            const int bh = it >> 2, rg = it & 3, b = bh >> 4, h = bh & 15;
            scan4_item(F, gb, b, h, rg, F.out + O_WKVP + (size_t)bh * 4096, WSP(float, WS_Y) + (size_t)(b * SEQ) * RW + h * 64);
            asm volatile("s_waitcnt vmcnt(0)" ::: "memory"); gbar(gb, F.lane); }
    } else {
        GBar gb{ctl + 8, c_att};
        const int gw = F.wave - 4;
        const int gwi = F.bid * 4 + gw, NGW = F.G * 4;
        for (int it = gwi; it < DB * RH * 16; it += NGW) scan_sample_witem(F, it);
        for (int it = gwi; it < DB * NPAGES + DB; it += NGW) d1_sample_item(F, it);
        group_queue(F, gb, gw);
    }
    __syncthreads();
}
__device__ __forceinline__ void p8_phase(Frame& F) {
    const int gw = F.bid * NWAVES + F.wave, NGW = F.G * NWAVES;
    for (int row = gw; row < NTOK; row += NGW) {
        float* y = F.out + (row < NTOKP ? O_YP + (size_t)row * DM : O_YS + (size_t)(row - NTOKP) * DM);
        f32x4* xr = (f32x4*)y + F.lane; const f32x4* wr = (const f32x4*)F.in[I_FNW] + F.lane;
        f32x4 v[8]; float s = 0.f;
#pragma unroll
        for (int j = 0; j < 8; ++j) { v[j] = xr[64 * j]; s += (v[j].x * v[j].x + v[j].y * v[j].y) + (v[j].z * v[j].z + v[j].w * v[j].w); }
        const float rs = 1.f / sqrtf(wave_sum(s) * (1.f / DM) + RMS_EPS);
#pragma unroll
        for (int j = 0; j < 8; ++j) { const f32x4 ww = wr[64 * j]; xr[64 * j] = (f32x4){v[j].x * rs * ww.x, v[j].y * rs * ww.y, v[j].z * rs * ww.z, v[j].w * rs * ww.w}; }
    }
}

constexpr int N_PHASES = 9;
struct Args { const void* in[N_IN]; float* out; unsigned char* ws; int ph_lo, ph_hi; };
__global__ void __launch_bounds__(NTHR, 2) hymba_fwd(Args args) {
    extern __shared__ __attribute__((aligned(16))) unsigned char lds[];
    Frame F;
    F.lds = (LAS unsigned char*)lds;
    F.tid = threadIdx.x; F.lane = F.tid & 63; F.wave = __builtin_amdgcn_readfirstlane(F.tid >> 6);
    F.G = gridDim.x; F.bid = blockIdx.x;
#pragma unroll
    for (int i = 0; i < N_IN; ++i) F.in[i] = (const float*)args.in[i];
    F.out = args.out; F.ws = args.ws;
    for (int u = F.tid; u < (LDS_BYTES - LDSCTL_OFF) / 4; u += NTHR) ((LAS unsigned*)(F.lds + LDSCTL_OFF))[u] = 0u;
    __syncthreads();
#if MK_SPLIT
#define GRID_BAR() do { } while (0)
#else
    XcdBarrier bar = xcd_barrier_post((unsigned*)(F.ws + WS_CTL) + CW_BAR, (volatile LAS unsigned*)(F.lds + MISC_OFF) + 8);
#define GRID_BAR() xcd_barrier(bar)
#endif
    const int lo = args.ph_lo, hi = args.ph_hi;
#ifndef PH_MASK
#define PH_MASK 0x1FF
#endif
#define IN(k) (((PH_MASK >> (k)) & 1) && lo <= (k) && (k) < hi)
#define BOTH(k) (IN(k) && IN((k) + 1))

#define RUNPH(k, ...) do { if (IN(k)) { __VA_ARGS__; if (PROBE_REPEAT == (k)) { GRID_BAR(); __VA_ARGS__; } if (BOTH(k)) GRID_BAR(); } } while (0)
    RUNPH(0, p0_prologue(F));
    RUNPH(1, {
        { pg8::Gemm g{WSP(bf16, WS_XN), WSP(bf16, WS_WINT), MPAD, INWP, DM, DM}; pg8::StaticOrder S; S.init(MPAD, INWP, F.G, F.bid);
          EpiProj E{WSP(float, WS_PROJ)};
          pg8::gemm_phase<EpiProj, pg8::StaticOrder, true, true>(F.lds + RING_OFF, g, S, E); }
        { pg8::Gemm g{WSP(bf16, WS_XM), WSP(bf16, WS_WMEMT), 1024, 1024, DM, DM}; pg8::StaticOrder S; S.init(1024, 1024, F.G, F.G - 1 - F.bid);
          EpiMem E{F.out};
          pg8::gemm_phase<EpiMem, pg8::StaticOrder, true, true>(F.lds + RING_OFF, g, S, E); }
    });
    RUNPH(2, p2_phase(F));
    if (F.G >= 64) { RUNPH(3, p3_overlap(F)); } else { RUNPH(3, p3_scan_phase(F)); }
    RUNPH(4, p4_phase(F));
    if (F.G < 64) { RUNPH(5, p5_phase(F)); }
    RUNPH(6, p6_phase(F));
    RUNPH(7, {
        { pg8::Gemm g{WSP(bf16, WS_YMIX), WSP(bf16, WS_WOUTT), NTOKP, DM, DM, DM}; pg8::StaticOrder S; S.init(NTOKP, DM, F.G, F.bid);
          EpiOut E{F.in[I_XP], F.in[I_XS], F.out};
          pg8::gemm_phase<EpiOut, pg8::StaticOrder, true, true>(F.lds + RING_OFF, g, S, E); }
        { pg8::Gemm g{WSP(bf16, WS_YMIX), WSP(bf16, WS_WOUTT), MPAD, DM, 256, DM}; pg8::ListOrder S{F.G, F.bid, 2};
          EpiOutAtomic E{F.out};
          pg8::gemm_phase<EpiOutAtomic, pg8::ListOrder, true, true>(F.lds + RING_OFF, g, S, E); }
    });
    if (IN(8)) { p8_phase(F); }
#undef IN
#undef BOTH
}

extern "C" void kernel_launch(void* const* d_in, const int* in_sizes, int n_in, void* d_out, int out_size, void* d_ws, size_t ws_size, hipStream_t stream) {
    static int grid = 0;
    if (grid == 0) {
        if (n_in != N_IN || out_size != (int)O_END || ws_size < WS_END) { fprintf(stderr, "kernel_launch: unexpected shapes: n_in %d out %d ws %zu (need %zu)\n", n_in, out_size, ws_size, (size_t)WS_END); grid = -1; return; }
        int dev = 0, cus = 0, per_cu = 0;
        if (hipGetDevice(&dev) != hipSuccess || hipDeviceGetAttribute(&cus, hipDeviceAttributeMultiprocessorCount, dev) != hipSuccess) { grid = -1; return; }
        if (hipFuncSetAttribute((const void*)hymba_fwd, hipFuncAttributeMaxDynamicSharedMemorySize, LDS_BYTES) != hipSuccess) { fprintf(stderr, "kernel_launch: hipFuncSetAttribute failed\n"); grid = -1; return; }
        if (hipOccupancyMaxActiveBlocksPerMultiprocessor(&per_cu, (const void*)hymba_fwd, NTHR, LDS_BYTES) != hipSuccess || per_cu < 1) { fprintf(stderr, "kernel_launch: occupancy query says %d\n", per_cu); }
        (void)hipGetLastError();
        grid = cus;
    }
    if (grid < 0) return;
    if (hipMemsetAsync((char*)d_ws + WS_CTL, 0, CTL_ZERO_BYTES, stream) != hipSuccess) { fprintf(stderr, "kernel_launch: memset failed\n"); return; }
    Args a{};
    for (int i = 0; i < N_IN; ++i) a.in[i] = d_in[i];
    a.out = (float*)d_out; a.ws = (unsigned char*)d_ws;
#if MK_SPLIT
    for (int p = 0; p < N_PHASES; ++p) { a.ph_lo = p; a.ph_hi = p + 1; hipLaunchKernelGGL(hymba_fwd, dim3(grid), dim3(NTHR), LDS_BYTES, stream, a); }
#else
    a.ph_lo = 0; a.ph_hi = N_PHASES;
    hipLaunchKernelGGL(hymba_fwd, dim3(grid), dim3(NTHR), LDS_BYTES, stream, a);
#endif
    const hipError_t le = hipPeekAtLastError();
    if (le != hipSuccess) fprintf(stderr, "kernel_launch: launch failed: %s\n", hipGetErrorName(le));
}
```

```cpp
#include <hip/hip_runtime.h>
#include <cstdio>
#include <cstdint>

#ifndef MK_SPLIT
#define MK_SPLIT 0
#endif

namespace pg8 {
#define PG8_LAS __attribute__((address_space(3)))
typedef unsigned short bf16_t;
typedef short bf16x8 __attribute__((ext_vector_type(8)));
typedef float f32x4 __attribute__((ext_vector_type(4)));
typedef unsigned u32x4 __attribute__((ext_vector_type(4)));
constexpr int BM = 256, BK = 64, HALF = 128, HTB = HALF * BK * 2, STAGE_BYTES = 8 * HTB, NXCD = 8, WGM = 8;

__host__ __device__ __forceinline__ int lds_byte(int r, int c) { const int st = (r >> 4) * 2 + (c >> 5), rr = r & 15, cc = c & 31, ob = rr * 64 + cc * 2; return st * 1024 + (ob ^ (((ob >> 9) & 1) << 5)); }
__host__ __device__ __forceinline__ void stage_rc(int b, int& R, int& C) { const int st = b / 1024, sb = b % 1024, swz = sb ^ (((sb >> 9) & 1) << 5); R = (st >> 1) * 16 + swz / 64; C = (st & 1) * 32 + (swz % 64) / 2; }

struct Unit { int pm, pn, koff; };
struct Gemm { const bf16_t* A; const bf16_t* Bt; int M, N, K, ld; };

struct StaticOrder {
    int nM, nN, nwg, G, c;
    __host__ __device__ void init(int M, int N, int G_, int c_) { nM = M / BM; nN = N / BM; nwg = nM * nN; G = G_; c = c_; }
    __host__ __device__ bool next(int i, Unit& u) const {
        const long L = (long)i * G + c; if (L >= nwg) return false;
        int wgid = (int)L; { const int q = nwg / NXCD, r = nwg % NXCD, xcd = wgid % NXCD, off = wgid / NXCD; wgid = (xcd < r ? xcd * (q + 1) : r * (q + 1) + (xcd - r) * q) + off; }
        const int nig = WGM * nN, gid = wgid / nig, fm = gid * WGM, gsz = (nM - fm) < WGM ? (nM - fm) : WGM;
        u.pm = fm + ((wgid % nig) % gsz); u.pn = (wgid % nig) / gsz; u.koff = 0; return true;
    }
    __device__ __forceinline__ void a_ready(const Unit&) const {}
    __device__ __forceinline__ void done(const Unit&) const {}
};

struct ListOrder {
    int G, c, mode;
    __device__ __forceinline__ bool next(int i, Unit& u) const {
        const int L = i * G + c;
        if (mode == 0) { if (L >= 260) return false; const int q = L & 3, uu = L >> 2; if (uu < 33) { u.pm = 32; u.pn = uu; } else { u.pm = uu - 33; u.pn = 32; } u.koff = q * 512; return true; }
        if (mode == 1) { if (L >= 64) return false; const int q = L & 3, uu = L >> 2; u.pm = uu >> 2; u.pn = uu & 3; u.koff = q * 512; return true; }
        if (L >= 64) return false; u.pm = 32; u.pn = L >> 3; u.koff = (L & 7) * 256; return true;
    }
    __device__ __forceinline__ void a_ready(const Unit&) const {}
    __device__ __forceinline__ void done(const Unit&) const {}
};
template <class Epi, class Sched, bool ALIGN_EPI = false, bool SP2 = false>
__device__ __forceinline__ void gemm_phase(PG8_LAS unsigned char* lds, const Gemm g, const Sched& S, const Epi& E) {
    const int tid = threadIdx.x, wid = __builtin_amdgcn_readfirstlane(tid >> 6), lane = tid & 63, wr = wid >> 2, wc = wid & 3, fr = lane & 15, fq = lane >> 4;
    const int K = g.K, nt = K / BK;
    unsigned voffA[2], voffB[2];
    const int ld = g.ld;
#pragma unroll
    for (int i = 0; i < 2; ++i) { int R, C; stage_rc(tid * 16 + i * 8192, R, C); voffA[i] = (unsigned)(R * ld + C) * 2u; voffB[i] = (unsigned)(R * ld + C) * 2u; }
    const size_t kstep = (size_t)(BK * 2);
    const size_t hstep = (size_t)HALF * ld * 2;
    const size_t tstep = 2 * hstep;
    const unsigned ldsw = (unsigned)wid * 1024u;
    const int aoff = lds_byte(wr * 64 + fr, fq * 8), boff = lds_byte(wc * 32 + fr, fq * 8);
#define PG8_SA(b, h) (((b) * 2 + (h)) * HTB)
#define PG8_SB(b, h) ((4 + (b) * 2 + (h)) * HTB)
#define PG8_STAGE(bufoff, gbase, voff) do { _Pragma("unroll") for (int _i = 0; _i < 2; ++_i) \
        __builtin_amdgcn_global_load_lds((const unsigned*)((const char*)(gbase) + (voff)[_i]), (PG8_LAS unsigned*)(lds + (bufoff) + ldsw + _i * 8192), 16, 0, 0); } while (0)
#define PG8_LDA(dst, b, h) do { _Pragma("unroll") for (int m = 0; m < 4; ++m) _Pragma("unroll") for (int k = 0; k < 2; ++k) dst[m][k] = *(const PG8_LAS bf16x8*)(lds + PG8_SA(b, h) + aoff + m * 2048 + k * 1024); } while (0)
#define PG8_LDB(dst, b, h) do { _Pragma("unroll") for (int n = 0; n < 2; ++n) _Pragma("unroll") for (int k = 0; k < 2; ++k) dst[n][k] = *(const PG8_LAS bf16x8*)(lds + PG8_SB(b, h) + boff + n * 2048 + k * 1024); } while (0)
#define PG8_MMA(ai, bj, At, Bt) do { __builtin_amdgcn_s_setprio(1); _Pragma("unroll") for (int m = 0; m < 4; ++m) _Pragma("unroll") for (int n = 0; n < 2; ++n) _Pragma("unroll") for (int k = 0; k < 2; ++k) \
        acc[ai][bj][m][n] = __builtin_amdgcn_mfma_f32_16x16x32_bf16(Bt[n][k], At[m][k], acc[ai][bj][m][n], 0, 0, 0); __builtin_amdgcn_s_setprio(0); } while (0)
#define PG8_WAIT_V(n) asm volatile("s_waitcnt vmcnt(" #n ")" ::: "memory")
#define PG8_WAIT_L(n) asm volatile("s_waitcnt lgkmcnt(" #n ")" ::: "memory")
#define PG8_BAR __builtin_amdgcn_s_barrier()
#define PG8_SCHED __builtin_amdgcn_sched_barrier(0)
    Unit cur, nxt; int ui = 0;
    if (!S.next(0, cur)) return;
    f32x4 acc[2][2][4][2];
#pragma unroll
    for (int a = 0; a < 2; ++a)
#pragma unroll
        for (int b = 0; b < 2; ++b)
#pragma unroll
            for (int m = 0; m < 4; ++m)
#pragma unroll
                for (int n = 0; n < 2; ++n) acc[a][b][m][n] = (f32x4){0.f, 0.f, 0.f, 0.f};
    bf16x8 At[4][2], B0[2][2], B1[2][2];
    const char* cA = (const char*)g.A + (size_t)cur.pm * tstep + (size_t)cur.koff * 2; const char* cB = (const char*)g.Bt + (size_t)cur.pn * tstep + (size_t)cur.koff * 2;
    S.a_ready(cur);
    if constexpr (SP2) {
        PG8_STAGE(PG8_SB(0, 0), cB, voffB); PG8_STAGE(PG8_SB(0, 1), cB + hstep, voffB); PG8_STAGE(PG8_SA(0, 0), cA, voffA); PG8_STAGE(PG8_SA(0, 1), cA + hstep, voffA);
        if (wr == 1) PG8_BAR;
        PG8_WAIT_V(2); PG8_BAR;
        PG8_STAGE(PG8_SB(1, 0), cB + kstep, voffB); PG8_STAGE(PG8_SA(1, 0), cA + kstep, voffA); PG8_STAGE(PG8_SB(1, 1), cB + hstep + kstep, voffB);
        PG8_WAIT_V(6); PG8_BAR;
    } else {
        PG8_STAGE(PG8_SB(0, 0), cB, voffB); PG8_STAGE(PG8_SA(0, 0), cA, voffA); PG8_STAGE(PG8_SB(0, 1), cB + hstep, voffB); PG8_STAGE(PG8_SA(0, 1), cA + hstep, voffA);
        if (wr == 1) PG8_BAR;
        PG8_WAIT_V(4); PG8_BAR;
        PG8_STAGE(PG8_SB(1, 0), cB + kstep, voffB); PG8_STAGE(PG8_SA(1, 0), cA + kstep, voffA); PG8_STAGE(PG8_SB(1, 1), cB + hstep + kstep, voffB);
        PG8_WAIT_V(6); PG8_BAR;
    }
    for (;;) {
        const bool has_next = S.next(ui + 1, nxt);
        const char* nA = has_next ? (const char*)g.A + (size_t)nxt.pm * tstep + (size_t)nxt.koff * 2 : cA; const char* nB = has_next ? (const char*)g.Bt + (size_t)nxt.pn * tstep + (size_t)nxt.koff * 2 : cB;
        for (int t = 0; t < nt; t += 2) {
            const bool last = (t == nt - 2);
            const char* a1 = cA + (size_t)(t + 1) * kstep;
            const char* a2 = last ? nA : cA + (size_t)(t + 2) * kstep; const char* b2 = last ? nB : cB + (size_t)(t + 2) * kstep;
            const char* a3 = a2 + kstep; const char* b3 = b2 + kstep;
            if (last && has_next) S.a_ready(nxt);
            if constexpr (SP2) {
            PG8_LDB(B0, 0, 0); PG8_LDB(B1, 0, 1); PG8_SCHED; PG8_LDA(At, 0, 0); PG8_STAGE(PG8_SA(1, 1), a1 + hstep, voffA);
            PG8_WAIT_V(8); PG8_WAIT_L(0); PG8_BAR; PG8_MMA(0, 0, At, B0); PG8_MMA(0, 1, At, B1); PG8_BAR; PG8_SCHED;
            PG8_LDA(At, 0, 1); PG8_STAGE(PG8_SB(0, 0), b2, voffB); PG8_STAGE(PG8_SB(0, 1), b2 + hstep, voffB); PG8_STAGE(PG8_SA(0, 0), a2, voffA);
            PG8_WAIT_V(8); PG8_WAIT_L(0); PG8_BAR; PG8_MMA(1, 0, At, B0); PG8_MMA(1, 1, At, B1); PG8_BAR; PG8_SCHED;
            PG8_LDB(B0, 1, 0); PG8_LDB(B1, 1, 1); PG8_SCHED; PG8_LDA(At, 1, 0); PG8_STAGE(PG8_SA(0, 1), a2 + hstep, voffA);
            PG8_WAIT_V(8); PG8_WAIT_L(0); PG8_BAR; PG8_MMA(0, 0, At, B0); PG8_MMA(0, 1, At, B1); PG8_BAR; PG8_SCHED;
            PG8_LDA(At, 1, 1); PG8_STAGE(PG8_SB(1, 0), b3, voffB); PG8_STAGE(PG8_SB(1, 1), b3 + hstep, voffB); PG8_STAGE(PG8_SA(1, 0), a3, voffA);
            PG8_WAIT_V(8); PG8_WAIT_L(0); PG8_BAR; PG8_MMA(1, 0, At, B0); PG8_MMA(1, 1, At, B1); PG8_BAR; PG8_SCHED;
            } else {
            PG8_LDB(B0, 0, 0); PG8_SCHED; PG8_LDA(At, 0, 0); PG8_STAGE(PG8_SA(1, 1), a1 + hstep, voffA);
            PG8_WAIT_L(8); PG8_BAR; PG8_WAIT_L(0); PG8_MMA(0, 0, At, B0); PG8_BAR; PG8_SCHED;
            PG8_LDB(B1, 0, 1); PG8_STAGE(PG8_SB(0, 0), b2, voffB);
            PG8_BAR; PG8_WAIT_L(0); PG8_MMA(0, 1, At, B1); PG8_BAR;
            PG8_LDA(At, 0, 1); PG8_STAGE(PG8_SA(0, 0), a2, voffA);
            PG8_BAR; PG8_WAIT_L(0); PG8_MMA(1, 0, At, B0); PG8_BAR; PG8_SCHED;
            PG8_STAGE(PG8_SB(0, 1), b2 + hstep, voffB);
            PG8_WAIT_V(6); PG8_BAR; PG8_MMA(1, 1, At, B1); PG8_BAR;
            PG8_LDB(B0, 1, 0); PG8_SCHED; PG8_LDA(At, 1, 0); PG8_STAGE(PG8_SA(0, 1), a2 + hstep, voffA);
            PG8_WAIT_L(8); PG8_BAR; PG8_WAIT_L(0); PG8_MMA(0, 0, At, B0); PG8_BAR; PG8_SCHED;
            PG8_LDB(B1, 1, 1); PG8_STAGE(PG8_SB(1, 0), b3, voffB);
            PG8_BAR; PG8_WAIT_L(0); PG8_MMA(0, 1, At, B1); PG8_BAR;
            PG8_LDA(At, 1, 1); PG8_STAGE(PG8_SA(1, 0), a3, voffA);
            PG8_BAR; PG8_WAIT_L(0); PG8_MMA(1, 0, At, B0); PG8_BAR; PG8_SCHED;
            PG8_STAGE(PG8_SB(1, 1), b3 + hstep, voffB);
            PG8_WAIT_V(6); PG8_BAR; PG8_MMA(1, 1, At, B1); PG8_BAR;
            }
        }
        if constexpr (ALIGN_EPI) { if (wr == 0) PG8_BAR; }
        E(acc, cur, wr, wc, fr, fq); S.done(cur);
        if (!has_next) break;
#pragma unroll
        for (int a = 0; a < 2; ++a)
#pragma unroll
            for (int b = 0; b < 2; ++b)
#pragma unroll
                for (int m = 0; m < 4; ++m)
#pragma unroll
                    for (int n = 0; n < 2; ++n) acc[a][b][m][n] = (f32x4){0.f, 0.f, 0.f, 0.f};
        cur = nxt; cA = nA; cB = nB; ++ui;
        if constexpr (ALIGN_EPI) { if (wr == 1) PG8_BAR; }
    }
    PG8_WAIT_V(0);
    if constexpr (!ALIGN_EPI) { if (wr == 0) PG8_BAR; }
    PG8_BAR;
#undef PG8_SA
#undef PG8_SB
#undef PG8_STAGE
#undef PG8_LDA
#undef PG8_LDB
#undef PG8_MMA
#undef PG8_WAIT_V
#undef PG8_WAIT_L
#undef PG8_BAR
#undef PG8_SCHED
}
}

constexpr int NWAVES = 8, NTHR = 512;
constexpr int DM = 2048, NB = 4, SEQ = 2048, DB = 32, DT = 4, PAST = 8192, PAGE = 128, NPAGES = 64;
constexpr int NTOKP = NB * SEQ;
constexpr int NTOKS = DB * DT;
constexpr int NTOK = NTOKP + NTOKS;
constexpr int MPAD = 8448;
constexpr int INW = 8400, INWP = 8448;
constexpr int RW = 1024, RH = 16, RD = 64, SHW = 3200;
constexpr int C_R = 0, C_K = 1024, C_V = 2048, C_CW = 3072, C_CA = 3136, C_GR = 3200, C_Q = 4224, C_AK = 4736, C_AV = 5248, C_GA = 5760, C_QI = 6272, C_QM = 7296, C_GM = 7808, C_KI = 8320, C_WI = 8384;
constexpr int MEMT = 256;
constexpr int TOPK = 256;
constexpr int SCS_LD = 8256;
constexpr float RMS_EPS = 1e-6f, GN_EPS = 64e-5f;
constexpr float QSCALE = 0.08838834764831845f * 1.4426950408889634f;
constexpr size_t O_YP = 0, O_YS = 16777216, O_WKVP = 17039360, O_SHP = 17301504, O_KP = 17314304, O_VP = 21508608, O_KIP = 25702912, O_MKP = 26227200, O_MVP = 26751488,
                 O_WKVS = 27275776, O_SHS = 29372928, O_KS = 29475328, O_VS = 29540864, O_KIS = 29606400, O_END = 29614592;
enum { I_XP = 0, I_XS, I_SWKV, I_SSH, I_CK, I_CV, I_CKI, I_CMK, I_CMV, I_PT, I_MEM, I_NW, I_WIN, I_MU, I_W0, I_W2, I_A0, I_A2, I_KK, I_KA, I_RK, I_GNW, I_GNB, I_MNW, I_WMEM, I_WOUT, I_FNW, N_IN };

constexpr size_t MiB = 1u << 20;
constexpr size_t al1m(size_t x) { return (x + MiB - 1) / MiB * MiB; }
constexpr size_t WS_CTL = 0, CTL_ZERO_BYTES = 1 * MiB;
constexpr size_t WS_WINT = 1 * MiB;
constexpr size_t WS_WOUTT = WS_WINT + al1m((size_t)INWP * DM * 2);
constexpr size_t WS_WMEMT = WS_WOUTT + al1m((size_t)DM * DM * 2);
constexpr size_t WS_W2T = WS_WMEMT + al1m((size_t)1024 * DM * 2);
constexpr size_t WS_A2T = WS_W2T + al1m((size_t)1024 * 64 * 2);
constexpr size_t WS_ROPE128 = WS_A2T + al1m((size_t)1024 * 64 * 2);
constexpr size_t WS_ROPE64 = WS_ROPE128 + al1m((size_t)2052 * 64 * 8);
constexpr size_t WS_XN = WS_ROPE64 + al1m((size_t)2052 * 32 * 8);
constexpr size_t WS_XM = WS_XN + al1m((size_t)MPAD * DM * 2);
constexpr size_t WS_PROJ = WS_XM + al1m((size_t)1024 * DM * 2);
constexpr size_t WS_SCANIN = WS_PROJ + al1m((size_t)MPAD * INWP * 4);
constexpr size_t WS_SCAL = WS_SCANIN + al1m((size_t)NTOK * RH * 384 * 4);
constexpr size_t WS_Y = WS_SCAL + al1m((size_t)NTOK * RH * 16 * 4 + 65536);
constexpr size_t WS_QB = WS_Y + al1m((size_t)NTOK * RW * 4);
constexpr size_t WS_KB = WS_QB + al1m((size_t)NTOK * 512 * 2);
constexpr size_t WS_VT = WS_KB + al1m((size_t)NTOK * 512 * 2);
constexpr size_t WS_QIB = WS_VT + al1m((size_t)NB * 4 * 128 * SEQ * 2);
constexpr size_t WS_KIB = WS_QIB + al1m((size_t)NTOK * 1024 * 2);
constexpr size_t WS_WIS = WS_KIB + al1m((size_t)NTOK * 64 * 2);
constexpr size_t WS_QMB = WS_WIS + al1m((size_t)NTOK * 16 * 4);
constexpr size_t WS_MKB = WS_QMB + al1m((size_t)NTOK * 512 * 2);
constexpr size_t WS_MVT = WS_MKB + al1m((size_t)1024 * 512 * 2);
constexpr size_t WS_SC = WS_MVT + al1m((size_t)1024 * 512 * 2);
constexpr size_t WS_SCS = WS_SC + al1m((size_t)NTOKP * SEQ * 4);
constexpr size_t WS_THR = WS_SCS + al1m((size_t)NTOKS * SCS_LD * 4);
constexpr size_t WS_IDX = WS_THR + al1m((size_t)NTOK * 8);
constexpr size_t WS_YMIX = WS_IDX + al1m((size_t)NTOKS * TOPK * 4);
constexpr size_t WS_END = WS_YMIX + al1m((size_t)MPAD * DM * 2);
constexpr int CW_BAR = 4096;

constexpr int RING_OFF = 0, RING_BYTES = 131072;
constexpr int LDSCTL_OFF = 159744, MISC_OFF = LDSCTL_OFF + 320;
constexpr int LDS_BYTES = 163840;

#define GAS __attribute__((address_space(1)))
#define LAS __attribute__((address_space(3)))
typedef unsigned short bf16;
typedef unsigned v4u __attribute__((ext_vector_type(4)));
typedef unsigned v2u __attribute__((ext_vector_type(2)));
typedef float f32x4 __attribute__((ext_vector_type(4)));
typedef float f32x2 __attribute__((ext_vector_type(2)));
typedef float f32x16 __attribute__((ext_vector_type(16)));
typedef short bf16x8 __attribute__((ext_vector_type(8)));
typedef short bf16x4 __attribute__((ext_vector_type(4)));
#define LDS_WAIT() asm volatile("s_waitcnt lgkmcnt(0)" ::: "memory")
#define VM_WAIT() asm volatile("s_waitcnt vmcnt(0)" ::: "memory")
__device__ __forceinline__ unsigned cvt_pk_bf16(float lo, float hi) { unsigned r; asm volatile("v_cvt_pk_bf16_f32 %0, %1, %2" : "=v"(r) : "v"(lo), "v"(hi)); return r; }
__device__ __forceinline__ float bf2f(unsigned short b) { return __uint_as_float(((unsigned)b) << 16); }
template <int CTRL> __device__ __forceinline__ float dpp(float x) { return __builtin_bit_cast(float, __builtin_amdgcn_mov_dpp(__builtin_bit_cast(int, x), CTRL, 0xf, 0xf, true)); }
__device__ __forceinline__ float row16_sum(float x) {
    x += dpp<0xB1>(x); x += dpp<0x4E>(x); x += dpp<0x141>(x); x += dpp<0x140>(x); return x;
}
__device__ __forceinline__ float wave_sum(float v) {
#pragma unroll
    for (int o = 1; o < 64; o <<= 1) v += __shfl_xor(v, o);
    return v;
}
__device__ __forceinline__ float xhalf_max(float x) { auto rr = __builtin_amdgcn_permlane32_swap(__float_as_uint(x), __float_as_uint(x), false, false); return fmaxf(__uint_as_float(rr[0]), __uint_as_float(rr[1])); }
__device__ __forceinline__ float xhalf_sum(float x) { auto rr = __builtin_amdgcn_permlane32_swap(__float_as_uint(x), __float_as_uint(x), false, false); return __uint_as_float(rr[0]) + __uint_as_float(rr[1]); }
__device__ __forceinline__ unsigned sort_key(float f) { const unsigned u = __float_as_uint(f); return (u & 0x80000000u) ? ~u : (u | 0x80000000u); }
__device__ __forceinline__ float silu(float g) { return g / (1.f + __expf(-g)); }

#define XB_TMO      128
#define XB_XCNT(j)  (256  + 64 * (j))
#define XB_XSUB(j)  (1280 + 64 * (j))
#define XB_XGEN(j)  (2304 + 64 * (j))
#define XB_TOP      3328
#define XB_TOPGEN   3392
#define XCD_BAR_WORDS 3456
#define XB_SPIN_CAP (1u << 18)
__device__ __forceinline__ unsigned xb_ld(unsigned* p)              { return __hip_atomic_load(p, __ATOMIC_RELAXED, __HIP_MEMORY_SCOPE_AGENT); }
__device__ __forceinline__ unsigned xb_add(unsigned* p, unsigned v) { return __hip_atomic_fetch_add(p, v, __ATOMIC_RELAXED, __HIP_MEMORY_SCOPE_AGENT); }
__device__ __forceinline__ unsigned xb_xcc_id() { return (unsigned)__builtin_amdgcn_s_getreg((3 << 11) | 20) & 0xFu; }
#define XB_SPIN(cond, bar) do { unsigned _sp = 0; while (cond) { __builtin_amdgcn_s_sleep(1); \
    if ((++_sp & 255u) == 0u) { if (xb_ld(&(bar)[XB_TMO])) break; if (_sp > XB_SPIN_CAP) { atomicAdd(&(bar)[XB_TMO], 1u); break; } } } } while (0)
struct XcdBarrier { unsigned* bar; unsigned x; volatile LAS unsigned* st; };
__device__ __forceinline__ XcdBarrier xcd_barrier_post(unsigned* bar, volatile LAS unsigned* st) {
    XcdBarrier b; b.bar = bar; b.x = xb_xcc_id(); b.st = st;
    if (threadIdx.x == 0) (void)xb_add(&bar[XB_XCNT(b.x)], 1u);
    return b;
}
__device__ __forceinline__ void xcd_barrier_complete(unsigned* bar, unsigned x, unsigned& nloc, unsigned& nx) {
    const unsigned G = gridDim.x * gridDim.y * gridDim.z;
    unsigned sum, cnt, mine, sp = 0u;
    for (;;) {
        sum = 0u; cnt = 0u; mine = 0u;
#pragma unroll
        for (unsigned j = 0; j < 16; ++j) { const unsigned c = xb_ld(&bar[XB_XCNT(j)]); sum += c; cnt += (c > 0u) ? 1u : 0u; mine = (j == x) ? c : mine; }
        if (sum == G) break;
        __builtin_amdgcn_s_sleep(1);
        if ((++sp & 255u) == 0u) { if (xb_ld(&bar[XB_TMO])) break; if (sp > XB_SPIN_CAP) { atomicAdd(&bar[XB_TMO], 1u); break; } }
    }
    nloc = mine > 0u ? mine : 1u; nx = cnt > 0u ? cnt : 1u;
}
__device__ __forceinline__ void xcd_barrier(const XcdBarrier& b) {
    asm volatile("s_waitcnt vmcnt(0)" ::: "memory");
    __syncthreads();
    if (threadIdx.x == 0) {
        unsigned* bar = b.bar;
        __builtin_amdgcn_s_waitcnt(0);
        unsigned nloc = b.st[0], nx = b.st[1];
        if (nloc == 0u) { xcd_barrier_complete(bar, b.x, nloc, nx); b.st[0] = nloc; b.st[1] = nx; }
        const unsigned old = xb_add(&bar[XB_XSUB(b.x)], 1u);
        const unsigned gen = old / nloc;
        if (old + 1u == (gen + 1u) * nloc) {
            __builtin_amdgcn_fence(__ATOMIC_RELEASE, "agent");
            asm volatile("s_waitcnt vmcnt(0)" ::: "memory");
            const unsigned og = xb_add(&bar[XB_TOP], 1u);
            const unsigned tg = og / nx;
            if (og + 1u == (tg + 1u) * nx) xb_add(&bar[XB_TOPGEN], 1u);
            else XB_SPIN(xb_ld(&bar[XB_TOPGEN]) == tg, bar);
            __builtin_amdgcn_fence(__ATOMIC_ACQUIRE, "agent");
            xb_add(&bar[XB_XGEN(b.x)], 1u);
            asm volatile("s_waitcnt vmcnt(0)" ::: "memory");
        } else {
            XB_SPIN(xb_ld(&bar[XB_XGEN(b.x)]) == gen, bar);
            __builtin_amdgcn_fence(__ATOMIC_ACQUIRE, "agent");
            asm volatile("s_waitcnt vmcnt(0)" ::: "memory");
        }
    }
    __syncthreads();
}

struct Frame {
    LAS unsigned char* lds;
    int tid, lane, wave, G, bid;
    const float* in[N_IN];
    float* out;
    unsigned char* ws;
};
#define WSP(T, off) ((T*)(F.ws + (off)))

__device__ __forceinline__ int src_col(int g);
__device__ __forceinline__ void p0_transpose_item(const float* W, int K, int N, int Npad, bf16* WT, LAS float* scr, int item, int lane, bool perm = false) {
    const int nblk = Npad / 32, kb = item / nblk, nb = item % nblk, k0 = 64 * kb, n0 = 32 * nb;
    const int nn = perm ? src_col(n0 + (lane & 31)) : ((n0 + (lane & 31)) < N ? n0 + (lane & 31) : -1);
    float tv[32];
#pragma unroll
    for (int i = 0; i < 32; ++i) { const int kk = 2 * i + (lane >> 5); tv[i] = (nn >= 0) ? W[(size_t)(k0 + kk) * N + nn] : 0.f; }
#pragma unroll
    for (int i = 0; i < 32; ++i) { const int kk = 2 * i + (lane >> 5); scr[kk * 33 + (lane & 31)] = tv[i]; }
    LDS_WAIT(); asm volatile("" ::: "memory");
    const int c = lane & 7;
#pragma unroll
    for (int j = 0; j < 4; ++j) { const int n = (lane >> 3) + 8 * j; const LAS float* s = scr + (8 * c) * 33 + n;
        v4u o; o.x = cvt_pk_bf16(s[0 * 33], s[1 * 33]); o.y = cvt_pk_bf16(s[2 * 33], s[3 * 33]); o.z = cvt_pk_bf16(s[4 * 33], s[5 * 33]); o.w = cvt_pk_bf16(s[6 * 33], s[7 * 33]);
        *(v4u*)(WT + (size_t)(n0 + n) * K + k0 + 8 * c) = o; }
    LDS_WAIT(); asm volatile("" ::: "memory");
}
__device__ __forceinline__ void rms_row_to_bf16(const float* xrow, const float* w, bf16* orow, int lane) {
    const f32x4* xr = (const f32x4*)xrow + lane; const f32x4* wr = (const f32x4*)w + lane;
    f32x4 v[8]; float s = 0.f;
#pragma unroll
    for (int j = 0; j < 8; ++j) { v[j] = xr[64 * j]; s += (v[j].x * v[j].x + v[j].y * v[j].y) + (v[j].z * v[j].z + v[j].w * v[j].w); }
    const float rs = 1.f / sqrtf(wave_sum(s) * (1.f / DM) + RMS_EPS);
    v2u* o8 = (v2u*)orow + lane;
#pragma unroll
    for (int j = 0; j < 8; ++j) { const f32x4 ww = wr[64 * j]; v2u o; o.x = cvt_pk_bf16(v[j].x * rs * ww.x, v[j].y * rs * ww.y); o.y = cvt_pk_bf16(v[j].z * rs * ww.z, v[j].w * rs * ww.w); o8[64 * j] = o; }
}
__device__ __forceinline__ void rope_cs(int pos, int i, double ratio, float& c, float& s) {
    double f = 1.0, b = ratio; int e = i;
    while (e) { if (e & 1) f *= b; b *= b; e >>= 1; }
    const double th = (double)pos * f;
    const double TWO_OVER_PI = 0.63661977236758134308, PIO2_HI = 1.57079632679489655800e+00, PIO2_LO = 6.12323399573676603587e-17;
    const double kq = rint(th * TWO_OVER_PI);
    double r = fma(-kq, PIO2_HI, th); r = fma(-kq, PIO2_LO, r);
    const int q = ((int)kq) & 3;
    const double z = r * r;
    const double sp = r + r * z * (-1.66666666666666324348e-01 + z * (8.33333333332248946124e-03 + z * (-1.98412698298579493134e-04 + z * (2.75573137070700676789e-06 + z * (-2.50507602534068634195e-08 + z * 1.58969099521155010221e-10)))));
    const double cp = 1.0 - 0.5 * z + z * z * (4.16666666666666019037e-02 + z * (-1.38888888888741095749e-03 + z * (2.48015872894767294178e-05 + z * (-2.75573143513906633035e-07 + z * (2.08757232129817482790e-09 + z * -1.13596475577881948265e-11)))));
    double cc, ss;
    if (q == 0) { cc = cp; ss = sp; } else if (q == 1) { cc = -sp; ss = cp; } else if (q == 2) { cc = -cp; ss = -sp; } else { cc = sp; ss = -cp; }
    c = (float)cc; s = (float)ss;
}
__device__ __forceinline__ void p0_prologue(Frame& F) {
    LAS float* scr = (LAS float*)(F.lds + RING_OFF + F.wave * 16384);
    const int gw = F.bid * NWAVES + F.wave, NGW = F.G * NWAVES;
    constexpr int T_IN = (DM / 64) * (INWP / 32), T_OUT = (DM / 64) * (DM / 32), T_MEM = (DM / 64) * (1024 / 32), T_L = 1024 / 32;
    constexpr int NITEMS = T_IN + T_OUT + T_MEM + 2 * T_L;
    for (int it = gw; it < NITEMS; it += NGW) {
        int r = it;
        if (r < T_IN) { p0_transpose_item(F.in[I_WIN], DM, INW, INWP, WSP(bf16, WS_WINT), scr, r, F.lane, true); continue; } r -= T_IN;
        if (r < T_OUT) { p0_transpose_item(F.in[I_WOUT], DM, DM, DM, WSP(bf16, WS_WOUTT), scr, r, F.lane); continue; } r -= T_OUT;
        if (r < T_MEM) { p0_transpose_item(F.in[I_WMEM], DM, 1024, 1024, WSP(bf16, WS_WMEMT), scr, r, F.lane); continue; } r -= T_MEM;
        if (r < T_L) { p0_transpose_item(F.in[I_W2], 64, 1024, 1024, WSP(bf16, WS_W2T), scr, r, F.lane); continue; } r -= T_L;
        p0_transpose_item(F.in[I_A2], 64, 1024, 1024, WSP(bf16, WS_A2T), scr, r, F.lane);
    }
    for (int m = gw; m < MPAD + 1024; m += NGW) {
        if (m < NTOKP) rms_row_to_bf16(F.in[I_XP] + (size_t)m * DM, F.in[I_NW], WSP(bf16, WS_XN) + (size_t)m * DM, F.lane);
        else if (m < NTOK) rms_row_to_bf16(F.in[I_XS] + (size_t)(m - NTOKP) * DM, F.in[I_NW], WSP(bf16, WS_XN) + (size_t)m * DM, F.lane);
        else if (m < MPAD) { v4u z = {0u, 0u, 0u, 0u}; v4u* o = (v4u*)(WSP(bf16, WS_XN) + (size_t)m * DM) + F.lane;
#pragma unroll
            for (int j = 0; j < 4; ++j) o[64 * j] = z; }
        else rms_row_to_bf16(F.in[I_MEM] + (size_t)(m - MPAD) * DM, F.in[I_MNW], WSP(bf16, WS_XM) + (size_t)(m - MPAD) * DM, F.lane);
    }
    const int gt = F.bid * NTHR + F.tid, NGT = F.G * NTHR;
    for (int e = gt; e < 2052 * 96; e += NGT) {
        const int p = e / 96, i = e % 96; const int pos = p < 2048 ? p : PAST + (p - 2048);
        float c, s;
        if (i < 64) { rope_cs(pos, i, 0.8659643233600653, c, s); WSP(f32x2, WS_ROPE128)[p * 64 + i] = (f32x2){c, s}; }
        else { rope_cs(pos, i - 64, 0.7498942093324559, c, s); WSP(f32x2, WS_ROPE64)[p * 32 + (i - 64)] = (f32x2){c, s}; }
    }
}

struct EpiProj {
    float* C;
    __device__ __forceinline__ void operator()(const f32x4 (&acc)[2][2][4][2], const pg8::Unit& u, int wr, int wc, int fr, int fq) const {
        const int row0 = u.pm * 256 + wr * 64 + fr, col0 = u.pn * 256 + wc * 32 + 4 * fq;
#pragma unroll
        for (int ai = 0; ai < 2; ++ai)
#pragma unroll
            for (int m = 0; m < 4; ++m) { float* rowp = C + (size_t)(row0 + ai * 128 + m * 16) * INWP + col0;
#pragma unroll
                for (int bj = 0; bj < 2; ++bj)
#pragma unroll
                    for (int n = 0; n < 2; ++n) *(f32x4*)(rowp + bj * 128 + n * 16) = acc[ai][bj][m][n]; }
    }
};
__device__ __forceinline__ size_t kf_off(int NT, int h, int s, int dim);
__device__ __forceinline__ size_t kif_off(int s, int dim);
__device__ __forceinline__ int src_col(int g) {
    if (g < 4224) return g;
    if (g < 5248) { const int base = g & ~127, p = g & 127; return base + (p >> 5) * 16 + (p & 15) + 64 * ((p >> 4) & 1); }
    if (g < 6272) return g;
    if (g < 7296) { const int base = g & ~63, p = g & 63; return base + (p >> 5) * 16 + (p & 15) + 32 * ((p >> 4) & 1); }
    if (g < 8320) return g + 80;
    if (g < 8384) { const int p = g - 8320; return 7312 + (p >> 5) * 16 + (p & 15) + 32 * ((p >> 4) & 1); }
    if (g < 8400) return 7296 + (g - 8384);
    return -1;
}
struct EpiProjFused {
    float* C; float* out; unsigned char* ws;
    __device__ __forceinline__ void operator()(const f32x4 (&acc)[2][2][4][2], const pg8::Unit& u, int wr, int wc, int fr, int fq) const {
        const int row00 = u.pm * 256 + wr * 64 + fr;
#pragma unroll
        for (int bj = 0; bj < 2; ++bj) {
            const int cb = 2 * u.pn + bj;
            const int cq = 128 * cb + 32 * wc + 4 * fq;
            if (cb <= 32 || (cb >= 41 && cb <= 48) || (cb >= 61 && cb <= 64)) {
#pragma unroll
                for (int ai = 0; ai < 2; ++ai)
#pragma unroll
                    for (int m = 0; m < 4; ++m) { const int row = row00 + ai * 128 + m * 16;
                        if (row < NTOK) {
                            float* rowp = C + (size_t)row * INWP + cq;
                            *(f32x4*)rowp = acc[ai][bj][m][0]; *(f32x4*)(rowp + 16) = acc[ai][bj][m][1];
                            const bool prm = row < NTOKP; const int srow = row - NTOKP;
                            if (cb >= 41 && cb <= 44) { float* vo = out + (prm ? O_VP + (size_t)row * 512 : O_VS + (size_t)srow * 512) + (cq - C_AV);
                                *(f32x4*)vo = acc[ai][bj][m][0]; *(f32x4*)(vo + 16) = acc[ai][bj][m][1]; }
                            if (cb <= 24 && (prm ? ((row & 2047) == 2047) : ((srow & 3) == 3))) {
                                float* so = out + (prm ? O_SHP + (size_t)(row >> 11) * SHW : O_SHS + (size_t)(srow >> 2) * SHW) + cq;
                                *(f32x4*)so = acc[ai][bj][m][0]; *(f32x4*)(so + 16) = acc[ai][bj][m][1]; }
                        } }
            } else if (cb <= 40) {
                const bool isq = cb <= 36; const int h = isq ? cb - 33 : cb - 37, i0 = 16 * wc + 4 * fq;
#pragma unroll
                for (int ai = 0; ai < 2; ++ai)
#pragma unroll
                    for (int m = 0; m < 4; ++m) { const int row = row00 + ai * 128 + m * 16;
                        if (row < NTOK) {
                            const bool prm = row < NTOKP; const int srow = row - NTOKP;
                            const int p = prm ? (row & 2047) : 2048 + (srow & 3);
                            const f32x4 t0 = *(const f32x4*)((const float*)(ws + WS_ROPE128) + (size_t)(p * 64 + i0) * 2), t1 = *(const f32x4*)((const float*)(ws + WS_ROPE128) + (size_t)(p * 64 + i0 + 2) * 2);
                            const f32x4 x1 = acc[ai][bj][m][0], x2 = acc[ai][bj][m][1];
                            f32x4 o1, o2;
                            o1.x = x1.x * t0.x - x2.x * t0.y; o2.x = x2.x * t0.x + x1.x * t0.y; o1.y = x1.y * t0.z - x2.y * t0.w; o2.y = x2.y * t0.z + x1.y * t0.w;
                            o1.z = x1.z * t1.x - x2.z * t1.y; o2.z = x2.z * t1.x + x1.z * t1.y; o1.w = x1.w * t1.z - x2.w * t1.w; o2.w = x2.w * t1.z + x1.w * t1.w;
                            if (isq) { bf16* qb = (bf16*)(ws + WS_QB) + (size_t)row * 512 + h * 128 + i0;
                                v2u a, b; a.x = cvt_pk_bf16(o1.x * QSCALE, o1.y * QSCALE); a.y = cvt_pk_bf16(o1.z * QSCALE, o1.w * QSCALE); b.x = cvt_pk_bf16(o2.x * QSCALE, o2.y * QSCALE); b.y = cvt_pk_bf16(o2.z * QSCALE, o2.w * QSCALE);
                                *(v2u*)qb = a; *(v2u*)(qb + 64) = b; }
                            else { float* ko = out + (prm ? O_KP + (size_t)row * 512 : O_KS + (size_t)srow * 512) + h * 128 + i0;
                                *(f32x4*)ko = o1; *(f32x4*)(ko + 64) = o2;
                                if (prm) { bf16* KF = (bf16*)(ws + WS_KB) + (size_t)(row >> 11) * SEQ * 512; const int sq = row & 2047;
                                    v2u a, b; a.x = cvt_pk_bf16(o1.x, o1.y); a.y = cvt_pk_bf16(o1.z, o1.w); b.x = cvt_pk_bf16(o2.x, o2.y); b.y = cvt_pk_bf16(o2.z, o2.w);
                                    *(v2u*)(KF + kf_off(64, h, sq, i0)) = a; *(v2u*)(KF + kf_off(64, h, sq, 64 + i0)) = b; } }
                        } }
            } else if (cb >= 49 && cb <= 56) {
                const int hd = 2 * (cb - 49) + (wc >> 1), i0 = 16 * (wc & 1) + 4 * fq;
#pragma unroll
                for (int ai = 0; ai < 2; ++ai)
#pragma unroll
                    for (int m = 0; m < 4; ++m) { const int row = row00 + ai * 128 + m * 16;
                        if (row < NTOK) {
                            const int p = row < NTOKP ? (row & 2047) : 2048 + ((row - NTOKP) & 3);
                            const f32x4 t0 = *(const f32x4*)((const float*)(ws + WS_ROPE64) + (size_t)(p * 32 + i0) * 2), t1 = *(const f32x4*)((const float*)(ws + WS_ROPE64) + (size_t)(p * 32 + i0 + 2) * 2);
                            const f32x4 x1 = acc[ai][bj][m][0], x2 = acc[ai][bj][m][1];
                            v2u a, b;
                            a.x = cvt_pk_bf16(x1.x * t0.x - x2.x * t0.y, x1.y * t0.z - x2.y * t0.w); a.y = cvt_pk_bf16(x1.z * t1.x - x2.z * t1.y, x1.w * t1.z - x2.w * t1.w);
                            b.x = cvt_pk_bf16(x2.x * t0.x + x1.x * t0.y, x2.y * t0.z + x1.y * t0.w); b.y = cvt_pk_bf16(x2.z * t1.x + x1.z * t1.y, x2.w * t1.z + x1.w * t1.w);
                            bf16* qi = (bf16*)(ws + WS_QIB) + (size_t)row * 1024 + hd * 64 + i0;
                            *(v2u*)qi = a; *(v2u*)(qi + 32) = b;
                        } }
            } else if (cb >= 57 && cb <= 60) {
#pragma unroll
                for (int ai = 0; ai < 2; ++ai)
#pragma unroll
                    for (int m = 0; m < 4; ++m) { const int row = row00 + ai * 128 + m * 16;
                        if (row < NTOK) { bf16* qm = (bf16*)(ws + WS_QMB) + (size_t)row * 512 + (cq - 7296);
#pragma unroll
                            for (int n = 0; n < 2; ++n) { const f32x4 v = acc[ai][bj][m][n]; v2u a; a.x = cvt_pk_bf16(v.x * QSCALE, v.y * QSCALE); a.y = cvt_pk_bf16(v.z * QSCALE, v.w * QSCALE); *(v2u*)(qm + 16 * n) = a; } } }
            } else if (cb == 65) {
                if (wc < 2) { const int i0 = 16 * wc + 4 * fq;
#pragma unroll
                    for (int ai = 0; ai < 2; ++ai)
#pragma unroll
                        for (int m = 0; m < 4; ++m) { const int row = row00 + ai * 128 + m * 16;
                            if (row < NTOK) {
                                const bool prm = row < NTOKP; const int srow = row - NTOKP;
                                const int p = prm ? (row & 2047) : 2048 + (srow & 3);
                                const f32x4 t0 = *(const f32x4*)((const float*)(ws + WS_ROPE64) + (size_t)(p * 32 + i0) * 2), t1 = *(const f32x4*)((const float*)(ws + WS_ROPE64) + (size_t)(p * 32 + i0 + 2) * 2);
                                const f32x4 x1 = acc[ai][bj][m][0], x2 = acc[ai][bj][m][1];
                                f32x4 o1, o2;
                                o1.x = x1.x * t0.x - x2.x * t0.y; o2.x = x2.x * t0.x + x1.x * t0.y; o1.y = x1.y * t0.z - x2.y * t0.w; o2.y = x2.y * t0.z + x1.y * t0.w;
                                o1.z = x1.z * t1.x - x2.z * t1.y; o2.z = x2.z * t1.x + x1.z * t1.y; o1.w = x1.w * t1.z - x2.w * t1.w; o2.w = x2.w * t1.z + x1.w * t1.w;
                                float* kio = out + (prm ? O_KIP + (size_t)row * 64 : O_KIS + (size_t)srow * 64) + i0;
                                *(f32x4*)kio = o1; *(f32x4*)(kio + 32) = o2;
                                v2u a, b; a.x = cvt_pk_bf16(o1.x, o1.y); a.y = cvt_pk_bf16(o1.z, o1.w); b.x = cvt_pk_bf16(o2.x, o2.y); b.y = cvt_pk_bf16(o2.z, o2.w);
                                bf16* kib = (bf16*)(ws + WS_KIB) + (size_t)row * 64 + i0; *(v2u*)kib = a; *(v2u*)(kib + 32) = b;
                                if (prm) { bf16* KIF = (bf16*)(ws + WS_SC) + (size_t)(row >> 11) * SEQ * 64; const int sq = row & 2047;
                                    *(v2u*)(KIF + kif_off(sq, i0)) = a; *(v2u*)(KIF + kif_off(sq, 32 + i0)) = b; }
                            } }
                } else if (wc == 2) {
#pragma unroll
                    for (int ai = 0; ai < 2; ++ai)
#pragma unroll
                        for (int m = 0; m < 4; ++m) { const int row = row00 + ai * 128 + m * 16;
                            if (row < NTOK) { const f32x4 v = acc[ai][bj][m][0]; *(f32x4*)((float*)(ws + WS_WIS) + (size_t)row * 16 + 4 * fq) = (f32x4){v.x * (1.f / 32.f), v.y * (1.f / 32.f), v.z * (1.f / 32.f), v.w * (1.f / 32.f)}; } }
                }
            }
        }
    }
};
struct EpiMem {
    float* out;
    __device__ __forceinline__ void operator()(const f32x4 (&acc)[2][2][4][2], const pg8::Unit& u, int wr, int wc, int fr, int fq) const {
        const int row0 = u.pm * 256 + wr * 64 + fr; int colt = u.pn * 256;
        float* base = out + (colt < 512 ? O_MKP : O_MVP); if (colt >= 512) colt -= 512;
        const int col0 = colt + wc * 32 + 4 * fq;
#pragma unroll
        for (int ai = 0; ai < 2; ++ai)
#pragma unroll
            for (int m = 0; m < 4; ++m) { float* rowp = base + (size_t)(row0 + ai * 128 + m * 16) * 512 + col0;
#pragma unroll
                for (int bj = 0; bj < 2; ++bj)
#pragma unroll
                    for (int n = 0; n < 2; ++n) *(f32x4*)(rowp + bj * 128 + n * 16) = acc[ai][bj][m][n]; }
    }
};
__device__ __forceinline__ void atomic_add4(float* p, const f32x4& v) { unsafeAtomicAdd(p, v.x); unsafeAtomicAdd(p + 1, v.y); unsafeAtomicAdd(p + 2, v.z); unsafeAtomicAdd(p + 3, v.w); }
struct EpiProjAtomic {
    float* C;
    __device__ __forceinline__ void operator()(const f32x4 (&acc)[2][2][4][2], const pg8::Unit& u, int wr, int wc, int fr, int fq) const {
        const int row0 = u.pm * 256 + wr * 64 + fr, col0 = u.pn * 256 + wc * 32 + 4 * fq;
#pragma unroll
        for (int ai = 0; ai < 2; ++ai)
#pragma unroll
            for (int m = 0; m < 4; ++m) { const int row = row0 + ai * 128 + m * 16; float* rowp = C + (size_t)row * INWP + col0;
                if (row < NTOK) {
#pragma unroll
                    for (int bj = 0; bj < 2; ++bj)
#pragma unroll
                        for (int n = 0; n < 2; ++n) atomic_add4(rowp + bj * 128 + n * 16, acc[ai][bj][m][n]); } }
    }
};
struct EpiMemAtomic {
    float* out;
    __device__ __forceinline__ void operator()(const f32x4 (&acc)[2][2][4][2], const pg8::Unit& u, int wr, int wc, int fr, int fq) const {
        const int row0 = u.pm * 256 + wr * 64 + fr; int colt = u.pn * 256;
        float* base = out + (colt < 512 ? O_MKP : O_MVP); if (colt >= 512) colt -= 512;
        const int col0 = colt + wc * 32 + 4 * fq;
#pragma unroll
        for (int ai = 0; ai < 2; ++ai)
#pragma unroll
            for (int m = 0; m < 4; ++m) { float* rowp = base + (size_t)(row0 + ai * 128 + m * 16) * 512 + col0;
#pragma unroll
                for (int bj = 0; bj < 2; ++bj)
#pragma unroll
                    for (int n = 0; n < 2; ++n) atomic_add4(rowp + bj * 128 + n * 16, acc[ai][bj][m][n]); }
    }
};
struct EpiOutAtomic {
    float* out;
    __device__ __forceinline__ void operator()(const f32x4 (&acc)[2][2][4][2], const pg8::Unit& u, int wr, int wc, int fr, int fq) const {
        const int row0 = u.pm * 256 + wr * 64 + fr, col0 = u.pn * 256 + wc * 32 + 4 * fq;
#pragma unroll
        for (int ai = 0; ai < 2; ++ai)
#pragma unroll
            for (int m = 0; m < 4; ++m) { const int row = row0 + ai * 128 + m * 16;
                if (row >= NTOKP && row < NTOK) { float* orow = out + O_YS + (size_t)(row - NTOKP) * DM + col0;
#pragma unroll
                    for (int bj = 0; bj < 2; ++bj)
#pragma unroll
                        for (int n = 0; n < 2; ++n) atomic_add4(orow + bj * 128 + n * 16, acc[ai][bj][m][n]); } }
    }
};
struct EpiOut {
    const float* xp; const float* xs; float* out;
    __device__ __forceinline__ void operator()(const f32x4 (&acc)[2][2][4][2], const pg8::Unit& u, int wr, int wc, int fr, int fq) const {
        const int row0 = u.pm * 256 + wr * 64 + fr, col0 = u.pn * 256 + wc * 32 + 4 * fq;
#pragma unroll
        for (int ai = 0; ai < 2; ++ai)
#pragma unroll
            for (int m = 0; m < 4; ++m) { const int row = row0 + ai * 128 + m * 16;
                if (row < NTOK) {
                    const float* xr = (row < NTOKP ? xp + (size_t)row * DM : xs + (size_t)(row - NTOKP) * DM) + col0;
                    float* orow = out + (row < NTOKP ? O_YP + (size_t)row * DM : O_YS + (size_t)(row - NTOKP) * DM) + col0;
#pragma unroll
                    for (int bj = 0; bj < 2; ++bj)
#pragma unroll
                        for (int n = 0; n < 2; ++n) *(f32x4*)(orow + bj * 128 + n * 16) = acc[ai][bj][m][n] + *(const f32x4*)(xr + bj * 128 + n * 16); } }
    }
};

__device__ __forceinline__ float prev_val(const Frame& F, const float* P, int row, int col) {
    if (row < NTOKP) { return (row & (SEQ - 1)) == 0 ? 0.f : P[(size_t)(row - 1) * INWP + col]; }
    const int s = row - NTOKP; return (s & 3) == 0 ? F.in[I_SSH][(size_t)(s >> 2) * SHW + col] : P[(size_t)(row - 1) * INWP + col];
}
__device__ __forceinline__ size_t scan_seq_off(int row, int h) {
    if (row < NTOKP) { const int b = row >> 11, t = row & 2047; return ((size_t)(b * RH + h) * SEQ + t); }
    const int s = row - NTOKP, db = s >> 2, t = s & 3; return (size_t)NB * RH * SEQ + ((size_t)(db * RH + h) * DT + t);
}
__device__ __forceinline__ size_t kf_off(int NT, int h, int s, int dim) { return ((size_t)((h * NT + (s >> 5)) * 8 + (dim >> 4))) * 512 + (((dim >> 3) & 1) * 32 + (s & 31)) * 8 + (dim & 7); }
__device__ __forceinline__ size_t kif_off(int s, int dim) { return ((size_t)((s >> 5) * 4 + (dim >> 4))) * 512 + (((dim >> 3) & 1) * 32 + (s & 31)) * 8 + (dim & 7); }
__device__ __forceinline__ f32x4 ld4(const float* p) { return *(const f32x4*)p; }
__device__ __forceinline__ f32x4 prev4(const Frame& F, const float* P, int row, int col) {
    if (row < NTOKP) { if ((row & (SEQ - 1)) == 0) return (f32x4){0.f, 0.f, 0.f, 0.f}; return ld4(P + (size_t)(row - 1) * INWP + col); }
    const int s = row - NTOKP; if ((s & 3) == 0) return ld4(F.in[I_SSH] + (size_t)(s >> 2) * SHW + col); return ld4(P + (size_t)(row - 1) * INWP + col);
}
__device__ __forceinline__ void p2_rwkv_witem(Frame& F, int tile, int h0, int nh) {
    const float* P = WSP(float, WS_PROJ);
    const int row0 = tile * 16;
    const int lane = F.lane, tk = lane & 15, kq = lane >> 4, row = row0 + tk;
    const float* mu = F.in[I_MU];
    bf16x8 bw[2], ba[2];
#pragma unroll
    for (int ks = 0; ks < 2; ++ks) {
        const int c0 = 32 * ks + 8 * kq;
        float xw[8], xa[8];
#pragma unroll
        for (int hf = 0; hf < 2; ++hf) {
            const f32x4 cw = ld4(P + (size_t)row * INWP + C_CW + c0 + 4 * hf), pw = prev4(F, P, row, C_CW + c0 + 4 * hf), mw = ld4(mu + C_CW + c0 + 4 * hf);
            const f32x4 ca = ld4(P + (size_t)row * INWP + C_CA + c0 + 4 * hf), pa = prev4(F, P, row, C_CA + c0 + 4 * hf), ma = ld4(mu + C_CA + c0 + 4 * hf);
#pragma unroll
            for (int e = 0; e < 4; ++e) { const float x = cw[e] + (pw[e] - cw[e]) * mw[e];
                const float t = __builtin_amdgcn_exp2f(x * 2.8853900817779268f); xw[4 * hf + e] = 1.f - 2.f * __builtin_amdgcn_rcpf(t + 1.f);
                xa[4 * hf + e] = ca[e] + (pa[e] - ca[e]) * ma[e]; }
        }
        v4u uw, ua; uw.x = cvt_pk_bf16(xw[0], xw[1]); uw.y = cvt_pk_bf16(xw[2], xw[3]); uw.z = cvt_pk_bf16(xw[4], xw[5]); uw.w = cvt_pk_bf16(xw[6], xw[7]);
        ua.x = cvt_pk_bf16(xa[0], xa[1]); ua.y = cvt_pk_bf16(xa[2], xa[3]); ua.z = cvt_pk_bf16(xa[4], xa[5]); ua.w = cvt_pk_bf16(xa[6], xa[7]);
        bw[ks] = __builtin_bit_cast(bf16x8, uw); ba[ks] = __builtin_bit_cast(bf16x8, ua);
    }
    const bf16* W2T = WSP(bf16, WS_W2T); const bf16* A2T = WSP(bf16, WS_A2T);
    float* SI = WSP(float, WS_SCANIN); float* SL = WSP(float, WS_SCAL);
    const float* pr = P + (size_t)row * INWP;
    for (int hh = 0; hh < nh; ++hh) {
        const int h = h0 + hh;
        f32x4 wl[4], al[4];
#pragma unroll
        for (int n = 0; n < 4; ++n) {
            const int chA = h * 64 + n * 16 + tk;
            wl[n] = (f32x4){0.f, 0.f, 0.f, 0.f}; al[n] = (f32x4){0.f, 0.f, 0.f, 0.f};
#pragma unroll
            for (int ks = 0; ks < 2; ++ks) {
                const bf16x8 aw = *(const bf16x8*)(W2T + (size_t)chA * 64 + 32 * ks + 8 * kq);
                const bf16x8 aa = *(const bf16x8*)(A2T + (size_t)chA * 64 + 32 * ks + 8 * kq);
                wl[n] = __builtin_amdgcn_mfma_f32_16x16x32_bf16(aw, bw[ks], wl[n], 0, 0, 0);
                al[n] = __builtin_amdgcn_mfma_f32_16x16x32_bf16(aa, ba[ks], al[n], 0, 0, 0);
            }
        }
        f32x4 Lxk[4], Lqk[4], Lxr[4], Lqr[4], Lxv[4], Lqv[4];
#pragma unroll
        for (int n = 0; n < 4; ++n) { const int ch = h * 64 + n * 16 + 4 * kq;
            Lxk[n] = ld4(pr + C_K + ch); Lqk[n] = prev4(F, P, row, C_K + ch); Lxr[n] = ld4(pr + C_R + ch); Lqr[n] = prev4(F, P, row, C_R + ch); Lxv[n] = ld4(pr + C_V + ch); Lqv[n] = prev4(F, P, row, C_V + ch); }
        __builtin_amdgcn_sched_barrier(0);
        f32x4 k4[4];
        float ss = 0.f;
#pragma unroll
        for (int n = 0; n < 4; ++n) {
            const int ch = h * 64 + n * 16 + 4 * kq;
            const f32x4 xk = Lxk[n], qk = Lqk[n], mk = ld4(mu + C_K + ch), kkw = ld4(F.in[I_KK] + ch);
#pragma unroll
            for (int j = 0; j < 4; ++j) { k4[n][j] = xk[j] + (qk[j] - xk[j]) * mk[j]; const float t = k4[n][j] * kkw[j]; ss += t * t; }
        }
        ss += __shfl_xor(ss, 16); ss += __shfl_xor(ss, 32);
        const float inv = 1.f / fmaxf(sqrtf(ss), 1e-12f);
        float s_nbr = 0.f, s_kr = 0.f, s_bon = 0.f;
        const size_t so = scan_seq_off(row, h);
        float* dst = SI + so * 384 + 4 * kq;
#pragma unroll
        for (int n = 0; n < 4; ++n) {
            const int ch = h * 64 + n * 16 + 4 * kq;
            const f32x4 xr = Lxr[n], xv = Lxv[n], qr = Lqr[n], qv = Lqv[n];
            const f32x4 mr = ld4(mu + C_R + ch), mv = ld4(mu + C_V + ch);
            const f32x4 w0 = ld4(F.in[I_W0] + ch), a0 = ld4(F.in[I_A0] + ch), kkw = ld4(F.in[I_KK] + ch), ka = ld4(F.in[I_KA] + ch), rk = ld4(F.in[I_RK] + ch);
            f32x4 kk, kp, nb, wr, wv, vv;
#pragma unroll
            for (int j = 0; j < 4; ++j) {
                const float r = xr[j] + (qr[j] - xr[j]) * mr[j]; vv[j] = xv[j] + (qv[j] - xv[j]) * mv[j];
                const float wlin = w0[j] + wl[n][j];
                const float sg = __builtin_amdgcn_rcpf(1.f + __builtin_amdgcn_exp2f(-wlin * 1.4426950408889634f));
                wv[j] = __builtin_amdgcn_exp2f(-0.8750338f * sg);
                const float alin = a0[j] + al[n][j];
                const float a = __builtin_amdgcn_rcpf(1.f + __builtin_amdgcn_exp2f(-alin * 1.4426950408889634f));
                kk[j] = k4[n][j] * kkw[j] * inv;
                kp[j] = k4[n][j] * (1.f + (a - 1.f) * ka[j]);
                nb[j] = -kk[j] * a;
                wr[j] = wv[j] * r;
                s_nbr += nb[j] * r; s_kr += kp[j] * r; s_bon += r * kp[j] * rk[j];
            }
            *(f32x4*)(dst + 0 * 64 + 16 * n) = kk; *(f32x4*)(dst + 1 * 64 + 16 * n) = wv; *(f32x4*)(dst + 2 * 64 + 16 * n) = nb;
            *(f32x4*)(dst + 3 * 64 + 16 * n) = kp; *(f32x4*)(dst + 4 * 64 + 16 * n) = wr; *(f32x4*)(dst + 5 * 64 + 16 * n) = vv;
        }
        s_nbr += __shfl_xor(s_nbr, 16); s_nbr += __shfl_xor(s_nbr, 32);
        s_kr += __shfl_xor(s_kr, 16); s_kr += __shfl_xor(s_kr, 32);
        s_bon += __shfl_xor(s_bon, 16); s_bon += __shfl_xor(s_bon, 32);
        if (kq == 0) *(f32x4*)(SL + so * 16) = (f32x4){s_nbr, s_kr, s_bon, 0.f};
    }
}
__device__ __forceinline__ void p2_row_item(Frame& F, int row) {
    const float* P = WSP(float, WS_PROJ) + (size_t)row * INWP;
    const int lane = F.lane;
    const bool prm = row < NTOKP; const int srow = row - NTOKP;
    const int p = prm ? (row & 2047) : 2048 + (srow & 3);
    const f32x2* T128 = WSP(f32x2, WS_ROPE128) + p * 64; const f32x2* T64 = WSP(f32x2, WS_ROPE64) + p * 32;
    bf16* QB = WSP(bf16, WS_QB) + (size_t)row * 512; bf16* KF = WSP(bf16, WS_KB) + (size_t)(row >> 11) * SEQ * 512; const int sq = row & 2047;
    float* ko = F.out + (prm ? O_KP + (size_t)row * 512 : O_KS + (size_t)srow * 512);
    float* vo = F.out + (prm ? O_VP + (size_t)row * 512 : O_VS + (size_t)srow * 512);
    const f32x2 cs = T128[lane];
    float Lq1[4], Lq2[4], Lk1[4], Lk2[4];
#pragma unroll
    for (int h = 0; h < 4; ++h) { Lq1[h] = P[C_Q + h * 128 + lane]; Lq2[h] = P[C_Q + h * 128 + 64 + lane]; Lk1[h] = P[C_AK + h * 128 + lane]; Lk2[h] = P[C_AK + h * 128 + 64 + lane]; }
    float Li1[8], Li2[8]; f32x2 Lc[8];
#pragma unroll
    for (int j = 0; j < 8; ++j) { const int pi = lane + 64 * j, hd = pi >> 5, i = pi & 31; Li1[j] = P[C_QI + hd * 64 + i]; Li2[j] = P[C_QI + hd * 64 + 32 + i]; Lc[j] = T64[i]; }
    const f32x4 Lv0 = *(const f32x4*)(P + C_AV + 4 * lane), Lv1 = *(const f32x4*)(P + C_AV + 256 + 4 * lane);
    const f32x4 Lm0 = *(const f32x4*)(P + C_QM + 8 * lane), Lm1 = *(const f32x4*)(P + C_QM + 8 * lane + 4);
    __builtin_amdgcn_sched_barrier(0);
#pragma unroll
    for (int h = 0; h < 4; ++h) {
        { const float x1 = Lq1[h], x2 = Lq2[h];
          const float o1 = (x1 * cs.x - x2 * cs.y) * QSCALE, o2 = (x2 * cs.x + x1 * cs.y) * QSCALE;
          QB[h * 128 + lane] = (bf16)(cvt_pk_bf16(o1, 0.f) & 0xffffu); QB[h * 128 + 64 + lane] = (bf16)(cvt_pk_bf16(o2, 0.f) & 0xffffu); }
        { const float x1 = Lk1[h], x2 = Lk2[h];
          const float o1 = x1 * cs.x - x2 * cs.y, o2 = x2 * cs.x + x1 * cs.y;
          ko[h * 128 + lane] = o1; ko[h * 128 + 64 + lane] = o2;
          if (prm) { KF[kf_off(64, h, sq, lane)] = (bf16)(cvt_pk_bf16(o1, 0.f) & 0xffffu); KF[kf_off(64, h, sq, 64 + lane)] = (bf16)(cvt_pk_bf16(o2, 0.f) & 0xffffu); } }
    }
    {
        f32x4* d = (f32x4*)vo;
        d[lane] = Lv0; d[64 + lane] = Lv1;
    }
    {
        bf16* QIB = WSP(bf16, WS_QIB) + (size_t)row * 1024;
#pragma unroll
        for (int j = 0; j < 8; ++j) { const int pi = lane + 64 * j, hd = pi >> 5, i = pi & 31; const f32x2 c2 = Lc[j];
            const float x1 = Li1[j], x2 = Li2[j];
            QIB[hd * 64 + i] = (bf16)(cvt_pk_bf16(x1 * c2.x - x2 * c2.y, 0.f) & 0xffffu); QIB[hd * 64 + 32 + i] = (bf16)(cvt_pk_bf16(x2 * c2.x + x1 * c2.y, 0.f) & 0xffffu); }
    }
    if (lane < 32) {
        const f32x2 c2 = T64[lane]; const float x1 = P[C_KI + lane], x2 = P[C_KI + 32 + lane];
        const float o1 = x1 * c2.x - x2 * c2.y, o2 = x2 * c2.x + x1 * c2.y;
        float* kio = F.out + (prm ? O_KIP + (size_t)row * 64 : O_KIS + (size_t)srow * 64);
        kio[lane] = o1; kio[32 + lane] = o2;
        bf16* KIB = WSP(bf16, WS_KIB) + (size_t)row * 64;
        KIB[lane] = (bf16)(cvt_pk_bf16(o1, 0.f) & 0xffffu); KIB[32 + lane] = (bf16)(cvt_pk_bf16(o2, 0.f) & 0xffffu);
        if (prm) { bf16* KIF = WSP(bf16, WS_SC) + (size_t)(row >> 11) * SEQ * 64; KIF[kif_off(sq, lane)] = (bf16)(cvt_pk_bf16(o1, 0.f) & 0xffffu); KIF[kif_off(sq, 32 + lane)] = (bf16)(cvt_pk_bf16(o2, 0.f) & 0xffffu); }
    }
    if (lane < 16) WSP(float, WS_WIS)[(size_t)row * 16 + lane] = P[C_WI + lane] * (1.f / 32.f);
    {
        bf16* QMB = WSP(bf16, WS_QMB) + (size_t)row * 512;
        const f32x4 a = Lm0, b = Lm1;
        v4u o; o.x = cvt_pk_bf16(a.x * QSCALE, a.y * QSCALE); o.y = cvt_pk_bf16(a.z * QSCALE, a.w * QSCALE); o.z = cvt_pk_bf16(b.x * QSCALE, b.y * QSCALE); o.w = cvt_pk_bf16(b.z * QSCALE, b.w * QSCALE);
        *(v4u*)(QMB + 8 * lane) = o;
    }
    if (prm ? ((row & 2047) == 2047) : ((srow & 3) == 3)) {
        float* so = F.out + (prm ? O_SHP + (size_t)(row >> 11) * SHW : O_SHS + (size_t)(srow >> 2) * SHW);
        for (int c = lane; c < SHW; c += 64) so[c] = P[c];
    }
}
__device__ __forceinline__ void p2_vt_item(Frame& F, const float* src, size_t ld_src, bf16* dstb, int NT, int ts) {
    LAS bf16* tile = (LAS bf16*)(F.lds + RING_OFF);
    { f32x4 tv[16];
#pragma unroll
      for (int i = 0; i < 16; ++i) { const int e = F.tid + i * NTHR, tok = e >> 7, c4 = (e & 127) * 4; tv[i] = *(const f32x4*)(src + (size_t)tok * ld_src + c4); }
#pragma unroll
      for (int i = 0; i < 16; ++i) { const int e = F.tid + i * NTHR, tok = e >> 7, c4 = (e & 127) * 4;
        v2u o; o.x = cvt_pk_bf16(tv[i].x, tv[i].y); o.y = cvt_pk_bf16(tv[i].z, tv[i].w); *(LAS v2u*)(tile + tok * 520 + c4) = o; } }
    __syncthreads();
    const int rsub = F.lane >> 3, chunk = F.lane & 7;
    for (int it = 0; it < 8; ++it) { const int hd = (it * 8 + F.wave) * 8 + rsub, h = hd >> 7, d = hd & 127;
        unsigned short e[8];
#pragma unroll
        for (int k = 0; k < 8; ++k) e[k] = tile[(chunk * 8 + k) * 520 + hd];
        const int kt = ts * 2 + (chunk >> 2), s2 = (chunk >> 1) & 1, g = chunk & 1;
        bf16* p = dstb + ((size_t)((h * NT + kt) * 8 + (d >> 5) * 2 + s2)) * 512 + (d & 31) * 8 + g * 4;
        v2u lo, hi; lo.x = e[0] | ((unsigned)e[1] << 16); lo.y = e[2] | ((unsigned)e[3] << 16); hi.x = e[4] | ((unsigned)e[5] << 16); hi.y = e[6] | ((unsigned)e[7] << 16);
        *(v2u*)p = lo; *(v2u*)(p + 32 * 8) = hi; }
    __syncthreads();
}
#ifndef PROBE_REPEAT
#define PROBE_REPEAT -1
#endif
__device__ __forceinline__ void p2_phase(Frame& F) {
    const int gw = F.bid * NWAVES + F.wave, NGW = F.G * NWAVES;
    for (int rep = 0; rep < (PROBE_REPEAT == 20 ? 2 : 1); ++rep)
    for (int it = gw; it < (NTOKP / 16) * 8; it += NGW) p2_rwkv_witem(F, it >> 3, (it & 7) * 2, 2);
    for (int it = NGW - 1 - gw; it < (NTOKS / 16) * 16; it += NGW) p2_rwkv_witem(F, NTOKP / 16 + (it >> 4), it & 15, 1);
    for (int rep = 0; rep < (PROBE_REPEAT == 21 ? 2 : 1); ++rep)
    for (int it = F.bid; it < 128 + 16; it += F.G) {
        if (it < 128) { const int b = it >> 5, ts = it & 31;
            p2_vt_item(F, WSP(float, WS_PROJ) + (size_t)(b * SEQ + ts * 64) * INWP + C_AV, INWP, WSP(bf16, WS_VT) + (size_t)b * 512 * SEQ, 64, ts); }
        else { const int j = it - 128, b = j >> 2, ts = j & 3;
            p2_vt_item(F, F.out + O_MVP + (size_t)(b * MEMT + ts * 64) * 512, 512, WSP(bf16, WS_MVT) + (size_t)b * 512 * MEMT, 8, ts); }
    }
    const int gt = F.bid * NTHR + F.tid, NGT = F.G * NTHR;
    for (int e = gt; e < 1024 * 512 / 4; e += NGT) { const f32x4 v = *(const f32x4*)(F.out + O_MKP + (size_t)e * 4); v2u o; o.x = cvt_pk_bf16(v.x, v.y); o.y = cvt_pk_bf16(v.z, v.w);
        const int rowm = e >> 7, col = (e & 127) * 4, bm = rowm >> 8, m = rowm & 255; *(v2u*)(WSP(bf16, WS_MKB) + (size_t)bm * MEMT * 512 + kf_off(8, col >> 7, m, col & 127)) = o; }
}

constexpr int TC = 32, SBUF_FLOATS = TC * 384;
#define SCAN_STAGE_LOAD(SIN, SCALP) do { \
    _Pragma("unroll") for (int i = 0; i < 10; ++i) { const int e = lt + 256 * i, st = e / 80, r = e % 80; rv[i] = *(const f32x4*)((SIN) + (size_t)st * 384 + r * 4); } \
    _Pragma("unroll") for (int i = 0; i < 2; ++i) { const int e = lt + 256 * i, st = e >> 4, row = e & 15; const float v_ = (SIN)[(size_t)st * 384 + 320 + rg * 16 + row]; const f32x2 sc_ = *(const f32x2*)((SCALP) + (size_t)st * 16); \
        rt[i].x = v_; rt[i].y = sc_.x; rt[i].z = sc_.y; rt[i].w = 0.f; } } while (0)
#define SCAN_STAGE_WRITE(BUF) do { \
    _Pragma("unroll") for (int i = 0; i < 10; ++i) { const int e = lt + 256 * i, st = e / 80, r = e % 80; *(LAS f32x4*)((BUF) + st * 384 + r * 4) = rv[i]; } \
    _Pragma("unroll") for (int i = 0; i < 2; ++i) { const int e = lt + 256 * i, st = e >> 4, row = e & 15; *(LAS f32x4*)((BUF) + st * 384 + 320 + row * 4) = rt[i]; } } while (0)
#define SCAN_STEP(KK, W4, NB, KP, WR, TB, YOUT) do { \
    f32x2 _a = s01 * (f32x2){KK.x, KK.y}; _a = __builtin_elementwise_fma(s23, (f32x2){KK.z, KK.w}, _a); \
    f32x2 _b = s01 * (f32x2){WR.x, WR.y}; _b = __builtin_elementwise_fma(s23, (f32x2){WR.z, WR.w}, _b); \
    float _p1 = _a.x + _a.y, _p2 = _b.x + _b.y; \
    _p1 += dpp<0xB1>(_p1); _p2 += dpp<0xB1>(_p2); _p1 += dpp<0x4E>(_p1); _p2 += dpp<0x4E>(_p2); _p1 += dpp<0x141>(_p1); _p2 += dpp<0x141>(_p2); _p1 += dpp<0x140>(_p1); _p2 += dpp<0x140>(_p2); \
    YOUT = __builtin_fmaf(TB.x, TB.z, __builtin_fmaf(_p1, TB.y, _p2)); \
    const f32x2 _pp = (f32x2){_p1, _p1}, _vv = (f32x2){TB.x, TB.x}; \
    f32x2 _t01 = _vv * (f32x2){KP.x, KP.y}; _t01 = __builtin_elementwise_fma(_pp, (f32x2){NB.x, NB.y}, _t01); s01 = __builtin_elementwise_fma(s01, (f32x2){W4.x, W4.y}, _t01); \
    f32x2 _t23 = _vv * (f32x2){KP.z, KP.w}; _t23 = __builtin_elementwise_fma(_pp, (f32x2){NB.z, NB.w}, _t23); s23 = __builtin_elementwise_fma(s23, (f32x2){W4.z, W4.w}, _t23); \
} while (0)
__device__ __forceinline__ void scan_prompt_item(Frame& F, const float* sin, const float* scal, float* s_out, float* y0, int rg) {
    LAS float* bufs = (LAS float*)(F.lds + RING_OFF);
    constexpr int nchunks = SEQ / TC;
    const bool scanner = F.wave < 4;
    const int ri = F.lane >> 4, kq = F.lane & 15;
    const int lrow = (F.wave & 3) * 4 + ri, vrow = rg * 16 + lrow;
    f32x2 s01 = (f32x2){0.f, 0.f}, s23 = (f32x2){0.f, 0.f};
#define SCAN_BAR() do { asm volatile("s_waitcnt lgkmcnt(0)" ::: "memory"); __builtin_amdgcn_s_barrier(); asm volatile("" ::: "memory"); } while (0)
    if (!scanner) {
        f32x4 rv[10], rt[2]; const int lt = F.tid - 256;
        SCAN_STAGE_LOAD(sin, scal); SCAN_STAGE_WRITE(bufs); SCAN_STAGE_LOAD(sin + (size_t)TC * 384, scal + (size_t)TC * 16);
        SCAN_BAR();
        for (int c = 0; c < nchunks; ++c) {
            if (c + 1 < nchunks) { SCAN_STAGE_WRITE(bufs + ((c + 1) & 1) * SBUF_FLOATS);
                if (c + 2 < nchunks) SCAN_STAGE_LOAD(sin + (size_t)(c + 2) * TC * 384, scal + (size_t)(c + 2) * TC * 16); }
            SCAN_BAR();
        }
    } else {
        SCAN_BAR();
        for (int c = 0; c < nchunks; ++c) {
            LAS float* buf = bufs + (c & 1) * SBUF_FLOATS;
            const LAS float* lb = buf + 4 * kq;
            const LAS float* tbp = buf + 320 + lrow * 4;
            float yacc = 0.f;
            f32x4 kkA = *(const LAS f32x4*)(lb), w4A = *(const LAS f32x4*)(lb + 64), nbA = *(const LAS f32x4*)(lb + 128), kpA = *(const LAS f32x4*)(lb + 192), wrA = *(const LAS f32x4*)(lb + 256), tbA = *(const LAS f32x4*)(tbp);
            f32x4 kkB = *(const LAS f32x4*)(lb + 384), w4B = *(const LAS f32x4*)(lb + 384 + 64), nbB = *(const LAS f32x4*)(lb + 384 + 128), kpB = *(const LAS f32x4*)(lb + 384 + 192), wrB = *(const LAS f32x4*)(lb + 384 + 256), tbB = *(const LAS f32x4*)(tbp + 384);
#pragma unroll
            for (int st = 0; st < TC; st += 2) {
                const int s2 = (st + 2 < TC) ? st + 2 : st, s3 = (st + 3 < TC) ? st + 3 : st + 1;
                float y;
                SCAN_STEP(kkA, w4A, nbA, kpA, wrA, tbA, y);
                yacc = (kq == (st & 15)) ? y : yacc;
                kkA = *(const LAS f32x4*)(lb + s2 * 384); w4A = *(const LAS f32x4*)(lb + s2 * 384 + 64); nbA = *(const LAS f32x4*)(lb + s2 * 384 + 128);
                kpA = *(const LAS f32x4*)(lb + s2 * 384 + 192); wrA = *(const LAS f32x4*)(lb + s2 * 384 + 256); tbA = *(const LAS f32x4*)(tbp + s2 * 384);
                __builtin_amdgcn_sched_barrier(0);
                SCAN_STEP(kkB, w4B, nbB, kpB, wrB, tbB, y);
                yacc = (kq == ((st + 1) & 15)) ? y : yacc;
                if (((st + 1) & 15) == 15) y0[(size_t)(c * TC + st + 1 - 15 + kq) * RW + vrow] = yacc;
                kkB = *(const LAS f32x4*)(lb + s3 * 384); w4B = *(const LAS f32x4*)(lb + s3 * 384 + 64); nbB = *(const LAS f32x4*)(lb + s3 * 384 + 128);
                kpB = *(const LAS f32x4*)(lb + s3 * 384 + 192); wrB = *(const LAS f32x4*)(lb + s3 * 384 + 256); tbB = *(const LAS f32x4*)(tbp + s3 * 384);
                __builtin_amdgcn_sched_barrier(0);
            }
            SCAN_BAR();
        }
    }
    __syncthreads();
    if (scanner) *(f32x4*)(s_out + (size_t)vrow * 64 + 4 * kq) = (f32x4){s01.x, s01.y, s23.x, s23.y};
}
__device__ __forceinline__ void scan_sample_witem(Frame& F, int item) {
    const int dbh = item >> 4, r4 = item & 15, db = dbh >> 4, h = dbh & 15;
    const int ri = F.lane >> 4, kq = F.lane & 15, vrow = r4 * 4 + ri;
    const size_t so = (size_t)NB * RH * SEQ + (size_t)dbh * DT;
    const float* sin = WSP(float, WS_SCANIN) + so * 384; const float* scal = WSP(float, WS_SCAL) + so * 16;
    const f32x4 s0 = *(const f32x4*)(F.in[I_SWKV] + (size_t)dbh * 4096 + (size_t)vrow * 64 + 4 * kq);
    f32x2 s01 = (f32x2){s0.x, s0.y}, s23 = (f32x2){s0.z, s0.w};
    f32x4 kk[DT], w4[DT], nb[DT], kp[DT], wr[DT], tb[DT];
#pragma unroll
    for (int st = 0; st < DT; ++st) { const float* p = sin + st * 384 + 4 * kq;
        kk[st] = *(const f32x4*)(p); w4[st] = *(const f32x4*)(p + 64); nb[st] = *(const f32x4*)(p + 128); kp[st] = *(const f32x4*)(p + 192); wr[st] = *(const f32x4*)(p + 256);
        const f32x2 sc = *(const f32x2*)(scal + st * 16); tb[st] = (f32x4){sin[st * 384 + 320 + vrow], sc.x, sc.y, 0.f}; }
    float* y0 = WSP(float, WS_Y) + (size_t)(NTOKP + db * DT) * RW + h * 64 + vrow;
#pragma unroll
    for (int st = 0; st < DT; ++st) { float y; SCAN_STEP(kk[st], w4[st], nb[st], kp[st], wr[st], tb[st], y); if (kq == 0) y0[(size_t)st * RW] = y; }
    *(f32x4*)(F.out + O_WKVS + (size_t)dbh * 4096 + (size_t)vrow * 64 + 4 * kq) = (f32x4){s01.x, s01.y, s23.x, s23.y};
}
__device__ __forceinline__ void p3_scan_phase(Frame& F) {
    const int gw = F.bid * NWAVES + F.wave, NGW = F.G * NWAVES;
    for (int it = gw; it < DB * RH * 16; it += NGW) scan_sample_witem(F, it);
    const float* SI = WSP(float, WS_SCANIN); const float* SL = WSP(float, WS_SCAL); float* Y = WSP(float, WS_Y);
    for (int it0 = F.bid; it0 < 256; it0 += F.G) { const int it = (F.G == 256) ? ((it0 & 7) * 32 + (it0 >> 3)) : it0;
        const int bh = it >> 2, rg = it & 3, b = bh >> 4, h = bh & 15;
        scan_prompt_item(F, SI + (size_t)bh * SEQ * 384, SL + (size_t)bh * SEQ * 16, F.out + O_WKVP + (size_t)bh * 4096, Y + (size_t)(b * SEQ) * RW + h * 64, rg); }
}

__device__ __forceinline__ void gn_row(Frame& F, int row) {
    const int lane = F.lane, h = lane >> 2, q = lane & 3, c0 = h * 64 + q * 16;
    const float* y = WSP(float, WS_Y) + (size_t)row * RW + c0;
    f32x4 v[4]; float s = 0.f;
#pragma unroll
    for (int j = 0; j < 4; ++j) { v[j] = *(const f32x4*)(y + 4 * j); s += (v[j].x + v[j].y) + (v[j].z + v[j].w); }
    s += dpp<0xB1>(s); s += dpp<0x4E>(s);
    const float mean = s * (1.f / 64.f); float s2 = 0.f;
#pragma unroll
    for (int j = 0; j < 4; ++j) { v[j] = v[j] - mean; s2 += (v[j].x * v[j].x + v[j].y * v[j].y) + (v[j].z * v[j].z + v[j].w * v[j].w); }
    s2 += dpp<0xB1>(s2); s2 += dpp<0x4E>(s2);
    const float rstd = 1.f / sqrtf(s2 * (1.f / 64.f) + GN_EPS);
    const size_t so = scan_seq_off(row, h);
    const float bonus = WSP(float, WS_SCAL)[so * 16 + 2];
    const float* vv = WSP(float, WS_SCANIN) + so * 384 + 5 * 64 + q * 16;
    const float* g = WSP(float, WS_PROJ) + (size_t)row * INWP + C_GR + c0;
    const float* gw = F.in[I_GNW] + c0; const float* gb = F.in[I_GNB] + c0;
    bf16* o = WSP(bf16, WS_YMIX) + (size_t)row * DM + c0;
#pragma unroll
    for (int j = 0; j < 4; ++j) { const f32x4 w4 = *(const f32x4*)(gw + 4 * j), b4 = *(const f32x4*)(gb + 4 * j), v4 = *(const f32x4*)(vv + 4 * j), g4 = *(const f32x4*)(g + 4 * j);
        const float o0 = (v[j].x * rstd * w4.x + b4.x + bonus * v4.x) * silu(g4.x), o1 = (v[j].y * rstd * w4.y + b4.y + bonus * v4.y) * silu(g4.y);
        const float o2 = (v[j].z * rstd * w4.z + b4.z + bonus * v4.z) * silu(g4.z), o3 = (v[j].w * rstd * w4.w + b4.w + bonus * v4.w) * silu(g4.w);
        v2u pk; pk.x = cvt_pk_bf16(o0, o1); pk.y = cvt_pk_bf16(o2, o3); *(v2u*)(o + 4 * j) = pk; }
}
__device__ __forceinline__ void idx_afrag(const bf16* QIB, int row0, int lane, bf16x8 (&af)[4]) {
    const int r = lane & 31, hh = lane >> 5;
    const bf16* p = QIB + (size_t)(row0 + ((r >> 2) & 1)) * 1024 + ((r >> 3) * 4 + (r & 3)) * 64 + 8 * hh;
#pragma unroll
    for (int ks = 0; ks < 4; ++ks) af[ks] = *(const bf16x8*)(p + 16 * ks);
}
__device__ __forceinline__ float idx_reduce(const f32x16& acc, const f32x4 (&w)[4]) {
    float v = 0.f;
#pragma unroll
    for (int j = 0; j < 16; ++j) v += w[j >> 2][j & 3] * fmaxf(acc[j], 0.f);
    return v;
}
__device__ __forceinline__ void d1_prompt_item(Frame& F, int item) {
    const int idx = item & 255, second = item >> 8, b = idx >> 6, qi = idx & 63, qt = second ? 127 - qi : qi;
    const int t0 = qt * 16 + 2 * F.wave, row0 = b * SEQ + t0;
    const int r = F.lane & 31, hh = F.lane >> 5;
    bf16x8 af[4]; idx_afrag(WSP(bf16, WS_QIB), row0, F.lane, af);
    f32x4 w[4];
#pragma unroll
    for (int j = 0; j < 4; ++j) w[j] = *(const f32x4*)(WSP(float, WS_WIS) + (size_t)(row0 + hh) * 16 + 4 * j);
    const int tq = t0 + hh;
    const bf16* KIB = WSP(bf16, WS_KIB) + (size_t)(b * SEQ) * 64;
    float* SC = WSP(float, WS_SC) + (size_t)(b * SEQ + tq) * SEQ;
    for (int s0 = 0; s0 <= t0 + 1; s0 += 32) {
        f32x16 acc;
#pragma unroll
        for (int j = 0; j < 16; ++j) acc[j] = 0.f;
#pragma unroll
        for (int ks = 0; ks < 4; ++ks) { const bf16x8 bfr = *(const bf16x8*)(KIB + (size_t)(s0 + r) * 64 + 16 * ks + 8 * hh);
            acc = __builtin_amdgcn_mfma_f32_32x32x16_bf16(af[ks], bfr, acc, 0, 0, 0); }
        SC[s0 + r] = idx_reduce(acc, w);
    }
}
__device__ __forceinline__ void d1_sample_item(Frame& F, int item) {
    const int r = F.lane & 31, hh = F.lane >> 5;
    int db, p = 0; bool newk = false;
    if (item < DB * NPAGES) { db = item >> 6; p = item & 63; } else { db = item - DB * NPAGES; newk = true; }
    const int row0 = NTOKP + db * DT;
    bf16x8 af0[4], af1[4]; idx_afrag(WSP(bf16, WS_QIB), row0, F.lane, af0); idx_afrag(WSP(bf16, WS_QIB), row0 + 2, F.lane, af1);
    f32x4 w0[4], w1[4];
#pragma unroll
    for (int j = 0; j < 4; ++j) { w0[j] = *(const f32x4*)(WSP(float, WS_WIS) + (size_t)(row0 + hh) * 16 + 4 * j); w1[j] = *(const f32x4*)(WSP(float, WS_WIS) + (size_t)(row0 + 2 + hh) * 16 + 4 * j); }
    float* SCS = WSP(float, WS_SCS);
    if (!newk) {
        const int page = ((const int*)F.in[I_PT])[db * NPAGES + p];
        const float* kp = F.in[I_CKI] + ((size_t)page * PAGE + r) * 64 + 8 * hh;
        f32x4 ka[4][4], kc[4][4];
#pragma unroll
        for (int kt = 0; kt < 4; ++kt)
#pragma unroll
            for (int ks = 0; ks < 4; ++ks) { ka[kt][ks] = *(const f32x4*)(kp + (size_t)kt * 32 * 64 + 16 * ks); kc[kt][ks] = *(const f32x4*)(kp + (size_t)kt * 32 * 64 + 16 * ks + 4); }
#pragma unroll
        for (int kt = 0; kt < 4; ++kt) {
            f32x16 acc0, acc1;
#pragma unroll
            for (int j = 0; j < 16; ++j) { acc0[j] = 0.f; acc1[j] = 0.f; }
#pragma unroll
            for (int ks = 0; ks < 4; ++ks) { const f32x4 a = ka[kt][ks], c = kc[kt][ks];
                v4u u; u.x = cvt_pk_bf16(a.x, a.y); u.y = cvt_pk_bf16(a.z, a.w); u.z = cvt_pk_bf16(c.x, c.y); u.w = cvt_pk_bf16(c.z, c.w);
                const bf16x8 bfr = __builtin_bit_cast(bf16x8, u);
                acc0 = __builtin_amdgcn_mfma_f32_32x32x16_bf16(af0[ks], bfr, acc0, 0, 0, 0); acc1 = __builtin_amdgcn_mfma_f32_32x32x16_bf16(af1[ks], bfr, acc1, 0, 0, 0); }
            SCS[(size_t)(db * DT + hh) * SCS_LD + p * PAGE + kt * 32 + r] = idx_reduce(acc0, w0);
            SCS[(size_t)(db * DT + 2 + hh) * SCS_LD + p * PAGE + kt * 32 + r] = idx_reduce(acc1, w1);
        }
    } else {
        f32x16 acc0, acc1;
#pragma unroll
        for (int j = 0; j < 16; ++j) { acc0[j] = 0.f; acc1[j] = 0.f; }
        const bf16* kp = WSP(bf16, WS_KIB) + (size_t)(row0 + (r & 3)) * 64 + 8 * hh;
#pragma unroll
        for (int ks = 0; ks < 4; ++ks) { bf16x8 bfr = *(const bf16x8*)(kp + 16 * ks);
            acc0 = __builtin_amdgcn_mfma_f32_32x32x16_bf16(af0[ks], bfr, acc0, 0, 0, 0); acc1 = __builtin_amdgcn_mfma_f32_32x32x16_bf16(af1[ks], bfr, acc1, 0, 0, 0); }
        if (r < 4) { SCS[(size_t)(db * DT + hh) * SCS_LD + PAST + r] = idx_reduce(acc0, w0); SCS[(size_t)(db * DT + 2 + hh) * SCS_LD + PAST + r] = idx_reduce(acc1, w1); }
    }
}
__device__ __forceinline__ void d2_sample_block(Frame& F, int q);
__device__ __forceinline__ void p4_phase(Frame& F) {
    const int gw = F.bid * NWAVES + F.wave, NGW = F.G * NWAVES;
    if (F.G >= 64) {
        for (int q = F.bid; q < NTOKS; q += F.G) d2_sample_block(F, q);
    } else {
        for (int it = gw; it < DB * NPAGES + DB; it += NGW) d1_sample_item(F, it);
    }
    for (int row = gw; row < NTOK; row += NGW) gn_row(F, row);
}

__device__ __forceinline__ unsigned wave_count(unsigned c) {
#pragma unroll
    for (int o = 1; o < 64; o <<= 1) c += __shfl_xor((int)c, o);
    return c;
}
template <int NV>
__device__ __forceinline__ void kth_select(const unsigned (&key)[NV * 4], unsigned xk, int xbase, int lane, unsigned& T_out, unsigned& cut_out) {
    unsigned T = 0u; bool exact = false;
    for (int bit = 31; bit >= 0; --bit) {
        const unsigned cand = T | (1u << bit);
        unsigned c = (xk >= cand) ? 1u : 0u;
#pragma unroll
        for (int i = 0; i < NV * 4; ++i) c += (key[i] >= cand) ? 1u : 0u;
        c = wave_count(c);
        if (c >= (unsigned)TOPK) T = cand;
        if (c == (unsigned)TOPK) { exact = true; break; }
    }
    unsigned cut = 0x7fffffffu;
    if (!exact) {
        unsigned cg = (xk > T) ? 1u : 0u, ce = (xk == T) ? 1u : 0u;
#pragma unroll
        for (int i = 0; i < NV * 4; ++i) { cg += (key[i] > T) ? 1u : 0u; ce += (key[i] == T) ? 1u : 0u; }
        cg = wave_count(cg); ce = wave_count(ce);
        const unsigned need = (unsigned)TOPK - cg;
        if (ce > need) {
            unsigned I = 0u;
            for (int bit = 14; bit >= 0; --bit) {
                const unsigned cand = I | (1u << bit);
                unsigned c = (xk == T && (unsigned)(xbase + lane) < cand && lane < 4) ? 1u : 0u;
#pragma unroll
                for (int i = 0; i < NV * 4; ++i) { const unsigned idx = 256u * (i >> 2) + 4u * lane + (i & 3); c += (key[i] == T && idx < cand) ? 1u : 0u; }
                c = wave_count(c);
                if (c < need) I = cand;
            }
            cut = I;
        }
    }
    T_out = T; cut_out = cut;
}
__device__ __forceinline__ void d2_prompt_row(Frame& F, int row) {
    const int t = row & 2047, lane = F.lane;
    unsigned* THR = WSP(unsigned, WS_THR) + (size_t)row * 2;
    if (t < TOPK) { if (lane == 0) { THR[0] = 0u; THR[1] = 0x7fffffffu; } return; }
    const float* SC = WSP(float, WS_SC) + (size_t)row * SEQ;
    unsigned key[32];
#pragma unroll
    for (int j = 0; j < 8; ++j) { const int i0 = 256 * j + 4 * lane;
        if (i0 <= t) { const f32x4 v = *(const f32x4*)(SC + i0);
            key[4 * j + 0] = sort_key(v.x); key[4 * j + 1] = (i0 + 1 <= t) ? sort_key(v.y) : 0u; key[4 * j + 2] = (i0 + 2 <= t) ? sort_key(v.z) : 0u; key[4 * j + 3] = (i0 + 3 <= t) ? sort_key(v.w) : 0u; }
        else { key[4 * j + 0] = 0u; key[4 * j + 1] = 0u; key[4 * j + 2] = 0u; key[4 * j + 3] = 0u; } }
    unsigned T, cut; kth_select<8>(key, 0u, 1 << 20, lane, T, cut);
    if (lane == 0) { THR[0] = T; THR[1] = cut; }
}
__device__ __forceinline__ void d2_sample_block(Frame& F, int q) {
    const int t = q & 3, tid = F.tid, lane = F.lane;
    const float* SCS = WSP(float, WS_SCS) + (size_t)q * SCS_LD;
    LAS unsigned* red = (LAS unsigned*)(F.lds + RING_OFF);
    unsigned key[16];
#pragma unroll
    for (int j = 0; j < 4; ++j) { const f32x4 v = *(const f32x4*)(SCS + 2048 * j + 4 * tid);
        key[4 * j + 0] = sort_key(v.x); key[4 * j + 1] = sort_key(v.y); key[4 * j + 2] = sort_key(v.z); key[4 * j + 3] = sort_key(v.w); }
    unsigned xk = 0u; if (tid <= t) xk = sort_key(SCS[PAST + tid]);
    if (tid == 0) red[16] = 0u;
    unsigned T = 0u; bool exact = false; int par = 0;
    for (int bit = 31; bit >= 0; --bit) {
        const unsigned cand = T | (1u << bit);
        unsigned c = (xk >= cand) ? 1u : 0u;
#pragma unroll
        for (int i = 0; i < 16; ++i) c += (key[i] >= cand) ? 1u : 0u;
        c = wave_count(c);
        if (lane == 0) red[par * 8 + F.wave] = c;
        __syncthreads();
        unsigned tot = 0u;
#pragma unroll
        for (int w = 0; w < 8; ++w) tot += red[par * 8 + w];
        par ^= 1;
        if (tot >= (unsigned)TOPK) T = cand;
        if (tot == (unsigned)TOPK) { exact = true; break; }
    }
    unsigned cut = 0x7fffffffu;
    if (!exact) {
        unsigned cg = (xk > T) ? 1u : 0u, ce = (xk == T) ? 1u : 0u;
#pragma unroll
        for (int i = 0; i < 16; ++i) { cg += (key[i] > T) ? 1u : 0u; ce += (key[i] == T) ? 1u : 0u; }
        cg = wave_count(cg); ce = wave_count(ce);
        if (lane == 0) red[par * 8 + F.wave] = (cg << 16) | ce;
        __syncthreads();
        unsigned tg = 0u, te = 0u;
#pragma unroll
        for (int w = 0; w < 8; ++w) { const unsigned v = red[par * 8 + w]; tg += v >> 16; te += v & 0xffffu; }
        par ^= 1;
        const unsigned need = (unsigned)TOPK - tg;
        if (te > need) {
            unsigned I = 0u;
            for (int bit = 14; bit >= 0; --bit) {
                const unsigned cand = I | (1u << bit);
                unsigned c = (xk == T && tid < 4 && (unsigned)(PAST + tid) < cand) ? 1u : 0u;
#pragma unroll
                for (int i = 0; i < 16; ++i) { const unsigned idx = 2048u * (i >> 2) + 4u * tid + (i & 3); c += (key[i] == T && idx < cand) ? 1u : 0u; }
                c = wave_count(c);
                if (lane == 0) red[par * 8 + F.wave] = c;
                __syncthreads();
                unsigned tot = 0u;
#pragma unroll
                for (int w = 0; w < 8; ++w) tot += red[par * 8 + w];
                par ^= 1;
                if (tot < need) I = cand;
            }
            cut = I;
        }
    }
    __syncthreads();
    int* IDX = WSP(int, WS_IDX) + (size_t)q * TOPK;
#pragma unroll
    for (int i = 0; i < 16; ++i) { const int idx = 2048 * (i >> 2) + 4 * tid + (i & 3);
        if (key[i] > T || (key[i] == T && (unsigned)idx <= cut)) { const unsigned pos = atomicAdd((unsigned*)&red[16], 1u); if (pos < (unsigned)TOPK) IDX[pos] = idx; } }
    if (tid <= t) { const int idx = PAST + tid; if (xk > T || (xk == T && (unsigned)idx <= cut)) { const unsigned pos = atomicAdd((unsigned*)&red[16], 1u); if (pos < (unsigned)TOPK) IDX[pos] = idx; } }
    __syncthreads();
}
__device__ __forceinline__ void p5_phase(Frame& F) {
    const int gw = F.bid * NWAVES + F.wave, NGW = F.G * NWAVES;
    for (int q = F.bid; q < NTOKS; q += F.G) d2_sample_block(F, q);
}

constexpr int DSA_MASK_OFF = RING_OFF;
constexpr int DSA_MERGE_OFF = RING_OFF + 8192;
__device__ __forceinline__ void cnt_ge(unsigned& c, unsigned k, unsigned cand) { asm volatile("v_cmp_ge_u32 vcc, %1, %2\n\tv_addc_co_u32 %0, vcc, 0, %0, vcc" : "+v"(c) : "v"(k), "v"(cand) : "vcc"); }
template <int CTRL> __device__ __forceinline__ unsigned dppu(unsigned x) { return (unsigned)__builtin_amdgcn_mov_dpp((int)x, CTRL, 0xf, 0xf, true); }
__device__ __forceinline__ unsigned half_sum_u(unsigned c) {
    c += dppu<0xB1>(c); c += dppu<0x4E>(c); c += dppu<0x141>(c); c += dppu<0x140>(c);
    auto s2 = __builtin_amdgcn_permlane16_swap(c, c, false, false);
    return s2[0] + s2[1];
}
template <bool MASKED>
__device__ __forceinline__ void attn_core(Frame& F, int row0, int nkt, int NT, const bf16* Qb, const bf16* Kf  , const bf16* Vf  , int gate_col, int out_col) {
    const int lane = F.lane, r = lane & 31, hh = lane >> 5, h = F.wave & 3, half = F.wave >> 2;
    const LAS unsigned* mask = (const LAS unsigned*)(F.lds + DSA_MASK_OFF) + r * 64;
    bf16x8 qf[8];
#pragma unroll
    for (int ks = 0; ks < 8; ++ks) qf[ks] = *(const bf16x8*)(Qb + (size_t)(row0 + r) * 512 + h * 128 + 16 * ks + 8 * hh);
    f32x16 o[4];
#pragma unroll
    for (int d = 0; d < 4; ++d)
#pragma unroll
        for (int j = 0; j < 16; ++j) o[d][j] = 0.f;
    float m = -INFINITY, lsum = 0.f;
    const bf16* kbase = Kf + (size_t)(h * NT) * 4096 + lane * 8;
    const bf16* vbase = Vf + (size_t)(h * NT) * 4096 + lane * 8;
    bf16x8 kf[8];
    if (half < nkt) {
#pragma unroll
        for (int ks = 0; ks < 8; ++ks) kf[ks] = *(const bf16x8*)(kbase + (size_t)half * 4096 + ks * 512);
    }
    for (int kt = half; kt < nkt; kt += 2) {
        bf16x8 vf[4][2];
#pragma unroll
        for (int d = 0; d < 4; ++d)
#pragma unroll
            for (int s = 0; s < 2; ++s) vf[d][s] = *(const bf16x8*)(vbase + (size_t)kt * 4096 + (d * 2 + s) * 512);
        f32x16 x;
#pragma unroll
        for (int j = 0; j < 16; ++j) x[j] = 0.f;
#pragma unroll
        for (int ks = 0; ks < 8; ++ks) x = __builtin_amdgcn_mfma_f32_32x32x16_bf16(kf[ks], qf[ks], x, 0, 0, 0);
        {
            const int ktn = (kt + 2 < nkt) ? kt + 2 : kt;
#pragma unroll
            for (int ks = 0; ks < 8; ++ks) kf[ks] = *(const bf16x8*)(kbase + (size_t)ktn * 4096 + ks * 512);
        }
        if (MASKED) {
            const unsigned m4 = mask[kt] >> (4 * hh);
#pragma unroll
            for (int g = 0; g < 4; ++g)
#pragma unroll
                for (int e = 0; e < 4; ++e) { const unsigned t = (unsigned)((int)(m4 << (31 - (8 * g + e))) >> 31);
                    x[4 * g + e] = __uint_as_float((__float_as_uint(x[4 * g + e]) & t) | (0xff800000u & ~t)); }
        }
        float mx = x[0];
#pragma unroll
        for (int j = 1; j < 16; ++j) mx = fmaxf(mx, x[j]);
        mx = xhalf_max(mx);
        const float mn = fmaxf(m, mx), mu = (mn == -INFINITY) ? 0.f : mn;
        const float alpha = __builtin_amdgcn_exp2f(m - mu);
        m = mn;
        float ls = 0.f;
#pragma unroll
        for (int j = 0; j < 16; ++j) { x[j] = __builtin_amdgcn_exp2f(x[j] - mu); ls += x[j]; }
        lsum = lsum * alpha + ls;
        if (__any(alpha != 1.f)) {
#pragma unroll
            for (int d = 0; d < 4; ++d)
#pragma unroll
                for (int j = 0; j < 16; ++j) o[d][j] *= alpha;
        }
        bf16x8 pf[2];
#pragma unroll
        for (int s = 0; s < 2; ++s) { v4u u; u.x = cvt_pk_bf16(x[8 * s + 0], x[8 * s + 1]); u.y = cvt_pk_bf16(x[8 * s + 2], x[8 * s + 3]); u.z = cvt_pk_bf16(x[8 * s + 4], x[8 * s + 5]); u.w = cvt_pk_bf16(x[8 * s + 6], x[8 * s + 7]);
            pf[s] = __builtin_bit_cast(bf16x8, u); }
#pragma unroll
        for (int d = 0; d < 4; ++d)
#pragma unroll
            for (int s = 0; s < 2; ++s) o[d] = __builtin_amdgcn_mfma_f32_32x32x16_bf16(vf[d][s], pf[s], o[d], 0, 0, 0);
    }
    lsum = xhalf_sum(lsum);
    LAS float* mg = (LAS float*)(F.lds + DSA_MERGE_OFF) + h * 66 * 64;
    if (half == 1) {
        mg[0 * 64 + lane] = m; mg[1 * 64 + lane] = lsum;
#pragma unroll
        for (int d = 0; d < 4; ++d)
#pragma unroll
            for (int j = 0; j < 16; ++j) mg[(2 + d * 16 + j) * 64 + lane] = o[d][j];
    }
    __syncthreads();
    if (half == 0) {
        const float m1 = mg[0 * 64 + lane], l1 = mg[1 * 64 + lane];
        const float mn = fmaxf(m, m1), mu = (mn == -INFINITY) ? 0.f : mn;
        const float a0 = __builtin_amdgcn_exp2f(m - mu), a1 = __builtin_amdgcn_exp2f(m1 - mu);
        const float l = lsum * a0 + l1 * a1; const float inv = l > 0.f ? 1.f / l : 0.f;
        const float* gp = WSP(float, WS_PROJ) + (size_t)(row0 + r) * INWP + gate_col + h * 128;
        bf16* op = WSP(bf16, WS_YMIX) + (size_t)(row0 + r) * DM + out_col + h * 128;
#pragma unroll
        for (int d = 0; d < 4; ++d)
#pragma unroll
            for (int g = 0; g < 4; ++g) { const int dd = d * 32 + 8 * g + 4 * hh; const f32x4 gv = *(const f32x4*)(gp + dd);
                float v[4];
#pragma unroll
                for (int e = 0; e < 4; ++e) v[e] = (o[d][4 * g + e] * a0 + mg[(2 + d * 16 + 4 * g + e) * 64 + lane] * a1) * inv * silu(gv[e]);
                v2u pk; pk.x = cvt_pk_bf16(v[0], v[1]); pk.y = cvt_pk_bf16(v[2], v[3]); *(v2u*)(op + dd) = pk; }
    }
    __syncthreads();
}
__device__ __forceinline__ void dsa_prompt_item(Frame& F, int b, int qt) {
    const int t0 = qt * 32, row0 = b * SEQ + t0, nkt = qt + 1;
    LAS unsigned* mask = (LAS unsigned*)(F.lds + DSA_MASK_OFF);
    if (t0 + 31 < TOPK) {
        for (int i = F.tid; i < 32 * 64; i += NTHR) { const int q = i >> 6, kt = i & 63; const int nb = t0 + q - 32 * kt + 1;
            mask[i] = nb >= 32 ? 0xffffffffu : (nb <= 0 ? 0u : ((1u << nb) - 1u)); }
    } else {
        const int lane = F.lane, r = lane & 31, hh = lane >> 5;
        int r4 = 4 * r; asm volatile("" : "+v"(r4));
        const bf16* KIB = WSP(bf16, WS_SC) + (size_t)(b * SEQ) * 64 + lane * 8;
        LAS unsigned* skl = (LAS unsigned*)(F.lds + DSA_MASK_OFF + 8192) + F.wave * 4096 + hh * 2048;
        for (int i = F.tid; i < 32 * 64; i += NTHR) mask[i] = 0u;
        __syncthreads();
        for (int pass = 0; pass < 2; ++pass) {
            const int q0 = 16 * pass + 2 * F.wave, tq = t0 + q0 + hh;
            {
                bf16x8 af[4]; idx_afrag(WSP(bf16, WS_QIB), row0 + q0, lane, af);
                f32x4 w[4];
#pragma unroll
                for (int j = 0; j < 4; ++j) w[j] = *(const f32x4*)(WSP(float, WS_WIS) + (size_t)(row0 + q0 + hh) * 16 + 4 * j);
                bf16x8 ring[4][4];
#pragma unroll
                for (int i = 0; i < 3; ++i) { const int ktc = i < nkt ? i : nkt - 1;
#pragma unroll
                    for (int ks = 0; ks < 4; ++ks) ring[i][ks] = *(const bf16x8*)(KIB + (size_t)ktc * 2048 + ks * 512); }
                for (int kt0 = 0; kt0 < nkt; kt0 += 4) {
#pragma unroll
                    for (int i = 0; i < 4; ++i) {
                        const int kt = kt0 + i, ktp = (kt + 3 < nkt) ? kt + 3 : nkt - 1;
#pragma unroll
                        for (int ks = 0; ks < 4; ++ks) ring[(i + 3) & 3][ks] = *(const bf16x8*)(KIB + (size_t)ktp * 2048 + ks * 512);
                        f32x16 acc;
#pragma unroll
                        for (int j = 0; j < 16; ++j) acc[j] = 0.f;
#pragma unroll
                        for (int ks = 0; ks < 4; ++ks) acc = __builtin_amdgcn_mfma_f32_32x32x16_bf16(af[ks], ring[i][ks], acc, 0, 0, 0);
                        if (kt < nkt) skl[kt * 32 + r] = sort_key(idx_reduce(acc, w));
                    }
                }
            }
            asm volatile("s_waitcnt lgkmcnt(0)" ::: "memory");
            unsigned sk[64];
            int tqr = tq - r4; asm volatile("" : "+v"(tqr));
#pragma unroll
            for (int i = 0; i < 16; ++i) { const v4u v = *(const LAS v4u*)(skl + 128 * i + r4);
                sk[4 * i + 0] = (128 * i + 0 <= tqr) ? v.x : 0u; sk[4 * i + 1] = (128 * i + 1 <= tqr) ? v.y : 0u; sk[4 * i + 2] = (128 * i + 2 <= tqr) ? v.z : 0u; sk[4 * i + 3] = (128 * i + 3 <= tqr) ? v.w : 0u; }
            unsigned T = 0u; bool exact = false;
            for (int bit = 31; bit >= 0; --bit) {
                const unsigned cand = T | (1u << bit);
                unsigned c = 0u;
#pragma unroll
                for (int i = 0; i < 64; ++i) cnt_ge(c, sk[i], cand);
                c = half_sum_u(c);
                if (!exact) { if (c >= (unsigned)TOPK) T = cand; if (c == (unsigned)TOPK) exact = true; }
                if (__all(exact)) break;
            }
            unsigned cut = 0x7fffffffu;
            if (__any(!exact)) {
                unsigned cg = 0u, ce = 0u;
                for (int i = 0; i < 16; ++i) { const v4u v = *(const LAS v4u*)(skl + 128 * i + r4); const int i0 = 128 * i + r4;
#pragma unroll
                    for (int e = 0; e < 4; ++e) { const unsigned k = (i0 + e <= tq) ? v[e] : 0u; cg += (k > T) ? 1u : 0u; ce += (k == T) ? 1u : 0u; } }
                cg = half_sum_u(cg); ce = half_sum_u(ce);
                const unsigned need = (unsigned)TOPK - cg;
                const bool tie = !exact && ce > need;
                unsigned I = 0u;
                for (int bit = 11; bit >= 0; --bit) {
                    const unsigned cand = I | (1u << bit);
                    unsigned c = 0u;
                    for (int i = 0; i < 16; ++i) { const v4u v = *(const LAS v4u*)(skl + 128 * i + r4); const int i0 = 128 * i + r4;
#pragma unroll
                        for (int e = 0; e < 4; ++e) { const unsigned k = (i0 + e <= tq) ? v[e] : 0u; c += (k == T && (unsigned)(i0 + e) < cand) ? 1u : 0u; } }
                    c = half_sum_u(c);
                    if (c < need) I = cand;
                }
                if (tie) cut = I;
            }
            int cutr = (int)cut - r4; asm volatile("" : "+v"(cutr));
#pragma unroll
            for (int i = 0; i < 16; ++i) {
                unsigned nib = 0u;
#pragma unroll
                for (int e = 0; e < 4; ++e) { const unsigned k = sk[4 * i + e]; const bool sel = k != 0u && (k > T || (k == T && (128 * i + e) <= cutr)); nib |= sel ? (1u << e) : 0u; }
                if (nib) __hip_atomic_fetch_or((LAS unsigned*)&mask[(q0 + hh) * 64 + 4 * i + (r >> 3)], nib << (4 * (r & 7)), __ATOMIC_RELAXED, __HIP_MEMORY_SCOPE_WORKGROUP);
            }
        }
    }
    __syncthreads();
#ifndef T_NOCORE
    attn_core<true>(F, row0, nkt, 64, WSP(bf16, WS_QB), WSP(bf16, WS_KB) + (size_t)b * SEQ * 512, WSP(bf16, WS_VT) + (size_t)b * 512 * SEQ, C_GA, 1024);
#endif
}
__device__ __forceinline__ void gather_attn_item(Frame& F, int q, bool dsa) {
    const int lane = F.lane, hd = lane >> 4, d0 = (lane & 15) * 8, db = q >> 2, row = NTOKP + q;
    LAS float* red = (LAS float*)(F.lds + RING_OFF);
    LAS float* racc = red + 64;
    const float* kptr; const float* vptr;
    {
        const int ki = F.wave * 32 + (lane & 31);
        if (dsa) { const int idx = WSP(int, WS_IDX)[(size_t)q * TOPK + ki];
            if (idx < PAST) { const size_t phys = (size_t)((const int*)F.in[I_PT])[db * NPAGES + (idx >> 7)] * PAGE + (idx & 127); kptr = F.in[I_CK] + phys * 512; vptr = F.in[I_CV] + phys * 512; }
            else { const int j = idx - PAST; kptr = F.out + O_KS + (size_t)(db * DT + j) * 512; vptr = F.out + O_VS + (size_t)(db * DT + j) * 512; } }
        else { kptr = F.in[I_CMK] + (size_t)(db * MEMT + ki) * 512; vptr = F.in[I_CMV] + (size_t)(db * MEMT + ki) * 512; }
    }
    const bf16* qb = (dsa ? WSP(bf16, WS_QB) : WSP(bf16, WS_QMB)) + (size_t)row * 512 + hd * 128 + d0;
    float qv[8];
    { const v4u u = *(const v4u*)qb; qv[0] = __uint_as_float(u.x << 16); qv[1] = __uint_as_float(u.x & 0xffff0000u); qv[2] = __uint_as_float(u.y << 16); qv[3] = __uint_as_float(u.y & 0xffff0000u);
      qv[4] = __uint_as_float(u.z << 16); qv[5] = __uint_as_float(u.z & 0xffff0000u); qv[6] = __uint_as_float(u.w << 16); qv[7] = __uint_as_float(u.w & 0xffff0000u); }
    LAS float* sl = racc + 8 * 8 * 64 + F.wave * 128;
    float mx = -INFINITY;
#pragma unroll 16
    for (int i = 0; i < 32; ++i) {
        const unsigned long long pk = (unsigned long long)kptr;
        const unsigned lo = __shfl((int)(unsigned)pk, i), hi = __shfl((int)(unsigned)(pk >> 32), i);
        const float* kr = (const float*)(((unsigned long long)hi << 32) | lo) + hd * 128 + d0;
        const f32x4 a = *(const f32x4*)kr, c = *(const f32x4*)(kr + 4);
        float s = (a.x * qv[0] + a.y * qv[1]) + (a.z * qv[2] + a.w * qv[3]) + (c.x * qv[4] + c.y * qv[5]) + (c.z * qv[6] + c.w * qv[7]);
        s = row16_sum(s); mx = fmaxf(mx, s);
        if ((lane & 15) == 0) sl[i * 4 + hd] = s;
    }
    if ((lane & 15) == 0) red[F.wave * 4 + hd] = mx;
    __syncthreads();
    float gm = red[hd];
#pragma unroll
    for (int w = 1; w < 8; ++w) gm = fmaxf(gm, red[w * 4 + hd]);
    __syncthreads();
    float acc[8]; float ls = 0.f;
#pragma unroll
    for (int e = 0; e < 8; ++e) acc[e] = 0.f;
#pragma unroll 16
    for (int i = 0; i < 32; ++i) {
        const unsigned long long pv = (unsigned long long)vptr;
        const unsigned lo = __shfl((int)(unsigned)pv, i), hi = __shfl((int)(unsigned)(pv >> 32), i);
        const float* vr = (const float*)(((unsigned long long)hi << 32) | lo) + hd * 128 + d0;
        const f32x4 a = *(const f32x4*)vr, c = *(const f32x4*)(vr + 4);
        const float p = exp2f(sl[i * 4 + hd] - gm); ls += p;
        acc[0] += p * a.x; acc[1] += p * a.y; acc[2] += p * a.z; acc[3] += p * a.w; acc[4] += p * c.x; acc[5] += p * c.y; acc[6] += p * c.z; acc[7] += p * c.w;
    }
    if ((lane & 15) == 0) red[F.wave * 4 + hd] = ls;
#pragma unroll
    for (int e = 0; e < 8; ++e) racc[(F.wave * 8 + e) * 64 + lane] = acc[e];
    __syncthreads();
    if (F.wave == 0) {
        float l = 0.f;
#pragma unroll
        for (int w = 0; w < 8; ++w) l += red[w * 4 + hd];
        const float inv = 1.f / l;
        const float* gp = WSP(float, WS_PROJ) + (size_t)row * INWP + (dsa ? C_GA : C_GM) + hd * 128 + d0;
        float v[8];
#pragma unroll
        for (int e = 0; e < 8; ++e) { float a = 0.f;
#pragma unroll
            for (int w = 0; w < 8; ++w) a += racc[(w * 8 + e) * 64 + lane];
            v[e] = a * inv * silu(gp[e]); }
        v4u pk; pk.x = cvt_pk_bf16(v[0], v[1]); pk.y = cvt_pk_bf16(v[2], v[3]); pk.z = cvt_pk_bf16(v[4], v[5]); pk.w = cvt_pk_bf16(v[6], v[7]);
        *(v4u*)(WSP(bf16, WS_YMIX) + (size_t)row * DM + (dsa ? 1024 : 1536) + hd * 128 + d0) = pk;
    }
    __syncthreads();
}
__device__ __forceinline__ void p6_phase(Frame& F) {
    { const int gt = F.bid * NTHR + F.tid, NGT = F.G * NTHR;
      for (int e = gt; e < NTOKS * DM / 4; e += NGT) *(f32x4*)(F.out + O_YS + (size_t)e * 4) = *(const f32x4*)(F.in[I_XS] + (size_t)e * 4); }
    if (F.G >= 64) { for (int it = F.bid; it < 256; it += F.G) gather_attn_item(F, it & 127, it < 128); return; }
    unsigned* qctr = (unsigned*)(F.ws + WS_CTL) + 8192;
    volatile LAS int* slot = (volatile LAS int*)(F.lds + LDSCTL_OFF + 64);
    for (;;) {
        if (F.tid == 0) *slot = (int)__hip_atomic_fetch_add(qctr, 1u, __ATOMIC_RELAXED, __HIP_MEMORY_SCOPE_AGENT);
        __syncthreads();
        const int it = *slot;
        __syncthreads();
        if (it >= 768) break;
        Frame Fi = F; asm volatile("" : "+v"(Fi.lane), "+v"(Fi.tid));
        if (it < 256) { const int b = it & 3, qt = 63 - (it >> 2); dsa_prompt_item(Fi, b, qt); }
        else if (it < 512) { const int j = it - 256; gather_attn_item(Fi, j & 127, j < 128); }
        else { const int j = it - 512, b = j >> 6, qt = j & 63;
            attn_core<false>(Fi, b * SEQ + qt * 32, 8, 8, WSP(bf16, WS_QMB), WSP(bf16, WS_MKB) + (size_t)b * MEMT * 512, WSP(bf16, WS_MVT) + (size_t)b * 512 * MEMT, C_GM, 1536); }
    }
}

constexpr int G4_RING_BYTES = 3 * (16 * 384 + 16 * 16) * 4;
constexpr int G4_MASK_OFF = 77824, G4_SKL_OFF = G4_MASK_OFF + 8192;
constexpr int G4_SLOT_OFF = LDSCTL_OFF + 128;
struct GBar { volatile LAS unsigned* cnt; unsigned target; };
__device__ __forceinline__ void gbar(GBar& g, int lane) {
    g.target += 4u;
    asm volatile("s_waitcnt lgkmcnt(0)" ::: "memory");
    if (lane == 0) __hip_atomic_fetch_add((LAS unsigned*)g.cnt, 1u, __ATOMIC_RELAXED, __HIP_MEMORY_SCOPE_WORKGROUP);
    unsigned sp = 0; while (*g.cnt < g.target) { __builtin_amdgcn_s_sleep(1); if (++sp > (1u << 24)) break; }
    asm volatile("" ::: "memory");
}
constexpr int S4_TC = 16, S4_NB = 3, S4_BUF_FLOATS = S4_TC * 384 + S4_TC * 16, S4_NCH = SEQ / S4_TC;
__device__ __forceinline__ void scan4_issue(LAS unsigned char* lds, const float* sin, const float* scal, int c, int sw, int lane) {
    LAS float* buf = (LAS float*)(lds + RING_OFF) + (c % S4_NB) * S4_BUF_FLOATS;
    const float* src = sin + (size_t)c * S4_TC * 384;
#pragma unroll
    for (int i = 0; i < 6; ++i) { const int piece = sw + 4 * i;
        __builtin_amdgcn_global_load_lds((const unsigned*)(src + piece * 256 + lane * 4), (LAS unsigned*)(buf + piece * 256), 16, 0, 0); }
    __builtin_amdgcn_global_load_lds((const unsigned*)(scal + (size_t)c * S4_TC * 16 + lane * 4), (LAS unsigned*)(buf + S4_TC * 384), 16, 0, 0);
}
__device__ __forceinline__ void scan4_item(Frame& F, GBar& gb, int b, int h, int rg, float* s_out, float* y0) {
    const int bh = b * RH + h, lane = F.lane, sw = F.wave;
    const float* sin = WSP(float, WS_SCANIN) + (size_t)bh * SEQ * 384; const float* scal = WSP(float, WS_SCAL) + (size_t)bh * SEQ * 16;
    const int ri = lane >> 4, kq = lane & 15, vrow = rg * 16 + sw * 4 + ri;
    f32x2 s01 = (f32x2){0.f, 0.f}, s23 = (f32x2){0.f, 0.f};
    scan4_issue(F.lds, sin, scal, 0, sw, lane); scan4_issue(F.lds, sin, scal, 1, sw, lane);
    for (int c = 0; c < S4_NCH; ++c) {
        if (c < 2 || c + 2 >= S4_NCH) asm volatile("s_waitcnt vmcnt(0)" ::: "memory");
        else asm volatile("s_waitcnt vmcnt(9)" ::: "memory");
        gbar(gb, lane);
        if (c + 2 < S4_NCH) scan4_issue(F.lds, sin, scal, c + 2, sw, lane);
        const LAS float* buf = (const LAS float*)(F.lds + RING_OFF) + (c % S4_NB) * S4_BUF_FLOATS;
        const LAS float* lb = buf + 4 * kq;
        const LAS float* vb = buf + 320 + vrow;
        const LAS float* sb = buf + S4_TC * 384;
        float yacc = 0.f;
#define S4_LOAD(ST, KK, W4, NB, KP, WR, TB) do { KK = *(const LAS f32x4*)(lb + (ST) * 384); W4 = *(const LAS f32x4*)(lb + (ST) * 384 + 64); NB = *(const LAS f32x4*)(lb + (ST) * 384 + 128); \
            KP = *(const LAS f32x4*)(lb + (ST) * 384 + 192); WR = *(const LAS f32x4*)(lb + (ST) * 384 + 256); const float _v = vb[(ST) * 384]; const f32x2 _s = *(const LAS f32x2*)(sb + (ST) * 16); \
            TB.x = _v; TB.y = _s.x; TB.z = _s.y; TB.w = 0.f; } while (0)
        f32x4 kkA, w4A, nbA, kpA, wrA, tbA, kkB, w4B, nbB, kpB, wrB, tbB;
        S4_LOAD(0, kkA, w4A, nbA, kpA, wrA, tbA); S4_LOAD(1, kkB, w4B, nbB, kpB, wrB, tbB);
#pragma unroll
        for (int st = 0; st < S4_TC; st += 2) {
            const int s2 = (st + 2 < S4_TC) ? st + 2 : st, s3 = (st + 3 < S4_TC) ? st + 3 : st + 1;
            float y;
            SCAN_STEP(kkA, w4A, nbA, kpA, wrA, tbA, y);
            yacc = (kq == st) ? y : yacc;
            S4_LOAD(s2, kkA, w4A, nbA, kpA, wrA, tbA);
            __builtin_amdgcn_sched_barrier(0);
            SCAN_STEP(kkB, w4B, nbB, kpB, wrB, tbB, y);
            yacc = (kq == st + 1) ? y : yacc;
            S4_LOAD(s3, kkB, w4B, nbB, kpB, wrB, tbB);
            __builtin_amdgcn_sched_barrier(0);
        }
#undef S4_LOAD
        y0[(size_t)(c * S4_TC + kq) * RW + vrow] = yacc;
    }
    *(f32x4*)(s_out + (size_t)vrow * 64 + 4 * kq) = (f32x4){s01.x, s01.y, s23.x, s23.y};
}
template <bool MASKED>
__device__ __forceinline__ void attn4(Frame& F, int gw, int row0, int nkt, int NT, const bf16* Qb, const bf16* Kf, const bf16* Vf, int gate_col, int out_col) {
    const int lane = F.lane, r = lane & 31, hh = lane >> 5, h = gw;
    const LAS unsigned* mask = (const LAS unsigned*)(F.lds + G4_MASK_OFF) + r * 64;
    bf16x8 qf[8];
#pragma unroll
    for (int ks = 0; ks < 8; ++ks) qf[ks] = *(const bf16x8*)(Qb + (size_t)(row0 + r) * 512 + h * 128 + 16 * ks + 8 * hh);
    f32x16 o[4];
#pragma unroll
    for (int d = 0; d < 4; ++d)
#pragma unroll
        for (int j = 0; j < 16; ++j) o[d][j] = 0.f;
    float m = -INFINITY, lsum = 0.f;
    const bf16* kbase = Kf + (size_t)(h * NT) * 4096 + lane * 8;
    const bf16* vbase = Vf + (size_t)(h * NT) * 4096 + lane * 8;
    bf16x8 kf[8];
#pragma unroll
    for (int ks = 0; ks < 8; ++ks) kf[ks] = *(const bf16x8*)(kbase + ks * 512);
#pragma unroll 1
    for (int kt = 0; kt < nkt; ++kt) {
        bf16x8 vf[4][2];
#pragma unroll
        for (int d = 0; d < 4; ++d)
#pragma unroll
            for (int s = 0; s < 2; ++s) vf[d][s] = *(const bf16x8*)(vbase + (size_t)kt * 4096 + (d * 2 + s) * 512);
        f32x16 x;
#pragma unroll
        for (int j = 0; j < 16; ++j) x[j] = 0.f;
#pragma unroll
        for (int ks = 0; ks < 8; ++ks) x = __builtin_amdgcn_mfma_f32_32x32x16_bf16(kf[ks], qf[ks], x, 0, 0, 0);
        {   const int ktn = (kt + 1 < nkt) ? kt + 1 : kt;
#pragma unroll
            for (int ks = 0; ks < 8; ++ks) kf[ks] = *(const bf16x8*)(kbase + (size_t)ktn * 4096 + ks * 512); }
        if (MASKED) {
            const unsigned m4 = mask[kt] >> (4 * hh);
#pragma unroll
            for (int g = 0; g < 4; ++g)
#pragma unroll
                for (int e = 0; e < 4; ++e) { const unsigned t = (unsigned)((int)(m4 << (31 - (8 * g + e))) >> 31);
                    x[4 * g + e] = __uint_as_float((__float_as_uint(x[4 * g + e]) & t) | (0xff800000u & ~t)); }
        }
        float mx = x[0];
#pragma unroll
        for (int j = 1; j < 16; ++j) mx = fmaxf(mx, x[j]);
        mx = xhalf_max(mx);
        const float mn = fmaxf(m, mx), mu = (mn == -INFINITY) ? 0.f : mn;
        const float alpha = __builtin_amdgcn_exp2f(m - mu);
        m = mn;
        float ls = 0.f;
#pragma unroll
        for (int j = 0; j < 16; ++j) { x[j] = __builtin_amdgcn_exp2f(x[j] - mu); ls += x[j]; }
        lsum = lsum * alpha + ls;
        if (__any(alpha != 1.f)) {
#pragma unroll
            for (int d = 0; d < 4; ++d)
#pragma unroll
                for (int j = 0; j < 16; ++j) o[d][j] *= alpha;
        }
        bf16x8 pf[2];
#pragma unroll
        for (int s = 0; s < 2; ++s) { v4u u; u.x = cvt_pk_bf16(x[8 * s + 0], x[8 * s + 1]); u.y = cvt_pk_bf16(x[8 * s + 2], x[8 * s + 3]); u.z = cvt_pk_bf16(x[8 * s + 4], x[8 * s + 5]); u.w = cvt_pk_bf16(x[8 * s + 6], x[8 * s + 7]);
            pf[s] = __builtin_bit_cast(bf16x8, u); }
#pragma unroll
        for (int d = 0; d < 4; ++d)
#pragma unroll
            for (int s = 0; s < 2; ++s) o[d] = __builtin_amdgcn_mfma_f32_32x32x16_bf16(vf[d][s], pf[s], o[d], 0, 0, 0);
    }
    lsum = xhalf_sum(lsum);
    const float inv = lsum > 0.f ? 1.f / lsum : 0.f;
    const float* gp = WSP(float, WS_PROJ) + (size_t)(row0 + r) * INWP + gate_col + h * 128;
    bf16* op = WSP(bf16, WS_YMIX) + (size_t)(row0 + r) * DM + out_col + h * 128;
#pragma unroll
    for (int d = 0; d < 4; ++d)
#pragma unroll
        for (int g = 0; g < 4; ++g) { const int dd = d * 32 + 8 * g + 4 * hh; const f32x4 gv = *(const f32x4*)(gp + dd);
            float v[4];
#pragma unroll
            for (int e = 0; e < 4; ++e) v[e] = o[d][4 * g + e] * inv * silu(gv[e]);
            v2u pk; pk.x = cvt_pk_bf16(v[0], v[1]); pk.y = cvt_pk_bf16(v[2], v[3]); *(v2u*)(op + dd) = pk; }
}
__device__ __forceinline__ void dsa4_item(Frame& F, GBar& gb, int gw, int b, int qt) {
    const int t0 = qt * 32, row0 = b * SEQ + t0, nkt = qt + 1, gt = gw * 64 + F.lane;
    LAS unsigned* mask = (LAS unsigned*)(F.lds + G4_MASK_OFF);
    if (t0 + 31 < TOPK) {
        for (int i = gt; i < 32 * 64; i += 256) { const int q = i >> 6, kt = i & 63; const int nb = t0 + q - 32 * kt + 1;
            mask[i] = nb >= 32 ? 0xffffffffu : (nb <= 0 ? 0u : ((1u << nb) - 1u)); }
    } else {
        const int lane = F.lane, r = lane & 31, hh = lane >> 5;
        int r4 = 4 * r; asm volatile("" : "+v"(r4));
        const bf16* KIB = WSP(bf16, WS_SC) + (size_t)(b * SEQ) * 64 + lane * 8;
        LAS unsigned* skl = (LAS unsigned*)(F.lds + G4_SKL_OFF) + gw * 4096 + hh * 2048;
        for (int i = gt; i < 32 * 64; i += 256) mask[i] = 0u;
        gbar(gb, lane);
        for (int pass = 0; pass < 4; ++pass) {
            const int q0 = 8 * pass + 2 * gw, tq = t0 + q0 + hh;
            {
                bf16x8 af[4]; idx_afrag(WSP(bf16, WS_QIB), row0 + q0, lane, af);
                f32x4 w[4];
#pragma unroll
                for (int j = 0; j < 4; ++j) w[j] = *(const f32x4*)(WSP(float, WS_WIS) + (size_t)(row0 + q0 + hh) * 16 + 4 * j);
                bf16x8 ring[4][4];
#pragma unroll
                for (int i = 0; i < 3; ++i) { const int ktc = i < nkt ? i : nkt - 1;
#pragma unroll
                    for (int ks = 0; ks < 4; ++ks) ring[i][ks] = *(const bf16x8*)(KIB + (size_t)ktc * 2048 + ks * 512); }
                for (int kt0 = 0; kt0 < nkt; kt0 += 4) {
#pragma unroll
                    for (int i = 0; i < 4; ++i) {
                        const int kt = kt0 + i, ktp = (kt + 3 < nkt) ? kt + 3 : nkt - 1;
#pragma unroll
                        for (int ks = 0; ks < 4; ++ks) ring[(i + 3) & 3][ks] = *(const bf16x8*)(KIB + (size_t)ktp * 2048 + ks * 512);
                        f32x16 acc;
#pragma unroll
                        for (int j = 0; j < 16; ++j) acc[j] = 0.f;
#pragma unroll
                        for (int ks = 0; ks < 4; ++ks) acc = __builtin_amdgcn_mfma_f32_32x32x16_bf16(af[ks], ring[i][ks], acc, 0, 0, 0);
                        if (kt < nkt) skl[kt * 32 + r] = sort_key(idx_reduce(acc, w));
                    }
                }
            }
            asm volatile("s_waitcnt lgkmcnt(0)" ::: "memory");
            unsigned sk[64];
            int tqr = tq - r4; asm volatile("" : "+v"(tqr));
#pragma unroll
            for (int i = 0; i < 16; ++i) { const v4u v = *(const LAS v4u*)(skl + 128 * i + r4);
                sk[4 * i + 0] = (128 * i + 0 <= tqr) ? v.x : 0u; sk[4 * i + 1] = (128 * i + 1 <= tqr) ? v.y : 0u; sk[4 * i + 2] = (128 * i + 2 <= tqr) ? v.z : 0u; sk[4 * i + 3] = (128 * i + 3 <= tqr) ? v.w : 0u; }
            unsigned T = 0u; bool exact = false;
            for (int bit = 31; bit >= 0; --bit) {
                const unsigned cand = T | (1u << bit);
                unsigned c = 0u;
#pragma unroll
                for (int i = 0; i < 64; ++i) cnt_ge(c, sk[i], cand);
                c = half_sum_u(c);
                if (!exact) { if (c >= (unsigned)TOPK) T = cand; if (c == (unsigned)TOPK) exact = true; }
                if (__all(exact)) break;
            }
            unsigned cut = 0x7fffffffu;
            if (__any(!exact)) {
                unsigned cg = 0u, ce = 0u;
                for (int i = 0; i < 16; ++i) { const v4u v = *(const LAS v4u*)(skl + 128 * i + r4); const int i0 = 128 * i + r4;
#pragma unroll
                    for (int e = 0; e < 4; ++e) { const unsigned k = (i0 + e <= tq) ? v[e] : 0u; cg += (k > T) ? 1u : 0u; ce += (k == T) ? 1u : 0u; } }
                cg = half_sum_u(cg); ce = half_sum_u(ce);
                const unsigned need = (unsigned)TOPK - cg;
                const bool tie = !exact && ce > need;
                unsigned I = 0u;
                for (int bit = 11; bit >= 0; --bit) {
                    const unsigned cand = I | (1u << bit);
                    unsigned c = 0u;
                    for (int i = 0; i < 16; ++i) { const v4u v = *(const LAS v4u*)(skl + 128 * i + r4); const int i0 = 128 * i + r4;
#pragma unroll
                        for (int e = 0; e < 4; ++e) { const unsigned k = (i0 + e <= tq) ? v[e] : 0u; c += (k == T && (unsigned)(i0 + e) < cand) ? 1u : 0u; } }
                    c = half_sum_u(c);
                    if (c < need) I = cand;
                }
                if (tie) cut = I;
            }
            int cutr = (int)cut - r4; asm volatile("" : "+v"(cutr));
#pragma unroll
            for (int i = 0; i < 16; ++i) {
                unsigned nib = 0u;
#pragma unroll
                for (int e = 0; e < 4; ++e) { const unsigned k = sk[4 * i + e]; const bool sel = k != 0u && (k > T || (k == T && (128 * i + e) <= cutr)); nib |= sel ? (1u << e) : 0u; }
                if (nib) __hip_atomic_fetch_or((LAS unsigned*)&mask[(q0 + hh) * 64 + 4 * i + (r >> 3)], nib << (4 * (r & 7)), __ATOMIC_RELAXED, __HIP_MEMORY_SCOPE_WORKGROUP);
            }
        }
    }
    gbar(gb, F.lane);
    attn4<true>(F, gw, row0, nkt, 64, WSP(bf16, WS_QB), WSP(bf16, WS_KB) + (size_t)b * SEQ * 512, WSP(bf16, WS_VT) + (size_t)b * 512 * SEQ, C_GA, 1024);
    gbar(gb, F.lane);
}
__device__ __forceinline__ void group_queue(Frame& F, GBar& gb, int gw) {
    unsigned* qctr = (unsigned*)(F.ws + WS_CTL) + 8192;
    volatile LAS int* slot = (volatile LAS int*)(F.lds + G4_SLOT_OFF);
    for (int n = 0;; ++n) {
        if (gw == 0 && F.lane == 0) slot[n & 1] = (int)__hip_atomic_fetch_add(qctr, 1u, __ATOMIC_RELAXED, __HIP_MEMORY_SCOPE_AGENT);
        gbar(gb, F.lane);
        const int it = slot[n & 1];
        if (it >= 512) break;
        Frame Fi = F; asm volatile("" : "+v"(Fi.lane), "+v"(Fi.tid));
        if (it < 256) dsa4_item(Fi, gb, gw, it & 3, 63 - (it >> 2));
        else { const int j = it - 256, b = j >> 6, qt = j & 63;
            attn4<false>(Fi, gw, b * SEQ + qt * 32, 8, 8, WSP(bf16, WS_QMB), WSP(bf16, WS_MKB) + (size_t)b * MEMT * 512, WSP(bf16, WS_MVT) + (size_t)b * 512 * MEMT, C_GM, 1536); }
    }
}
__device__ __forceinline__ bool overlap_mode(const Frame& F) { return F.G >= 64; }
__device__ __forceinline__ void p3_overlap(Frame& F) {
    volatile LAS unsigned* ctl = (volatile LAS unsigned*)(F.lds + G4_SLOT_OFF);
    const unsigned c_scan = ctl[4], c_att = ctl[8];
    __syncthreads();
    if (F.wave < 4) {
        GBar gb{ctl + 4, c_scan};
        for (int it0 = F.bid; it0 < 256; it0 += F.G) { const int it = (F.G == 256) ? ((it0 & 7) * 32 + (it0 >> 3)) : it0;
            const int bh = it >> 2, rg = it & 3, b = bh >> 4, h = bh & 15;
            scan4_item(F, gb, b, h, rg, F.out + O_WKVP + (size_t)bh * 4096, WSP(float, WS_Y) + (size_t)(b * SEQ) * RW + h * 64);
            asm volatile("s_waitcnt vmcnt(0)" ::: "memory"); gbar(gb, F.lane); }
    } else {
        GBar gb{ctl + 8, c_att};
        const int gw = F.wave - 4;
        const int gwi = F.bid * 4 + gw, NGW = F.G * 4;
        for (int it = gwi; it < DB * RH * 16; it += NGW) scan_sample_witem(F, it);
        for (int it = gwi; it < DB * NPAGES + DB; it += NGW) d1_sample_item(F, it);
        group_queue(F, gb, gw);
    }
    __syncthreads();
}
__device__ __forceinline__ void p8_phase(Frame& F) {
    const int gw = F.bid * NWAVES + F.wave, NGW = F.G * NWAVES;
    for (int row = gw; row < NTOK; row += NGW) {
        float* y = F.out + (row < NTOKP ? O_YP + (size_t)row * DM : O_YS + (size_t)(row - NTOKP) * DM);
        f32x4* xr = (f32x4*)y + F.lane; const f32x4* wr = (const f32x4*)F.in[I_FNW] + F.lane;
        f32x4 v[8]; float s = 0.f;
#pragma unroll
        for (int j = 0; j < 8; ++j) { v[j] = xr[64 * j]; s += (v[j].x * v[j].x + v[j].y * v[j].y) + (v[j].z * v[j].z + v[j].w * v[j].w); }
        const float rs = 1.f / sqrtf(wave_sum(s) * (1.f / DM) + RMS_EPS);
#pragma unroll
        for (int j = 0; j < 8; ++j) { const f32x4 ww = wr[64 * j]; xr[64 * j] = (f32x4){v[j].x * rs * ww.x, v[j].y * rs * ww.y, v[j].z * rs * ww.z, v[j].w * rs * ww.w}; }
    }
}

constexpr int N_PHASES = 9;
struct Args { const void* in[N_IN]; float* out; unsigned char* ws; int ph_lo, ph_hi; };
__global__ void __launch_bounds__(NTHR, 2) hymba_fwd(Args args) {
    extern __shared__ __attribute__((aligned(16))) unsigned char lds[];
    Frame F;
    F.lds = (LAS unsigned char*)lds;
    F.tid = threadIdx.x; F.lane = F.tid & 63; F.wave = __builtin_amdgcn_readfirstlane(F.tid >> 6);
    F.G = gridDim.x; F.bid = blockIdx.x;
#pragma unroll
    for (int i = 0; i < N_IN; ++i) F.in[i] = (const float*)args.in[i];
    F.out = args.out; F.ws = args.ws;
    for (int u = F.tid; u < (LDS_BYTES - LDSCTL_OFF) / 4; u += NTHR) ((LAS unsigned*)(F.lds + LDSCTL_OFF))[u] = 0u;
    __syncthreads();
#if MK_SPLIT
#define GRID_BAR() do { } while (0)
#else
    XcdBarrier bar = xcd_barrier_post((unsigned*)(F.ws + WS_CTL) + CW_BAR, (volatile LAS unsigned*)(F.lds + MISC_OFF) + 8);
#define GRID_BAR() xcd_barrier(bar)
#endif
    const int lo = args.ph_lo, hi = args.ph_hi;
#ifndef PH_MASK
#define PH_MASK 0x1FF
#endif
#define IN(k) (((PH_MASK >> (k)) & 1) && lo <= (k) && (k) < hi)
#define BOTH(k) (IN(k) && IN((k) + 1))

#define RUNPH(k, ...) do { if (IN(k)) { __VA_ARGS__; if (PROBE_REPEAT == (k)) { GRID_BAR(); __VA_ARGS__; } if (BOTH(k)) GRID_BAR(); } } while (0)
    RUNPH(0, p0_prologue(F));
    RUNPH(1, {
        { pg8::Gemm g{WSP(bf16, WS_XN), WSP(bf16, WS_WINT), MPAD, INWP, DM, DM}; pg8::StaticOrder S; S.init(MPAD, INWP, F.G, F.bid);
          EpiProjFused E{WSP(float, WS_PROJ), F.out, F.ws};
          pg8::gemm_phase<EpiProjFused, pg8::StaticOrder, true, true>(F.lds + RING_OFF, g, S, E); }
        { pg8::Gemm g{WSP(bf16, WS_XM), WSP(bf16, WS_WMEMT), 1024, 1024, DM, DM}; pg8::StaticOrder S; S.init(1024, 1024, F.G, F.G - 1 - F.bid);
          EpiMem E{F.out};
          pg8::gemm_phase<EpiMem, pg8::StaticOrder, true, true>(F.lds + RING_OFF, g, S, E); }
    });
    RUNPH(2, p2_phase(F));
    if (F.G >= 64) { RUNPH(3, p3_overlap(F)); } else { RUNPH(3, p3_scan_phase(F)); }
    RUNPH(4, p4_phase(F));
    if (F.G < 64) { RUNPH(5, p5_phase(F)); }
    RUNPH(6, p6_phase(F));
    RUNPH(7, {
        { pg8::Gemm g{WSP(bf16, WS_YMIX), WSP(bf16, WS_WOUTT), NTOKP, DM, DM, DM}; pg8::StaticOrder S; S.init(NTOKP, DM, F.G, F.bid);
          EpiOut E{F.in[I_XP], F.in[I_XS], F.out};
          pg8::gemm_phase<EpiOut, pg8::StaticOrder, true, true>(F.lds + RING_OFF, g, S, E); }
        { pg8::Gemm g{WSP(bf16, WS_YMIX), WSP(bf16, WS_WOUTT), MPAD, DM, 256, DM}; pg8::ListOrder S{F.G, F.bid, 2};
          EpiOutAtomic E{F.out};
          pg8::gemm_phase<EpiOutAtomic, pg8::ListOrder, true, true>(F.lds + RING_OFF, g, S, E); }
    });
    if (IN(8)) { p8_phase(F); }
#undef IN
#undef BOTH
}

extern "C" void kernel_launch(void* const* d_in, const int* in_sizes, int n_in, void* d_out, int out_size, void* d_ws, size_t ws_size, hipStream_t stream) {
    static int grid = 0;
    if (grid == 0) {
        if (n_in != N_IN || out_size != (int)O_END || ws_size < WS_END) { fprintf(stderr, "kernel_launch: unexpected shapes: n_in %d out %d ws %zu (need %zu)\n", n_in, out_size, ws_size, (size_t)WS_END); grid = -1; return; }
        int dev = 0, cus = 0, per_cu = 0;
        if (hipGetDevice(&dev) != hipSuccess || hipDeviceGetAttribute(&cus, hipDeviceAttributeMultiprocessorCount, dev) != hipSuccess) { grid = -1; return; }
        if (hipFuncSetAttribute((const void*)hymba_fwd, hipFuncAttributeMaxDynamicSharedMemorySize, LDS_BYTES) != hipSuccess) { fprintf(stderr, "kernel_launch: hipFuncSetAttribute failed\n"); grid = -1; return; }
        if (hipOccupancyMaxActiveBlocksPerMultiprocessor(&per_cu, (const void*)hymba_fwd, NTHR, LDS_BYTES) != hipSuccess || per_cu < 1) { fprintf(stderr, "kernel_launch: occupancy query says %d\n", per_cu); }
        (void)hipGetLastError();
        grid = cus;
    }
    if (grid < 0) return;
    if (hipMemsetAsync((char*)d_ws + WS_CTL, 0, CTL_ZERO_BYTES, stream) != hipSuccess) { fprintf(stderr, "kernel_launch: memset failed\n"); return; }
    Args a{};
    for (int i = 0; i < N_IN; ++i) a.in[i] = d_in[i];
    a.out = (float*)d_out; a.ws = (unsigned char*)d_ws;
#if MK_SPLIT
    for (int p = 0; p < N_PHASES; ++p) { a.ph_lo = p; a.ph_hi = p + 1; hipLaunchKernelGGL(hymba_fwd, dim3(grid), dim3(NTHR), LDS_BYTES, stream, a); }
#else
    a.ph_lo = 0; a.ph_hi = N_PHASES;
    hipLaunchKernelGGL(hymba_fwd, dim3(grid), dim3(NTHR), LDS_BYTES, stream, a);
#endif
    const hipError_t le = hipPeekAtLastError();
    if (le != hipSuccess) fprintf(stderr, "kernel_launch: launch failed: %s\n", hipGetErrorName(le));
}
```

```cpp
#include <hip/hip_runtime.h>
#include <cstdio>
#include <cstdint>

#ifndef MK_SPLIT
#define MK_SPLIT 0
#endif

namespace pg8 {
#define PG8_LAS __attribute__((address_space(3)))
typedef unsigned short bf16_t;
typedef short bf16x8 __attribute__((ext_vector_type(8)));
typedef float f32x4 __attribute__((ext_vector_type(4)));
typedef unsigned u32x4 __attribute__((ext_vector_type(4)));
constexpr int BM = 256, BK = 64, HALF = 128, HTB = HALF * BK * 2, STAGE_BYTES = 8 * HTB, NXCD = 8, WGM = 8;

__host__ __device__ __forceinline__ int lds_byte(int r, int c) { const int st = (r >> 4) * 2 + (c >> 5), rr = r & 15, cc = c & 31, ob = rr * 64 + cc * 2; return st * 1024 + (ob ^ (((ob >> 9) & 1) << 5)); }
__host__ __device__ __forceinline__ void stage_rc(int b, int& R, int& C) { const int st = b / 1024, sb = b % 1024, swz = sb ^ (((sb >> 9) & 1) << 5); R = (st >> 1) * 16 + swz / 64; C = (st & 1) * 32 + (swz % 64) / 2; }

struct Unit { int pm, pn, koff; };
struct Gemm { const bf16_t* A; const bf16_t* Bt; int M, N, K, ld; };

struct StaticOrder {
    int nM, nN, nwg, G, c;
    __host__ __device__ void init(int M, int N, int G_, int c_) { nM = M / BM; nN = N / BM; nwg = nM * nN; G = G_; c = c_; }
    __host__ __device__ bool next(int i, Unit& u) const {
        const long L = (long)i * G + c; if (L >= nwg) return false;
        int wgid = (int)L; { const int q = nwg / NXCD, r = nwg % NXCD, xcd = wgid % NXCD, off = wgid / NXCD; wgid = (xcd < r ? xcd * (q + 1) : r * (q + 1) + (xcd - r) * q) + off; }
        const int nig = WGM * nN, gid = wgid / nig, fm = gid * WGM, gsz = (nM - fm) < WGM ? (nM - fm) : WGM;
        u.pm = fm + ((wgid % nig) % gsz); u.pn = (wgid % nig) / gsz; u.koff = 0; return true;
    }
    __device__ __forceinline__ void a_ready(const Unit&) const {}
    __device__ __forceinline__ void done(const Unit&) const {}
};

struct ListOrder {
    int G, c, mode;
    __device__ __forceinline__ bool next(int i, Unit& u) const {
        const int L = i * G + c;
        if (mode == 0) { if (L >= 260) return false; const int q = L & 3, uu = L >> 2; if (uu < 33) { u.pm = 32; u.pn = uu; } else { u.pm = uu - 33; u.pn = 32; } u.koff = q * 512; return true; }
        if (mode == 1) { if (L >= 64) return false; const int q = L & 3, uu = L >> 2; u.pm = uu >> 2; u.pn = uu & 3; u.koff = q * 512; return true; }
        if (L >= 64) return false; u.pm = 32; u.pn = L >> 3; u.koff = (L & 7) * 256; return true;
    }
    __device__ __forceinline__ void a_ready(const Unit&) const {}
    __device__ __forceinline__ void done(const Unit&) const {}
};
template <class Epi, class Sched, bool ALIGN_EPI = false, bool SP2 = false>
__device__ __forceinline__ void gemm_phase(PG8_LAS unsigned char* lds, const Gemm g, const Sched& S, const Epi& E) {
    const int tid = threadIdx.x, wid = __builtin_amdgcn_readfirstlane(tid >> 6), lane = tid & 63, wr = wid >> 2, wc = wid & 3, fr = lane & 15, fq = lane >> 4;
    const int K = g.K, nt = K / BK;
    unsigned voffA[2], voffB[2];
    const int ld = g.ld;
#pragma unroll
    for (int i = 0; i < 2; ++i) { int R, C; stage_rc(tid * 16 + i * 8192, R, C); voffA[i] = (unsigned)(R * ld + C) * 2u; voffB[i] = (unsigned)(R * ld + C) * 2u; }
    const size_t kstep = (size_t)(BK * 2);
    const size_t hstep = (size_t)HALF * ld * 2;
    const size_t tstep = 2 * hstep;
    const unsigned ldsw = (unsigned)wid * 1024u;
    const int aoff = lds_byte(wr * 64 + fr, fq * 8), boff = lds_byte(wc * 32 + fr, fq * 8);
#define PG8_SA(b, h) (((b) * 2 + (h)) * HTB)
#define PG8_SB(b, h) ((4 + (b) * 2 + (h)) * HTB)
#define PG8_STAGE(bufoff, gbase, voff) do { _Pragma("unroll") for (int _i = 0; _i < 2; ++_i) \
        __builtin_amdgcn_global_load_lds((const unsigned*)((const char*)(gbase) + (voff)[_i]), (PG8_LAS unsigned*)(lds + (bufoff) + ldsw + _i * 8192), 16, 0, 0); } while (0)
#define PG8_LDA(dst, b, h) do { _Pragma("unroll") for (int m = 0; m < 4; ++m) _Pragma("unroll") for (int k = 0; k < 2; ++k) dst[m][k] = *(const PG8_LAS bf16x8*)(lds + PG8_SA(b, h) + aoff + m * 2048 + k * 1024); } while (0)
#define PG8_LDB(dst, b, h) do { _Pragma("unroll") for (int n = 0; n < 2; ++n) _Pragma("unroll") for (int k = 0; k < 2; ++k) dst[n][k] = *(const PG8_LAS bf16x8*)(lds + PG8_SB(b, h) + boff + n * 2048 + k * 1024); } while (0)
#define PG8_MMA(ai, bj, At, Bt) do { __builtin_amdgcn_s_setprio(1); _Pragma("unroll") for (int m = 0; m < 4; ++m) _Pragma("unroll") for (int n = 0; n < 2; ++n) _Pragma("unroll") for (int k = 0; k < 2; ++k) \
        acc[ai][bj][m][n] = __builtin_amdgcn_mfma_f32_16x16x32_bf16(Bt[n][k], At[m][k], acc[ai][bj][m][n], 0, 0, 0); __builtin_amdgcn_s_setprio(0); } while (0)
#define PG8_WAIT_V(n) asm volatile("s_waitcnt vmcnt(" #n ")" ::: "memory")
#define PG8_WAIT_L(n) asm volatile("s_waitcnt lgkmcnt(" #n ")" ::: "memory")
#define PG8_BAR __builtin_amdgcn_s_barrier()
#define PG8_SCHED __builtin_amdgcn_sched_barrier(0)
    Unit cur, nxt; int ui = 0;
    if (!S.next(0, cur)) return;
    f32x4 acc[2][2][4][2];
#pragma unroll
    for (int a = 0; a < 2; ++a)
#pragma unroll
        for (int b = 0; b < 2; ++b)
#pragma unroll
            for (int m = 0; m < 4; ++m)
#pragma unroll
                for (int n = 0; n < 2; ++n) acc[a][b][m][n] = (f32x4){0.f, 0.f, 0.f, 0.f};
    bf16x8 At[4][2], B0[2][2], B1[2][2];
    const char* cA = (const char*)g.A + (size_t)cur.pm * tstep + (size_t)cur.koff * 2; const char* cB = (const char*)g.Bt + (size_t)cur.pn * tstep + (size_t)cur.koff * 2;
    S.a_ready(cur);
    if constexpr (SP2) {
        PG8_STAGE(PG8_SB(0, 0), cB, voffB); PG8_STAGE(PG8_SB(0, 1), cB + hstep, voffB); PG8_STAGE(PG8_SA(0, 0), cA, voffA); PG8_STAGE(PG8_SA(0, 1), cA + hstep, voffA);
        if (wr == 1) PG8_BAR;
        PG8_WAIT_V(2); PG8_BAR;
        PG8_STAGE(PG8_SB(1, 0), cB + kstep, voffB); PG8_STAGE(PG8_SA(1, 0), cA + kstep, voffA); PG8_STAGE(PG8_SB(1, 1), cB + hstep + kstep, voffB);
        PG8_WAIT_V(6); PG8_BAR;
    } else {
        PG8_STAGE(PG8_SB(0, 0), cB, voffB); PG8_STAGE(PG8_SA(0, 0), cA, voffA); PG8_STAGE(PG8_SB(0, 1), cB + hstep, voffB); PG8_STAGE(PG8_SA(0, 1), cA + hstep, voffA);
        if (wr == 1) PG8_BAR;
        PG8_WAIT_V(4); PG8_BAR;
        PG8_STAGE(PG8_SB(1, 0), cB + kstep, voffB); PG8_STAGE(PG8_SA(1, 0), cA + kstep, voffA); PG8_STAGE(PG8_SB(1, 1), cB + hstep + kstep, voffB);
        PG8_WAIT_V(6); PG8_BAR;
    }
    for (;;) {
        const bool has_next = S.next(ui + 1, nxt);
        const char* nA = has_next ? (const char*)g.A + (size_t)nxt.pm * tstep + (size_t)nxt.koff * 2 : cA; const char* nB = has_next ? (const char*)g.Bt + (size_t)nxt.pn * tstep + (size_t)nxt.koff * 2 : cB;
        for (int t = 0; t < nt; t += 2) {
            const bool last = (t == nt - 2);
            const char* a1 = cA + (size_t)(t + 1) * kstep;
            const char* a2 = last ? nA : cA + (size_t)(t + 2) * kstep; const char* b2 = last ? nB : cB + (size_t)(t + 2) * kstep;
            const char* a3 = a2 + kstep; const char* b3 = b2 + kstep;
            if (last && has_next) S.a_ready(nxt);
            if constexpr (SP2) {
            PG8_LDB(B0, 0, 0); PG8_LDB(B1, 0, 1); PG8_SCHED; PG8_LDA(At, 0, 0); PG8_STAGE(PG8_SA(1, 1), a1 + hstep, voffA);
            PG8_WAIT_V(8); PG8_WAIT_L(0); PG8_BAR; PG8_MMA(0, 0, At, B0); PG8_MMA(0, 1, At, B1); PG8_BAR; PG8_SCHED;
            PG8_LDA(At, 0, 1); PG8_STAGE(PG8_SB(0, 0), b2, voffB); PG8_STAGE(PG8_SB(0, 1), b2 + hstep, voffB); PG8_STAGE(PG8_SA(0, 0), a2, voffA);
            PG8_WAIT_V(8); PG8_WAIT_L(0); PG8_BAR; PG8_MMA(1, 0, At, B0); PG8_MMA(1, 1, At, B1); PG8_BAR; PG8_SCHED;
            PG8_LDB(B0, 1, 0); PG8_LDB(B1, 1, 1); PG8_SCHED; PG8_LDA(At, 1, 0); PG8_STAGE(PG8_SA(0, 1), a2 + hstep, voffA);
            PG8_WAIT_V(8); PG8_WAIT_L(0); PG8_BAR; PG8_MMA(0, 0, At, B0); PG8_MMA(0, 1, At, B1); PG8_BAR; PG8_SCHED;
            PG8_LDA(At, 1, 1); PG8_STAGE(PG8_SB(1, 0), b3, voffB); PG8_STAGE(PG8_SB(1, 1), b3 + hstep, voffB); PG8_STAGE(PG8_SA(1, 0), a3, voffA);
            PG8_WAIT_V(8); PG8_WAIT_L(0); PG8_BAR; PG8_MMA(1, 0, At, B0); PG8_MMA(1, 1, At, B1); PG8_BAR; PG8_SCHED;
            } else {
            PG8_LDB(B0, 0, 0); PG8_SCHED; PG8_LDA(At, 0, 0); PG8_STAGE(PG8_SA(1, 1), a1 + hstep, voffA);
            PG8_WAIT_L(8); PG8_BAR; PG8_WAIT_L(0); PG8_MMA(0, 0, At, B0); PG8_BAR; PG8_SCHED;
            PG8_LDB(B1, 0, 1); PG8_STAGE(PG8_SB(0, 0), b2, voffB);
            PG8_BAR; PG8_WAIT_L(0); PG8_MMA(0, 1, At, B1); PG8_BAR;
            PG8_LDA(At, 0, 1); PG8_STAGE(PG8_SA(0, 0), a2, voffA);
            PG8_BAR; PG8_WAIT_L(0); PG8_MMA(1, 0, At, B0); PG8_BAR; PG8_SCHED;
            PG8_STAGE(PG8_SB(0, 1), b2 + hstep, voffB);
            PG8_WAIT_V(6); PG8_BAR; PG8_MMA(1, 1, At, B1); PG8_BAR;
            PG8_LDB(B0, 1, 0); PG8_SCHED; PG8_LDA(At, 1, 0); PG8_STAGE(PG8_SA(0, 1), a2 + hstep, voffA);
            PG8_WAIT_L(8); PG8_BAR; PG8_WAIT_L(0); PG8_MMA(0, 0, At, B0); PG8_BAR; PG8_SCHED;
            PG8_LDB(B1, 1, 1); PG8_STAGE(PG8_SB(1, 0), b3, voffB);
            PG8_BAR; PG8_WAIT_L(0); PG8_MMA(0, 1, At, B1); PG8_BAR;
            PG8_LDA(At, 1, 1); PG8_STAGE(PG8_SA(1, 0), a3, voffA);
            PG8_BAR; PG8_WAIT_L(0); PG8_MMA(1, 0, At, B0); PG8_BAR; PG8_SCHED;
            PG8_STAGE(PG8_SB(1, 1), b3 + hstep, voffB);
            PG8_WAIT_V(6); PG8_BAR; PG8_MMA(1, 1, At, B1); PG8_BAR;
            }
        }
        if constexpr (ALIGN_EPI) { if (wr == 0) PG8_BAR; }
        E(acc, cur, wr, wc, fr, fq); S.done(cur);
        if (!has_next) break;
#pragma unroll
        for (int a = 0; a < 2; ++a)
#pragma unroll
            for (int b = 0; b < 2; ++b)
#pragma unroll
                for (int m = 0; m < 4; ++m)
#pragma unroll
                    for (int n = 0; n < 2; ++n) acc[a][b][m][n] = (f32x4){0.f, 0.f, 0.f, 0.f};
        cur = nxt; cA = nA; cB = nB; ++ui;
        if constexpr (ALIGN_EPI) { if (wr == 1) PG8_BAR; }
    }
    PG8_WAIT_V(0);
    if constexpr (!ALIGN_EPI) { if (wr == 0) PG8_BAR; }
    PG8_BAR;
#undef PG8_SA
#undef PG8_SB
#undef PG8_STAGE
#undef PG8_LDA
#undef PG8_LDB
#undef PG8_MMA
#undef PG8_WAIT_V
#undef PG8_WAIT_L
#undef PG8_BAR
#undef PG8_SCHED
}
}

constexpr int NWAVES = 8, NTHR = 512;
constexpr int DM = 2048, NB = 4, SEQ = 2048, DB = 32, DT = 4, PAST = 8192, PAGE = 128, NPAGES = 64;
constexpr int NTOKP = NB * SEQ;
constexpr int NTOKS = DB * DT;
constexpr int NTOK = NTOKP + NTOKS;
constexpr int MPAD = 8448;
constexpr int INW = 8400, INWP = 8448;
constexpr int RW = 1024, RH = 16, RD = 64, SHW = 3200;
constexpr int C_R = 0, C_K = 1024, C_V = 2048, C_CW = 3072, C_CA = 3136, C_GR = 3200, C_Q = 4224, C_AK = 4736, C_AV = 5248, C_GA = 5760, C_QI = 6272, C_QM = 7296, C_GM = 7808, C_KI = 8320, C_WI = 8384;
constexpr int MEMT = 256;
constexpr int TOPK = 256;
constexpr int SCS_LD = 8256;
constexpr float RMS_EPS = 1e-6f, GN_EPS = 64e-5f;
constexpr float QSCALE = 0.08838834764831845f * 1.4426950408889634f;
constexpr size_t O_YP = 0, O_YS = 16777216, O_WKVP = 17039360, O_SHP = 17301504, O_KP = 17314304, O_VP = 21508608, O_KIP = 25702912, O_MKP = 26227200, O_MVP = 26751488,
                 O_WKVS = 27275776, O_SHS = 29372928, O_KS = 29475328, O_VS = 29540864, O_KIS = 29606400, O_END = 29614592;
enum { I_XP = 0, I_XS, I_SWKV, I_SSH, I_CK, I_CV, I_CKI, I_CMK, I_CMV, I_PT, I_MEM, I_NW, I_WIN, I_MU, I_W0, I_W2, I_A0, I_A2, I_KK, I_KA, I_RK, I_GNW, I_GNB, I_MNW, I_WMEM, I_WOUT, I_FNW, N_IN };

constexpr size_t MiB = 1u << 20;
constexpr size_t al1m(size_t x) { return (x + MiB - 1) / MiB * MiB; }
constexpr size_t WS_CTL = 0, CTL_ZERO_BYTES = 1 * MiB;
constexpr size_t WS_WINT = 1 * MiB;
constexpr size_t WS_WOUTT = WS_WINT + al1m((size_t)INWP * DM * 2);
constexpr size_t WS_WMEMT = WS_WOUTT + al1m((size_t)DM * DM * 2);
constexpr size_t WS_W2T = WS_WMEMT + al1m((size_t)1024 * DM * 2);
constexpr size_t WS_A2T = WS_W2T + al1m((size_t)1024 * 64 * 2);
constexpr size_t WS_ROPE128 = WS_A2T + al1m((size_t)1024 * 64 * 2);
constexpr size_t WS_ROPE64 = WS_ROPE128 + al1m((size_t)2052 * 64 * 8);
constexpr size_t WS_XN = WS_ROPE64 + al1m((size_t)2052 * 32 * 8);
constexpr size_t WS_XM = WS_XN + al1m((size_t)MPAD * DM * 2);
constexpr size_t WS_PROJ = WS_XM + al1m((size_t)1024 * DM * 2);
constexpr size_t WS_SCANIN = WS_PROJ + al1m((size_t)MPAD * INWP * 4);
constexpr size_t WS_SCAL = WS_SCANIN + al1m((size_t)NTOK * RH * 384 * 4);
constexpr size_t WS_Y = WS_SCAL + al1m((size_t)NTOK * RH * 16 * 4 + 65536);
constexpr size_t WS_QB = WS_Y + al1m((size_t)NTOK * RW * 4);
constexpr size_t WS_KB = WS_QB + al1m((size_t)NTOK * 512 * 2);
constexpr size_t WS_VT = WS_KB + al1m((size_t)NTOK * 512 * 2);
constexpr size_t WS_QIB = WS_VT + al1m((size_t)NB * 4 * 128 * SEQ * 2);
constexpr size_t WS_KIB = WS_QIB + al1m((size_t)NTOK * 1024 * 2);
constexpr size_t WS_WIS = WS_KIB + al1m((size_t)NTOK * 64 * 2);
constexpr size_t WS_QMB = WS_WIS + al1m((size_t)NTOK * 16 * 4);
constexpr size_t WS_MKB = WS_QMB + al1m((size_t)NTOK * 512 * 2);
constexpr size_t WS_MVT = WS_MKB + al1m((size_t)1024 * 512 * 2);
constexpr size_t WS_SC = WS_MVT + al1m((size_t)1024 * 512 * 2);
constexpr size_t WS_SCS = WS_SC + al1m((size_t)NTOKP * SEQ * 4);
constexpr size_t WS_THR = WS_SCS + al1m((size_t)NTOKS * SCS_LD * 4);
constexpr size_t WS_IDX = WS_THR + al1m((size_t)NTOK * 8);
constexpr size_t WS_YMIX = WS_IDX + al1m((size_t)NTOKS * TOPK * 4);
constexpr size_t WS_SHT = WS_YMIX + al1m((size_t)MPAD * DM * 2);
constexpr size_t WS_END = WS_SHT + al1m((size_t)(MPAD / 16) * 800 * 16 * 16);
constexpr int CW_BAR = 4096;

constexpr int RING_OFF = 0, RING_BYTES = 131072;
constexpr int LDSCTL_OFF = 159744, MISC_OFF = LDSCTL_OFF + 320;
constexpr int LDS_BYTES = 163840;

#define GAS __attribute__((address_space(1)))
#define LAS __attribute__((address_space(3)))
typedef unsigned short bf16;
typedef unsigned v4u __attribute__((ext_vector_type(4)));
typedef unsigned v2u __attribute__((ext_vector_type(2)));
typedef float f32x4 __attribute__((ext_vector_type(4)));
typedef float f32x2 __attribute__((ext_vector_type(2)));
typedef float f32x16 __attribute__((ext_vector_type(16)));
typedef short bf16x8 __attribute__((ext_vector_type(8)));
typedef short bf16x4 __attribute__((ext_vector_type(4)));
#define LDS_WAIT() asm volatile("s_waitcnt lgkmcnt(0)" ::: "memory")
#define VM_WAIT() asm volatile("s_waitcnt vmcnt(0)" ::: "memory")
__device__ __forceinline__ unsigned cvt_pk_bf16(float lo, float hi) { unsigned r; asm volatile("v_cvt_pk_bf16_f32 %0, %1, %2" : "=v"(r) : "v"(lo), "v"(hi)); return r; }
__device__ __forceinline__ float bf2f(unsigned short b) { return __uint_as_float(((unsigned)b) << 16); }
template <int CTRL> __device__ __forceinline__ float dpp(float x) { return __builtin_bit_cast(float, __builtin_amdgcn_mov_dpp(__builtin_bit_cast(int, x), CTRL, 0xf, 0xf, true)); }
__device__ __forceinline__ float row16_sum(float x) {
    x += dpp<0xB1>(x); x += dpp<0x4E>(x); x += dpp<0x141>(x); x += dpp<0x140>(x); return x;
}
__device__ __forceinline__ float wave_sum(float v) {
#pragma unroll
    for (int o = 1; o < 64; o <<= 1) v += __shfl_xor(v, o);
    return v;
}
__device__ __forceinline__ float xhalf_max(float x) { auto rr = __builtin_amdgcn_permlane32_swap(__float_as_uint(x), __float_as_uint(x), false, false); return fmaxf(__uint_as_float(rr[0]), __uint_as_float(rr[1])); }
__device__ __forceinline__ float xhalf_sum(float x) { auto rr = __builtin_amdgcn_permlane32_swap(__float_as_uint(x), __float_as_uint(x), false, false); return __uint_as_float(rr[0]) + __uint_as_float(rr[1]); }
__device__ __forceinline__ unsigned sort_key(float f) { const unsigned u = __float_as_uint(f); return (u & 0x80000000u) ? ~u : (u | 0x80000000u); }
__device__ __forceinline__ float silu(float g) { return g / (1.f + __expf(-g)); }

#define XB_TMO      128
#define XB_XCNT(j)  (256  + 64 * (j))
#define XB_XSUB(j)  (1280 + 64 * (j))
#define XB_XGEN(j)  (2304 + 64 * (j))
#define XB_TOP      3328
#define XB_TOPGEN   3392
#define XCD_BAR_WORDS 3456
#define XB_SPIN_CAP (1u << 18)
__device__ __forceinline__ unsigned xb_ld(unsigned* p)              { return __hip_atomic_load(p, __ATOMIC_RELAXED, __HIP_MEMORY_SCOPE_AGENT); }
__device__ __forceinline__ unsigned xb_add(unsigned* p, unsigned v) { return __hip_atomic_fetch_add(p, v, __ATOMIC_RELAXED, __HIP_MEMORY_SCOPE_AGENT); }
__device__ __forceinline__ unsigned xb_xcc_id() { return (unsigned)__builtin_amdgcn_s_getreg((3 << 11) | 20) & 0xFu; }
#define XB_SPIN(cond, bar) do { unsigned _sp = 0; while (cond) { __builtin_amdgcn_s_sleep(1); \
    if ((++_sp & 255u) == 0u) { if (xb_ld(&(bar)[XB_TMO])) break; if (_sp > XB_SPIN_CAP) { atomicAdd(&(bar)[XB_TMO], 1u); break; } } } } while (0)
struct XcdBarrier { unsigned* bar; unsigned x; volatile LAS unsigned* st; };
__device__ __forceinline__ XcdBarrier xcd_barrier_post(unsigned* bar, volatile LAS unsigned* st) {
    XcdBarrier b; b.bar = bar; b.x = xb_xcc_id(); b.st = st;
    if (threadIdx.x == 0) (void)xb_add(&bar[XB_XCNT(b.x)], 1u);
    return b;
}
__device__ __forceinline__ void xcd_barrier_complete(unsigned* bar, unsigned x, unsigned& nloc, unsigned& nx) {
    const unsigned G = gridDim.x * gridDim.y * gridDim.z;
    unsigned sum, cnt, mine, sp = 0u;
    for (;;) {
        sum = 0u; cnt = 0u; mine = 0u;
#pragma unroll
        for (unsigned j = 0; j < 16; ++j) { const unsigned c = xb_ld(&bar[XB_XCNT(j)]); sum += c; cnt += (c > 0u) ? 1u : 0u; mine = (j == x) ? c : mine; }
        if (sum == G) break;
        __builtin_amdgcn_s_sleep(1);
        if ((++sp & 255u) == 0u) { if (xb_ld(&bar[XB_TMO])) break; if (sp > XB_SPIN_CAP) { atomicAdd(&bar[XB_TMO], 1u); break; } }
    }
    nloc = mine > 0u ? mine : 1u; nx = cnt > 0u ? cnt : 1u;
}
__device__ __forceinline__ void xcd_barrier(const XcdBarrier& b) {
    asm volatile("s_waitcnt vmcnt(0)" ::: "memory");
    __syncthreads();
    if (threadIdx.x == 0) {
        unsigned* bar = b.bar;
        __builtin_amdgcn_s_waitcnt(0);
        unsigned nloc = b.st[0], nx = b.st[1];
        if (nloc == 0u) { xcd_barrier_complete(bar, b.x, nloc, nx); b.st[0] = nloc; b.st[1] = nx; }
        const unsigned old = xb_add(&bar[XB_XSUB(b.x)], 1u);
        const unsigned gen = old / nloc;
        if (old + 1u == (gen + 1u) * nloc) {
            __builtin_amdgcn_fence(__ATOMIC_RELEASE, "agent");
            asm volatile("s_waitcnt vmcnt(0)" ::: "memory");
            const unsigned og = xb_add(&bar[XB_TOP], 1u);
            const unsigned tg = og / nx;
            if (og + 1u == (tg + 1u) * nx) xb_add(&bar[XB_TOPGEN], 1u);
            else XB_SPIN(xb_ld(&bar[XB_TOPGEN]) == tg, bar);
            __builtin_amdgcn_fence(__ATOMIC_ACQUIRE, "agent");
            xb_add(&bar[XB_XGEN(b.x)], 1u);
            asm volatile("s_waitcnt vmcnt(0)" ::: "memory");
        } else {
            XB_SPIN(xb_ld(&bar[XB_XGEN(b.x)]) == gen, bar);
            __builtin_amdgcn_fence(__ATOMIC_ACQUIRE, "agent");
            asm volatile("s_waitcnt vmcnt(0)" ::: "memory");
        }
    }
    __syncthreads();
}

struct Frame {
    LAS unsigned char* lds;
    int tid, lane, wave, G, bid;
    const float* in[N_IN];
    float* out;
    unsigned char* ws;
};
#define WSP(T, off) ((T*)(F.ws + (off)))

__device__ __forceinline__ int src_col(int g);
__device__ __forceinline__ void p0_transpose_item(const float* W, int K, int N, int Npad, bf16* WT, LAS float* scr, int item, int lane, bool perm = false) {
    const int nblk = Npad / 32, kb = item / nblk, nb = item % nblk, k0 = 64 * kb, n0 = 32 * nb;
    const int nn = perm ? src_col(n0 + (lane & 31)) : ((n0 + (lane & 31)) < N ? n0 + (lane & 31) : -1);
    float tv[32];
#pragma unroll
    for (int i = 0; i < 32; ++i) { const int kk = 2 * i + (lane >> 5); tv[i] = (nn >= 0) ? W[(size_t)(k0 + kk) * N + nn] : 0.f; }
#pragma unroll
    for (int i = 0; i < 32; ++i) { const int kk = 2 * i + (lane >> 5); scr[kk * 33 + (lane & 31)] = tv[i]; }
    LDS_WAIT(); asm volatile("" ::: "memory");
    const int c = lane & 7;
#pragma unroll
    for (int j = 0; j < 4; ++j) { const int n = (lane >> 3) + 8 * j; const LAS float* s = scr + (8 * c) * 33 + n;
        v4u o; o.x = cvt_pk_bf16(s[0 * 33], s[1 * 33]); o.y = cvt_pk_bf16(s[2 * 33], s[3 * 33]); o.z = cvt_pk_bf16(s[4 * 33], s[5 * 33]); o.w = cvt_pk_bf16(s[6 * 33], s[7 * 33]);
        *(v4u*)(WT + (size_t)(n0 + n) * K + k0 + 8 * c) = o; }
    LDS_WAIT(); asm volatile("" ::: "memory");
}
__device__ __forceinline__ void rms_row_to_bf16(const float* xrow, const float* w, bf16* orow, int lane) {
    const f32x4* xr = (const f32x4*)xrow + lane; const f32x4* wr = (const f32x4*)w + lane;
    f32x4 v[8]; float s = 0.f;
#pragma unroll
    for (int j = 0; j < 8; ++j) { v[j] = xr[64 * j]; s += (v[j].x * v[j].x + v[j].y * v[j].y) + (v[j].z * v[j].z + v[j].w * v[j].w); }
    const float rs = 1.f / sqrtf(wave_sum(s) * (1.f / DM) + RMS_EPS);
    v2u* o8 = (v2u*)orow + lane;
#pragma unroll
    for (int j = 0; j < 8; ++j) { const f32x4 ww = wr[64 * j]; v2u o; o.x = cvt_pk_bf16(v[j].x * rs * ww.x, v[j].y * rs * ww.y); o.y = cvt_pk_bf16(v[j].z * rs * ww.z, v[j].w * rs * ww.w); o8[64 * j] = o; }
}
__device__ __forceinline__ void rope_cs(int pos, int i, double ratio, float& c, float& s) {
    double f = 1.0, b = ratio; int e = i;
    while (e) { if (e & 1) f *= b; b *= b; e >>= 1; }
    const double th = (double)pos * f;
    const double TWO_OVER_PI = 0.63661977236758134308, PIO2_HI = 1.57079632679489655800e+00, PIO2_LO = 6.12323399573676603587e-17;
    const double kq = rint(th * TWO_OVER_PI);
    double r = fma(-kq, PIO2_HI, th); r = fma(-kq, PIO2_LO, r);
    const int q = ((int)kq) & 3;
    const double z = r * r;
    const double sp = r + r * z * (-1.66666666666666324348e-01 + z * (8.33333333332248946124e-03 + z * (-1.98412698298579493134e-04 + z * (2.75573137070700676789e-06 + z * (-2.50507602534068634195e-08 + z * 1.58969099521155010221e-10)))));
    const double cp = 1.0 - 0.5 * z + z * z * (4.16666666666666019037e-02 + z * (-1.38888888888741095749e-03 + z * (2.48015872894767294178e-05 + z * (-2.75573143513906633035e-07 + z * (2.08757232129817482790e-09 + z * -1.13596475577881948265e-11)))));
    double cc, ss;
    if (q == 0) { cc = cp; ss = sp; } else if (q == 1) { cc = -sp; ss = cp; } else if (q == 2) { cc = -cp; ss = -sp; } else { cc = sp; ss = -cp; }
    c = (float)cc; s = (float)ss;
}
__device__ __forceinline__ void p0_prologue(Frame& F) {
    LAS float* scr = (LAS float*)(F.lds + RING_OFF + F.wave * 16384);
    const int gw = F.bid * NWAVES + F.wave, NGW = F.G * NWAVES;
    constexpr int T_IN = (DM / 64) * (INWP / 32), T_OUT = (DM / 64) * (DM / 32), T_MEM = (DM / 64) * (1024 / 32), T_L = 1024 / 32;
    constexpr int NITEMS = T_IN + T_OUT + T_MEM + 2 * T_L;
    for (int it = gw; it < NITEMS; it += NGW) {
        int r = it;
        if (r < T_IN) { p0_transpose_item(F.in[I_WIN], DM, INW, INWP, WSP(bf16, WS_WINT), scr, r, F.lane, true); continue; } r -= T_IN;
        if (r < T_OUT) { p0_transpose_item(F.in[I_WOUT], DM, DM, DM, WSP(bf16, WS_WOUTT), scr, r, F.lane); continue; } r -= T_OUT;
        if (r < T_MEM) { p0_transpose_item(F.in[I_WMEM], DM, 1024, 1024, WSP(bf16, WS_WMEMT), scr, r, F.lane); continue; } r -= T_MEM;
        if (r < T_L) { p0_transpose_item(F.in[I_W2], 64, 1024, 1024, WSP(bf16, WS_W2T), scr, r, F.lane); continue; } r -= T_L;
        p0_transpose_item(F.in[I_A2], 64, 1024, 1024, WSP(bf16, WS_A2T), scr, r, F.lane);
    }
    for (int m = gw; m < MPAD + 1024; m += NGW) {
        if (m < NTOKP) rms_row_to_bf16(F.in[I_XP] + (size_t)m * DM, F.in[I_NW], WSP(bf16, WS_XN) + (size_t)m * DM, F.lane);
        else if (m < NTOK) rms_row_to_bf16(F.in[I_XS] + (size_t)(m - NTOKP) * DM, F.in[I_NW], WSP(bf16, WS_XN) + (size_t)m * DM, F.lane);
        else if (m < MPAD) { v4u z = {0u, 0u, 0u, 0u}; v4u* o = (v4u*)(WSP(bf16, WS_XN) + (size_t)m * DM) + F.lane;
#pragma unroll
            for (int j = 0; j < 4; ++j) o[64 * j] = z; }
        else rms_row_to_bf16(F.in[I_MEM] + (size_t)(m - MPAD) * DM, F.in[I_MNW], WSP(bf16, WS_XM) + (size_t)(m - MPAD) * DM, F.lane);
    }
    const int gt = F.bid * NTHR + F.tid, NGT = F.G * NTHR;
    for (int e = gt; e < 2052 * 96; e += NGT) {
        const int p = e / 96, i = e % 96; const int pos = p < 2048 ? p : PAST + (p - 2048);
        float c, s;
        if (i < 64) { rope_cs(pos, i, 0.8659643233600653, c, s); WSP(f32x2, WS_ROPE128)[p * 64 + i] = (f32x2){c, s}; }
        else { rope_cs(pos, i - 64, 0.7498942093324559, c, s); WSP(f32x2, WS_ROPE64)[p * 32 + (i - 64)] = (f32x2){c, s}; }
    }
}

struct EpiProj {
    float* C;
    __device__ __forceinline__ void operator()(const f32x4 (&acc)[2][2][4][2], const pg8::Unit& u, int wr, int wc, int fr, int fq) const {
        const int row0 = u.pm * 256 + wr * 64 + fr, col0 = u.pn * 256 + wc * 32 + 4 * fq;
#pragma unroll
        for (int ai = 0; ai < 2; ++ai)
#pragma unroll
            for (int m = 0; m < 4; ++m) { float* rowp = C + (size_t)(row0 + ai * 128 + m * 16) * INWP + col0;
#pragma unroll
                for (int bj = 0; bj < 2; ++bj)
#pragma unroll
                    for (int n = 0; n < 2; ++n) *(f32x4*)(rowp + bj * 128 + n * 16) = acc[ai][bj][m][n]; }
    }
};
__device__ __forceinline__ size_t kf_off(int NT, int h, int s, int dim);
__device__ __forceinline__ size_t kif_off(int s, int dim);
__device__ __forceinline__ int src_col(int g) {
    if (g < 4224) return g;
    if (g < 5248) { const int base = g & ~127, p = g & 127; return base + (p >> 5) * 16 + (p & 15) + 64 * ((p >> 4) & 1); }
    if (g < 6272) return g;
    if (g < 7296) { const int base = g & ~63, p = g & 63; return base + (p >> 5) * 16 + (p & 15) + 32 * ((p >> 4) & 1); }
    if (g < 8320) return g + 80;
    if (g < 8384) { const int p = g - 8320; return 7312 + (p >> 5) * 16 + (p & 15) + 32 * ((p >> 4) & 1); }
    if (g < 8400) return 7296 + (g - 8384);
    return -1;
}
struct EpiProjFused {
    float* C; float* out; unsigned char* ws;
    __device__ __forceinline__ void operator()(const f32x4 (&acc)[2][2][4][2], const pg8::Unit& u, int wr, int wc, int fr_in, int fq_in) const {
        int fr = fr_in, fq = fq_in; asm volatile("" : "+v"(fr), "+v"(fq));
        const int row00 = u.pm * 256 + wr * 64 + fr;
#pragma unroll
        for (int bj = 0; bj < 2; ++bj) {
            const int cb = 2 * u.pn + bj;
            const int cq = 128 * cb + 32 * wc + 4 * fq;
            if (cb <= 32 || (cb >= 41 && cb <= 48) || (cb >= 61 && cb <= 64)) {
#pragma unroll
                for (int ai = 0; ai < 2; ++ai)
#pragma unroll
                    for (int m = 0; m < 4; ++m) { const int row = row00 + ai * 128 + m * 16;
                        if (row < NTOK) {
                            if (cb <= 24) { float* sp = (float*)(ws + WS_SHT) + (((size_t)(row >> 4) * 800 + (cq >> 2)) * 16 + (row & 15)) * 4;
                                *(f32x4*)sp = acc[ai][bj][m][0]; *(f32x4*)(sp + 4 * 16 * 4) = acc[ai][bj][m][1]; }
                            else { float* rowp = C + (size_t)row * INWP + cq;
                                *(f32x4*)rowp = acc[ai][bj][m][0]; *(f32x4*)(rowp + 16) = acc[ai][bj][m][1]; }
                            const bool prm = row < NTOKP; const int srow = row - NTOKP;
                            if (cb >= 41 && cb <= 44) { float* vo = out + (prm ? O_VP + (size_t)row * 512 : O_VS + (size_t)srow * 512) + (cq - C_AV);
                                *(f32x4*)vo = acc[ai][bj][m][0]; *(f32x4*)(vo + 16) = acc[ai][bj][m][1]; }
                            if (cb <= 24 && (prm ? ((row & 2047) == 2047) : ((srow & 3) == 3))) {
                                float* so = out + (prm ? O_SHP + (size_t)(row >> 11) * SHW : O_SHS + (size_t)(srow >> 2) * SHW) + cq;
                                *(f32x4*)so = acc[ai][bj][m][0]; *(f32x4*)(so + 16) = acc[ai][bj][m][1]; }
                        } }
            } else if (cb <= 40) {
                const bool isq = cb <= 36; const int h = isq ? cb - 33 : cb - 37, i0 = 16 * wc + 4 * fq;
#pragma unroll
                for (int ai = 0; ai < 2; ++ai)
#pragma unroll
                    for (int m = 0; m < 4; ++m) { const int row = row00 + ai * 128 + m * 16;
                        if (row < NTOK) {
                            const bool prm = row < NTOKP; const int srow = row - NTOKP;
                            const int p = prm ? (row & 2047) : 2048 + (srow & 3);
                            const f32x4 t0 = *(const f32x4*)((const float*)(ws + WS_ROPE128) + (size_t)(p * 64 + i0) * 2), t1 = *(const f32x4*)((const float*)(ws + WS_ROPE128) + (size_t)(p * 64 + i0 + 2) * 2);
                            const f32x4 x1 = acc[ai][bj][m][0], x2 = acc[ai][bj][m][1];
                            f32x4 o1, o2;
                            o1.x = x1.x * t0.x - x2.x * t0.y; o2.x = x2.x * t0.x + x1.x * t0.y; o1.y = x1.y * t0.z - x2.y * t0.w; o2.y = x2.y * t0.z + x1.y * t0.w;
                            o1.z = x1.z * t1.x - x2.z * t1.y; o2.z = x2.z * t1.x + x1.z * t1.y; o1.w = x1.w * t1.z - x2.w * t1.w; o2.w = x2.w * t1.z + x1.w * t1.w;
                            if (isq) { bf16* qb = (bf16*)(ws + WS_QB) + (size_t)row * 512 + h * 128 + i0;
                                v2u a, b; a.x = cvt_pk_bf16(o1.x * QSCALE, o1.y * QSCALE); a.y = cvt_pk_bf16(o1.z * QSCALE, o1.w * QSCALE); b.x = cvt_pk_bf16(o2.x * QSCALE, o2.y * QSCALE); b.y = cvt_pk_bf16(o2.z * QSCALE, o2.w * QSCALE);
                                *(v2u*)qb = a; *(v2u*)(qb + 64) = b; }
                            else { float* ko = out + (prm ? O_KP + (size_t)row * 512 : O_KS + (size_t)srow * 512) + h * 128 + i0;
                                *(f32x4*)ko = o1; *(f32x4*)(ko + 64) = o2;
                                if (prm) { bf16* KF = (bf16*)(ws + WS_KB) + (size_t)(row >> 11) * SEQ * 512; const int sq = row & 2047;
                                    v2u a, b; a.x = cvt_pk_bf16(o1.x, o1.y); a.y = cvt_pk_bf16(o1.z, o1.w); b.x = cvt_pk_bf16(o2.x, o2.y); b.y = cvt_pk_bf16(o2.z, o2.w);
                                    *(v2u*)(KF + kf_off(64, h, sq, i0)) = a; *(v2u*)(KF + kf_off(64, h, sq, 64 + i0)) = b; } }
                        } }
            } else if (cb >= 49 && cb <= 56) {
                const int hd = 2 * (cb - 49) + (wc >> 1), i0 = 16 * (wc & 1) + 4 * fq;
#pragma unroll
                for (int ai = 0; ai < 2; ++ai)
#pragma unroll
                    for (int m = 0; m < 4; ++m) { const int row = row00 + ai * 128 + m * 16;
                        if (row < NTOK) {
                            const int p = row < NTOKP ? (row & 2047) : 2048 + ((row - NTOKP) & 3);
                            const f32x4 t0 = *(const f32x4*)((const float*)(ws + WS_ROPE64) + (size_t)(p * 32 + i0) * 2), t1 = *(const f32x4*)((const float*)(ws + WS_ROPE64) + (size_t)(p * 32 + i0 + 2) * 2);
                            const f32x4 x1 = acc[ai][bj][m][0], x2 = acc[ai][bj][m][1];
                            v2u a, b;
                            a.x = cvt_pk_bf16(x1.x * t0.x - x2.x * t0.y, x1.y * t0.z - x2.y * t0.w); a.y = cvt_pk_bf16(x1.z * t1.x - x2.z * t1.y, x1.w * t1.z - x2.w * t1.w);
                            b.x = cvt_pk_bf16(x2.x * t0.x + x1.x * t0.y, x2.y * t0.z + x1.y * t0.w); b.y = cvt_pk_bf16(x2.z * t1.x + x1.z * t1.y, x2.w * t1.z + x1.w * t1.w);
                            bf16* qi = (bf16*)(ws + WS_QIB) + (size_t)row * 1024 + hd * 64 + i0;
                            *(v2u*)qi = a; *(v2u*)(qi + 32) = b;
                        } }
            } else if (cb >= 57 && cb <= 60) {
#pragma unroll
                for (int ai = 0; ai < 2; ++ai)
#pragma unroll
                    for (int m = 0; m < 4; ++m) { const int row = row00 + ai * 128 + m * 16;
                        if (row < NTOK) { bf16* qm = (bf16*)(ws + WS_QMB) + (size_t)row * 512 + (cq - 7296);
#pragma unroll
                            for (int n = 0; n < 2; ++n) { const f32x4 v = acc[ai][bj][m][n]; v2u a; a.x = cvt_pk_bf16(v.x * QSCALE, v.y * QSCALE); a.y = cvt_pk_bf16(v.z * QSCALE, v.w * QSCALE); *(v2u*)(qm + 16 * n) = a; } } }
            } else if (cb == 65) {
                if (wc < 2) { const int i0 = 16 * wc + 4 * fq;
#pragma unroll
                    for (int ai = 0; ai < 2; ++ai)
#pragma unroll
                        for (int m = 0; m < 4; ++m) { const int row = row00 + ai * 128 + m * 16;
                            if (row < NTOK) {
                                const bool prm = row < NTOKP; const int srow = row - NTOKP;
                                const int p = prm ? (row & 2047) : 2048 + (srow & 3);
                                const f32x4 t0 = *(const f32x4*)((const float*)(ws + WS_ROPE64) + (size_t)(p * 32 + i0) * 2), t1 = *(const f32x4*)((const float*)(ws + WS_ROPE64) + (size_t)(p * 32 + i0 + 2) * 2);
                                const f32x4 x1 = acc[ai][bj][m][0], x2 = acc[ai][bj][m][1];
                                f32x4 o1, o2;
                                o1.x = x1.x * t0.x - x2.x * t0.y; o2.x = x2.x * t0.x + x1.x * t0.y; o1.y = x1.y * t0.z - x2.y * t0.w; o2.y = x2.y * t0.z + x1.y * t0.w;
                                o1.z = x1.z * t1.x - x2.z * t1.y; o2.z = x2.z * t1.x + x1.z * t1.y; o1.w = x1.w * t1.z - x2.w * t1.w; o2.w = x2.w * t1.z + x1.w * t1.w;
                                float* kio = out + (prm ? O_KIP + (size_t)row * 64 : O_KIS + (size_t)srow * 64) + i0;
                                *(f32x4*)kio = o1; *(f32x4*)(kio + 32) = o2;
                                v2u a, b; a.x = cvt_pk_bf16(o1.x, o1.y); a.y = cvt_pk_bf16(o1.z, o1.w); b.x = cvt_pk_bf16(o2.x, o2.y); b.y = cvt_pk_bf16(o2.z, o2.w);
                                bf16* kib = (bf16*)(ws + WS_KIB) + (size_t)row * 64 + i0; *(v2u*)kib = a; *(v2u*)(kib + 32) = b;
                                if (prm) { bf16* KIF = (bf16*)(ws + WS_SC) + (size_t)(row >> 11) * SEQ * 64; const int sq = row & 2047;
                                    *(v2u*)(KIF + kif_off(sq, i0)) = a; *(v2u*)(KIF + kif_off(sq, 32 + i0)) = b; }
                            } }
                } else if (wc == 2) {
#pragma unroll
                    for (int ai = 0; ai < 2; ++ai)
#pragma unroll
                        for (int m = 0; m < 4; ++m) { const int row = row00 + ai * 128 + m * 16;
                            if (row < NTOK) { const f32x4 v = acc[ai][bj][m][0]; *(f32x4*)((float*)(ws + WS_WIS) + (size_t)row * 16 + 4 * fq) = (f32x4){v.x * (1.f / 32.f), v.y * (1.f / 32.f), v.z * (1.f / 32.f), v.w * (1.f / 32.f)}; } }
                }
            }
        }
    }
};
struct EpiMem {
    float* out;
    __device__ __forceinline__ void operator()(const f32x4 (&acc)[2][2][4][2], const pg8::Unit& u, int wr, int wc, int fr, int fq) const {
        const int row0 = u.pm * 256 + wr * 64 + fr; int colt = u.pn * 256;
        float* base = out + (colt < 512 ? O_MKP : O_MVP); if (colt >= 512) colt -= 512;
        const int col0 = colt + wc * 32 + 4 * fq;
#pragma unroll
        for (int ai = 0; ai < 2; ++ai)
#pragma unroll
            for (int m = 0; m < 4; ++m) { float* rowp = base + (size_t)(row0 + ai * 128 + m * 16) * 512 + col0;
#pragma unroll
                for (int bj = 0; bj < 2; ++bj)
#pragma unroll
                    for (int n = 0; n < 2; ++n) *(f32x4*)(rowp + bj * 128 + n * 16) = acc[ai][bj][m][n]; }
    }
};
__device__ __forceinline__ void atomic_add4(float* p, const f32x4& v) { unsafeAtomicAdd(p, v.x); unsafeAtomicAdd(p + 1, v.y); unsafeAtomicAdd(p + 2, v.z); unsafeAtomicAdd(p + 3, v.w); }
struct EpiProjAtomic {
    float* C;
    __device__ __forceinline__ void operator()(const f32x4 (&acc)[2][2][4][2], const pg8::Unit& u, int wr, int wc, int fr, int fq) const {
        const int row0 = u.pm * 256 + wr * 64 + fr, col0 = u.pn * 256 + wc * 32 + 4 * fq;
#pragma unroll
        for (int ai = 0; ai < 2; ++ai)
#pragma unroll
            for (int m = 0; m < 4; ++m) { const int row = row0 + ai * 128 + m * 16; float* rowp = C + (size_t)row * INWP + col0;
                if (row < NTOK) {
#pragma unroll
                    for (int bj = 0; bj < 2; ++bj)
#pragma unroll
                        for (int n = 0; n < 2; ++n) atomic_add4(rowp + bj * 128 + n * 16, acc[ai][bj][m][n]); } }
    }
};
struct EpiMemAtomic {
    float* out;
    __device__ __forceinline__ void operator()(const f32x4 (&acc)[2][2][4][2], const pg8::Unit& u, int wr, int wc, int fr, int fq) const {
        const int row0 = u.pm * 256 + wr * 64 + fr; int colt = u.pn * 256;
        float* base = out + (colt < 512 ? O_MKP : O_MVP); if (colt >= 512) colt -= 512;
        const int col0 = colt + wc * 32 + 4 * fq;
#pragma unroll
        for (int ai = 0; ai < 2; ++ai)
#pragma unroll
            for (int m = 0; m < 4; ++m) { float* rowp = base + (size_t)(row0 + ai * 128 + m * 16) * 512 + col0;
#pragma unroll
                for (int bj = 0; bj < 2; ++bj)
#pragma unroll
                    for (int n = 0; n < 2; ++n) atomic_add4(rowp + bj * 128 + n * 16, acc[ai][bj][m][n]); }
    }
};
struct EpiOutAtomic {
    float* out;
    __device__ __forceinline__ void operator()(const f32x4 (&acc)[2][2][4][2], const pg8::Unit& u, int wr, int wc, int fr, int fq) const {
        const int row0 = u.pm * 256 + wr * 64 + fr, col0 = u.pn * 256 + wc * 32 + 4 * fq;
#pragma unroll
        for (int ai = 0; ai < 2; ++ai)
#pragma unroll
            for (int m = 0; m < 4; ++m) { const int row = row0 + ai * 128 + m * 16;
                if (row >= NTOKP && row < NTOK) { float* orow = out + O_YS + (size_t)(row - NTOKP) * DM + col0;
#pragma unroll
                    for (int bj = 0; bj < 2; ++bj)
#pragma unroll
                        for (int n = 0; n < 2; ++n) atomic_add4(orow + bj * 128 + n * 16, acc[ai][bj][m][n]); } }
    }
};
struct EpiOut {
    const float* xp; const float* xs; float* out;
    __device__ __forceinline__ void operator()(const f32x4 (&acc)[2][2][4][2], const pg8::Unit& u, int wr, int wc, int fr, int fq) const {
        const int row0 = u.pm * 256 + wr * 64 + fr, col0 = u.pn * 256 + wc * 32 + 4 * fq;
#pragma unroll
        for (int ai = 0; ai < 2; ++ai)
#pragma unroll
            for (int m = 0; m < 4; ++m) { const int row = row0 + ai * 128 + m * 16;
                if (row < NTOK) {
                    const float* xr = (row < NTOKP ? xp + (size_t)row * DM : xs + (size_t)(row - NTOKP) * DM) + col0;
                    float* orow = out + (row < NTOKP ? O_YP + (size_t)row * DM : O_YS + (size_t)(row - NTOKP) * DM) + col0;
#pragma unroll
                    for (int bj = 0; bj < 2; ++bj)
#pragma unroll
                        for (int n = 0; n < 2; ++n) *(f32x4*)(orow + bj * 128 + n * 16) = acc[ai][bj][m][n] + *(const f32x4*)(xr + bj * 128 + n * 16); } }
    }
};

__device__ __forceinline__ float prev_val(const Frame& F, const float* P, int row, int col) {
    if (row < NTOKP) { return (row & (SEQ - 1)) == 0 ? 0.f : P[(size_t)(row - 1) * INWP + col]; }
    const int s = row - NTOKP; return (s & 3) == 0 ? F.in[I_SSH][(size_t)(s >> 2) * SHW + col] : P[(size_t)(row - 1) * INWP + col];
}
__device__ __forceinline__ size_t scan_seq_off(int row, int h) {
    if (row < NTOKP) { const int b = row >> 11, t = row & 2047; return ((size_t)(b * RH + h) * SEQ + t); }
    const int s = row - NTOKP, db = s >> 2, t = s & 3; return (size_t)NB * RH * SEQ + ((size_t)(db * RH + h) * DT + t);
}
__device__ __forceinline__ size_t kf_off(int NT, int h, int s, int dim) { return ((size_t)((h * NT + (s >> 5)) * 8 + (dim >> 4))) * 512 + (((dim >> 3) & 1) * 32 + (s & 31)) * 8 + (dim & 7); }
__device__ __forceinline__ size_t kif_off(int s, int dim) { return ((size_t)((s >> 5) * 4 + (dim >> 4))) * 512 + (((dim >> 3) & 1) * 32 + (s & 31)) * 8 + (dim & 7); }
__device__ __forceinline__ f32x4 ld4(const float* p) { return *(const f32x4*)p; }
__device__ __forceinline__ f32x4 sht4(const float* SHT, int row, int col) { return *(const f32x4*)(SHT + (((size_t)(row >> 4) * 800 + (col >> 2)) * 16 + (row & 15)) * 4); }
__device__ __forceinline__ f32x4 prev4(const Frame& F, const float* SHT, int row, int col) {
    if (row < NTOKP) { if ((row & (SEQ - 1)) == 0) return (f32x4){0.f, 0.f, 0.f, 0.f}; return sht4(SHT, row - 1, col); }
    const int s = row - NTOKP; if ((s & 3) == 0) return ld4(F.in[I_SSH] + (size_t)(s >> 2) * SHW + col); return sht4(SHT, row - 1, col);
}
__device__ __forceinline__ void p2_rwkv_witem(Frame& F, int tile, int h0, int nh) {
    const int row0 = tile * 16;
    const int lane = F.lane, tk = lane & 15, kq = lane >> 4, row = row0 + tk;
    const float* SHT = WSP(float, WS_SHT);
    const float* cbp = SHT + ((size_t)(row >> 4) * 800 * 16 + (row & 15)) * 4;
    const bool prm = row < NTOKP; const int srow = row - NTOKP;
    const bool first = prm ? ((row & (SEQ - 1)) == 0) : ((srow & 3) == 0);
    const int r1 = first ? row : row - 1;
    const float* pbp = (first && !prm) ? F.in[I_SSH] + (size_t)(srow >> 2) * SHW : SHT + ((size_t)(r1 >> 4) * 800 * 16 + (r1 & 15)) * 4;
    const int pst = (first && !prm) ? 4 : 64;
    const float pz = (first && prm) ? 0.f : 1.f;
#define CUR4(col) ld4(cbp + (size_t)((col) >> 2) * 64)
#define PRV4(col) (ld4(pbp + (size_t)((col) >> 2) * pst) * pz)
    const float* mu = F.in[I_MU];
    bf16x8 bw[2], ba[2];
#pragma unroll
    for (int ks = 0; ks < 2; ++ks) {
        const int c0 = 32 * ks + 8 * kq;
        float xw[8], xa[8];
#pragma unroll
        for (int hf = 0; hf < 2; ++hf) {
            const f32x4 cw = CUR4(C_CW + c0 + 4 * hf), pw = PRV4(C_CW + c0 + 4 * hf), mw = ld4(mu + C_CW + c0 + 4 * hf);
            const f32x4 ca = CUR4(C_CA + c0 + 4 * hf), pa = PRV4(C_CA + c0 + 4 * hf), ma = ld4(mu + C_CA + c0 + 4 * hf);
#pragma unroll
            for (int e = 0; e < 4; ++e) { const float x = cw[e] + (pw[e] - cw[e]) * mw[e];
                const float t = __builtin_amdgcn_exp2f(x * 2.8853900817779268f); xw[4 * hf + e] = 1.f - 2.f * __builtin_amdgcn_rcpf(t + 1.f);
                xa[4 * hf + e] = ca[e] + (pa[e] - ca[e]) * ma[e]; }
        }
        v4u uw, ua; uw.x = cvt_pk_bf16(xw[0], xw[1]); uw.y = cvt_pk_bf16(xw[2], xw[3]); uw.z = cvt_pk_bf16(xw[4], xw[5]); uw.w = cvt_pk_bf16(xw[6], xw[7]);
        ua.x = cvt_pk_bf16(xa[0], xa[1]); ua.y = cvt_pk_bf16(xa[2], xa[3]); ua.z = cvt_pk_bf16(xa[4], xa[5]); ua.w = cvt_pk_bf16(xa[6], xa[7]);
        bw[ks] = __builtin_bit_cast(bf16x8, uw); ba[ks] = __builtin_bit_cast(bf16x8, ua);
    }
    const bf16* W2T = WSP(bf16, WS_W2T); const bf16* A2T = WSP(bf16, WS_A2T);
    float* SI = WSP(float, WS_SCANIN); float* SL = WSP(float, WS_SCAL);
    for (int hh = 0; hh < nh; ++hh) {
        const int h = h0 + hh;
        f32x4 wl[4], al[4];
#pragma unroll
        for (int n = 0; n < 4; ++n) {
            const int chA = h * 64 + n * 16 + tk;
            wl[n] = (f32x4){0.f, 0.f, 0.f, 0.f}; al[n] = (f32x4){0.f, 0.f, 0.f, 0.f};
#pragma unroll
            for (int ks = 0; ks < 2; ++ks) {
                const bf16x8 aw = *(const bf16x8*)(W2T + (size_t)chA * 64 + 32 * ks + 8 * kq);
                const bf16x8 aa = *(const bf16x8*)(A2T + (size_t)chA * 64 + 32 * ks + 8 * kq);
                wl[n] = __builtin_amdgcn_mfma_f32_16x16x32_bf16(aw, bw[ks], wl[n], 0, 0, 0);
                al[n] = __builtin_amdgcn_mfma_f32_16x16x32_bf16(aa, ba[ks], al[n], 0, 0, 0);
            }
        }
        f32x4 Lxk[4], Lqk[4], Lxr[4], Lqr[4], Lxv[4], Lqv[4];
#pragma unroll
        for (int n = 0; n < 4; ++n) { const int ch = h * 64 + n * 16 + 4 * kq;
            Lxk[n] = CUR4(C_K + ch); Lqk[n] = PRV4(C_K + ch); }
        __builtin_amdgcn_sched_barrier(0);
#pragma unroll
        for (int n = 0; n < 4; ++n) { const int ch = h * 64 + n * 16 + 4 * kq; Lxr[n] = CUR4(C_R + ch); Lqr[n] = PRV4(C_R + ch); Lxv[n] = CUR4(C_V + ch); Lqv[n] = PRV4(C_V + ch); }
        f32x4 k4[4];
        float ss = 0.f;
#pragma unroll
        for (int n = 0; n < 4; ++n) {
            const int ch = h * 64 + n * 16 + 4 * kq;
            const f32x4 xk = Lxk[n], qk = Lqk[n], mk = ld4(mu + C_K + ch), kkw = ld4(F.in[I_KK] + ch);
#pragma unroll
            for (int j = 0; j < 4; ++j) { k4[n][j] = xk[j] + (qk[j] - xk[j]) * mk[j]; const float t = k4[n][j] * kkw[j]; ss += t * t; }
        }
        ss += __shfl_xor(ss, 16); ss += __shfl_xor(ss, 32);
        const float inv = 1.f / fmaxf(sqrtf(ss), 1e-12f);
        float s_nbr = 0.f, s_kr = 0.f, s_bon = 0.f;
        const size_t so = scan_seq_off(row, h);
        float* dst = SI + so * 384 + 4 * kq;
#pragma unroll
        for (int n = 0; n < 4; ++n) {
            const int ch = h * 64 + n * 16 + 4 * kq;
            const f32x4 xr = Lxr[n], xv = Lxv[n], qr = Lqr[n], qv = Lqv[n];
            const f32x4 mr = ld4(mu + C_R + ch), mv = ld4(mu + C_V + ch);
            const f32x4 w0 = ld4(F.in[I_W0] + ch), a0 = ld4(F.in[I_A0] + ch), kkw = ld4(F.in[I_KK] + ch), ka = ld4(F.in[I_KA] + ch), rk = ld4(F.in[I_RK] + ch);
            f32x4 kk, kp, nb, wr, wv, vv;
#pragma unroll
            for (int j = 0; j < 4; ++j) {
                const float r = xr[j] + (qr[j] - xr[j]) * mr[j]; vv[j] = xv[j] + (qv[j] - xv[j]) * mv[j];
                const float wlin = w0[j] + wl[n][j];
                const float sg = __builtin_amdgcn_rcpf(1.f + __builtin_amdgcn_exp2f(-wlin * 1.4426950408889634f));
                wv[j] = __builtin_amdgcn_exp2f(-0.8750338f * sg);
                const float alin = a0[j] + al[n][j];
                const float a = __builtin_amdgcn_rcpf(1.f + __builtin_amdgcn_exp2f(-alin * 1.4426950408889634f));
                kk[j] = k4[n][j] * kkw[j] * inv;
                kp[j] = k4[n][j] * (1.f + (a - 1.f) * ka[j]);
                nb[j] = -kk[j] * a;
                wr[j] = wv[j] * r;
                s_nbr += nb[j] * r; s_kr += kp[j] * r; s_bon += r * kp[j] * rk[j];
            }
            *(f32x4*)(dst + 0 * 64 + 16 * n) = kk; *(f32x4*)(dst + 1 * 64 + 16 * n) = wv; *(f32x4*)(dst + 2 * 64 + 16 * n) = nb;
            *(f32x4*)(dst + 3 * 64 + 16 * n) = kp; *(f32x4*)(dst + 4 * 64 + 16 * n) = wr; *(f32x4*)(dst + 5 * 64 + 16 * n) = vv;
        }
        s_nbr += __shfl_xor(s_nbr, 16); s_nbr += __shfl_xor(s_nbr, 32);
        s_kr += __shfl_xor(s_kr, 16); s_kr += __shfl_xor(s_kr, 32);
        s_bon += __shfl_xor(s_bon, 16); s_bon += __shfl_xor(s_bon, 32);
        if (kq == 0) *(f32x4*)(SL + so * 16) = (f32x4){s_nbr, s_kr, s_bon, 0.f};
    }
}
#undef CUR4
#undef PRV4
__device__ __forceinline__ void p2_row_item(Frame& F, int row) {
    const float* P = WSP(float, WS_PROJ) + (size_t)row * INWP;
    const int lane = F.lane;
    const bool prm = row < NTOKP; const int srow = row - NTOKP;
    const int p = prm ? (row & 2047) : 2048 + (srow & 3);
    const f32x2* T128 = WSP(f32x2, WS_ROPE128) + p * 64; const f32x2* T64 = WSP(f32x2, WS_ROPE64) + p * 32;
    bf16* QB = WSP(bf16, WS_QB) + (size_t)row * 512; bf16* KF = WSP(bf16, WS_KB) + (size_t)(row >> 11) * SEQ * 512; const int sq = row & 2047;
    float* ko = F.out + (prm ? O_KP + (size_t)row * 512 : O_KS + (size_t)srow * 512);
    float* vo = F.out + (prm ? O_VP + (size_t)row * 512 : O_VS + (size_t)srow * 512);
    const f32x2 cs = T128[lane];
    float Lq1[4], Lq2[4], Lk1[4], Lk2[4];
#pragma unroll
    for (int h = 0; h < 4; ++h) { Lq1[h] = P[C_Q + h * 128 + lane]; Lq2[h] = P[C_Q + h * 128 + 64 + lane]; Lk1[h] = P[C_AK + h * 128 + lane]; Lk2[h] = P[C_AK + h * 128 + 64 + lane]; }
    float Li1[8], Li2[8]; f32x2 Lc[8];
#pragma unroll
    for (int j = 0; j < 8; ++j) { const int pi = lane + 64 * j, hd = pi >> 5, i = pi & 31; Li1[j] = P[C_QI + hd * 64 + i]; Li2[j] = P[C_QI + hd * 64 + 32 + i]; Lc[j] = T64[i]; }
    const f32x4 Lv0 = *(const f32x4*)(P + C_AV + 4 * lane), Lv1 = *(const f32x4*)(P + C_AV + 256 + 4 * lane);
    const f32x4 Lm0 = *(const f32x4*)(P + C_QM + 8 * lane), Lm1 = *(const f32x4*)(P + C_QM + 8 * lane + 4);
    __builtin_amdgcn_sched_barrier(0);
#pragma unroll
    for (int h = 0; h < 4; ++h) {
        { const float x1 = Lq1[h], x2 = Lq2[h];
          const float o1 = (x1 * cs.x - x2 * cs.y) * QSCALE, o2 = (x2 * cs.x + x1 * cs.y) * QSCALE;
          QB[h * 128 + lane] = (bf16)(cvt_pk_bf16(o1, 0.f) & 0xffffu); QB[h * 128 + 64 + lane] = (bf16)(cvt_pk_bf16(o2, 0.f) & 0xffffu); }
        { const float x1 = Lk1[h], x2 = Lk2[h];
          const float o1 = x1 * cs.x - x2 * cs.y, o2 = x2 * cs.x + x1 * cs.y;
          ko[h * 128 + lane] = o1; ko[h * 128 + 64 + lane] = o2;
          if (prm) { KF[kf_off(64, h, sq, lane)] = (bf16)(cvt_pk_bf16(o1, 0.f) & 0xffffu); KF[kf_off(64, h, sq, 64 + lane)] = (bf16)(cvt_pk_bf16(o2, 0.f) & 0xffffu); } }
    }
    {
        f32x4* d = (f32x4*)vo;
        d[lane] = Lv0; d[64 + lane] = Lv1;
    }
    {
        bf16* QIB = WSP(bf16, WS_QIB) + (size_t)row * 1024;
#pragma unroll
        for (int j = 0; j < 8; ++j) { const int pi = lane + 64 * j, hd = pi >> 5, i = pi & 31; const f32x2 c2 = Lc[j];
            const float x1 = Li1[j], x2 = Li2[j];
            QIB[hd * 64 + i] = (bf16)(cvt_pk_bf16(x1 * c2.x - x2 * c2.y, 0.f) & 0xffffu); QIB[hd * 64 + 32 + i] = (bf16)(cvt_pk_bf16(x2 * c2.x + x1 * c2.y, 0.f) & 0xffffu); }
    }
    if (lane < 32) {
        const f32x2 c2 = T64[lane]; const float x1 = P[C_KI + lane], x2 = P[C_KI + 32 + lane];
        const float o1 = x1 * c2.x - x2 * c2.y, o2 = x2 * c2.x + x1 * c2.y;
        float* kio = F.out + (prm ? O_KIP + (size_t)row * 64 : O_KIS + (size_t)srow * 64);
        kio[lane] = o1; kio[32 + lane] = o2;
        bf16* KIB = WSP(bf16, WS_KIB) + (size_t)row * 64;
        KIB[lane] = (bf16)(cvt_pk_bf16(o1, 0.f) & 0xffffu); KIB[32 + lane] = (bf16)(cvt_pk_bf16(o2, 0.f) & 0xffffu);
        if (prm) { bf16* KIF = WSP(bf16, WS_SC) + (size_t)(row >> 11) * SEQ * 64; KIF[kif_off(sq, lane)] = (bf16)(cvt_pk_bf16(o1, 0.f) & 0xffffu); KIF[kif_off(sq, 32 + lane)] = (bf16)(cvt_pk_bf16(o2, 0.f) & 0xffffu); }
    }
    if (lane < 16) WSP(float, WS_WIS)[(size_t)row * 16 + lane] = P[C_WI + lane] * (1.f / 32.f);
    {
        bf16* QMB = WSP(bf16, WS_QMB) + (size_t)row * 512;
        const f32x4 a = Lm0, b = Lm1;
        v4u o; o.x = cvt_pk_bf16(a.x * QSCALE, a.y * QSCALE); o.y = cvt_pk_bf16(a.z * QSCALE, a.w * QSCALE); o.z = cvt_pk_bf16(b.x * QSCALE, b.y * QSCALE); o.w = cvt_pk_bf16(b.z * QSCALE, b.w * QSCALE);
        *(v4u*)(QMB + 8 * lane) = o;
    }
    if (prm ? ((row & 2047) == 2047) : ((srow & 3) == 3)) {
        float* so = F.out + (prm ? O_SHP + (size_t)(row >> 11) * SHW : O_SHS + (size_t)(srow >> 2) * SHW);
        for (int c = lane; c < SHW; c += 64) so[c] = P[c];
    }
}
__device__ __forceinline__ void p2_vt_item(Frame& F, const float* src, size_t ld_src, bf16* dstb, int NT, int ts) {
    LAS bf16* tile = (LAS bf16*)(F.lds + RING_OFF);
    { f32x4 tv[16];
#pragma unroll
      for (int i = 0; i < 16; ++i) { const int e = F.tid + i * NTHR, tok = e >> 7, c4 = (e & 127) * 4; tv[i] = *(const f32x4*)(src + (size_t)tok * ld_src + c4); }
#pragma unroll
      for (int i = 0; i < 16; ++i) { const int e = F.tid + i * NTHR, tok = e >> 7, c4 = (e & 127) * 4;
        v2u o; o.x = cvt_pk_bf16(tv[i].x, tv[i].y); o.y = cvt_pk_bf16(tv[i].z, tv[i].w); *(LAS v2u*)(tile + tok * 520 + c4) = o; } }
    __syncthreads();
    const int rsub = F.lane >> 3, chunk = F.lane & 7;
    for (int it = 0; it < 8; ++it) { const int hd = (it * 8 + F.wave) * 8 + rsub, h = hd >> 7, d = hd & 127;
        unsigned short e[8];
#pragma unroll
        for (int k = 0; k < 8; ++k) e[k] = tile[(chunk * 8 + k) * 520 + hd];
        const int kt = ts * 2 + (chunk >> 2), s2 = (chunk >> 1) & 1, g = chunk & 1;
        bf16* p = dstb + ((size_t)((h * NT + kt) * 8 + (d >> 5) * 2 + s2)) * 512 + (d & 31) * 8 + g * 4;
        v2u lo, hi; lo.x = e[0] | ((unsigned)e[1] << 16); lo.y = e[2] | ((unsigned)e[3] << 16); hi.x = e[4] | ((unsigned)e[5] << 16); hi.y = e[6] | ((unsigned)e[7] << 16);
        *(v2u*)p = lo; *(v2u*)(p + 32 * 8) = hi; }
    __syncthreads();
}
#ifndef PROBE_REPEAT
#define PROBE_REPEAT -1
#endif
__device__ __forceinline__ void p2_phase(Frame& F) {
    const int gw = F.bid * NWAVES + F.wave, NGW = F.G * NWAVES;
    for (int rep = 0; rep < (PROBE_REPEAT == 20 ? 2 : 1); ++rep)
    for (int it = gw; it < (NTOKP / 16) * 8; it += NGW) p2_rwkv_witem(F, it >> 3, (it & 7) * 2, 2);
    for (int it = NGW - 1 - gw; it < (NTOKS / 16) * 16; it += NGW) p2_rwkv_witem(F, NTOKP / 16 + (it >> 4), it & 15, 1);
    for (int rep = 0; rep < (PROBE_REPEAT == 21 ? 2 : 1); ++rep)
    for (int it = F.bid; it < 128 + 16; it += F.G) {
        if (it < 128) { const int b = it >> 5, ts = it & 31;
            p2_vt_item(F, WSP(float, WS_PROJ) + (size_t)(b * SEQ + ts * 64) * INWP + C_AV, INWP, WSP(bf16, WS_VT) + (size_t)b * 512 * SEQ, 64, ts); }
        else { const int j = it - 128, b = j >> 2, ts = j & 3;
            p2_vt_item(F, F.out + O_MVP + (size_t)(b * MEMT + ts * 64) * 512, 512, WSP(bf16, WS_MVT) + (size_t)b * 512 * MEMT, 8, ts); }
    }
    const int gt = F.bid * NTHR + F.tid, NGT = F.G * NTHR;
    for (int e = gt; e < 1024 * 512 / 4; e += NGT) { const f32x4 v = *(const f32x4*)(F.out + O_MKP + (size_t)e * 4); v2u o; o.x = cvt_pk_bf16(v.x, v.y); o.y = cvt_pk_bf16(v.z, v.w);
        const int rowm = e >> 7, col = (e & 127) * 4, bm = rowm >> 8, m = rowm & 255; *(v2u*)(WSP(bf16, WS_MKB) + (size_t)bm * MEMT * 512 + kf_off(8, col >> 7, m, col & 127)) = o; }
}

constexpr int TC = 32, SBUF_FLOATS = TC * 384;
#define SCAN_STAGE_LOAD(SIN, SCALP) do { \
    _Pragma("unroll") for (int i = 0; i < 10; ++i) { const int e = lt + 256 * i, st = e / 80, r = e % 80; rv[i] = *(const f32x4*)((SIN) + (size_t)st * 384 + r * 4); } \
    _Pragma("unroll") for (int i = 0; i < 2; ++i) { const int e = lt + 256 * i, st = e >> 4, row = e & 15; const float v_ = (SIN)[(size_t)st * 384 + 320 + rg * 16 + row]; const f32x2 sc_ = *(const f32x2*)((SCALP) + (size_t)st * 16); \
        rt[i].x = v_; rt[i].y = sc_.x; rt[i].z = sc_.y; rt[i].w = 0.f; } } while (0)
#define SCAN_STAGE_WRITE(BUF) do { \
    _Pragma("unroll") for (int i = 0; i < 10; ++i) { const int e = lt + 256 * i, st = e / 80, r = e % 80; *(LAS f32x4*)((BUF) + st * 384 + r * 4) = rv[i]; } \
    _Pragma("unroll") for (int i = 0; i < 2; ++i) { const int e = lt + 256 * i, st = e >> 4, row = e & 15; *(LAS f32x4*)((BUF) + st * 384 + 320 + row * 4) = rt[i]; } } while (0)
#define SCAN_STEP(KK, W4, NB, KP, WR, TB, YOUT) do { \
    f32x2 _a = s01 * (f32x2){KK.x, KK.y}; _a = __builtin_elementwise_fma(s23, (f32x2){KK.z, KK.w}, _a); \
    f32x2 _b = s01 * (f32x2){WR.x, WR.y}; _b = __builtin_elementwise_fma(s23, (f32x2){WR.z, WR.w}, _b); \
    float _p1 = _a.x + _a.y, _p2 = _b.x + _b.y; \
    _p1 += dpp<0xB1>(_p1); _p2 += dpp<0xB1>(_p2); _p1 += dpp<0x4E>(_p1); _p2 += dpp<0x4E>(_p2); _p1 += dpp<0x141>(_p1); _p2 += dpp<0x141>(_p2); _p1 += dpp<0x140>(_p1); _p2 += dpp<0x140>(_p2); \
    YOUT = __builtin_fmaf(TB.x, TB.z, __builtin_fmaf(_p1, TB.y, _p2)); \
    const f32x2 _pp = (f32x2){_p1, _p1}, _vv = (f32x2){TB.x, TB.x}; \
    f32x2 _t01 = _vv * (f32x2){KP.x, KP.y}; _t01 = __builtin_elementwise_fma(_pp, (f32x2){NB.x, NB.y}, _t01); s01 = __builtin_elementwise_fma(s01, (f32x2){W4.x, W4.y}, _t01); \
    f32x2 _t23 = _vv * (f32x2){KP.z, KP.w}; _t23 = __builtin_elementwise_fma(_pp, (f32x2){NB.z, NB.w}, _t23); s23 = __builtin_elementwise_fma(s23, (f32x2){W4.z, W4.w}, _t23); \
} while (0)
__device__ __forceinline__ void scan_prompt_item(Frame& F, const float* sin, const float* scal, float* s_out, float* y0, int rg) {
    LAS float* bufs = (LAS float*)(F.lds + RING_OFF);
    constexpr int nchunks = SEQ / TC;
    const bool scanner = F.wave < 4;
    const int ri = F.lane >> 4, kq = F.lane & 15;
    const int lrow = (F.wave & 3) * 4 + ri, vrow = rg * 16 + lrow;
    f32x2 s01 = (f32x2){0.f, 0.f}, s23 = (f32x2){0.f, 0.f};
#define SCAN_BAR() do { asm volatile("s_waitcnt lgkmcnt(0)" ::: "memory"); __builtin_amdgcn_s_barrier(); asm volatile("" ::: "memory"); } while (0)
    if (!scanner) {
        f32x4 rv[10], rt[2]; const int lt = F.tid - 256;
        SCAN_STAGE_LOAD(sin, scal); SCAN_STAGE_WRITE(bufs); SCAN_STAGE_LOAD(sin + (size_t)TC * 384, scal + (size_t)TC * 16);
        SCAN_BAR();
        for (int c = 0; c < nchunks; ++c) {
            if (c + 1 < nchunks) { SCAN_STAGE_WRITE(bufs + ((c + 1) & 1) * SBUF_FLOATS);
                if (c + 2 < nchunks) SCAN_STAGE_LOAD(sin + (size_t)(c + 2) * TC * 384, scal + (size_t)(c + 2) * TC * 16); }
            SCAN_BAR();
        }
    } else {
        SCAN_BAR();
        for (int c = 0; c < nchunks; ++c) {
            LAS float* buf = bufs + (c & 1) * SBUF_FLOATS;
            const LAS float* lb = buf + 4 * kq;
            const LAS float* tbp = buf + 320 + lrow * 4;
            float yacc = 0.f;
            f32x4 kkA = *(const LAS f32x4*)(lb), w4A = *(const LAS f32x4*)(lb + 64), nbA = *(const LAS f32x4*)(lb + 128), kpA = *(const LAS f32x4*)(lb + 192), wrA = *(const LAS f32x4*)(lb + 256), tbA = *(const LAS f32x4*)(tbp);
            f32x4 kkB = *(const LAS f32x4*)(lb + 384), w4B = *(const LAS f32x4*)(lb + 384 + 64), nbB = *(const LAS f32x4*)(lb + 384 + 128), kpB = *(const LAS f32x4*)(lb + 384 + 192), wrB = *(const LAS f32x4*)(lb + 384 + 256), tbB = *(const LAS f32x4*)(tbp + 384);
#pragma unroll
            for (int st = 0; st < TC; st += 2) {
                const int s2 = (st + 2 < TC) ? st + 2 : st, s3 = (st + 3 < TC) ? st + 3 : st + 1;
                float y;
                SCAN_STEP(kkA, w4A, nbA, kpA, wrA, tbA, y);
                yacc = (kq == (st & 15)) ? y : yacc;
                kkA = *(const LAS f32x4*)(lb + s2 * 384); w4A = *(const LAS f32x4*)(lb + s2 * 384 + 64); nbA = *(const LAS f32x4*)(lb + s2 * 384 + 128);
                kpA = *(const LAS f32x4*)(lb + s2 * 384 + 192); wrA = *(const LAS f32x4*)(lb + s2 * 384 + 256); tbA = *(const LAS f32x4*)(tbp + s2 * 384);
                __builtin_amdgcn_sched_barrier(0);
                SCAN_STEP(kkB, w4B, nbB, kpB, wrB, tbB, y);
                yacc = (kq == ((st + 1) & 15)) ? y : yacc;
                if (((st + 1) & 15) == 15) y0[(size_t)(c * TC + st + 1 - 15 + kq) * RW + vrow] = yacc;
                kkB = *(const LAS f32x4*)(lb + s3 * 384); w4B = *(const LAS f32x4*)(lb + s3 * 384 + 64); nbB = *(const LAS f32x4*)(lb + s3 * 384 + 128);
                kpB = *(const LAS f32x4*)(lb + s3 * 384 + 192); wrB = *(const LAS f32x4*)(lb + s3 * 384 + 256); tbB = *(const LAS f32x4*)(tbp + s3 * 384);
                __builtin_amdgcn_sched_barrier(0);
            }
            SCAN_BAR();
        }
    }
    __syncthreads();
    if (scanner) *(f32x4*)(s_out + (size_t)vrow * 64 + 4 * kq) = (f32x4){s01.x, s01.y, s23.x, s23.y};
}
__device__ __forceinline__ void scan_sample_witem(Frame& F, int item) {
    const int dbh = item >> 4, r4 = item & 15, db = dbh >> 4, h = dbh & 15;
    const int ri = F.lane >> 4, kq = F.lane & 15, vrow = r4 * 4 + ri;
    const size_t so = (size_t)NB * RH * SEQ + (size_t)dbh * DT;
    const float* sin = WSP(float, WS_SCANIN) + so * 384; const float* scal = WSP(float, WS_SCAL) + so * 16;
    const f32x4 s0 = *(const f32x4*)(F.in[I_SWKV] + (size_t)dbh * 4096 + (size_t)vrow * 64 + 4 * kq);
    f32x2 s01 = (f32x2){s0.x, s0.y}, s23 = (f32x2){s0.z, s0.w};
    f32x4 kk[DT], w4[DT], nb[DT], kp[DT], wr[DT], tb[DT];
#pragma unroll
    for (int st = 0; st < DT; ++st) { const float* p = sin + st * 384 + 4 * kq;
        kk[st] = *(const f32x4*)(p); w4[st] = *(const f32x4*)(p + 64); nb[st] = *(const f32x4*)(p + 128); kp[st] = *(const f32x4*)(p + 192); wr[st] = *(const f32x4*)(p + 256);
        const f32x2 sc = *(const f32x2*)(scal + st * 16); tb[st] = (f32x4){sin[st * 384 + 320 + vrow], sc.x, sc.y, 0.f}; }
    float* y0 = WSP(float, WS_Y) + (size_t)(NTOKP + db * DT) * RW + h * 64 + vrow;
#pragma unroll
    for (int st = 0; st < DT; ++st) { float y; SCAN_STEP(kk[st], w4[st], nb[st], kp[st], wr[st], tb[st], y); if (kq == 0) y0[(size_t)st * RW] = y; }
    *(f32x4*)(F.out + O_WKVS + (size_t)dbh * 4096 + (size_t)vrow * 64 + 4 * kq) = (f32x4){s01.x, s01.y, s23.x, s23.y};
}
__device__ __forceinline__ void p3_scan_phase(Frame& F) {
    const int gw = F.bid * NWAVES + F.wave, NGW = F.G * NWAVES;
    for (int it = gw; it < DB * RH * 16; it += NGW) scan_sample_witem(F, it);
    const float* SI = WSP(float, WS_SCANIN); const float* SL = WSP(float, WS_SCAL); float* Y = WSP(float, WS_Y);
    for (int it0 = F.bid; it0 < 256; it0 += F.G) { const int it = (F.G == 256) ? ((it0 & 7) * 32 + (it0 >> 3)) : it0;
        const int bh = it >> 2, rg = it & 3, b = bh >> 4, h = bh & 15;
        scan_prompt_item(F, SI + (size_t)bh * SEQ * 384, SL + (size_t)bh * SEQ * 16, F.out + O_WKVP + (size_t)bh * 4096, Y + (size_t)(b * SEQ) * RW + h * 64, rg); }
}

__device__ __forceinline__ void gn_row(Frame& F, int row) {
    const int lane = F.lane, h = lane >> 2, q = lane & 3, c0 = h * 64 + q * 16;
    const float* y = WSP(float, WS_Y) + (size_t)row * RW + c0;
    f32x4 v[4]; float s = 0.f;
#pragma unroll
    for (int j = 0; j < 4; ++j) { v[j] = *(const f32x4*)(y + 4 * j); s += (v[j].x + v[j].y) + (v[j].z + v[j].w); }
    s += dpp<0xB1>(s); s += dpp<0x4E>(s);
    const float mean = s * (1.f / 64.f); float s2 = 0.f;
#pragma unroll
    for (int j = 0; j < 4; ++j) { v[j] = v[j] - mean; s2 += (v[j].x * v[j].x + v[j].y * v[j].y) + (v[j].z * v[j].z + v[j].w * v[j].w); }
    s2 += dpp<0xB1>(s2); s2 += dpp<0x4E>(s2);
    const float rstd = 1.f / sqrtf(s2 * (1.f / 64.f) + GN_EPS);
    const size_t so = scan_seq_off(row, h);
    const float bonus = WSP(float, WS_SCAL)[so * 16 + 2];
    const float* vv = WSP(float, WS_SCANIN) + so * 384 + 5 * 64 + q * 16;
    const float* g = WSP(float, WS_PROJ) + (size_t)row * INWP + C_GR + c0;
    const float* gw = F.in[I_GNW] + c0; const float* gb = F.in[I_GNB] + c0;
    bf16* o = WSP(bf16, WS_YMIX) + (size_t)row * DM + c0;
#pragma unroll
    for (int j = 0; j < 4; ++j) { const f32x4 w4 = *(const f32x4*)(gw + 4 * j), b4 = *(const f32x4*)(gb + 4 * j), v4 = *(const f32x4*)(vv + 4 * j), g4 = *(const f32x4*)(g + 4 * j);
        const float o0 = (v[j].x * rstd * w4.x + b4.x + bonus * v4.x) * silu(g4.x), o1 = (v[j].y * rstd * w4.y + b4.y + bonus * v4.y) * silu(g4.y);
        const float o2 = (v[j].z * rstd * w4.z + b4.z + bonus * v4.z) * silu(g4.z), o3 = (v[j].w * rstd * w4.w + b4.w + bonus * v4.w) * silu(g4.w);
        v2u pk; pk.x = cvt_pk_bf16(o0, o1); pk.y = cvt_pk_bf16(o2, o3); *(v2u*)(o + 4 * j) = pk; }
}
__device__ __forceinline__ void idx_afrag(const bf16* QIB, int row0, int lane, bf16x8 (&af)[4]) {
    const int r = lane & 31, hh = lane >> 5;
    const bf16* p = QIB + (size_t)(row0 + ((r >> 2) & 1)) * 1024 + ((r >> 3) * 4 + (r & 3)) * 64 + 8 * hh;
#pragma unroll
    for (int ks = 0; ks < 4; ++ks) af[ks] = *(const bf16x8*)(p + 16 * ks);
}
__device__ __forceinline__ float idx_reduce(const f32x16& acc, const f32x4 (&w)[4]) {
    float v = 0.f;
#pragma unroll
    for (int j = 0; j < 16; ++j) v += w[j >> 2][j & 3] * fmaxf(acc[j], 0.f);
    return v;
}
__device__ __forceinline__ void d1_prompt_item(Frame& F, int item) {
    const int idx = item & 255, second = item >> 8, b = idx >> 6, qi = idx & 63, qt = second ? 127 - qi : qi;
    const int t0 = qt * 16 + 2 * F.wave, row0 = b * SEQ + t0;
    const int r = F.lane & 31, hh = F.lane >> 5;
    bf16x8 af[4]; idx_afrag(WSP(bf16, WS_QIB), row0, F.lane, af);
    f32x4 w[4];
#pragma unroll
    for (int j = 0; j < 4; ++j) w[j] = *(const f32x4*)(WSP(float, WS_WIS) + (size_t)(row0 + hh) * 16 + 4 * j);
    const int tq = t0 + hh;
    const bf16* KIB = WSP(bf16, WS_KIB) + (size_t)(b * SEQ) * 64;
    float* SC = WSP(float, WS_SC) + (size_t)(b * SEQ + tq) * SEQ;
    for (int s0 = 0; s0 <= t0 + 1; s0 += 32) {
        f32x16 acc;
#pragma unroll
        for (int j = 0; j < 16; ++j) acc[j] = 0.f;
#pragma unroll
        for (int ks = 0; ks < 4; ++ks) { const bf16x8 bfr = *(const bf16x8*)(KIB + (size_t)(s0 + r) * 64 + 16 * ks + 8 * hh);
            acc = __builtin_amdgcn_mfma_f32_32x32x16_bf16(af[ks], bfr, acc, 0, 0, 0); }
        SC[s0 + r] = idx_reduce(acc, w);
    }
}
__device__ __forceinline__ void d1_sample_item(Frame& F, int item) {
    const int r = F.lane & 31, hh = F.lane >> 5;
    int db, p = 0; bool newk = false;
    if (item < DB * NPAGES) { db = item >> 6; p = item & 63; } else { db = item - DB * NPAGES; newk = true; }
    const int row0 = NTOKP + db * DT;
    bf16x8 af0[4], af1[4]; idx_afrag(WSP(bf16, WS_QIB), row0, F.lane, af0); idx_afrag(WSP(bf16, WS_QIB), row0 + 2, F.lane, af1);
    f32x4 w0[4], w1[4];
#pragma unroll
    for (int j = 0; j < 4; ++j) { w0[j] = *(const f32x4*)(WSP(float, WS_WIS) + (size_t)(row0 + hh) * 16 + 4 * j); w1[j] = *(const f32x4*)(WSP(float, WS_WIS) + (size_t)(row0 + 2 + hh) * 16 + 4 * j); }
    float* SCS = WSP(float, WS_SCS);
    if (!newk) {
        const int page = ((const int*)F.in[I_PT])[db * NPAGES + p];
        const float* kp = F.in[I_CKI] + ((size_t)page * PAGE + r) * 64 + 8 * hh;
        f32x4 ka[4][4], kc[4][4];
#pragma unroll
        for (int kt = 0; kt < 4; ++kt)
#pragma unroll
            for (int ks = 0; ks < 4; ++ks) { ka[kt][ks] = *(const f32x4*)(kp + (size_t)kt * 32 * 64 + 16 * ks); kc[kt][ks] = *(const f32x4*)(kp + (size_t)kt * 32 * 64 + 16 * ks + 4); }
#pragma unroll
        for (int kt = 0; kt < 4; ++kt) {
            f32x16 acc0, acc1;
#pragma unroll
            for (int j = 0; j < 16; ++j) { acc0[j] = 0.f; acc1[j] = 0.f; }
#pragma unroll
            for (int ks = 0; ks < 4; ++ks) { const f32x4 a = ka[kt][ks], c = kc[kt][ks];
                v4u u; u.x = cvt_pk_bf16(a.x, a.y); u.y = cvt_pk_bf16(a.z, a.w); u.z = cvt_pk_bf16(c.x, c.y); u.w = cvt_pk_bf16(c.z, c.w);
                const bf16x8 bfr = __builtin_bit_cast(bf16x8, u);
                acc0 = __builtin_amdgcn_mfma_f32_32x32x16_bf16(af0[ks], bfr, acc0, 0, 0, 0); acc1 = __builtin_amdgcn_mfma_f32_32x32x16_bf16(af1[ks], bfr, acc1, 0, 0, 0); }
            SCS[(size_t)(db * DT + hh) * SCS_LD + p * PAGE + kt * 32 + r] = idx_reduce(acc0, w0);
            SCS[(size_t)(db * DT + 2 + hh) * SCS_LD + p * PAGE + kt * 32 + r] = idx_reduce(acc1, w1);
        }
    } else {
        f32x16 acc0, acc1;
#pragma unroll
        for (int j = 0; j < 16; ++j) { acc0[j] = 0.f; acc1[j] = 0.f; }
        const bf16* kp = WSP(bf16, WS_KIB) + (size_t)(row0 + (r & 3)) * 64 + 8 * hh;
#pragma unroll
        for (int ks = 0; ks < 4; ++ks) { bf16x8 bfr = *(const bf16x8*)(kp + 16 * ks);
            acc0 = __builtin_amdgcn_mfma_f32_32x32x16_bf16(af0[ks], bfr, acc0, 0, 0, 0); acc1 = __builtin_amdgcn_mfma_f32_32x32x16_bf16(af1[ks], bfr, acc1, 0, 0, 0); }
        if (r < 4) { SCS[(size_t)(db * DT + hh) * SCS_LD + PAST + r] = idx_reduce(acc0, w0); SCS[(size_t)(db * DT + 2 + hh) * SCS_LD + PAST + r] = idx_reduce(acc1, w1); }
    }
}
__device__ __forceinline__ void d2_sample_block(Frame& F, int q);
__device__ __forceinline__ void p4_phase(Frame& F) {
    const int gw = F.bid * NWAVES + F.wave, NGW = F.G * NWAVES;
    if (F.G >= 64) {
        for (int q = F.bid; q < NTOKS; q += F.G) d2_sample_block(F, q);
    } else {
        for (int it = gw; it < DB * NPAGES + DB; it += NGW) d1_sample_item(F, it);
    }
    for (int row = gw; row < NTOK; row += NGW) gn_row(F, row);
}

__device__ __forceinline__ unsigned wave_count(unsigned c) {
#pragma unroll
    for (int o = 1; o < 64; o <<= 1) c += __shfl_xor((int)c, o);
    return c;
}
template <int NV>
__device__ __forceinline__ void kth_select(const unsigned (&key)[NV * 4], unsigned xk, int xbase, int lane, unsigned& T_out, unsigned& cut_out) {
    unsigned T = 0u; bool exact = false;
    for (int bit = 31; bit >= 0; --bit) {
        const unsigned cand = T | (1u << bit);
        unsigned c = (xk >= cand) ? 1u : 0u;
#pragma unroll
        for (int i = 0; i < NV * 4; ++i) c += (key[i] >= cand) ? 1u : 0u;
        c = wave_count(c);
        if (c >= (unsigned)TOPK) T = cand;
        if (c == (unsigned)TOPK) { exact = true; break; }
    }
    unsigned cut = 0x7fffffffu;
    if (!exact) {
        unsigned cg = (xk > T) ? 1u : 0u, ce = (xk == T) ? 1u : 0u;
#pragma unroll
        for (int i = 0; i < NV * 4; ++i) { cg += (key[i] > T) ? 1u : 0u; ce += (key[i] == T) ? 1u : 0u; }
        cg = wave_count(cg); ce = wave_count(ce);
        const unsigned need = (unsigned)TOPK - cg;
        if (ce > need) {
            unsigned I = 0u;
            for (int bit = 14; bit >= 0; --bit) {
                const unsigned cand = I | (1u << bit);
                unsigned c = (xk == T && (unsigned)(xbase + lane) < cand && lane < 4) ? 1u : 0u;
#pragma unroll
                for (int i = 0; i < NV * 4; ++i) { const unsigned idx = 256u * (i >> 2) + 4u * lane + (i & 3); c += (key[i] == T && idx < cand) ? 1u : 0u; }
                c = wave_count(c);
                if (c < need) I = cand;
            }
            cut = I;
        }
    }
    T_out = T; cut_out = cut;
}
__device__ __forceinline__ void d2_prompt_row(Frame& F, int row) {
    const int t = row & 2047, lane = F.lane;
    unsigned* THR = WSP(unsigned, WS_THR) + (size_t)row * 2;
    if (t < TOPK) { if (lane == 0) { THR[0] = 0u; THR[1] = 0x7fffffffu; } return; }
    const float* SC = WSP(float, WS_SC) + (size_t)row * SEQ;
    unsigned key[32];
#pragma unroll
    for (int j = 0; j < 8; ++j) { const int i0 = 256 * j + 4 * lane;
        if (i0 <= t) { const f32x4 v = *(const f32x4*)(SC + i0);
            key[4 * j + 0] = sort_key(v.x); key[4 * j + 1] = (i0 + 1 <= t) ? sort_key(v.y) : 0u; key[4 * j + 2] = (i0 + 2 <= t) ? sort_key(v.z) : 0u; key[4 * j + 3] = (i0 + 3 <= t) ? sort_key(v.w) : 0u; }
        else { key[4 * j + 0] = 0u; key[4 * j + 1] = 0u; key[4 * j + 2] = 0u; key[4 * j + 3] = 0u; } }
    unsigned T, cut; kth_select<8>(key, 0u, 1 << 20, lane, T, cut);
    if (lane == 0) { THR[0] = T; THR[1] = cut; }
}
__device__ __forceinline__ void d2_sample_block(Frame& F, int q) {
    const int t = q & 3, tid = F.tid, lane = F.lane;
    const float* SCS = WSP(float, WS_SCS) + (size_t)q * SCS_LD;
    LAS unsigned* red = (LAS unsigned*)(F.lds + RING_OFF);
    unsigned key[16];
#pragma unroll
    for (int j = 0; j < 4; ++j) { const f32x4 v = *(const f32x4*)(SCS + 2048 * j + 4 * tid);
        key[4 * j + 0] = sort_key(v.x); key[4 * j + 1] = sort_key(v.y); key[4 * j + 2] = sort_key(v.z); key[4 * j + 3] = sort_key(v.w); }
    unsigned xk = 0u; if (tid <= t) xk = sort_key(SCS[PAST + tid]);
    if (tid == 0) red[16] = 0u;
    unsigned T = 0u; bool exact = false; int par = 0;
    for (int bit = 31; bit >= 0; --bit) {
        const unsigned cand = T | (1u << bit);
        unsigned c = (xk >= cand) ? 1u : 0u;
#pragma unroll
        for (int i = 0; i < 16; ++i) c += (key[i] >= cand) ? 1u : 0u;
        c = wave_count(c);
        if (lane == 0) red[par * 8 + F.wave] = c;
        __syncthreads();
        unsigned tot = 0u;
#pragma unroll
        for (int w = 0; w < 8; ++w) tot += red[par * 8 + w];
        par ^= 1;
        if (tot >= (unsigned)TOPK) T = cand;
        if (tot == (unsigned)TOPK) { exact = true; break; }
    }
    unsigned cut = 0x7fffffffu;
    if (!exact) {
        unsigned cg = (xk > T) ? 1u : 0u, ce = (xk == T) ? 1u : 0u;
#pragma unroll
        for (int i = 0; i < 16; ++i) { cg += (key[i] > T) ? 1u : 0u; ce += (key[i] == T) ? 1u : 0u; }
        cg = wave_count(cg); ce = wave_count(ce);
        if (lane == 0) red[par * 8 + F.wave] = (cg << 16) | ce;
        __syncthreads();
        unsigned tg = 0u, te = 0u;
#pragma unroll
        for (int w = 0; w < 8; ++w) { const unsigned v = red[par * 8 + w]; tg += v >> 16; te += v & 0xffffu; }
        par ^= 1;
        const unsigned need = (unsigned)TOPK - tg;
        if (te > need) {
            unsigned I = 0u;
            for (int bit = 14; bit >= 0; --bit) {
                const unsigned cand = I | (1u << bit);
                unsigned c = (xk == T && tid < 4 && (unsigned)(PAST + tid) < cand) ? 1u : 0u;
#pragma unroll
                for (int i = 0; i < 16; ++i) { const unsigned idx = 2048u * (i >> 2) + 4u * tid + (i & 3); c += (key[i] == T && idx < cand) ? 1u : 0u; }
                c = wave_count(c);
                if (lane == 0) red[par * 8 + F.wave] = c;
                __syncthreads();
                unsigned tot = 0u;
#pragma unroll
                for (int w = 0; w < 8; ++w) tot += red[par * 8 + w];
                par ^= 1;
                if (tot < need) I = cand;
            }
            cut = I;
        }
    }
    __syncthreads();
    int* IDX = WSP(int, WS_IDX) + (size_t)q * TOPK;
#pragma unroll
    for (int i = 0; i < 16; ++i) { const int idx = 2048 * (i >> 2) + 4 * tid + (i & 3);
        if (key[i] > T || (key[i] == T && (unsigned)idx <= cut)) { const unsigned pos = atomicAdd((unsigned*)&red[16], 1u); if (pos < (unsigned)TOPK) IDX[pos] = idx; } }
    if (tid <= t) { const int idx = PAST + tid; if (xk > T || (xk == T && (unsigned)idx <= cut)) { const unsigned pos = atomicAdd((unsigned*)&red[16], 1u); if (pos < (unsigned)TOPK) IDX[pos] = idx; } }
    __syncthreads();
}
__device__ __forceinline__ void p5_phase(Frame& F) {
    const int gw = F.bid * NWAVES + F.wave, NGW = F.G * NWAVES;
    for (int q = F.bid; q < NTOKS; q += F.G) d2_sample_block(F, q);
}

constexpr int DSA_MASK_OFF = RING_OFF;
constexpr int DSA_MERGE_OFF = RING_OFF + 8192;
__device__ __forceinline__ void cnt_ge(unsigned& c, unsigned k, unsigned cand) { asm volatile("v_cmp_ge_u32 vcc, %1, %2\n\tv_addc_co_u32 %0, vcc, 0, %0, vcc" : "+v"(c) : "v"(k), "v"(cand) : "vcc"); }
template <int CTRL> __device__ __forceinline__ unsigned dppu(unsigned x) { return (unsigned)__builtin_amdgcn_mov_dpp((int)x, CTRL, 0xf, 0xf, true); }
__device__ __forceinline__ unsigned half_sum_u(unsigned c) {
    c += dppu<0xB1>(c); c += dppu<0x4E>(c); c += dppu<0x141>(c); c += dppu<0x140>(c);
    auto s2 = __builtin_amdgcn_permlane16_swap(c, c, false, false);
    return s2[0] + s2[1];
}
template <bool MASKED>
__device__ __forceinline__ void attn_core(Frame& F, int row0, int nkt, int NT, const bf16* Qb, const bf16* Kf  , const bf16* Vf  , int gate_col, int out_col) {
    const int lane = F.lane, r = lane & 31, hh = lane >> 5, h = F.wave & 3, half = F.wave >> 2;
    const LAS unsigned* mask = (const LAS unsigned*)(F.lds + DSA_MASK_OFF) + r * 64;
    bf16x8 qf[8];
#pragma unroll
    for (int ks = 0; ks < 8; ++ks) qf[ks] = *(const bf16x8*)(Qb + (size_t)(row0 + r) * 512 + h * 128 + 16 * ks + 8 * hh);
    f32x16 o[4];
#pragma unroll
    for (int d = 0; d < 4; ++d)
#pragma unroll
        for (int j = 0; j < 16; ++j) o[d][j] = 0.f;
    float m = -INFINITY, lsum = 0.f;
    const bf16* kbase = Kf + (size_t)(h * NT) * 4096 + lane * 8;
    const bf16* vbase = Vf + (size_t)(h * NT) * 4096 + lane * 8;
    bf16x8 kf[8];
    if (half < nkt) {
#pragma unroll
        for (int ks = 0; ks < 8; ++ks) kf[ks] = *(const bf16x8*)(kbase + (size_t)half * 4096 + ks * 512);
    }
    for (int kt = half; kt < nkt; kt += 2) {
        bf16x8 vf[4][2];
#pragma unroll
        for (int d = 0; d < 4; ++d)
#pragma unroll
            for (int s = 0; s < 2; ++s) vf[d][s] = *(const bf16x8*)(vbase + (size_t)kt * 4096 + (d * 2 + s) * 512);
        f32x16 x;
#pragma unroll
        for (int j = 0; j < 16; ++j) x[j] = 0.f;
#pragma unroll
        for (int ks = 0; ks < 8; ++ks) x = __builtin_amdgcn_mfma_f32_32x32x16_bf16(kf[ks], qf[ks], x, 0, 0, 0);
        {
            const int ktn = (kt + 2 < nkt) ? kt + 2 : kt;
#pragma unroll
            for (int ks = 0; ks < 8; ++ks) kf[ks] = *(const bf16x8*)(kbase + (size_t)ktn * 4096 + ks * 512);
        }
        if (MASKED) {
            const unsigned m4 = mask[kt] >> (4 * hh);
#pragma unroll
            for (int g = 0; g < 4; ++g)
#pragma unroll
                for (int e = 0; e < 4; ++e) { const unsigned t = (unsigned)((int)(m4 << (31 - (8 * g + e))) >> 31);
                    x[4 * g + e] = __uint_as_float((__float_as_uint(x[4 * g + e]) & t) | (0xff800000u & ~t)); }
        }
        float mx = x[0];
#pragma unroll
        for (int j = 1; j < 16; ++j) mx = fmaxf(mx, x[j]);
        mx = xhalf_max(mx);
        const float mn = fmaxf(m, mx), mu = (mn == -INFINITY) ? 0.f : mn;
        const float alpha = __builtin_amdgcn_exp2f(m - mu);
        m = mn;
        float ls = 0.f;
#pragma unroll
        for (int j = 0; j < 16; ++j) { x[j] = __builtin_amdgcn_exp2f(x[j] - mu); ls += x[j]; }
        lsum = lsum * alpha + ls;
        if (__any(alpha != 1.f)) {
#pragma unroll
            for (int d = 0; d < 4; ++d)
#pragma unroll
                for (int j = 0; j < 16; ++j) o[d][j] *= alpha;
        }
        bf16x8 pf[2];
#pragma unroll
        for (int s = 0; s < 2; ++s) { v4u u; u.x = cvt_pk_bf16(x[8 * s + 0], x[8 * s + 1]); u.y = cvt_pk_bf16(x[8 * s + 2], x[8 * s + 3]); u.z = cvt_pk_bf16(x[8 * s + 4], x[8 * s + 5]); u.w = cvt_pk_bf16(x[8 * s + 6], x[8 * s + 7]);
            pf[s] = __builtin_bit_cast(bf16x8, u); }
#pragma unroll
        for (int d = 0; d < 4; ++d)
#pragma unroll
            for (int s = 0; s < 2; ++s) o[d] = __builtin_amdgcn_mfma_f32_32x32x16_bf16(vf[d][s], pf[s], o[d], 0, 0, 0);
    }
    lsum = xhalf_sum(lsum);
    LAS float* mg = (LAS float*)(F.lds + DSA_MERGE_OFF) + h * 66 * 64;
    if (half == 1) {
        mg[0 * 64 + lane] = m; mg[1 * 64 + lane] = lsum;
#pragma unroll
        for (int d = 0; d < 4; ++d)
#pragma unroll
            for (int j = 0; j < 16; ++j) mg[(2 + d * 16 + j) * 64 + lane] = o[d][j];
    }
    __syncthreads();
    if (half == 0) {
        const float m1 = mg[0 * 64 + lane], l1 = mg[1 * 64 + lane];
        const float mn = fmaxf(m, m1), mu = (mn == -INFINITY) ? 0.f : mn;
        const float a0 = __builtin_amdgcn_exp2f(m - mu), a1 = __builtin_amdgcn_exp2f(m1 - mu);
        const float l = lsum * a0 + l1 * a1; const float inv = l > 0.f ? 1.f / l : 0.f;
        const float* gp = WSP(float, WS_PROJ) + (size_t)(row0 + r) * INWP + gate_col + h * 128;
        bf16* op = WSP(bf16, WS_YMIX) + (size_t)(row0 + r) * DM + out_col + h * 128;
#pragma unroll
        for (int d = 0; d < 4; ++d)
#pragma unroll
            for (int g = 0; g < 4; ++g) { const int dd = d * 32 + 8 * g + 4 * hh; const f32x4 gv = *(const f32x4*)(gp + dd);
                float v[4];
#pragma unroll
                for (int e = 0; e < 4; ++e) v[e] = (o[d][4 * g + e] * a0 + mg[(2 + d * 16 + 4 * g + e) * 64 + lane] * a1) * inv * silu(gv[e]);
                v2u pk; pk.x = cvt_pk_bf16(v[0], v[1]); pk.y = cvt_pk_bf16(v[2], v[3]); *(v2u*)(op + dd) = pk; }
    }
    __syncthreads();
}
__device__ __forceinline__ void dsa_prompt_item(Frame& F, int b, int qt) {
    const int t0 = qt * 32, row0 = b * SEQ + t0, nkt = qt + 1;
    LAS unsigned* mask = (LAS unsigned*)(F.lds + DSA_MASK_OFF);
    if (t0 + 31 < TOPK) {
        for (int i = F.tid; i < 32 * 64; i += NTHR) { const int q = i >> 6, kt = i & 63; const int nb = t0 + q - 32 * kt + 1;
            mask[i] = nb >= 32 ? 0xffffffffu : (nb <= 0 ? 0u : ((1u << nb) - 1u)); }
    } else {
        const int lane = F.lane, r = lane & 31, hh = lane >> 5;
        int r4 = 4 * r; asm volatile("" : "+v"(r4));
        const bf16* KIB = WSP(bf16, WS_SC) + (size_t)(b * SEQ) * 64 + lane * 8;
        LAS unsigned* skl = (LAS unsigned*)(F.lds + DSA_MASK_OFF + 8192) + F.wave * 4096 + hh * 2048;
        for (int i = F.tid; i < 32 * 64; i += NTHR) mask[i] = 0u;
        __syncthreads();
        for (int pass = 0; pass < 2; ++pass) {
            const int q0 = 16 * pass + 2 * F.wave, tq = t0 + q0 + hh;
            {
                bf16x8 af[4]; idx_afrag(WSP(bf16, WS_QIB), row0 + q0, lane, af);
                f32x4 w[4];
#pragma unroll
                for (int j = 0; j < 4; ++j) w[j] = *(const f32x4*)(WSP(float, WS_WIS) + (size_t)(row0 + q0 + hh) * 16 + 4 * j);
                bf16x8 ring[4][4];
#pragma unroll
                for (int i = 0; i < 3; ++i) { const int ktc = i < nkt ? i : nkt - 1;
#pragma unroll
                    for (int ks = 0; ks < 4; ++ks) ring[i][ks] = *(const bf16x8*)(KIB + (size_t)ktc * 2048 + ks * 512); }
                for (int kt0 = 0; kt0 < nkt; kt0 += 4) {
#pragma unroll
                    for (int i = 0; i < 4; ++i) {
                        const int kt = kt0 + i, ktp = (kt + 3 < nkt) ? kt + 3 : nkt - 1;
#pragma unroll
                        for (int ks = 0; ks < 4; ++ks) ring[(i + 3) & 3][ks] = *(const bf16x8*)(KIB + (size_t)ktp * 2048 + ks * 512);
                        f32x16 acc;
#pragma unroll
                        for (int j = 0; j < 16; ++j) acc[j] = 0.f;
#pragma unroll
                        for (int ks = 0; ks < 4; ++ks) acc = __builtin_amdgcn_mfma_f32_32x32x16_bf16(af[ks], ring[i][ks], acc, 0, 0, 0);
                        if (kt < nkt) skl[kt * 32 + r] = sort_key(idx_reduce(acc, w));
                    }
                }
            }
            asm volatile("s_waitcnt lgkmcnt(0)" ::: "memory");
            unsigned sk[64];
            int tqr = tq - r4; asm volatile("" : "+v"(tqr));
#pragma unroll
            for (int i = 0; i < 16; ++i) { const v4u v = *(const LAS v4u*)(skl + 128 * i + r4);
                sk[4 * i + 0] = (128 * i + 0 <= tqr) ? v.x : 0u; sk[4 * i + 1] = (128 * i + 1 <= tqr) ? v.y : 0u; sk[4 * i + 2] = (128 * i + 2 <= tqr) ? v.z : 0u; sk[4 * i + 3] = (128 * i + 3 <= tqr) ? v.w : 0u; }
            unsigned T = 0u; bool exact = false;
            for (int bit = 31; bit >= 0; --bit) {
                const unsigned cand = T | (1u << bit);
                unsigned c = 0u;
#pragma unroll
                for (int i = 0; i < 64; ++i) cnt_ge(c, sk[i], cand);
                c = half_sum_u(c);
                if (!exact) { if (c >= (unsigned)TOPK) T = cand; if (c == (unsigned)TOPK) exact = true; }
                if (__all(exact)) break;
            }
            unsigned cut = 0x7fffffffu;
            if (__any(!exact)) {
                unsigned cg = 0u, ce = 0u;
                for (int i = 0; i < 16; ++i) { const v4u v = *(const LAS v4u*)(skl + 128 * i + r4); const int i0 = 128 * i + r4;
#pragma unroll
                    for (int e = 0; e < 4; ++e) { const unsigned k = (i0 + e <= tq) ? v[e] : 0u; cg += (k > T) ? 1u : 0u; ce += (k == T) ? 1u : 0u; } }
                cg = half_sum_u(cg); ce = half_sum_u(ce);
                const unsigned need = (unsigned)TOPK - cg;
                const bool tie = !exact && ce > need;
                unsigned I = 0u;
                for (int bit = 11; bit >= 0; --bit) {
                    const unsigned cand = I | (1u << bit);
                    unsigned c = 0u;
                    for (int i = 0; i < 16; ++i) { const v4u v = *(const LAS v4u*)(skl + 128 * i + r4); const int i0 = 128 * i + r4;
#pragma unroll
                        for (int e = 0; e < 4; ++e) { const unsigned k = (i0 + e <= tq) ? v[e] : 0u; c += (k == T && (unsigned)(i0 + e) < cand) ? 1u : 0u; } }
                    c = half_sum_u(c);
                    if (c < need) I = cand;
                }
                if (tie) cut = I;
            }
            int cutr = (int)cut - r4; asm volatile("" : "+v"(cutr));
#pragma unroll
            for (int i = 0; i < 16; ++i) {
                unsigned nib = 0u;
#pragma unroll
                for (int e = 0; e < 4; ++e) { const unsigned k = sk[4 * i + e]; const bool sel = k != 0u && (k > T || (k == T && (128 * i + e) <= cutr)); nib |= sel ? (1u << e) : 0u; }
                if (nib) __hip_atomic_fetch_or((LAS unsigned*)&mask[(q0 + hh) * 64 + 4 * i + (r >> 3)], nib << (4 * (r & 7)), __ATOMIC_RELAXED, __HIP_MEMORY_SCOPE_WORKGROUP);
            }
        }
    }
    __syncthreads();
#ifndef T_NOCORE
    attn_core<true>(F, row0, nkt, 64, WSP(bf16, WS_QB), WSP(bf16, WS_KB) + (size_t)b * SEQ * 512, WSP(bf16, WS_VT) + (size_t)b * 512 * SEQ, C_GA, 1024);
#endif
}
__device__ __forceinline__ void gather_attn_item(Frame& F, int q, bool dsa) {
    const int lane = F.lane, hd = lane >> 4, d0 = (lane & 15) * 8, db = q >> 2, row = NTOKP + q;
    LAS float* red = (LAS float*)(F.lds + RING_OFF);
    LAS float* racc = red + 64;
    const float* kptr; const float* vptr;
    {
        const int ki = F.wave * 32 + (lane & 31);
        if (dsa) { const int idx = WSP(int, WS_IDX)[(size_t)q * TOPK + ki];
            if (idx < PAST) { const size_t phys = (size_t)((const int*)F.in[I_PT])[db * NPAGES + (idx >> 7)] * PAGE + (idx & 127); kptr = F.in[I_CK] + phys * 512; vptr = F.in[I_CV] + phys * 512; }
            else { const int j = idx - PAST; kptr = F.out + O_KS + (size_t)(db * DT + j) * 512; vptr = F.out + O_VS + (size_t)(db * DT + j) * 512; } }
        else { kptr = F.in[I_CMK] + (size_t)(db * MEMT + ki) * 512; vptr = F.in[I_CMV] + (size_t)(db * MEMT + ki) * 512; }
    }
    const bf16* qb = (dsa ? WSP(bf16, WS_QB) : WSP(bf16, WS_QMB)) + (size_t)row * 512 + hd * 128 + d0;
    float qv[8];
    { const v4u u = *(const v4u*)qb; qv[0] = __uint_as_float(u.x << 16); qv[1] = __uint_as_float(u.x & 0xffff0000u); qv[2] = __uint_as_float(u.y << 16); qv[3] = __uint_as_float(u.y & 0xffff0000u);
      qv[4] = __uint_as_float(u.z << 16); qv[5] = __uint_as_float(u.z & 0xffff0000u); qv[6] = __uint_as_float(u.w << 16); qv[7] = __uint_as_float(u.w & 0xffff0000u); }
    LAS float* sl = racc + 8 * 8 * 64 + F.wave * 128;
    float mx = -INFINITY;
#pragma unroll 16
    for (int i = 0; i < 32; ++i) {
        const unsigned long long pk = (unsigned long long)kptr;
        const unsigned lo = __shfl((int)(unsigned)pk, i), hi = __shfl((int)(unsigned)(pk >> 32), i);
        const float* kr = (const float*)(((unsigned long long)hi << 32) | lo) + hd * 128 + d0;
        const f32x4 a = *(const f32x4*)kr, c = *(const f32x4*)(kr + 4);
        float s = (a.x * qv[0] + a.y * qv[1]) + (a.z * qv[2] + a.w * qv[3]) + (c.x * qv[4] + c.y * qv[5]) + (c.z * qv[6] + c.w * qv[7]);
        s = row16_sum(s); mx = fmaxf(mx, s);
        if ((lane & 15) == 0) sl[i * 4 + hd] = s;
    }
    if ((lane & 15) == 0) red[F.wave * 4 + hd] = mx;
    __syncthreads();
    float gm = red[hd];
#pragma unroll
    for (int w = 1; w < 8; ++w) gm = fmaxf(gm, red[w * 4 + hd]);
    __syncthreads();
    float acc[8]; float ls = 0.f;
#pragma unroll
    for (int e = 0; e < 8; ++e) acc[e] = 0.f;
#pragma unroll 16
    for (int i = 0; i < 32; ++i) {
        const unsigned long long pv = (unsigned long long)vptr;
        const unsigned lo = __shfl((int)(unsigned)pv, i), hi = __shfl((int)(unsigned)(pv >> 32), i);
        const float* vr = (const float*)(((unsigned long long)hi << 32) | lo) + hd * 128 + d0;
        const f32x4 a = *(const f32x4*)vr, c = *(const f32x4*)(vr + 4);
        const float p = exp2f(sl[i * 4 + hd] - gm); ls += p;
        acc[0] += p * a.x; acc[1] += p * a.y; acc[2] += p * a.z; acc[3] += p * a.w; acc[4] += p * c.x; acc[5] += p * c.y; acc[6] += p * c.z; acc[7] += p * c.w;
    }
    if ((lane & 15) == 0) red[F.wave * 4 + hd] = ls;
#pragma unroll
    for (int e = 0; e < 8; ++e) racc[(F.wave * 8 + e) * 64 + lane] = acc[e];
    __syncthreads();
    if (F.wave == 0) {
        float l = 0.f;
#pragma unroll
        for (int w = 0; w < 8; ++w) l += red[w * 4 + hd];
        const float inv = 1.f / l;
        const float* gp = WSP(float, WS_PROJ) + (size_t)row * INWP + (dsa ? C_GA : C_GM) + hd * 128 + d0;
        float v[8];
#pragma unroll
        for (int e = 0; e < 8; ++e) { float a = 0.f;
#pragma unroll
            for (int w = 0; w < 8; ++w) a += racc[(w * 8 + e) * 64 + lane];
            v[e] = a * inv * silu(gp[e]); }
        v4u pk; pk.x = cvt_pk_bf16(v[0], v[1]); pk.y = cvt_pk_bf16(v[2], v[3]); pk.z = cvt_pk_bf16(v[4], v[5]); pk.w = cvt_pk_bf16(v[6], v[7]);
        *(v4u*)(WSP(bf16, WS_YMIX) + (size_t)row * DM + (dsa ? 1024 : 1536) + hd * 128 + d0) = pk;
    }
    __syncthreads();
}
__device__ __forceinline__ void p6_phase(Frame& F) {
    { const int gt = F.bid * NTHR + F.tid, NGT = F.G * NTHR;
      for (int e = gt; e < NTOKS * DM / 4; e += NGT) *(f32x4*)(F.out + O_YS + (size_t)e * 4) = *(const f32x4*)(F.in[I_XS] + (size_t)e * 4); }
    if (F.G >= 64) { for (int it = F.bid; it < 256; it += F.G) { const int i = it & 127; gather_attn_item(F, (i & 31) * 4 + (i >> 5), it < 128); } return; }
    unsigned* qctr = (unsigned*)(F.ws + WS_CTL) + 8192;
    volatile LAS int* slot = (volatile LAS int*)(F.lds + LDSCTL_OFF + 64);
    for (;;) {
        if (F.tid == 0) *slot = (int)__hip_atomic_fetch_add(qctr, 1u, __ATOMIC_RELAXED, __HIP_MEMORY_SCOPE_AGENT);
        __syncthreads();
        const int it = *slot;
        __syncthreads();
        if (it >= 768) break;
        Frame Fi = F; asm volatile("" : "+v"(Fi.lane), "+v"(Fi.tid));
        if (it < 256) { const int b = it & 3, qt = 63 - (it >> 2); dsa_prompt_item(Fi, b, qt); }
        else if (it < 512) { const int j = it - 256; gather_attn_item(Fi, j & 127, j < 128); }
        else { const int j = it - 512, b = j >> 6, qt = j & 63;
            attn_core<false>(Fi, b * SEQ + qt * 32, 8, 8, WSP(bf16, WS_QMB), WSP(bf16, WS_MKB) + (size_t)b * MEMT * 512, WSP(bf16, WS_MVT) + (size_t)b * 512 * MEMT, C_GM, 1536); }
    }
}

constexpr int G4_RING_BYTES = 3 * (16 * 384 + 16 * 16) * 4;
constexpr int G4_MASK_OFF = 77824, G4_SKL_OFF = G4_MASK_OFF + 8192;
constexpr int G4_SLOT_OFF = LDSCTL_OFF + 128;
struct GBar { volatile LAS unsigned* cnt; unsigned target; };
__device__ __forceinline__ void gbar(GBar& g, int lane) {
    g.target += 4u;
    asm volatile("s_waitcnt lgkmcnt(0)" ::: "memory");
    if (lane == 0) __hip_atomic_fetch_add((LAS unsigned*)g.cnt, 1u, __ATOMIC_RELAXED, __HIP_MEMORY_SCOPE_WORKGROUP);
    unsigned sp = 0; while (*g.cnt < g.target) { __builtin_amdgcn_s_sleep(1); if (++sp > (1u << 24)) break; }
    asm volatile("" ::: "memory");
}
constexpr int S4_TC = 16, S4_NB = 3, S4_BUF_FLOATS = S4_TC * 384 + S4_TC * 16, S4_NCH = SEQ / S4_TC;
__device__ __forceinline__ void scan4_issue(LAS unsigned char* lds, const float* sin, const float* scal, int c, int sw, int lane) {
    LAS float* buf = (LAS float*)(lds + RING_OFF) + (c % S4_NB) * S4_BUF_FLOATS;
    const float* src = sin + (size_t)c * S4_TC * 384;
#pragma unroll
    for (int i = 0; i < 6; ++i) { const int piece = sw + 4 * i;
        __builtin_amdgcn_global_load_lds((const unsigned*)(src + piece * 256 + lane * 4), (LAS unsigned*)(buf + piece * 256), 16, 0, 0); }
    __builtin_amdgcn_global_load_lds((const unsigned*)(scal + (size_t)c * S4_TC * 16 + lane * 4), (LAS unsigned*)(buf + S4_TC * 384), 16, 0, 0);
}
__device__ __forceinline__ void scan4_item(Frame& F, GBar& gb, int b, int h, int rg, float* s_out, float* y0) {
    const int bh = b * RH + h, lane = F.lane, sw = F.wave;
    const float* sin = WSP(float, WS_SCANIN) + (size_t)bh * SEQ * 384; const float* scal = WSP(float, WS_SCAL) + (size_t)bh * SEQ * 16;
    const int ri = lane >> 4, kq = lane & 15, vrow = rg * 16 + sw * 4 + ri;
    f32x2 s01 = (f32x2){0.f, 0.f}, s23 = (f32x2){0.f, 0.f};
    scan4_issue(F.lds, sin, scal, 0, sw, lane); scan4_issue(F.lds, sin, scal, 1, sw, lane);
    for (int c = 0; c < S4_NCH; ++c) {
        if (c < 2 || c + 2 >= S4_NCH) asm volatile("s_waitcnt vmcnt(0)" ::: "memory");
        else asm volatile("s_waitcnt vmcnt(9)" ::: "memory");
        gbar(gb, lane);
        if (c + 2 < S4_NCH) scan4_issue(F.lds, sin, scal, c + 2, sw, lane);
        const LAS float* buf = (const LAS float*)(F.lds + RING_OFF) + (c % S4_NB) * S4_BUF_FLOATS;
        const LAS float* lb = buf + 4 * kq;
        const LAS float* vb = buf + 320 + vrow;
        const LAS float* sb = buf + S4_TC * 384;
        float yacc = 0.f;
#define S4_LOAD(ST, KK, W4, NB, KP, WR, TB) do { KK = *(const LAS f32x4*)(lb + (ST) * 384); W4 = *(const LAS f32x4*)(lb + (ST) * 384 + 64); NB = *(const LAS f32x4*)(lb + (ST) * 384 + 128); \
            KP = *(const LAS f32x4*)(lb + (ST) * 384 + 192); WR = *(const LAS f32x4*)(lb + (ST) * 384 + 256); const float _v = vb[(ST) * 384]; const f32x2 _s = *(const LAS f32x2*)(sb + (ST) * 16); \
            TB.x = _v; TB.y = _s.x; TB.z = _s.y; TB.w = 0.f; } while (0)
        f32x4 kkA, w4A, nbA, kpA, wrA, tbA, kkB, w4B, nbB, kpB, wrB, tbB;
        S4_LOAD(0, kkA, w4A, nbA, kpA, wrA, tbA); S4_LOAD(1, kkB, w4B, nbB, kpB, wrB, tbB);
#pragma unroll
        for (int st = 0; st < S4_TC; st += 2) {
            const int s2 = (st + 2 < S4_TC) ? st + 2 : st, s3 = (st + 3 < S4_TC) ? st + 3 : st + 1;
            float y;
            SCAN_STEP(kkA, w4A, nbA, kpA, wrA, tbA, y);
            yacc = (kq == st) ? y : yacc;
            S4_LOAD(s2, kkA, w4A, nbA, kpA, wrA, tbA);
            __builtin_amdgcn_sched_barrier(0);
            SCAN_STEP(kkB, w4B, nbB, kpB, wrB, tbB, y);
            yacc = (kq == st + 1) ? y : yacc;
            S4_LOAD(s3, kkB, w4B, nbB, kpB, wrB, tbB);
            __builtin_amdgcn_sched_barrier(0);
        }
#undef S4_LOAD
        y0[(size_t)(c * S4_TC + kq) * RW + vrow] = yacc;
    }
    *(f32x4*)(s_out + (size_t)vrow * 64 + 4 * kq) = (f32x4){s01.x, s01.y, s23.x, s23.y};
}
template <bool MASKED>
__device__ __forceinline__ void attn4(Frame& F, int gw, int row0, int nkt, int NT, const bf16* Qb, const bf16* Kf, const bf16* Vf, int gate_col, int out_col) {
    const int lane = F.lane, r = lane & 31, hh = lane >> 5, h = gw;
    const LAS unsigned* mask = (const LAS unsigned*)(F.lds + G4_MASK_OFF) + r * 64;
    bf16x8 qf[8];
#pragma unroll
    for (int ks = 0; ks < 8; ++ks) qf[ks] = *(const bf16x8*)(Qb + (size_t)(row0 + r) * 512 + h * 128 + 16 * ks + 8 * hh);
    f32x16 o[4];
#pragma unroll
    for (int d = 0; d < 4; ++d)
#pragma unroll
        for (int j = 0; j < 16; ++j) o[d][j] = 0.f;
    float m = -INFINITY, lsum = 0.f;
    const bf16* kbase = Kf + (size_t)(h * NT) * 4096 + lane * 8;
    const bf16* vbase = Vf + (size_t)(h * NT) * 4096 + lane * 8;
    bf16x8 kf[8];
#pragma unroll
    for (int ks = 0; ks < 8; ++ks) kf[ks] = *(const bf16x8*)(kbase + ks * 512);
#pragma unroll 1
    for (int kt = 0; kt < nkt; ++kt) {
        bf16x8 vf[4][2];
#pragma unroll
        for (int d = 0; d < 4; ++d)
#pragma unroll
            for (int s = 0; s < 2; ++s) vf[d][s] = *(const bf16x8*)(vbase + (size_t)kt * 4096 + (d * 2 + s) * 512);
        f32x16 x;
#pragma unroll
        for (int j = 0; j < 16; ++j) x[j] = 0.f;
#pragma unroll
        for (int ks = 0; ks < 8; ++ks) x = __builtin_amdgcn_mfma_f32_32x32x16_bf16(kf[ks], qf[ks], x, 0, 0, 0);
        {   const int ktn = (kt + 1 < nkt) ? kt + 1 : kt;
#pragma unroll
            for (int ks = 0; ks < 8; ++ks) kf[ks] = *(const bf16x8*)(kbase + (size_t)ktn * 4096 + ks * 512); }
        if (MASKED) {
            const unsigned m4 = mask[kt] >> (4 * hh);
#pragma unroll
            for (int g = 0; g < 4; ++g)
#pragma unroll
                for (int e = 0; e < 4; ++e) { const unsigned t = (unsigned)((int)(m4 << (31 - (8 * g + e))) >> 31);
                    x[4 * g + e] = __uint_as_float((__float_as_uint(x[4 * g + e]) & t) | (0xff800000u & ~t)); }
        }
        float mx = x[0];
#pragma unroll
        for (int j = 1; j < 16; ++j) mx = fmaxf(mx, x[j]);
        mx = xhalf_max(mx);
        const float mn = fmaxf(m, mx), mu = (mn == -INFINITY) ? 0.f : mn;
        const float alpha = __builtin_amdgcn_exp2f(m - mu);
        m = mn;
        float ls = 0.f;
#pragma unroll
        for (int j = 0; j < 16; ++j) { x[j] = __builtin_amdgcn_exp2f(x[j] - mu); ls += x[j]; }
        lsum = lsum * alpha + ls;
        if (__any(alpha != 1.f)) {
#pragma unroll
            for (int d = 0; d < 4; ++d)
#pragma unroll
                for (int j = 0; j < 16; ++j) o[d][j] *= alpha;
        }
        bf16x8 pf[2];
#pragma unroll
        for (int s = 0; s < 2; ++s) { v4u u; u.x = cvt_pk_bf16(x[8 * s + 0], x[8 * s + 1]); u.y = cvt_pk_bf16(x[8 * s + 2], x[8 * s + 3]); u.z = cvt_pk_bf16(x[8 * s + 4], x[8 * s + 5]); u.w = cvt_pk_bf16(x[8 * s + 6], x[8 * s + 7]);
            pf[s] = __builtin_bit_cast(bf16x8, u); }
#pragma unroll
        for (int d = 0; d < 4; ++d)
#pragma unroll
            for (int s = 0; s < 2; ++s) o[d] = __builtin_amdgcn_mfma_f32_32x32x16_bf16(vf[d][s], pf[s], o[d], 0, 0, 0);
    }
    lsum = xhalf_sum(lsum);
    const float inv = lsum > 0.f ? 1.f / lsum : 0.f;
    const float* gp = WSP(float, WS_PROJ) + (size_t)(row0 + r) * INWP + gate_col + h * 128;
    bf16* op = WSP(bf16, WS_YMIX) + (size_t)(row0 + r) * DM + out_col + h * 128;
#pragma unroll
    for (int d = 0; d < 4; ++d)
#pragma unroll
        for (int g = 0; g < 4; ++g) { const int dd = d * 32 + 8 * g + 4 * hh; const f32x4 gv = *(const f32x4*)(gp + dd);
            float v[4];
#pragma unroll
            for (int e = 0; e < 4; ++e) v[e] = o[d][4 * g + e] * inv * silu(gv[e]);
            v2u pk; pk.x = cvt_pk_bf16(v[0], v[1]); pk.y = cvt_pk_bf16(v[2], v[3]); *(v2u*)(op + dd) = pk; }
}
__device__ __forceinline__ void dsa4_item(Frame& F, GBar& gb, int gw, int b, int qt) {
    const int t0 = qt * 32, row0 = b * SEQ + t0, nkt = qt + 1, gt = gw * 64 + F.lane;
    LAS unsigned* mask = (LAS unsigned*)(F.lds + G4_MASK_OFF);
    if (t0 + 31 < TOPK) {
        for (int i = gt; i < 32 * 64; i += 256) { const int q = i >> 6, kt = i & 63; const int nb = t0 + q - 32 * kt + 1;
            mask[i] = nb >= 32 ? 0xffffffffu : (nb <= 0 ? 0u : ((1u << nb) - 1u)); }
    } else {
        const int lane = F.lane, r = lane & 31, hh = lane >> 5;
        int r4 = 4 * r; asm volatile("" : "+v"(r4));
        const bf16* KIB = WSP(bf16, WS_SC) + (size_t)(b * SEQ) * 64 + lane * 8;
        LAS unsigned* skl = (LAS unsigned*)(F.lds + G4_SKL_OFF) + gw * 4096 + hh * 2048;
        for (int i = gt; i < 32 * 64; i += 256) mask[i] = 0u;
        gbar(gb, lane);
        for (int pass = 0; pass < 4; ++pass) {
            const int q0 = 8 * pass + 2 * gw, tq = t0 + q0 + hh;
            {
                bf16x8 af[4]; idx_afrag(WSP(bf16, WS_QIB), row0 + q0, lane, af);
                f32x4 w[4];
#pragma unroll
                for (int j = 0; j < 4; ++j) w[j] = *(const f32x4*)(WSP(float, WS_WIS) + (size_t)(row0 + q0 + hh) * 16 + 4 * j);
                bf16x8 ring[4][4];
#pragma unroll
                for (int i = 0; i < 3; ++i) { const int ktc = i < nkt ? i : nkt - 1;
#pragma unroll
                    for (int ks = 0; ks < 4; ++ks) ring[i][ks] = *(const bf16x8*)(KIB + (size_t)ktc * 2048 + ks * 512); }
                for (int kt0 = 0; kt0 < nkt; kt0 += 4) {
#pragma unroll
                    for (int i = 0; i < 4; ++i) {
                        const int kt = kt0 + i, ktp = (kt + 3 < nkt) ? kt + 3 : nkt - 1;
#pragma unroll
                        for (int ks = 0; ks < 4; ++ks) ring[(i + 3) & 3][ks] = *(const bf16x8*)(KIB + (size_t)ktp * 2048 + ks * 512);
                        f32x16 acc;
#pragma unroll
                        for (int j = 0; j < 16; ++j) acc[j] = 0.f;
#pragma unroll
                        for (int ks = 0; ks < 4; ++ks) acc = __builtin_amdgcn_mfma_f32_32x32x16_bf16(af[ks], ring[i][ks], acc, 0, 0, 0);
                        if (kt < nkt) skl[kt * 32 + r] = sort_key(idx_reduce(acc, w));
                    }
                }
            }
            asm volatile("s_waitcnt lgkmcnt(0)" ::: "memory");
            unsigned sk[64];
            int tqr = tq - r4; asm volatile("" : "+v"(tqr));
#pragma unroll
            for (int i = 0; i < 16; ++i) { const v4u v = *(const LAS v4u*)(skl + 128 * i + r4);
                sk[4 * i + 0] = (128 * i + 0 <= tqr) ? v.x : 0u; sk[4 * i + 1] = (128 * i + 1 <= tqr) ? v.y : 0u; sk[4 * i + 2] = (128 * i + 2 <= tqr) ? v.z : 0u; sk[4 * i + 3] = (128 * i + 3 <= tqr) ? v.w : 0u; }
            unsigned T = 0u; bool exact = false;
            for (int bit = 31; bit >= 0; --bit) {
                const unsigned cand = T | (1u << bit);
                unsigned c = 0u;
#pragma unroll
                for (int i = 0; i < 64; ++i) cnt_ge(c, sk[i], cand);
                c = half_sum_u(c);
                if (!exact) { if (c >= (unsigned)TOPK) T = cand; if (c == (unsigned)TOPK) exact = true; }
                if (__all(exact)) break;
            }
            unsigned cut = 0x7fffffffu;
            if (__any(!exact)) {
                unsigned cg = 0u, ce = 0u;
                for (int i = 0; i < 16; ++i) { const v4u v = *(const LAS v4u*)(skl + 128 * i + r4); const int i0 = 128 * i + r4;
#pragma unroll
                    for (int e = 0; e < 4; ++e) { const unsigned k = (i0 + e <= tq) ? v[e] : 0u; cg += (k > T) ? 1u : 0u; ce += (k == T) ? 1u : 0u; } }
                cg = half_sum_u(cg); ce = half_sum_u(ce);
                const unsigned need = (unsigned)TOPK - cg;
                const bool tie = !exact && ce > need;
                unsigned I = 0u;
                for (int bit = 11; bit >= 0; --bit) {
                    const unsigned cand = I | (1u << bit);
                    unsigned c = 0u;
                    for (int i = 0; i < 16; ++i) { const v4u v = *(const LAS v4u*)(skl + 128 * i + r4); const int i0 = 128 * i + r4;
#pragma unroll
                        for (int e = 0; e < 4; ++e) { const unsigned k = (i0 + e <= tq) ? v[e] : 0u; c += (k == T && (unsigned)(i0 + e) < cand) ? 1u : 0u; } }
                    c = half_sum_u(c);
                    if (c < need) I = cand;
                }
                if (tie) cut = I;
            }
            int cutr = (int)cut - r4; asm volatile("" : "+v"(cutr));
#pragma unroll
            for (int i = 0; i < 16; ++i) {
                unsigned nib = 0u;
#pragma unroll
                for (int e = 0; e < 4; ++e) { const unsigned k = sk[4 * i + e]; const bool sel = k != 0u && (k > T || (k == T && (128 * i + e) <= cutr)); nib |= sel ? (1u << e) : 0u; }
                if (nib) __hip_atomic_fetch_or((LAS unsigned*)&mask[(q0 + hh) * 64 + 4 * i + (r >> 3)], nib << (4 * (r & 7)), __ATOMIC_RELAXED, __HIP_MEMORY_SCOPE_WORKGROUP);
            }
        }
    }
    gbar(gb, F.lane);
    attn4<true>(F, gw, row0, nkt, 64, WSP(bf16, WS_QB), WSP(bf16, WS_KB) + (size_t)b * SEQ * 512, WSP(bf16, WS_VT) + (size_t)b * 512 * SEQ, C_GA, 1024);
    gbar(gb, F.lane);
}
__device__ __forceinline__ void group_queue(Frame& F, GBar& gb, int gw) {
    unsigned* qctr = (unsigned*)(F.ws + WS_CTL) + 8192;
    volatile LAS int* slot = (volatile LAS int*)(F.lds + G4_SLOT_OFF);
    for (int n = 0;; ++n) {
        if (gw == 0 && F.lane == 0) slot[n & 1] = (int)__hip_atomic_fetch_add(qctr, 1u, __ATOMIC_RELAXED, __HIP_MEMORY_SCOPE_AGENT);
        gbar(gb, F.lane);
        const int it = slot[n & 1];
        if (it >= 512) break;
        Frame Fi = F; asm volatile("" : "+v"(Fi.lane), "+v"(Fi.tid));
        if (it < 256) dsa4_item(Fi, gb, gw, it & 3, 63 - (it >> 2));
        else { const int j = it - 256, b = j >> 6, qt = j & 63;
            attn4<false>(Fi, gw, b * SEQ + qt * 32, 8, 8, WSP(bf16, WS_QMB), WSP(bf16, WS_MKB) + (size_t)b * MEMT * 512, WSP(bf16, WS_MVT) + (size_t)b * 512 * MEMT, C_GM, 1536); }
    }
}
__device__ __forceinline__ bool overlap_mode(const Frame& F) { return F.G >= 64; }
__device__ __forceinline__ void p3_overlap(Frame& F) {
    volatile LAS unsigned* ctl = (volatile LAS unsigned*)(F.lds + G4_SLOT_OFF);
    const unsigned c_scan = ctl[4], c_att = ctl[8];
    __syncthreads();
    if (F.wave < 4) {
        GBar gb{ctl + 4, c_scan};
        for (int it0 = F.bid; it0 < 256; it0 += F.G) { const int it = (F.G == 256) ? ((it0 & 7) * 32 + (it0 >> 3)) : it0;
            const int bh = it >> 2, rg = it & 3, b = bh >> 4, h = bh & 15;
            scan4_item(F, gb, b, h, rg, F.out + O_WKVP + (size_t)bh * 4096, WSP(float, WS_Y) + (size_t)(b * SEQ) * RW + h * 64);
            asm volatile("s_waitcnt vmcnt(0)" ::: "memory"); gbar(gb, F.lane); }
    } else {
        GBar gb{ctl + 8, c_att};
        const int gw = F.wave - 4;
        const int gwi = F.bid * 4 + gw, NGW = F.G * 4;
        for (int it = gwi; it < DB * RH * 16; it += NGW) scan_sample_witem(F, it);
        for (int it = gwi; it < DB * NPAGES + DB; it += NGW) d1_sample_item(F, it);
        group_queue(F, gb, gw);
    }
    __syncthreads();
}
__device__ __forceinline__ void p8_phase(Frame& F) {
    const int gw = F.bid * NWAVES + F.wave, NGW = F.G * NWAVES;
    int t_ = threadIdx.x; asm volatile("" : "+v"(t_)); const int lane_ = t_ & 63;
    for (int row = gw; row < NTOK; row += NGW) {
        float* y = F.out + (row < NTOKP ? O_YP + (size_t)row * DM : O_YS + (size_t)(row - NTOKP) * DM);
        f32x4* xr = (f32x4*)y + lane_; const f32x4* wr = (const f32x4*)F.in[I_FNW] + lane_;
        f32x4 v[8]; float s = 0.f;
#pragma unroll
        for (int j = 0; j < 8; ++j) { v[j] = xr[64 * j]; s += (v[j].x * v[j].x + v[j].y * v[j].y) + (v[j].z * v[j].z + v[j].w * v[j].w); }
        const float rs = 1.f / sqrtf(wave_sum(s) * (1.f / DM) + RMS_EPS);
#pragma unroll
        for (int j = 0; j < 8; ++j) { const f32x4 ww = wr[64 * j]; xr[64 * j] = (f32x4){v[j].x * rs * ww.x, v[j].y * rs * ww.y, v[j].z * rs * ww.z, v[j].w * rs * ww.w}; }
    }
}

constexpr int N_PHASES = 9;
struct Args { const void* in[N_IN]; float* out; unsigned char* ws; int ph_lo, ph_hi; };
__global__ void __launch_bounds__(NTHR, 2) hymba_fwd(Args args) {
    extern __shared__ __attribute__((aligned(16))) unsigned char lds[];
    Frame F;
    F.lds = (LAS unsigned char*)lds;
    F.tid = threadIdx.x; F.lane = F.tid & 63; F.wave = __builtin_amdgcn_readfirstlane(F.tid >> 6);
    F.G = gridDim.x; F.bid = blockIdx.x;
#pragma unroll
    for (int i = 0; i < N_IN; ++i) F.in[i] = (const float*)args.in[i];
    F.out = args.out; F.ws = args.ws;
    for (int u = F.tid; u < (LDS_BYTES - LDSCTL_OFF) / 4; u += NTHR) ((LAS unsigned*)(F.lds + LDSCTL_OFF))[u] = 0u;
    __syncthreads();

#if MK_SPLIT
#define GRID_BAR() do { } while (0)
#else
    XcdBarrier bar = xcd_barrier_post((unsigned*)(F.ws + WS_CTL) + CW_BAR, (volatile LAS unsigned*)(F.lds + MISC_OFF) + 8);
#define GRID_BAR() xcd_barrier(bar)
#endif
    const int lo = args.ph_lo, hi = args.ph_hi;
#ifndef PH_MASK
#define PH_MASK 0x1FF
#endif
#define IN(k) (((PH_MASK >> (k)) & 1) && lo <= (k) && (k) < hi)
#define BOTH(k) (IN(k) && IN((k) + 1))

#define RUNPH(k, ...) do { if (IN(k)) { __VA_ARGS__; if (PROBE_REPEAT == (k)) { GRID_BAR(); __VA_ARGS__; } if (BOTH(k)) GRID_BAR(); } } while (0)
    RUNPH(0, p0_prologue(F));
    RUNPH(1, {
        { pg8::Gemm g{WSP(bf16, WS_XN), WSP(bf16, WS_WINT), MPAD, INWP, DM, DM}; pg8::StaticOrder S; S.init(MPAD, INWP, F.G, F.bid);
          EpiProjFused E{WSP(float, WS_PROJ), F.out, F.ws};
          pg8::gemm_phase<EpiProjFused, pg8::StaticOrder, true, true>(F.lds + RING_OFF, g, S, E); }
        { pg8::Gemm g{WSP(bf16, WS_XM), WSP(bf16, WS_WMEMT), 1024, 1024, DM, DM}; pg8::StaticOrder S; S.init(1024, 1024, F.G, F.G - 1 - F.bid);
          EpiMem E{F.out};
          pg8::gemm_phase<EpiMem, pg8::StaticOrder, true, true>(F.lds + RING_OFF, g, S, E); }
    });
    RUNPH(2, p2_phase(F));
    if (F.G >= 64) { RUNPH(3, p3_overlap(F)); } else { RUNPH(3, p3_scan_phase(F)); }
    RUNPH(4, p4_phase(F));
    if (F.G < 64) { RUNPH(5, p5_phase(F)); }
    RUNPH(6, p6_phase(F));
    RUNPH(7, {
        { pg8::Gemm g{WSP(bf16, WS_YMIX), WSP(bf16, WS_WOUTT), NTOKP, DM, DM, DM}; pg8::StaticOrder S; S.init(NTOKP, DM, F.G, F.bid);
          EpiOut E{F.in[I_XP], F.in[I_XS], F.out};
          pg8::gemm_phase<EpiOut, pg8::StaticOrder, true, true>(F.lds + RING_OFF, g, S, E); }
        { pg8::Gemm g{WSP(bf16, WS_YMIX), WSP(bf16, WS_WOUTT), MPAD, DM, 256, DM}; pg8::ListOrder S{F.G, F.bid, 2};
          EpiOutAtomic E{F.out};
          pg8::gemm_phase<EpiOutAtomic, pg8::ListOrder, true, true>(F.lds + RING_OFF, g, S, E); }
    });
    if (IN(8)) { p8_phase(F); }
#undef IN
#undef BOTH
}

extern "C" void kernel_launch(void* const* d_in, const int* in_sizes, int n_in, void* d_out, int out_size, void* d_ws, size_t ws_size, hipStream_t stream) {
    static int grid = 0;
    if (grid == 0) {
        if (n_in != N_IN || out_size != (int)O_END || ws_size < WS_END) { fprintf(stderr, "kernel_launch: unexpected shapes: n_in %d out %d ws %zu (need %zu)\n", n_in, out_size, ws_size, (size_t)WS_END); grid = -1; return; }
        int dev = 0, cus = 0, per_cu = 0;
        if (hipGetDevice(&dev) != hipSuccess || hipDeviceGetAttribute(&cus, hipDeviceAttributeMultiprocessorCount, dev) != hipSuccess) { grid = -1; return; }
        if (hipFuncSetAttribute((const void*)hymba_fwd, hipFuncAttributeMaxDynamicSharedMemorySize, LDS_BYTES) != hipSuccess) { fprintf(stderr, "kernel_launch: hipFuncSetAttribute failed\n"); grid = -1; return; }
        if (hipOccupancyMaxActiveBlocksPerMultiprocessor(&per_cu, (const void*)hymba_fwd, NTHR, LDS_BYTES) != hipSuccess || per_cu < 1) { fprintf(stderr, "kernel_launch: occupancy query says %d\n", per_cu); }
        (void)hipGetLastError();
        grid = cus;
    }
    if (grid < 0) return;
    if (hipMemsetAsync((char*)d_ws + WS_CTL, 0, CTL_ZERO_BYTES, stream) != hipSuccess) { fprintf(stderr, "kernel_launch: memset failed\n"); return; }
    Args a{};
    for (int i = 0; i < N_IN; ++i) a.in[i] = d_in[i];
    a.out = (float*)d_out; a.ws = (unsigned char*)d_ws;
#if MK_SPLIT
    for (int p = 0; p < N_PHASES; ++p) { a.ph_lo = p; a.ph_hi = p + 1; hipLaunchKernelGGL(hymba_fwd, dim3(grid), dim3(NTHR), LDS_BYTES, stream, a); }
#else
    a.ph_lo = 0; a.ph_hi = N_PHASES;
    hipLaunchKernelGGL(hymba_fwd, dim3(grid), dim3(NTHR), LDS_BYTES, stream, a);
#endif
    const hipError_t le = hipPeekAtLastError();
    if (le != hipSuccess) fprintf(stderr, "kernel_launch: launch failed: %s\n", hipGetErrorName(le));
}
```

```cpp
#include <hip/hip_runtime.h>
#include <cstdio>
#include <cstdint>

#ifndef MK_SPLIT
#define MK_SPLIT 0
#endif

namespace pg8 {
#define PG8_LAS __attribute__((address_space(3)))
typedef unsigned short bf16_t;
typedef short bf16x8 __attribute__((ext_vector_type(8)));
typedef float f32x4 __attribute__((ext_vector_type(4)));
typedef unsigned u32x4 __attribute__((ext_vector_type(4)));
constexpr int BM = 256, BK = 64, HALF = 128, HTB = HALF * BK * 2, STAGE_BYTES = 8 * HTB, NXCD = 8, WGM = 8;

__host__ __device__ __forceinline__ int lds_byte(int r, int c) { const int st = (r >> 4) * 2 + (c >> 5), rr = r & 15, cc = c & 31, ob = rr * 64 + cc * 2; return st * 1024 + (ob ^ (((ob >> 9) & 1) << 5)); }
__host__ __device__ __forceinline__ void stage_rc(int b, int& R, int& C) { const int st = b / 1024, sb = b % 1024, swz = sb ^ (((sb >> 9) & 1) << 5); R = (st >> 1) * 16 + swz / 64; C = (st & 1) * 32 + (swz % 64) / 2; }

struct Unit { int pm, pn, koff; };
struct Gemm { const bf16_t* A; const bf16_t* Bt; int M, N, K, ld; };

struct StaticOrder {
    int nM, nN, nwg, G, c;
    __host__ __device__ void init(int M, int N, int G_, int c_) { nM = M / BM; nN = N / BM; nwg = nM * nN; G = G_; c = c_; }
    __host__ __device__ bool next(int i, Unit& u) const {
        const long L = (long)i * G + c; if (L >= nwg) return false;
        int wgid = (int)L; { const int q = nwg / NXCD, r = nwg % NXCD, xcd = wgid % NXCD, off = wgid / NXCD; wgid = (xcd < r ? xcd * (q + 1) : r * (q + 1) + (xcd - r) * q) + off; }
        const int nig = WGM * nN, gid = wgid / nig, fm = gid * WGM, gsz = (nM - fm) < WGM ? (nM - fm) : WGM;
        u.pm = fm + ((wgid % nig) % gsz); u.pn = (wgid % nig) / gsz; u.koff = 0; return true;
    }
    __device__ __forceinline__ void a_ready(const Unit&) const {}
    __device__ __forceinline__ void done(const Unit&) const {}
};

struct ListOrder {
    int G, c, mode;
    __device__ __forceinline__ bool next(int i, Unit& u) const {
        const int L = i * G + c;
        if (mode == 0) { if (L >= 260) return false; const int q = L & 3, uu = L >> 2; if (uu < 33) { u.pm = 32; u.pn = uu; } else { u.pm = uu - 33; u.pn = 32; } u.koff = q * 512; return true; }
        if (mode == 1) { if (L >= 64) return false; const int q = L & 3, uu = L >> 2; u.pm = uu >> 2; u.pn = uu & 3; u.koff = q * 512; return true; }
        if (L >= 64) return false; u.pm = 32; u.pn = L >> 3; u.koff = (L & 7) * 256; return true;
    }
    __device__ __forceinline__ void a_ready(const Unit&) const {}
    __device__ __forceinline__ void done(const Unit&) const {}
};
template <class Epi, class Sched, bool ALIGN_EPI = false, bool SP2 = false>
__device__ __forceinline__ void gemm_phase(PG8_LAS unsigned char* lds, const Gemm g, const Sched& S, const Epi& E) {
    const int tid = threadIdx.x, wid = __builtin_amdgcn_readfirstlane(tid >> 6), lane = tid & 63, wr = wid >> 2, wc = wid & 3, fr = lane & 15, fq = lane >> 4;
    const int K = g.K, nt = K / BK;
    unsigned voffA[2], voffB[2];
    const int ld = g.ld;
#pragma unroll
    for (int i = 0; i < 2; ++i) { int R, C; stage_rc(tid * 16 + i * 8192, R, C); voffA[i] = (unsigned)(R * ld + C) * 2u; voffB[i] = (unsigned)(R * ld + C) * 2u; }
    const size_t kstep = (size_t)(BK * 2);
    const size_t hstep = (size_t)HALF * ld * 2;
    const size_t tstep = 2 * hstep;
    const unsigned ldsw = (unsigned)wid * 1024u;
    const int aoff = lds_byte(wr * 64 + fr, fq * 8), boff = lds_byte(wc * 32 + fr, fq * 8);
#define PG8_SA(b, h) (((b) * 2 + (h)) * HTB)
#define PG8_SB(b, h) ((4 + (b) * 2 + (h)) * HTB)
#define PG8_STAGE(bufoff, gbase, voff) do { _Pragma("unroll") for (int _i = 0; _i < 2; ++_i) \
        __builtin_amdgcn_global_load_lds((const unsigned*)((const char*)(gbase) + (voff)[_i]), (PG8_LAS unsigned*)(lds + (bufoff) + ldsw + _i * 8192), 16, 0, 0); } while (0)
#define PG8_LDA(dst, b, h) do { _Pragma("unroll") for (int m = 0; m < 4; ++m) _Pragma("unroll") for (int k = 0; k < 2; ++k) dst[m][k] = *(const PG8_LAS bf16x8*)(lds + PG8_SA(b, h) + aoff + m * 2048 + k * 1024); } while (0)
#define PG8_LDB(dst, b, h) do { _Pragma("unroll") for (int n = 0; n < 2; ++n) _Pragma("unroll") for (int k = 0; k < 2; ++k) dst[n][k] = *(const PG8_LAS bf16x8*)(lds + PG8_SB(b, h) + boff + n * 2048 + k * 1024); } while (0)
#define PG8_MMA(ai, bj, At, Bt) do { __builtin_amdgcn_s_setprio(1); _Pragma("unroll") for (int m = 0; m < 4; ++m) _Pragma("unroll") for (int n = 0; n < 2; ++n) _Pragma("unroll") for (int k = 0; k < 2; ++k) \
        acc[ai][bj][m][n] = __builtin_amdgcn_mfma_f32_16x16x32_bf16(Bt[n][k], At[m][k], acc[ai][bj][m][n], 0, 0, 0); __builtin_amdgcn_s_setprio(0); } while (0)
#define PG8_WAIT_V(n) asm volatile("s_waitcnt vmcnt(" #n ")" ::: "memory")
#define PG8_WAIT_L(n) asm volatile("s_waitcnt lgkmcnt(" #n ")" ::: "memory")
#define PG8_BAR __builtin_amdgcn_s_barrier()
#define PG8_SCHED __builtin_amdgcn_sched_barrier(0)
    Unit cur, nxt; int ui = 0;
    if (!S.next(0, cur)) return;
    f32x4 acc[2][2][4][2];
#pragma unroll
    for (int a = 0; a < 2; ++a)
#pragma unroll
        for (int b = 0; b < 2; ++b)
#pragma unroll
            for (int m = 0; m < 4; ++m)
#pragma unroll
                for (int n = 0; n < 2; ++n) acc[a][b][m][n] = (f32x4){0.f, 0.f, 0.f, 0.f};
    bf16x8 At[4][2], B0[2][2], B1[2][2];
    const char* cA = (const char*)g.A + (size_t)cur.pm * tstep + (size_t)cur.koff * 2; const char* cB = (const char*)g.Bt + (size_t)cur.pn * tstep + (size_t)cur.koff * 2;
    S.a_ready(cur);
    if constexpr (SP2) {
        PG8_STAGE(PG8_SB(0, 0), cB, voffB); PG8_STAGE(PG8_SB(0, 1), cB + hstep, voffB); PG8_STAGE(PG8_SA(0, 0), cA, voffA); PG8_STAGE(PG8_SA(0, 1), cA + hstep, voffA);
        if (wr == 1) PG8_BAR;
        PG8_WAIT_V(2); PG8_BAR;
        PG8_STAGE(PG8_SB(1, 0), cB + kstep, voffB); PG8_STAGE(PG8_SA(1, 0), cA + kstep, voffA); PG8_STAGE(PG8_SB(1, 1), cB + hstep + kstep, voffB);
        PG8_WAIT_V(6); PG8_BAR;
    } else {
        PG8_STAGE(PG8_SB(0, 0), cB, voffB); PG8_STAGE(PG8_SA(0, 0), cA, voffA); PG8_STAGE(PG8_SB(0, 1), cB + hstep, voffB); PG8_STAGE(PG8_SA(0, 1), cA + hstep, voffA);
        if (wr == 1) PG8_BAR;
        PG8_WAIT_V(4); PG8_BAR;
        PG8_STAGE(PG8_SB(1, 0), cB + kstep, voffB); PG8_STAGE(PG8_SA(1, 0), cA + kstep, voffA); PG8_STAGE(PG8_SB(1, 1), cB + hstep + kstep, voffB);
        PG8_WAIT_V(6); PG8_BAR;
    }
    for (;;) {
        const bool has_next = S.next(ui + 1, nxt);
        const char* nA = has_next ? (const char*)g.A + (size_t)nxt.pm * tstep + (size_t)nxt.koff * 2 : cA; const char* nB = has_next ? (const char*)g.Bt + (size_t)nxt.pn * tstep + (size_t)nxt.koff * 2 : cB;
        for (int t = 0; t < nt; t += 2) {
            const bool last = (t == nt - 2);
            const char* a1 = cA + (size_t)(t + 1) * kstep;
            const char* a2 = last ? nA : cA + (size_t)(t + 2) * kstep; const char* b2 = last ? nB : cB + (size_t)(t + 2) * kstep;
            const char* a3 = a2 + kstep; const char* b3 = b2 + kstep;
            if (last && has_next) S.a_ready(nxt);
            if constexpr (SP2) {
            PG8_LDB(B0, 0, 0); PG8_LDB(B1, 0, 1); PG8_SCHED; PG8_LDA(At, 0, 0); PG8_STAGE(PG8_SA(1, 1), a1 + hstep, voffA);
            PG8_WAIT_V(8); PG8_WAIT_L(0); PG8_BAR; PG8_MMA(0, 0, At, B0); PG8_MMA(0, 1, At, B1); PG8_BAR; PG8_SCHED;
            PG8_LDA(At, 0, 1); PG8_STAGE(PG8_SB(0, 0), b2, voffB); PG8_STAGE(PG8_SB(0, 1), b2 + hstep, voffB); PG8_STAGE(PG8_SA(0, 0), a2, voffA);
            PG8_WAIT_V(8); PG8_WAIT_L(0); PG8_BAR; PG8_MMA(1, 0, At, B0); PG8_MMA(1, 1, At, B1); PG8_BAR; PG8_SCHED;
            PG8_LDB(B0, 1, 0); PG8_LDB(B1, 1, 1); PG8_SCHED; PG8_LDA(At, 1, 0); PG8_STAGE(PG8_SA(0, 1), a2 + hstep, voffA);
            PG8_WAIT_V(8); PG8_WAIT_L(0); PG8_BAR; PG8_MMA(0, 0, At, B0); PG8_MMA(0, 1, At, B1); PG8_BAR; PG8_SCHED;
            PG8_LDA(At, 1, 1); PG8_STAGE(PG8_SB(1, 0), b3, voffB); PG8_STAGE(PG8_SB(1, 1), b3 + hstep, voffB); PG8_STAGE(PG8_SA(1, 0), a3, voffA);
            PG8_WAIT_V(8); PG8_WAIT_L(0); PG8_BAR; PG8_MMA(1, 0, At, B0); PG8_MMA(1, 1, At, B1); PG8_BAR; PG8_SCHED;
            } else {
            PG8_LDB(B0, 0, 0); PG8_SCHED; PG8_LDA(At, 0, 0); PG8_STAGE(PG8_SA(1, 1), a1 + hstep, voffA);
            PG8_WAIT_L(8); PG8_BAR; PG8_WAIT_L(0); PG8_MMA(0, 0, At, B0); PG8_BAR; PG8_SCHED;
            PG8_LDB(B1, 0, 1); PG8_STAGE(PG8_SB(0, 0), b2, voffB);
            PG8_BAR; PG8_WAIT_L(0); PG8_MMA(0, 1, At, B1); PG8_BAR;
            PG8_LDA(At, 0, 1); PG8_STAGE(PG8_SA(0, 0), a2, voffA);
            PG8_BAR; PG8_WAIT_L(0); PG8_MMA(1, 0, At, B0); PG8_BAR; PG8_SCHED;
            PG8_STAGE(PG8_SB(0, 1), b2 + hstep, voffB);
            PG8_WAIT_V(6); PG8_BAR; PG8_MMA(1, 1, At, B1); PG8_BAR;
            PG8_LDB(B0, 1, 0); PG8_SCHED; PG8_LDA(At, 1, 0); PG8_STAGE(PG8_SA(0, 1), a2 + hstep, voffA);
            PG8_WAIT_L(8); PG8_BAR; PG8_WAIT_L(0); PG8_MMA(0, 0, At, B0); PG8_BAR; PG8_SCHED;
            PG8_LDB(B1, 1, 1); PG8_STAGE(PG8_SB(1, 0), b3, voffB);
            PG8_BAR; PG8_WAIT_L(0); PG8_MMA(0, 1, At, B1); PG8_BAR;
            PG8_LDA(At, 1, 1); PG8_STAGE(PG8_SA(1, 0), a3, voffA);
            PG8_BAR; PG8_WAIT_L(0); PG8_MMA(1, 0, At, B0); PG8_BAR; PG8_SCHED;
            PG8_STAGE(PG8_SB(1, 1), b3 + hstep, voffB);
            PG8_WAIT_V(6); PG8_BAR; PG8_MMA(1, 1, At, B1); PG8_BAR;
            }
        }
        if constexpr (ALIGN_EPI) { if (wr == 0) PG8_BAR; }
        E(acc, cur, wr, wc, fr, fq); S.done(cur);
        if (!has_next) break;
#pragma unroll
        for (int a = 0; a < 2; ++a)
#pragma unroll
            for (int b = 0; b < 2; ++b)
#pragma unroll
                for (int m = 0; m < 4; ++m)
#pragma unroll
                    for (int n = 0; n < 2; ++n) acc[a][b][m][n] = (f32x4){0.f, 0.f, 0.f, 0.f};
        cur = nxt; cA = nA; cB = nB; ++ui;
        if constexpr (ALIGN_EPI) { if (wr == 1) PG8_BAR; }
    }
    PG8_WAIT_V(0);
    if constexpr (!ALIGN_EPI) { if (wr == 0) PG8_BAR; }
    PG8_BAR;
#undef PG8_SA
#undef PG8_SB
#undef PG8_STAGE
#undef PG8_LDA
#undef PG8_LDB
#undef PG8_MMA
#undef PG8_WAIT_V
#undef PG8_WAIT_L
#undef PG8_BAR
#undef PG8_SCHED
}
}

constexpr int NWAVES = 8, NTHR = 512;
constexpr int DM = 2048, NB = 4, SEQ = 2048, DB = 32, DT = 4, PAST = 8192, PAGE = 128, NPAGES = 64;
constexpr int NTOKP = NB * SEQ;
constexpr int NTOKS = DB * DT;
constexpr int NTOK = NTOKP + NTOKS;
constexpr int MPAD = 8448;
constexpr int INW = 8400, INWP = 8448;
constexpr int RW = 1024, RH = 16, RD = 64, SHW = 3200;
constexpr int C_R = 0, C_K = 1024, C_V = 2048, C_CW = 3072, C_CA = 3136, C_GR = 3200, C_Q = 4224, C_AK = 4736, C_AV = 5248, C_GA = 5760, C_QI = 6272, C_QM = 7296, C_GM = 7808, C_KI = 8320, C_WI = 8384;
constexpr int MEMT = 256;
constexpr int TOPK = 256;
constexpr int SCS_LD = 8256;
constexpr float RMS_EPS = 1e-6f, GN_EPS = 64e-5f;
constexpr float QSCALE = 0.08838834764831845f * 1.4426950408889634f;
constexpr size_t O_YP = 0, O_YS = 16777216, O_WKVP = 17039360, O_SHP = 17301504, O_KP = 17314304, O_VP = 21508608, O_KIP = 25702912, O_MKP = 26227200, O_MVP = 26751488,
                 O_WKVS = 27275776, O_SHS = 29372928, O_KS = 29475328, O_VS = 29540864, O_KIS = 29606400, O_END = 29614592;
enum { I_XP = 0, I_XS, I_SWKV, I_SSH, I_CK, I_CV, I_CKI, I_CMK, I_CMV, I_PT, I_MEM, I_NW, I_WIN, I_MU, I_W0, I_W2, I_A0, I_A2, I_KK, I_KA, I_RK, I_GNW, I_GNB, I_MNW, I_WMEM, I_WOUT, I_FNW, N_IN };

constexpr size_t MiB = 1u << 20;
constexpr size_t al1m(size_t x) { return (x + MiB - 1) / MiB * MiB; }
constexpr size_t WS_CTL = 0, CTL_ZERO_BYTES = 1 * MiB;
constexpr size_t WS_WINT = 1 * MiB;
constexpr size_t WS_WOUTT = WS_WINT + al1m((size_t)INWP * DM * 2);
constexpr size_t WS_WMEMT = WS_WOUTT + al1m((size_t)DM * DM * 2);
constexpr size_t WS_W2T = WS_WMEMT + al1m((size_t)1024 * DM * 2);
constexpr size_t WS_A2T = WS_W2T + al1m((size_t)1024 * 64 * 2);
constexpr size_t WS_ROPE128 = WS_A2T + al1m((size_t)1024 * 64 * 2);
constexpr size_t WS_ROPE64 = WS_ROPE128 + al1m((size_t)2052 * 64 * 8);
constexpr size_t WS_XN = WS_ROPE64 + al1m((size_t)2052 * 32 * 8);
constexpr size_t WS_XM = WS_XN + al1m((size_t)MPAD * DM * 2);
constexpr size_t WS_PROJ = WS_XM + al1m((size_t)1024 * DM * 2);
constexpr size_t WS_SCANIN = WS_PROJ + al1m((size_t)MPAD * INWP * 4);
constexpr size_t WS_SCAL = WS_SCANIN + al1m((size_t)NTOK * RH * 384 * 4);
constexpr size_t WS_Y = WS_SCAL + al1m((size_t)NTOK * RH * 16 * 4 + 65536);
constexpr size_t WS_QB = WS_Y + al1m((size_t)NTOK * RW * 4);
constexpr size_t WS_KB = WS_QB + al1m((size_t)NTOK * 512 * 2);
constexpr size_t WS_VT = WS_KB + al1m((size_t)NTOK * 512 * 2);
constexpr size_t WS_QIB = WS_VT + al1m((size_t)NB * 4 * 128 * SEQ * 2);
constexpr size_t WS_KIB = WS_QIB + al1m((size_t)NTOK * 1024 * 2);
constexpr size_t WS_WIS = WS_KIB + al1m((size_t)NTOK * 64 * 2);
constexpr size_t WS_QMB = WS_WIS + al1m((size_t)NTOK * 16 * 4);
constexpr size_t WS_MKB = WS_QMB + al1m((size_t)NTOK * 512 * 2);
constexpr size_t WS_MVT = WS_MKB + al1m((size_t)1024 * 512 * 2);
constexpr size_t WS_SC = WS_MVT + al1m((size_t)1024 * 512 * 2);
constexpr size_t WS_SCS = WS_SC + al1m((size_t)NTOKP * SEQ * 4);
constexpr size_t WS_THR = WS_SCS + al1m((size_t)NTOKS * SCS_LD * 4);
constexpr size_t WS_IDX = WS_THR + al1m((size_t)NTOK * 8);
constexpr size_t WS_YMIX = WS_IDX + al1m((size_t)NTOKS * TOPK * 4);
constexpr size_t WS_SHT = WS_YMIX + al1m((size_t)MPAD * DM * 2);
constexpr size_t WS_END = WS_SHT + al1m((size_t)(MPAD / 16) * 800 * 16 * 16);
constexpr int CW_BAR = 4096;

constexpr int RING_OFF = 0, RING_BYTES = 131072;
constexpr int LDSCTL_OFF = 159744, MISC_OFF = LDSCTL_OFF + 320;
constexpr int LDS_BYTES = 163840;

#define GAS __attribute__((address_space(1)))
#define LAS __attribute__((address_space(3)))
typedef unsigned short bf16;
typedef unsigned v4u __attribute__((ext_vector_type(4)));
typedef unsigned v2u __attribute__((ext_vector_type(2)));
typedef float f32x4 __attribute__((ext_vector_type(4)));
typedef float f32x2 __attribute__((ext_vector_type(2)));
typedef float f32x16 __attribute__((ext_vector_type(16)));
typedef short bf16x8 __attribute__((ext_vector_type(8)));
typedef short bf16x4 __attribute__((ext_vector_type(4)));
#define LDS_WAIT() asm volatile("s_waitcnt lgkmcnt(0)" ::: "memory")
#define VM_WAIT() asm volatile("s_waitcnt vmcnt(0)" ::: "memory")
__device__ __forceinline__ unsigned cvt_pk_bf16(float lo, float hi) { unsigned r; asm volatile("v_cvt_pk_bf16_f32 %0, %1, %2" : "=v"(r) : "v"(lo), "v"(hi)); return r; }
__device__ __forceinline__ float bf2f(unsigned short b) { return __uint_as_float(((unsigned)b) << 16); }
template <int CTRL> __device__ __forceinline__ float dpp(float x) { return __builtin_bit_cast(float, __builtin_amdgcn_mov_dpp(__builtin_bit_cast(int, x), CTRL, 0xf, 0xf, true)); }
__device__ __forceinline__ float row16_sum(float x) {
    x += dpp<0xB1>(x); x += dpp<0x4E>(x); x += dpp<0x141>(x); x += dpp<0x140>(x); return x;
}
__device__ __forceinline__ float wave_sum(float v) {
#pragma unroll
    for (int o = 1; o < 64; o <<= 1) v += __shfl_xor(v, o);
    return v;
}
__device__ __forceinline__ float xhalf_max(float x) { auto rr = __builtin_amdgcn_permlane32_swap(__float_as_uint(x), __float_as_uint(x), false, false); return fmaxf(__uint_as_float(rr[0]), __uint_as_float(rr[1])); }
__device__ __forceinline__ float xhalf_sum(float x) { auto rr = __builtin_amdgcn_permlane32_swap(__float_as_uint(x), __float_as_uint(x), false, false); return __uint_as_float(rr[0]) + __uint_as_float(rr[1]); }
__device__ __forceinline__ unsigned sort_key(float f) { const unsigned u = __float_as_uint(f); return (u & 0x80000000u) ? ~u : (u | 0x80000000u); }
__device__ __forceinline__ float silu(float g) { return g / (1.f + __expf(-g)); }

#define XB_TMO      128
#define XB_XCNT(j)  (256  + 64 * (j))
#define XB_XSUB(j)  (1280 + 64 * (j))
#define XB_XGEN(j)  (2304 + 64 * (j))
#define XB_TOP      3328
#define XB_TOPGEN   3392
#define XCD_BAR_WORDS 3456
#define XB_SPIN_CAP (1u << 18)
__device__ __forceinline__ unsigned xb_ld(unsigned* p)              { return __hip_atomic_load(p, __ATOMIC_RELAXED, __HIP_MEMORY_SCOPE_AGENT); }
__device__ __forceinline__ unsigned xb_add(unsigned* p, unsigned v) { return __hip_atomic_fetch_add(p, v, __ATOMIC_RELAXED, __HIP_MEMORY_SCOPE_AGENT); }
__device__ __forceinline__ unsigned xb_xcc_id() { return (unsigned)__builtin_amdgcn_s_getreg((3 << 11) | 20) & 0xFu; }
#define XB_SPIN(cond, bar) do { unsigned _sp = 0; while (cond) { __builtin_amdgcn_s_sleep(1); \
    if ((++_sp & 255u) == 0u) { if (xb_ld(&(bar)[XB_TMO])) break; if (_sp > XB_SPIN_CAP) { atomicAdd(&(bar)[XB_TMO], 1u); break; } } } } while (0)
struct XcdBarrier { unsigned* bar; unsigned x; volatile LAS unsigned* st; };
__device__ __forceinline__ XcdBarrier xcd_barrier_post(unsigned* bar, volatile LAS unsigned* st) {
    XcdBarrier b; b.bar = bar; b.x = xb_xcc_id(); b.st = st;
    if (threadIdx.x == 0) (void)xb_add(&bar[XB_XCNT(b.x)], 1u);
    return b;
}
__device__ __forceinline__ void xcd_barrier_complete(unsigned* bar, unsigned x, unsigned& nloc, unsigned& nx) {
    const unsigned G = gridDim.x * gridDim.y * gridDim.z;
    unsigned sum, cnt, mine, sp = 0u;
    for (;;) {
        sum = 0u; cnt = 0u; mine = 0u;
#pragma unroll
        for (unsigned j = 0; j < 16; ++j) { const unsigned c = xb_ld(&bar[XB_XCNT(j)]); sum += c; cnt += (c > 0u) ? 1u : 0u; mine = (j == x) ? c : mine; }
        if (sum == G) break;
        __builtin_amdgcn_s_sleep(1);
        if ((++sp & 255u) == 0u) { if (xb_ld(&bar[XB_TMO])) break; if (sp > XB_SPIN_CAP) { atomicAdd(&bar[XB_TMO], 1u); break; } }
    }
    nloc = mine > 0u ? mine : 1u; nx = cnt > 0u ? cnt : 1u;
}
__device__ __forceinline__ void xcd_barrier(const XcdBarrier& b) {
    asm volatile("s_waitcnt vmcnt(0)" ::: "memory");
    __syncthreads();
    if (threadIdx.x == 0) {
        unsigned* bar = b.bar;
        __builtin_amdgcn_s_waitcnt(0);
        unsigned nloc = b.st[0], nx = b.st[1];
        if (nloc == 0u) { xcd_barrier_complete(bar, b.x, nloc, nx); b.st[0] = nloc; b.st[1] = nx; }
        const unsigned old = xb_add(&bar[XB_XSUB(b.x)], 1u);
        const unsigned gen = old / nloc;
        if (old + 1u == (gen + 1u) * nloc) {
            __builtin_amdgcn_fence(__ATOMIC_RELEASE, "agent");
            asm volatile("s_waitcnt vmcnt(0)" ::: "memory");
            const unsigned og = xb_add(&bar[XB_TOP], 1u);
            const unsigned tg = og / nx;
            if (og + 1u == (tg + 1u) * nx) xb_add(&bar[XB_TOPGEN], 1u);
            else XB_SPIN(xb_ld(&bar[XB_TOPGEN]) == tg, bar);
            __builtin_amdgcn_fence(__ATOMIC_ACQUIRE, "agent");
            xb_add(&bar[XB_XGEN(b.x)], 1u);
            asm volatile("s_waitcnt vmcnt(0)" ::: "memory");
        } else {
            XB_SPIN(xb_ld(&bar[XB_XGEN(b.x)]) == gen, bar);
            __builtin_amdgcn_fence(__ATOMIC_ACQUIRE, "agent");
            asm volatile("s_waitcnt vmcnt(0)" ::: "memory");
        }
    }
    __syncthreads();
}

struct Frame {
    LAS unsigned char* lds;
    int tid, lane, wave, G, bid;
    const float* in[N_IN];
    float* out;
    unsigned char* ws;
};
#define WSP(T, off) ((T*)(F.ws + (off)))

__device__ __forceinline__ int src_col(int g);
__device__ __forceinline__ void p0_transpose_item(const float* W, int K, int N, int Npad, bf16* WT, LAS float* scr, int item, int lane, bool perm = false) {
    const int nblk = Npad / 32, kb = item / nblk, nb = item % nblk, k0 = 64 * kb, n0 = 32 * nb;
    const int nn = perm ? src_col(n0 + (lane & 31)) : ((n0 + (lane & 31)) < N ? n0 + (lane & 31) : -1);
    float tv[32];
#pragma unroll
    for (int i = 0; i < 32; ++i) { const int kk = 2 * i + (lane >> 5); tv[i] = (nn >= 0) ? W[(size_t)(k0 + kk) * N + nn] : 0.f; }
#pragma unroll
    for (int i = 0; i < 32; ++i) { const int kk = 2 * i + (lane >> 5); scr[kk * 33 + (lane & 31)] = tv[i]; }
    LDS_WAIT(); asm volatile("" ::: "memory");
    const int c = lane & 7;
#pragma unroll
    for (int j = 0; j < 4; ++j) { const int n = (lane >> 3) + 8 * j; const LAS float* s = scr + (8 * c) * 33 + n;
        v4u o; o.x = cvt_pk_bf16(s[0 * 33], s[1 * 33]); o.y = cvt_pk_bf16(s[2 * 33], s[3 * 33]); o.z = cvt_pk_bf16(s[4 * 33], s[5 * 33]); o.w = cvt_pk_bf16(s[6 * 33], s[7 * 33]);
        *(v4u*)(WT + (size_t)(n0 + n) * K + k0 + 8 * c) = o; }
    LDS_WAIT(); asm volatile("" ::: "memory");
}
__device__ __forceinline__ void rms_row_to_bf16(const float* xrow, const float* w, bf16* orow, int lane) {
    const f32x4* xr = (const f32x4*)xrow + lane; const f32x4* wr = (const f32x4*)w + lane;
    f32x4 v[8]; float s = 0.f;
#pragma unroll
    for (int j = 0; j < 8; ++j) { v[j] = xr[64 * j]; s += (v[j].x * v[j].x + v[j].y * v[j].y) + (v[j].z * v[j].z + v[j].w * v[j].w); }
    const float rs = 1.f / sqrtf(wave_sum(s) * (1.f / DM) + RMS_EPS);
    v2u* o8 = (v2u*)orow + lane;
#pragma unroll
    for (int j = 0; j < 8; ++j) { const f32x4 ww = wr[64 * j]; v2u o; o.x = cvt_pk_bf16(v[j].x * rs * ww.x, v[j].y * rs * ww.y); o.y = cvt_pk_bf16(v[j].z * rs * ww.z, v[j].w * rs * ww.w); o8[64 * j] = o; }
}
__device__ __forceinline__ void rope_cs(int pos, int i, double ratio, float& c, float& s) {
    double f = 1.0, b = ratio; int e = i;
    while (e) { if (e & 1) f *= b; b *= b; e >>= 1; }
    const double th = (double)pos * f;
    const double TWO_OVER_PI = 0.63661977236758134308, PIO2_HI = 1.57079632679489655800e+00, PIO2_LO = 6.12323399573676603587e-17;
    const double kq = rint(th * TWO_OVER_PI);
    double r = fma(-kq, PIO2_HI, th); r = fma(-kq, PIO2_LO, r);
    const int q = ((int)kq) & 3;
    const double z = r * r;
    const double sp = r + r * z * (-1.66666666666666324348e-01 + z * (8.33333333332248946124e-03 + z * (-1.98412698298579493134e-04 + z * (2.75573137070700676789e-06 + z * (-2.50507602534068634195e-08 + z * 1.58969099521155010221e-10)))));
    const double cp = 1.0 - 0.5 * z + z * z * (4.16666666666666019037e-02 + z * (-1.38888888888741095749e-03 + z * (2.48015872894767294178e-05 + z * (-2.75573143513906633035e-07 + z * (2.08757232129817482790e-09 + z * -1.13596475577881948265e-11)))));
    double cc, ss;
    if (q == 0) { cc = cp; ss = sp; } else if (q == 1) { cc = -sp; ss = cp; } else if (q == 2) { cc = -cp; ss = -sp; } else { cc = sp; ss = -cp; }
    c = (float)cc; s = (float)ss;
}
__device__ __forceinline__ void p0_prologue(Frame& F) {
    LAS float* scr = (LAS float*)(F.lds + RING_OFF + F.wave * 16384);
    const int gw = F.bid * NWAVES + F.wave, NGW = F.G * NWAVES;
    constexpr int T_IN = (DM / 64) * (INWP / 32), T_OUT = (DM / 64) * (DM / 32), T_MEM = (DM / 64) * (1024 / 32), T_L = 1024 / 32;
    constexpr int NITEMS = T_IN + T_OUT + T_MEM + 2 * T_L;
    for (int it = gw; it < NITEMS; it += NGW) {
        int r = it;
        if (r < T_IN) { p0_transpose_item(F.in[I_WIN], DM, INW, INWP, WSP(bf16, WS_WINT), scr, r, F.lane, true); continue; } r -= T_IN;
        if (r < T_OUT) { p0_transpose_item(F.in[I_WOUT], DM, DM, DM, WSP(bf16, WS_WOUTT), scr, r, F.lane); continue; } r -= T_OUT;
        if (r < T_MEM) { p0_transpose_item(F.in[I_WMEM], DM, 1024, 1024, WSP(bf16, WS_WMEMT), scr, r, F.lane); continue; } r -= T_MEM;
        if (r < T_L) { p0_transpose_item(F.in[I_W2], 64, 1024, 1024, WSP(bf16, WS_W2T), scr, r, F.lane); continue; } r -= T_L;
        p0_transpose_item(F.in[I_A2], 64, 1024, 1024, WSP(bf16, WS_A2T), scr, r, F.lane);
    }
    for (int m = gw; m < MPAD + 1024; m += NGW) {
        if (m < NTOKP) rms_row_to_bf16(F.in[I_XP] + (size_t)m * DM, F.in[I_NW], WSP(bf16, WS_XN) + (size_t)m * DM, F.lane);
        else if (m < NTOK) rms_row_to_bf16(F.in[I_XS] + (size_t)(m - NTOKP) * DM, F.in[I_NW], WSP(bf16, WS_XN) + (size_t)m * DM, F.lane);
        else if (m < MPAD) { v4u z = {0u, 0u, 0u, 0u}; v4u* o = (v4u*)(WSP(bf16, WS_XN) + (size_t)m * DM) + F.lane;
#pragma unroll
            for (int j = 0; j < 4; ++j) o[64 * j] = z; }
        else rms_row_to_bf16(F.in[I_MEM] + (size_t)(m - MPAD) * DM, F.in[I_MNW], WSP(bf16, WS_XM) + (size_t)(m - MPAD) * DM, F.lane);
    }
    const int gt = F.bid * NTHR + F.tid, NGT = F.G * NTHR;
    for (int e = gt; e < 2052 * 96; e += NGT) {
        const int p = e / 96, i = e % 96; const int pos = p < 2048 ? p : PAST + (p - 2048);
        float c, s;
        if (i < 64) { rope_cs(pos, i, 0.8659643233600653, c, s); WSP(f32x2, WS_ROPE128)[p * 64 + i] = (f32x2){c, s}; }
        else { rope_cs(pos, i - 64, 0.7498942093324559, c, s); WSP(f32x2, WS_ROPE64)[p * 32 + (i - 64)] = (f32x2){c, s}; }
    }
}

struct EpiProj {
    float* C;
    __device__ __forceinline__ void operator()(const f32x4 (&acc)[2][2][4][2], const pg8::Unit& u, int wr, int wc, int fr, int fq) const {
        const int row0 = u.pm * 256 + wr * 64 + fr, col0 = u.pn * 256 + wc * 32 + 4 * fq;
#pragma unroll
        for (int ai = 0; ai < 2; ++ai)
#pragma unroll
            for (int m = 0; m < 4; ++m) { float* rowp = C + (size_t)(row0 + ai * 128 + m * 16) * INWP + col0;
#pragma unroll
                for (int bj = 0; bj < 2; ++bj)
#pragma unroll
                    for (int n = 0; n < 2; ++n) *(f32x4*)(rowp + bj * 128 + n * 16) = acc[ai][bj][m][n]; }
    }
};
__device__ __forceinline__ size_t kf_off(int NT, int h, int s, int dim);
__device__ __forceinline__ size_t kif_off(int s, int dim);
__device__ __forceinline__ int src_col(int g) {
    if (g < 4224) return g;
    if (g < 5248) { const int base = g & ~127, p = g & 127; return base + (p >> 5) * 16 + (p & 15) + 64 * ((p >> 4) & 1); }
    if (g < 6272) return g;
    if (g < 7296) { const int base = g & ~63, p = g & 63; return base + (p >> 5) * 16 + (p & 15) + 32 * ((p >> 4) & 1); }
    if (g < 8320) return g + 80;
    if (g < 8384) { const int p = g - 8320; return 7312 + (p >> 5) * 16 + (p & 15) + 32 * ((p >> 4) & 1); }
    if (g < 8400) return 7296 + (g - 8384);
    return -1;
}
struct EpiProjFused {
    float* C; float* out; unsigned char* ws;
    __device__ __forceinline__ void operator()(const f32x4 (&acc)[2][2][4][2], const pg8::Unit& u, int wr, int wc, int fr_in, int fq_in) const {
        int fr = fr_in, fq = fq_in; asm volatile("" : "+v"(fr), "+v"(fq));
        const int row00 = u.pm * 256 + wr * 64 + fr;
#pragma unroll
        for (int bj = 0; bj < 2; ++bj) {
            const int cb = 2 * u.pn + bj;
            const int cq = 128 * cb + 32 * wc + 4 * fq;
            if (cb <= 32 || (cb >= 41 && cb <= 48) || (cb >= 61 && cb <= 64)) {
#pragma unroll
                for (int ai = 0; ai < 2; ++ai)
#pragma unroll
                    for (int m = 0; m < 4; ++m) { const int row = row00 + ai * 128 + m * 16;
                        if (row < NTOK) {
                            if (cb <= 24) { float* sp = (float*)(ws + WS_SHT) + (((size_t)(row >> 4) * 800 + (cq >> 2)) * 16 + (row & 15)) * 4;
                                *(f32x4*)sp = acc[ai][bj][m][0]; *(f32x4*)(sp + 4 * 16 * 4) = acc[ai][bj][m][1]; }
                            else { float* rowp = C + (size_t)row * INWP + cq;
                                *(f32x4*)rowp = acc[ai][bj][m][0]; *(f32x4*)(rowp + 16) = acc[ai][bj][m][1]; }
                            const bool prm = row < NTOKP; const int srow = row - NTOKP;
                            if (cb >= 41 && cb <= 44) { float* vo = out + (prm ? O_VP + (size_t)row * 512 : O_VS + (size_t)srow * 512) + (cq - C_AV);
                                *(f32x4*)vo = acc[ai][bj][m][0]; *(f32x4*)(vo + 16) = acc[ai][bj][m][1]; }
                            if (cb <= 24 && (prm ? ((row & 2047) == 2047) : ((srow & 3) == 3))) {
                                float* so = out + (prm ? O_SHP + (size_t)(row >> 11) * SHW : O_SHS + (size_t)(srow >> 2) * SHW) + cq;
                                *(f32x4*)so = acc[ai][bj][m][0]; *(f32x4*)(so + 16) = acc[ai][bj][m][1]; }
                        } }
            } else if (cb <= 40) {
                const bool isq = cb <= 36; const int h = isq ? cb - 33 : cb - 37, i0 = 16 * wc + 4 * fq;
#pragma unroll
                for (int ai = 0; ai < 2; ++ai)
#pragma unroll
                    for (int m = 0; m < 4; ++m) { const int row = row00 + ai * 128 + m * 16;
                        if (row < NTOK) {
                            const bool prm = row < NTOKP; const int srow = row - NTOKP;
                            const int p = prm ? (row & 2047) : 2048 + (srow & 3);
                            const f32x4 t0 = *(const f32x4*)((const float*)(ws + WS_ROPE128) + (size_t)(p * 64 + i0) * 2), t1 = *(const f32x4*)((const float*)(ws + WS_ROPE128) + (size_t)(p * 64 + i0 + 2) * 2);
                            const f32x4 x1 = acc[ai][bj][m][0], x2 = acc[ai][bj][m][1];
                            f32x4 o1, o2;
                            o1.x = x1.x * t0.x - x2.x * t0.y; o2.x = x2.x * t0.x + x1.x * t0.y; o1.y = x1.y * t0.z - x2.y * t0.w; o2.y = x2.y * t0.z + x1.y * t0.w;
                            o1.z = x1.z * t1.x - x2.z * t1.y; o2.z = x2.z * t1.x + x1.z * t1.y; o1.w = x1.w * t1.z - x2.w * t1.w; o2.w = x2.w * t1.z + x1.w * t1.w;
                            if (isq) { bf16* qb = (bf16*)(ws + WS_QB) + (size_t)row * 512 + h * 128 + i0;
                                v2u a, b; a.x = cvt_pk_bf16(o1.x * QSCALE, o1.y * QSCALE); a.y = cvt_pk_bf16(o1.z * QSCALE, o1.w * QSCALE); b.x = cvt_pk_bf16(o2.x * QSCALE, o2.y * QSCALE); b.y = cvt_pk_bf16(o2.z * QSCALE, o2.w * QSCALE);
                                *(v2u*)qb = a; *(v2u*)(qb + 64) = b; }
                            else { float* ko = out + (prm ? O_KP + (size_t)row * 512 : O_KS + (size_t)srow * 512) + h * 128 + i0;
                                *(f32x4*)ko = o1; *(f32x4*)(ko + 64) = o2;
                                if (prm) { bf16* KF = (bf16*)(ws + WS_KB) + (size_t)(row >> 11) * SEQ * 512; const int sq = row & 2047;
                                    v2u a, b; a.x = cvt_pk_bf16(o1.x, o1.y); a.y = cvt_pk_bf16(o1.z, o1.w); b.x = cvt_pk_bf16(o2.x, o2.y); b.y = cvt_pk_bf16(o2.z, o2.w);
                                    *(v2u*)(KF + kf_off(64, h, sq, i0)) = a; *(v2u*)(KF + kf_off(64, h, sq, 64 + i0)) = b; } }
                        } }
            } else if (cb >= 49 && cb <= 56) {
                const int hd = 2 * (cb - 49) + (wc >> 1), i0 = 16 * (wc & 1) + 4 * fq;
#pragma unroll
                for (int ai = 0; ai < 2; ++ai)
#pragma unroll
                    for (int m = 0; m < 4; ++m) { const int row = row00 + ai * 128 + m * 16;
                        if (row < NTOK) {
                            const int p = row < NTOKP ? (row & 2047) : 2048 + ((row - NTOKP) & 3);
                            const f32x4 t0 = *(const f32x4*)((const float*)(ws + WS_ROPE64) + (size_t)(p * 32 + i0) * 2), t1 = *(const f32x4*)((const float*)(ws + WS_ROPE64) + (size_t)(p * 32 + i0 + 2) * 2);
                            const f32x4 x1 = acc[ai][bj][m][0], x2 = acc[ai][bj][m][1];
                            v2u a, b;
                            a.x = cvt_pk_bf16(x1.x * t0.x - x2.x * t0.y, x1.y * t0.z - x2.y * t0.w); a.y = cvt_pk_bf16(x1.z * t1.x - x2.z * t1.y, x1.w * t1.z - x2.w * t1.w);
                            b.x = cvt_pk_bf16(x2.x * t0.x + x1.x * t0.y, x2.y * t0.z + x1.y * t0.w); b.y = cvt_pk_bf16(x2.z * t1.x + x1.z * t1.y, x2.w * t1.z + x1.w * t1.w);
                            bf16* qi = (bf16*)(ws + WS_QIB) + (size_t)row * 1024 + hd * 64 + i0;
                            *(v2u*)qi = a; *(v2u*)(qi + 32) = b;
                        } }
            } else if (cb >= 57 && cb <= 60) {
#pragma unroll
                for (int ai = 0; ai < 2; ++ai)
#pragma unroll
                    for (int m = 0; m < 4; ++m) { const int row = row00 + ai * 128 + m * 16;
                        if (row < NTOK) { bf16* qm = (bf16*)(ws + WS_QMB) + (size_t)row * 512 + (cq - 7296);
#pragma unroll
                            for (int n = 0; n < 2; ++n) { const f32x4 v = acc[ai][bj][m][n]; v2u a; a.x = cvt_pk_bf16(v.x * QSCALE, v.y * QSCALE); a.y = cvt_pk_bf16(v.z * QSCALE, v.w * QSCALE); *(v2u*)(qm + 16 * n) = a; } } }
            } else if (cb == 65) {
                if (wc < 2) { const int i0 = 16 * wc + 4 * fq;
#pragma unroll
                    for (int ai = 0; ai < 2; ++ai)
#pragma unroll
                        for (int m = 0; m < 4; ++m) { const int row = row00 + ai * 128 + m * 16;
                            if (row < NTOK) {
                                const bool prm = row < NTOKP; const int srow = row - NTOKP;
                                const int p = prm ? (row & 2047) : 2048 + (srow & 3);
                                const f32x4 t0 = *(const f32x4*)((const float*)(ws + WS_ROPE64) + (size_t)(p * 32 + i0) * 2), t1 = *(const f32x4*)((const float*)(ws + WS_ROPE64) + (size_t)(p * 32 + i0 + 2) * 2);
                                const f32x4 x1 = acc[ai][bj][m][0], x2 = acc[ai][bj][m][1];
                                f32x4 o1, o2;
                                o1.x = x1.x * t0.x - x2.x * t0.y; o2.x = x2.x * t0.x + x1.x * t0.y; o1.y = x1.y * t0.z - x2.y * t0.w; o2.y = x2.y * t0.z + x1.y * t0.w;
                                o1.z = x1.z * t1.x - x2.z * t1.y; o2.z = x2.z * t1.x + x1.z * t1.y; o1.w = x1.w * t1.z - x2.w * t1.w; o2.w = x2.w * t1.z + x1.w * t1.w;
                                float* kio = out + (prm ? O_KIP + (size_t)row * 64 : O_KIS + (size_t)srow * 64) + i0;
                                *(f32x4*)kio = o1; *(f32x4*)(kio + 32) = o2;
                                v2u a, b; a.x = cvt_pk_bf16(o1.x, o1.y); a.y = cvt_pk_bf16(o1.z, o1.w); b.x = cvt_pk_bf16(o2.x, o2.y); b.y = cvt_pk_bf16(o2.z, o2.w);
                                bf16* kib = (bf16*)(ws + WS_KIB) + (size_t)row * 64 + i0; *(v2u*)kib = a; *(v2u*)(kib + 32) = b;
                                if (prm) { bf16* KIF = (bf16*)(ws + WS_SC) + (size_t)(row >> 11) * SEQ * 64; const int sq = row & 2047;
                                    *(v2u*)(KIF + kif_off(sq, i0)) = a; *(v2u*)(KIF + kif_off(sq, 32 + i0)) = b; }
                            } }
                } else if (wc == 2) {
#pragma unroll
                    for (int ai = 0; ai < 2; ++ai)
#pragma unroll
                        for (int m = 0; m < 4; ++m) { const int row = row00 + ai * 128 + m * 16;
                            if (row < NTOK) { const f32x4 v = acc[ai][bj][m][0]; *(f32x4*)((float*)(ws + WS_WIS) + (size_t)row * 16 + 4 * fq) = (f32x4){v.x * (1.f / 32.f), v.y * (1.f / 32.f), v.z * (1.f / 32.f), v.w * (1.f / 32.f)}; } }
                }
            }
        }
    }
};
struct EpiMem {
    float* out;
    __device__ __forceinline__ void operator()(const f32x4 (&acc)[2][2][4][2], const pg8::Unit& u, int wr, int wc, int fr, int fq) const {
        const int row0 = u.pm * 256 + wr * 64 + fr; int colt = u.pn * 256;
        float* base = out + (colt < 512 ? O_MKP : O_MVP); if (colt >= 512) colt -= 512;
        const int col0 = colt + wc * 32 + 4 * fq;
#pragma unroll
        for (int ai = 0; ai < 2; ++ai)
#pragma unroll
            for (int m = 0; m < 4; ++m) { float* rowp = base + (size_t)(row0 + ai * 128 + m * 16) * 512 + col0;
#pragma unroll
                for (int bj = 0; bj < 2; ++bj)
#pragma unroll
                    for (int n = 0; n < 2; ++n) *(f32x4*)(rowp + bj * 128 + n * 16) = acc[ai][bj][m][n]; }
    }
};
__device__ __forceinline__ void atomic_add4(float* p, const f32x4& v) { unsafeAtomicAdd(p, v.x); unsafeAtomicAdd(p + 1, v.y); unsafeAtomicAdd(p + 2, v.z); unsafeAtomicAdd(p + 3, v.w); }
struct EpiProjAtomic {
    float* C;
    __device__ __forceinline__ void operator()(const f32x4 (&acc)[2][2][4][2], const pg8::Unit& u, int wr, int wc, int fr, int fq) const {
        const int row0 = u.pm * 256 + wr * 64 + fr, col0 = u.pn * 256 + wc * 32 + 4 * fq;
#pragma unroll
        for (int ai = 0; ai < 2; ++ai)
#pragma unroll
            for (int m = 0; m < 4; ++m) { const int row = row0 + ai * 128 + m * 16; float* rowp = C + (size_t)row * INWP + col0;
                if (row < NTOK) {
#pragma unroll
                    for (int bj = 0; bj < 2; ++bj)
#pragma unroll
                        for (int n = 0; n < 2; ++n) atomic_add4(rowp + bj * 128 + n * 16, acc[ai][bj][m][n]); } }
    }
};
struct EpiMemAtomic {
    float* out;
    __device__ __forceinline__ void operator()(const f32x4 (&acc)[2][2][4][2], const pg8::Unit& u, int wr, int wc, int fr, int fq) const {
        const int row0 = u.pm * 256 + wr * 64 + fr; int colt = u.pn * 256;
        float* base = out + (colt < 512 ? O_MKP : O_MVP); if (colt >= 512) colt -= 512;
        const int col0 = colt + wc * 32 + 4 * fq;
#pragma unroll
        for (int ai = 0; ai < 2; ++ai)
#pragma unroll
            for (int m = 0; m < 4; ++m) { float* rowp = base + (size_t)(row0 + ai * 128 + m * 16) * 512 + col0;
#pragma unroll
                for (int bj = 0; bj < 2; ++bj)
#pragma unroll
                    for (int n = 0; n < 2; ++n) atomic_add4(rowp + bj * 128 + n * 16, acc[ai][bj][m][n]); }
    }
};
struct EpiOutAtomic {
    float* out;
    __device__ __forceinline__ void operator()(const f32x4 (&acc)[2][2][4][2], const pg8::Unit& u, int wr, int wc, int fr, int fq) const {
        const int row0 = u.pm * 256 + wr * 64 + fr, col0 = u.pn * 256 + wc * 32 + 4 * fq;
#pragma unroll
        for (int ai = 0; ai < 2; ++ai)
#pragma unroll
            for (int m = 0; m < 4; ++m) { const int row = row0 + ai * 128 + m * 16;
                if (row >= NTOKP && row < NTOK) { float* orow = out + O_YS + (size_t)(row - NTOKP) * DM + col0;
#pragma unroll
                    for (int bj = 0; bj < 2; ++bj)
#pragma unroll
                        for (int n = 0; n < 2; ++n) atomic_add4(orow + bj * 128 + n * 16, acc[ai][bj][m][n]); } }
    }
};
struct EpiOut {
    const float* xp; const float* xs; float* out;
    __device__ __forceinline__ void operator()(const f32x4 (&acc)[2][2][4][2], const pg8::Unit& u, int wr, int wc, int fr, int fq) const {
        const int row0 = u.pm * 256 + wr * 64 + fr, col0 = u.pn * 256 + wc * 32 + 4 * fq;
#pragma unroll
        for (int ai = 0; ai < 2; ++ai)
#pragma unroll
            for (int m = 0; m < 4; ++m) { const int row = row0 + ai * 128 + m * 16;
                if (row < NTOK) {
                    const float* xr = (row < NTOKP ? xp + (size_t)row * DM : xs + (size_t)(row - NTOKP) * DM) + col0;
                    float* orow = out + (row < NTOKP ? O_YP + (size_t)row * DM : O_YS + (size_t)(row - NTOKP) * DM) + col0;
#pragma unroll
                    for (int bj = 0; bj < 2; ++bj)
#pragma unroll
                        for (int n = 0; n < 2; ++n) *(f32x4*)(orow + bj * 128 + n * 16) = acc[ai][bj][m][n] + *(const f32x4*)(xr + bj * 128 + n * 16); } }
    }
};

__device__ __forceinline__ float prev_val(const Frame& F, const float* P, int row, int col) {
    if (row < NTOKP) { return (row & (SEQ - 1)) == 0 ? 0.f : P[(size_t)(row - 1) * INWP + col]; }
    const int s = row - NTOKP; return (s & 3) == 0 ? F.in[I_SSH][(size_t)(s >> 2) * SHW + col] : P[(size_t)(row - 1) * INWP + col];
}
__device__ __forceinline__ size_t scan_seq_off(int row, int h) {
    if (row < NTOKP) { const int b = row >> 11, t = row & 2047; return ((size_t)(b * RH + h) * SEQ + t); }
    const int s = row - NTOKP, db = s >> 2, t = s & 3; return (size_t)NB * RH * SEQ + ((size_t)(db * RH + h) * DT + t);
}
__device__ __forceinline__ size_t kf_off(int NT, int h, int s, int dim) { return ((size_t)((h * NT + (s >> 5)) * 8 + (dim >> 4))) * 512 + (((dim >> 3) & 1) * 32 + (s & 31)) * 8 + (dim & 7); }
__device__ __forceinline__ size_t kif_off(int s, int dim) { return ((size_t)((s >> 5) * 4 + (dim >> 4))) * 512 + (((dim >> 3) & 1) * 32 + (s & 31)) * 8 + (dim & 7); }
__device__ __forceinline__ f32x4 ld4(const float* p) { return *(const f32x4*)p; }
__device__ __forceinline__ f32x4 sht4(const float* SHT, int row, int col) { return *(const f32x4*)(SHT + (((size_t)(row >> 4) * 800 + (col >> 2)) * 16 + (row & 15)) * 4); }
__device__ __forceinline__ f32x4 prev4(const Frame& F, const float* SHT, int row, int col) {
    if (row < NTOKP) { if ((row & (SEQ - 1)) == 0) return (f32x4){0.f, 0.f, 0.f, 0.f}; return sht4(SHT, row - 1, col); }
    const int s = row - NTOKP; if ((s & 3) == 0) return ld4(F.in[I_SSH] + (size_t)(s >> 2) * SHW + col); return sht4(SHT, row - 1, col);
}
__device__ __forceinline__ void p2_rwkv_witem(Frame& F, int tile, int h0, int nh) {
    const int row0 = tile * 16;
    const int lane = F.lane, tk = lane & 15, kq = lane >> 4, row = row0 + tk;
    const float* SHT = WSP(float, WS_SHT);
    const float* cbp = SHT + ((size_t)(row >> 4) * 800 * 16 + (row & 15)) * 4;
    const bool prm = row < NTOKP; const int srow = row - NTOKP;
    const bool first = prm ? ((row & (SEQ - 1)) == 0) : ((srow & 3) == 0);
    const int r1 = first ? row : row - 1;
    const float* pbp = (first && !prm) ? F.in[I_SSH] + (size_t)(srow >> 2) * SHW : SHT + ((size_t)(r1 >> 4) * 800 * 16 + (r1 & 15)) * 4;
    const int pst = (first && !prm) ? 4 : 64;
    const float pz = (first && prm) ? 0.f : 1.f;
#define CUR4(col) ld4(cbp + (size_t)((col) >> 2) * 64)
#define PRV4(col) (ld4(pbp + (size_t)((col) >> 2) * pst) * pz)
    const float* mu = F.in[I_MU];
    bf16x8 bw[2], ba[2];
#pragma unroll
    for (int ks = 0; ks < 2; ++ks) {
        const int c0 = 32 * ks + 8 * kq;
        float xw[8], xa[8];
#pragma unroll
        for (int hf = 0; hf < 2; ++hf) {
            const f32x4 cw = CUR4(C_CW + c0 + 4 * hf), pw = PRV4(C_CW + c0 + 4 * hf), mw = ld4(mu + C_CW + c0 + 4 * hf);
            const f32x4 ca = CUR4(C_CA + c0 + 4 * hf), pa = PRV4(C_CA + c0 + 4 * hf), ma = ld4(mu + C_CA + c0 + 4 * hf);
#pragma unroll
            for (int e = 0; e < 4; ++e) { const float x = cw[e] + (pw[e] - cw[e]) * mw[e];
                const float t = __builtin_amdgcn_exp2f(x * 2.8853900817779268f); xw[4 * hf + e] = 1.f - 2.f * __builtin_amdgcn_rcpf(t + 1.f);
                xa[4 * hf + e] = ca[e] + (pa[e] - ca[e]) * ma[e]; }
        }
        v4u uw, ua; uw.x = cvt_pk_bf16(xw[0], xw[1]); uw.y = cvt_pk_bf16(xw[2], xw[3]); uw.z = cvt_pk_bf16(xw[4], xw[5]); uw.w = cvt_pk_bf16(xw[6], xw[7]);
        ua.x = cvt_pk_bf16(xa[0], xa[1]); ua.y = cvt_pk_bf16(xa[2], xa[3]); ua.z = cvt_pk_bf16(xa[4], xa[5]); ua.w = cvt_pk_bf16(xa[6], xa[7]);
        bw[ks] = __builtin_bit_cast(bf16x8, uw); ba[ks] = __builtin_bit_cast(bf16x8, ua);
    }
    const bf16* W2T = WSP(bf16, WS_W2T); const bf16* A2T = WSP(bf16, WS_A2T);
    float* SI = WSP(float, WS_SCANIN); float* SL = WSP(float, WS_SCAL);
    for (int hh = 0; hh < nh; ++hh) {
        const int h = h0 + hh;
        f32x4 wl[4], al[4];
#pragma unroll
        for (int n = 0; n < 4; ++n) {
            const int chA = h * 64 + n * 16 + tk;
            wl[n] = (f32x4){0.f, 0.f, 0.f, 0.f}; al[n] = (f32x4){0.f, 0.f, 0.f, 0.f};
#pragma unroll
            for (int ks = 0; ks < 2; ++ks) {
                const bf16x8 aw = *(const bf16x8*)(W2T + (size_t)chA * 64 + 32 * ks + 8 * kq);
                const bf16x8 aa = *(const bf16x8*)(A2T + (size_t)chA * 64 + 32 * ks + 8 * kq);
                wl[n] = __builtin_amdgcn_mfma_f32_16x16x32_bf16(aw, bw[ks], wl[n], 0, 0, 0);
                al[n] = __builtin_amdgcn_mfma_f32_16x16x32_bf16(aa, ba[ks], al[n], 0, 0, 0);
            }
        }
        f32x4 Lxk[4], Lqk[4], Lxr[4], Lqr[4], Lxv[4], Lqv[4];
#pragma unroll
        for (int n = 0; n < 4; ++n) { const int ch = h * 64 + n * 16 + 4 * kq;
            Lxk[n] = CUR4(C_K + ch); Lqk[n] = PRV4(C_K + ch); }
        __builtin_amdgcn_sched_barrier(0);
#pragma unroll
        for (int n = 0; n < 4; ++n) { const int ch = h * 64 + n * 16 + 4 * kq; Lxr[n] = CUR4(C_R + ch); Lqr[n] = PRV4(C_R + ch); Lxv[n] = CUR4(C_V + ch); Lqv[n] = PRV4(C_V + ch); }
        f32x4 k4[4];
        float ss = 0.f;
#pragma unroll
        for (int n = 0; n < 4; ++n) {
            const int ch = h * 64 + n * 16 + 4 * kq;
            const f32x4 xk = Lxk[n], qk = Lqk[n], mk = ld4(mu + C_K + ch), kkw = ld4(F.in[I_KK] + ch);
#pragma unroll
            for (int j = 0; j < 4; ++j) { k4[n][j] = xk[j] + (qk[j] - xk[j]) * mk[j]; const float t = k4[n][j] * kkw[j]; ss += t * t; }
        }
        ss += __shfl_xor(ss, 16); ss += __shfl_xor(ss, 32);
        const float inv = 1.f / fmaxf(sqrtf(ss), 1e-12f);
        float s_nbr = 0.f, s_kr = 0.f, s_bon = 0.f;
        const size_t so = scan_seq_off(row, h);
        float* dst = SI + so * 384 + 4 * kq;
#pragma unroll
        for (int n = 0; n < 4; ++n) {
            const int ch = h * 64 + n * 16 + 4 * kq;
            const f32x4 xr = Lxr[n], xv = Lxv[n], qr = Lqr[n], qv = Lqv[n];
            const f32x4 mr = ld4(mu + C_R + ch), mv = ld4(mu + C_V + ch);
            const f32x4 w0 = ld4(F.in[I_W0] + ch), a0 = ld4(F.in[I_A0] + ch), kkw = ld4(F.in[I_KK] + ch), ka = ld4(F.in[I_KA] + ch), rk = ld4(F.in[I_RK] + ch);
            f32x4 kk, kp, nb, wr, wv, vv;
#pragma unroll
            for (int j = 0; j < 4; ++j) {
                const float r = xr[j] + (qr[j] - xr[j]) * mr[j]; vv[j] = xv[j] + (qv[j] - xv[j]) * mv[j];
                const float wlin = w0[j] + wl[n][j];
                const float sg = __builtin_amdgcn_rcpf(1.f + __builtin_amdgcn_exp2f(-wlin * 1.4426950408889634f));
                wv[j] = __builtin_amdgcn_exp2f(-0.8750338f * sg);
                const float alin = a0[j] + al[n][j];
                const float a = __builtin_amdgcn_rcpf(1.f + __builtin_amdgcn_exp2f(-alin * 1.4426950408889634f));
                kk[j] = k4[n][j] * kkw[j] * inv;
                kp[j] = k4[n][j] * (1.f + (a - 1.f) * ka[j]);
                nb[j] = -kk[j] * a;
                wr[j] = wv[j] * r;
                s_nbr += nb[j] * r; s_kr += kp[j] * r; s_bon += r * kp[j] * rk[j];
            }
            *(f32x4*)(dst + 0 * 64 + 16 * n) = kk; *(f32x4*)(dst + 1 * 64 + 16 * n) = wv; *(f32x4*)(dst + 2 * 64 + 16 * n) = nb;
            *(f32x4*)(dst + 3 * 64 + 16 * n) = kp; *(f32x4*)(dst + 4 * 64 + 16 * n) = wr; *(f32x4*)(dst + 5 * 64 + 16 * n) = vv;
        }
        s_nbr += __shfl_xor(s_nbr, 16); s_nbr += __shfl_xor(s_nbr, 32);
        s_kr += __shfl_xor(s_kr, 16); s_kr += __shfl_xor(s_kr, 32);
        s_bon += __shfl_xor(s_bon, 16); s_bon += __shfl_xor(s_bon, 32);
        if (kq == 0) *(f32x4*)(SL + so * 16) = (f32x4){s_nbr, s_kr, s_bon, 0.f};
    }
}
#undef CUR4
#undef PRV4
__device__ __forceinline__ void p2_row_item(Frame& F, int row) {
    const float* P = WSP(float, WS_PROJ) + (size_t)row * INWP;
    const int lane = F.lane;
    const bool prm = row < NTOKP; const int srow = row - NTOKP;
    const int p = prm ? (row & 2047) : 2048 + (srow & 3);
    const f32x2* T128 = WSP(f32x2, WS_ROPE128) + p * 64; const f32x2* T64 = WSP(f32x2, WS_ROPE64) + p * 32;
    bf16* QB = WSP(bf16, WS_QB) + (size_t)row * 512; bf16* KF = WSP(bf16, WS_KB) + (size_t)(row >> 11) * SEQ * 512; const int sq = row & 2047;
    float* ko = F.out + (prm ? O_KP + (size_t)row * 512 : O_KS + (size_t)srow * 512);
    float* vo = F.out + (prm ? O_VP + (size_t)row * 512 : O_VS + (size_t)srow * 512);
    const f32x2 cs = T128[lane];
    float Lq1[4], Lq2[4], Lk1[4], Lk2[4];
#pragma unroll
    for (int h = 0; h < 4; ++h) { Lq1[h] = P[C_Q + h * 128 + lane]; Lq2[h] = P[C_Q + h * 128 + 64 + lane]; Lk1[h] = P[C_AK + h * 128 + lane]; Lk2[h] = P[C_AK + h * 128 + 64 + lane]; }
    float Li1[8], Li2[8]; f32x2 Lc[8];
#pragma unroll
    for (int j = 0; j < 8; ++j) { const int pi = lane + 64 * j, hd = pi >> 5, i = pi & 31; Li1[j] = P[C_QI + hd * 64 + i]; Li2[j] = P[C_QI + hd * 64 + 32 + i]; Lc[j] = T64[i]; }
    const f32x4 Lv0 = *(const f32x4*)(P + C_AV + 4 * lane), Lv1 = *(const f32x4*)(P + C_AV + 256 + 4 * lane);
    const f32x4 Lm0 = *(const f32x4*)(P + C_QM + 8 * lane), Lm1 = *(const f32x4*)(P + C_QM + 8 * lane + 4);
    __builtin_amdgcn_sched_barrier(0);
#pragma unroll
    for (int h = 0; h < 4; ++h) {
        { const float x1 = Lq1[h], x2 = Lq2[h];
          const float o1 = (x1 * cs.x - x2 * cs.y) * QSCALE, o2 = (x2 * cs.x + x1 * cs.y) * QSCALE;
          QB[h * 128 + lane] = (bf16)(cvt_pk_bf16(o1, 0.f) & 0xffffu); QB[h * 128 + 64 + lane] = (bf16)(cvt_pk_bf16(o2, 0.f) & 0xffffu); }
        { const float x1 = Lk1[h], x2 = Lk2[h];
          const float o1 = x1 * cs.x - x2 * cs.y, o2 = x2 * cs.x + x1 * cs.y;
          ko[h * 128 + lane] = o1; ko[h * 128 + 64 + lane] = o2;
          if (prm) { KF[kf_off(64, h, sq, lane)] = (bf16)(cvt_pk_bf16(o1, 0.f) & 0xffffu); KF[kf_off(64, h, sq, 64 + lane)] = (bf16)(cvt_pk_bf16(o2, 0.f) & 0xffffu); } }
    }
    {
        f32x4* d = (f32x4*)vo;
        d[lane] = Lv0; d[64 + lane] = Lv1;
    }
    {
        bf16* QIB = WSP(bf16, WS_QIB) + (size_t)row * 1024;
#pragma unroll
        for (int j = 0; j < 8; ++j) { const int pi = lane + 64 * j, hd = pi >> 5, i = pi & 31; const f32x2 c2 = Lc[j];
            const float x1 = Li1[j], x2 = Li2[j];
            QIB[hd * 64 + i] = (bf16)(cvt_pk_bf16(x1 * c2.x - x2 * c2.y, 0.f) & 0xffffu); QIB[hd * 64 + 32 + i] = (bf16)(cvt_pk_bf16(x2 * c2.x + x1 * c2.y, 0.f) & 0xffffu); }
    }
    if (lane < 32) {
        const f32x2 c2 = T64[lane]; const float x1 = P[C_KI + lane], x2 = P[C_KI + 32 + lane];
        const float o1 = x1 * c2.x - x2 * c2.y, o2 = x2 * c2.x + x1 * c2.y;
        float* kio = F.out + (prm ? O_KIP + (size_t)row * 64 : O_KIS + (size_t)srow * 64);
        kio[lane] = o1; kio[32 + lane] = o2;
        bf16* KIB = WSP(bf16, WS_KIB) + (size_t)row * 64;
        KIB[lane] = (bf16)(cvt_pk_bf16(o1, 0.f) & 0xffffu); KIB[32 + lane] = (bf16)(cvt_pk_bf16(o2, 0.f) & 0xffffu);
        if (prm) { bf16* KIF = WSP(bf16, WS_SC) + (size_t)(row >> 11) * SEQ * 64; KIF[kif_off(sq, lane)] = (bf16)(cvt_pk_bf16(o1, 0.f) & 0xffffu); KIF[kif_off(sq, 32 + lane)] = (bf16)(cvt_pk_bf16(o2, 0.f) & 0xffffu); }
    }
    if (lane < 16) WSP(float, WS_WIS)[(size_t)row * 16 + lane] = P[C_WI + lane] * (1.f / 32.f);
    {
        bf16* QMB = WSP(bf16, WS_QMB) + (size_t)row * 512;
        const f32x4 a = Lm0, b = Lm1;
        v4u o; o.x = cvt_pk_bf16(a.x * QSCALE, a.y * QSCALE); o.y = cvt_pk_bf16(a.z * QSCALE, a.w * QSCALE); o.z = cvt_pk_bf16(b.x * QSCALE, b.y * QSCALE); o.w = cvt_pk_bf16(b.z * QSCALE, b.w * QSCALE);
        *(v4u*)(QMB + 8 * lane) = o;
    }
    if (prm ? ((row & 2047) == 2047) : ((srow & 3) == 3)) {
        float* so = F.out + (prm ? O_SHP + (size_t)(row >> 11) * SHW : O_SHS + (size_t)(srow >> 2) * SHW);
        for (int c = lane; c < SHW; c += 64) so[c] = P[c];
    }
}
__device__ __forceinline__ void p2_vt_item(Frame& F, const float* src, size_t ld_src, bf16* dstb, int NT, int ts) {
    LAS bf16* tile = (LAS bf16*)(F.lds + RING_OFF);
    { f32x4 tv[16];
#pragma unroll
      for (int i = 0; i < 16; ++i) { const int e = F.tid + i * NTHR, tok = e >> 7, c4 = (e & 127) * 4; tv[i] = *(const f32x4*)(src + (size_t)tok * ld_src + c4); }
#pragma unroll
      for (int i = 0; i < 16; ++i) { const int e = F.tid + i * NTHR, tok = e >> 7, c4 = (e & 127) * 4;
        v2u o; o.x = cvt_pk_bf16(tv[i].x, tv[i].y); o.y = cvt_pk_bf16(tv[i].z, tv[i].w); *(LAS v2u*)(tile + tok * 520 + c4) = o; } }
    __syncthreads();
    const int rsub = F.lane >> 3, chunk = F.lane & 7;
    for (int it = 0; it < 8; ++it) { const int hd = (it * 8 + F.wave) * 8 + rsub, h = hd >> 7, d = hd & 127;
        unsigned short e[8];
#pragma unroll
        for (int k = 0; k < 8; ++k) e[k] = tile[(chunk * 8 + k) * 520 + hd];
        const int kt = ts * 2 + (chunk >> 2), s2 = (chunk >> 1) & 1, g = chunk & 1;
        bf16* p = dstb + ((size_t)((h * NT + kt) * 8 + (d >> 5) * 2 + s2)) * 512 + (d & 31) * 8 + g * 4;
        v2u lo, hi; lo.x = e[0] | ((unsigned)e[1] << 16); lo.y = e[2] | ((unsigned)e[3] << 16); hi.x = e[4] | ((unsigned)e[5] << 16); hi.y = e[6] | ((unsigned)e[7] << 16);
        *(v2u*)p = lo; *(v2u*)(p + 32 * 8) = hi; }
    __syncthreads();
}
#ifndef PROBE_REPEAT
#define PROBE_REPEAT -1
#endif
__device__ __forceinline__ void p2_phase(Frame& F) {
    const int gw = F.bid * NWAVES + F.wave, NGW = F.G * NWAVES;
    for (int rep = 0; rep < (PROBE_REPEAT == 20 ? 2 : 1); ++rep)
    for (int it = gw; it < (NTOKP / 16) * 8; it += NGW) p2_rwkv_witem(F, it >> 3, (it & 7) * 2, 2);
    for (int it = NGW - 1 - gw; it < (NTOKS / 16) * 16; it += NGW) p2_rwkv_witem(F, NTOKP / 16 + (it >> 4), it & 15, 1);
    for (int rep = 0; rep < (PROBE_REPEAT == 21 ? 2 : 1); ++rep)
    for (int it = F.bid; it < 128 + 16; it += F.G) {
        if (it < 128) { const int b = it >> 5, ts = it & 31;
            p2_vt_item(F, WSP(float, WS_PROJ) + (size_t)(b * SEQ + ts * 64) * INWP + C_AV, INWP, WSP(bf16, WS_VT) + (size_t)b * 512 * SEQ, 64, ts); }
        else { const int j = it - 128, b = j >> 2, ts = j & 3;
            p2_vt_item(F, F.out + O_MVP + (size_t)(b * MEMT + ts * 64) * 512, 512, WSP(bf16, WS_MVT) + (size_t)b * 512 * MEMT, 8, ts); }
    }
    const int gt = F.bid * NTHR + F.tid, NGT = F.G * NTHR;
    for (int e = gt; e < 1024 * 512 / 4; e += NGT) { const f32x4 v = *(const f32x4*)(F.out + O_MKP + (size_t)e * 4); v2u o; o.x = cvt_pk_bf16(v.x, v.y); o.y = cvt_pk_bf16(v.z, v.w);
        const int rowm = e >> 7, col = (e & 127) * 4, bm = rowm >> 8, m = rowm & 255; *(v2u*)(WSP(bf16, WS_MKB) + (size_t)bm * MEMT * 512 + kf_off(8, col >> 7, m, col & 127)) = o; }
}

constexpr int TC = 32, SBUF_FLOATS = TC * 384;
#define SCAN_STAGE_LOAD(SIN, SCALP) do { \
    _Pragma("unroll") for (int i = 0; i < 10; ++i) { const int e = lt + 256 * i, st = e / 80, r = e % 80; rv[i] = *(const f32x4*)((SIN) + (size_t)st * 384 + r * 4); } \
    _Pragma("unroll") for (int i = 0; i < 2; ++i) { const int e = lt + 256 * i, st = e >> 4, row = e & 15; const float v_ = (SIN)[(size_t)st * 384 + 320 + rg * 16 + row]; const f32x2 sc_ = *(const f32x2*)((SCALP) + (size_t)st * 16); \
        rt[i].x = v_; rt[i].y = sc_.x; rt[i].z = sc_.y; rt[i].w = 0.f; } } while (0)
#define SCAN_STAGE_WRITE(BUF) do { \
    _Pragma("unroll") for (int i = 0; i < 10; ++i) { const int e = lt + 256 * i, st = e / 80, r = e % 80; *(LAS f32x4*)((BUF) + st * 384 + r * 4) = rv[i]; } \
    _Pragma("unroll") for (int i = 0; i < 2; ++i) { const int e = lt + 256 * i, st = e >> 4, row = e & 15; *(LAS f32x4*)((BUF) + st * 384 + 320 + row * 4) = rt[i]; } } while (0)
#define SCAN_STEP(KK, W4, NB, KP, WR, TB, YOUT) do { \
    f32x2 _a = s01 * (f32x2){KK.x, KK.y}; _a = __builtin_elementwise_fma(s23, (f32x2){KK.z, KK.w}, _a); \
    f32x2 _b = s01 * (f32x2){WR.x, WR.y}; _b = __builtin_elementwise_fma(s23, (f32x2){WR.z, WR.w}, _b); \
    float _p1 = _a.x + _a.y, _p2 = _b.x + _b.y; \
    _p1 += dpp<0xB1>(_p1); _p2 += dpp<0xB1>(_p2); _p1 += dpp<0x4E>(_p1); _p2 += dpp<0x4E>(_p2); _p1 += dpp<0x141>(_p1); _p2 += dpp<0x141>(_p2); _p1 += dpp<0x140>(_p1); _p2 += dpp<0x140>(_p2); \
    YOUT = __builtin_fmaf(TB.x, TB.z, __builtin_fmaf(_p1, TB.y, _p2)); \
    const f32x2 _pp = (f32x2){_p1, _p1}, _vv = (f32x2){TB.x, TB.x}; \
    f32x2 _t01 = _vv * (f32x2){KP.x, KP.y}; _t01 = __builtin_elementwise_fma(_pp, (f32x2){NB.x, NB.y}, _t01); s01 = __builtin_elementwise_fma(s01, (f32x2){W4.x, W4.y}, _t01); \
    f32x2 _t23 = _vv * (f32x2){KP.z, KP.w}; _t23 = __builtin_elementwise_fma(_pp, (f32x2){NB.z, NB.w}, _t23); s23 = __builtin_elementwise_fma(s23, (f32x2){W4.z, W4.w}, _t23); \
} while (0)
__device__ __forceinline__ void scan_prompt_item(Frame& F, const float* sin, const float* scal, float* s_out, float* y0, int rg) {
    LAS float* bufs = (LAS float*)(F.lds + RING_OFF);
    constexpr int nchunks = SEQ / TC;
    const bool scanner = F.wave < 4;
    const int ri = F.lane >> 4, kq = F.lane & 15;
    const int lrow = (F.wave & 3) * 4 + ri, vrow = rg * 16 + lrow;
    f32x2 s01 = (f32x2){0.f, 0.f}, s23 = (f32x2){0.f, 0.f};
#define SCAN_BAR() do { asm volatile("s_waitcnt lgkmcnt(0)" ::: "memory"); __builtin_amdgcn_s_barrier(); asm volatile("" ::: "memory"); } while (0)
    if (!scanner) {
        f32x4 rv[10], rt[2]; const int lt = F.tid - 256;
        SCAN_STAGE_LOAD(sin, scal); SCAN_STAGE_WRITE(bufs); SCAN_STAGE_LOAD(sin + (size_t)TC * 384, scal + (size_t)TC * 16);
        SCAN_BAR();
        for (int c = 0; c < nchunks; ++c) {
            if (c + 1 < nchunks) { SCAN_STAGE_WRITE(bufs + ((c + 1) & 1) * SBUF_FLOATS);
                if (c + 2 < nchunks) SCAN_STAGE_LOAD(sin + (size_t)(c + 2) * TC * 384, scal + (size_t)(c + 2) * TC * 16); }
            SCAN_BAR();
        }
    } else {
        SCAN_BAR();
        for (int c = 0; c < nchunks; ++c) {
            LAS float* buf = bufs + (c & 1) * SBUF_FLOATS;
            const LAS float* lb = buf + 4 * kq;
            const LAS float* tbp = buf + 320 + lrow * 4;
            float yacc = 0.f;
            f32x4 kkA = *(const LAS f32x4*)(lb), w4A = *(const LAS f32x4*)(lb + 64), nbA = *(const LAS f32x4*)(lb + 128), kpA = *(const LAS f32x4*)(lb + 192), wrA = *(const LAS f32x4*)(lb + 256), tbA = *(const LAS f32x4*)(tbp);
            f32x4 kkB = *(const LAS f32x4*)(lb + 384), w4B = *(const LAS f32x4*)(lb + 384 + 64), nbB = *(const LAS f32x4*)(lb + 384 + 128), kpB = *(const LAS f32x4*)(lb + 384 + 192), wrB = *(const LAS f32x4*)(lb + 384 + 256), tbB = *(const LAS f32x4*)(tbp + 384);
#pragma unroll
            for (int st = 0; st < TC; st += 2) {
                const int s2 = (st + 2 < TC) ? st + 2 : st, s3 = (st + 3 < TC) ? st + 3 : st + 1;
                float y;
                SCAN_STEP(kkA, w4A, nbA, kpA, wrA, tbA, y);
                yacc = (kq == (st & 15)) ? y : yacc;
                kkA = *(const LAS f32x4*)(lb + s2 * 384); w4A = *(const LAS f32x4*)(lb + s2 * 384 + 64); nbA = *(const LAS f32x4*)(lb + s2 * 384 + 128);
                kpA = *(const LAS f32x4*)(lb + s2 * 384 + 192); wrA = *(const LAS f32x4*)(lb + s2 * 384 + 256); tbA = *(const LAS f32x4*)(tbp + s2 * 384);
                __builtin_amdgcn_sched_barrier(0);
                SCAN_STEP(kkB, w4B, nbB, kpB, wrB, tbB, y);
                yacc = (kq == ((st + 1) & 15)) ? y : yacc;
                if (((st + 1) & 15) == 15) y0[(size_t)(c * TC + st + 1 - 15 + kq) * RW + vrow] = yacc;
                kkB = *(const LAS f32x4*)(lb + s3 * 384); w4B = *(const LAS f32x4*)(lb + s3 * 384 + 64); nbB = *(const LAS f32x4*)(lb + s3 * 384 + 128);
                kpB = *(const LAS f32x4*)(lb + s3 * 384 + 192); wrB = *(const LAS f32x4*)(lb + s3 * 384 + 256); tbB = *(const LAS f32x4*)(tbp + s3 * 384);
                __builtin_amdgcn_sched_barrier(0);
            }
            SCAN_BAR();
        }
    }
    __syncthreads();
    if (scanner) *(f32x4*)(s_out + (size_t)vrow * 64 + 4 * kq) = (f32x4){s01.x, s01.y, s23.x, s23.y};
}
__device__ __forceinline__ void scan_sample_witem(Frame& F, int item) {
    const int dbh = item >> 4, r4 = item & 15, db = dbh >> 4, h = dbh & 15;
    const int ri = F.lane >> 4, kq = F.lane & 15, vrow = r4 * 4 + ri;
    const size_t so = (size_t)NB * RH * SEQ + (size_t)dbh * DT;
    const float* sin = WSP(float, WS_SCANIN) + so * 384; const float* scal = WSP(float, WS_SCAL) + so * 16;
    const f32x4 s0 = *(const f32x4*)(F.in[I_SWKV] + (size_t)dbh * 4096 + (size_t)vrow * 64 + 4 * kq);
    f32x2 s01 = (f32x2){s0.x, s0.y}, s23 = (f32x2){s0.z, s0.w};
    f32x4 kk[DT], w4[DT], nb[DT], kp[DT], wr[DT], tb[DT];
#pragma unroll
    for (int st = 0; st < DT; ++st) { const float* p = sin + st * 384 + 4 * kq;
        kk[st] = *(const f32x4*)(p); w4[st] = *(const f32x4*)(p + 64); nb[st] = *(const f32x4*)(p + 128); kp[st] = *(const f32x4*)(p + 192); wr[st] = *(const f32x4*)(p + 256);
        const f32x2 sc = *(const f32x2*)(scal + st * 16); tb[st] = (f32x4){sin[st * 384 + 320 + vrow], sc.x, sc.y, 0.f}; }
    float* y0 = WSP(float, WS_Y) + (size_t)(NTOKP + db * DT) * RW + h * 64 + vrow;
#pragma unroll
    for (int st = 0; st < DT; ++st) { float y; SCAN_STEP(kk[st], w4[st], nb[st], kp[st], wr[st], tb[st], y); if (kq == 0) y0[(size_t)st * RW] = y; }
    *(f32x4*)(F.out + O_WKVS + (size_t)dbh * 4096 + (size_t)vrow * 64 + 4 * kq) = (f32x4){s01.x, s01.y, s23.x, s23.y};
}
__device__ __forceinline__ void p3_scan_phase(Frame& F) {
    const int gw = F.bid * NWAVES + F.wave, NGW = F.G * NWAVES;
    for (int it = gw; it < DB * RH * 16; it += NGW) scan_sample_witem(F, it);
    const float* SI = WSP(float, WS_SCANIN); const float* SL = WSP(float, WS_SCAL); float* Y = WSP(float, WS_Y);
    for (int it0 = F.bid; it0 < 256; it0 += F.G) { const int it = (F.G == 256) ? ((it0 & 7) * 32 + (it0 >> 3)) : it0;
        const int bh = it >> 2, rg = it & 3, b = bh >> 4, h = bh & 15;
        scan_prompt_item(F, SI + (size_t)bh * SEQ * 384, SL + (size_t)bh * SEQ * 16, F.out + O_WKVP + (size_t)bh * 4096, Y + (size_t)(b * SEQ) * RW + h * 64, rg); }
}

__device__ __forceinline__ void gn_row(Frame& F, int row) {
    const int lane = F.lane, h = lane >> 2, q = lane & 3, c0 = h * 64 + q * 16;
    const float* y = WSP(float, WS_Y) + (size_t)row * RW + c0;
    f32x4 v[4]; float s = 0.f;
#pragma unroll
    for (int j = 0; j < 4; ++j) { v[j] = *(const f32x4*)(y + 4 * j); s += (v[j].x + v[j].y) + (v[j].z + v[j].w); }
    s += dpp<0xB1>(s); s += dpp<0x4E>(s);
    const float mean = s * (1.f / 64.f); float s2 = 0.f;
#pragma unroll
    for (int j = 0; j < 4; ++j) { v[j] = v[j] - mean; s2 += (v[j].x * v[j].x + v[j].y * v[j].y) + (v[j].z * v[j].z + v[j].w * v[j].w); }
    s2 += dpp<0xB1>(s2); s2 += dpp<0x4E>(s2);
    const float rstd = 1.f / sqrtf(s2 * (1.f / 64.f) + GN_EPS);
    const size_t so = scan_seq_off(row, h);
    const float bonus = WSP(float, WS_SCAL)[so * 16 + 2];
    const float* vv = WSP(float, WS_SCANIN) + so * 384 + 5 * 64 + q * 16;
    const float* g = WSP(float, WS_PROJ) + (size_t)row * INWP + C_GR + c0;
    const float* gw = F.in[I_GNW] + c0; const float* gb = F.in[I_GNB] + c0;
    bf16* o = WSP(bf16, WS_YMIX) + (size_t)row * DM + c0;
#pragma unroll
    for (int j = 0; j < 4; ++j) { const f32x4 w4 = *(const f32x4*)(gw + 4 * j), b4 = *(const f32x4*)(gb + 4 * j), v4 = *(const f32x4*)(vv + 4 * j), g4 = *(const f32x4*)(g + 4 * j);
        const float o0 = (v[j].x * rstd * w4.x + b4.x + bonus * v4.x) * silu(g4.x), o1 = (v[j].y * rstd * w4.y + b4.y + bonus * v4.y) * silu(g4.y);
        const float o2 = (v[j].z * rstd * w4.z + b4.z + bonus * v4.z) * silu(g4.z), o3 = (v[j].w * rstd * w4.w + b4.w + bonus * v4.w) * silu(g4.w);
        v2u pk; pk.x = cvt_pk_bf16(o0, o1); pk.y = cvt_pk_bf16(o2, o3); *(v2u*)(o + 4 * j) = pk; }
}
__device__ __forceinline__ void idx_afrag(const bf16* QIB, int row0, int lane, bf16x8 (&af)[4]) {
    const int r = lane & 31, hh = lane >> 5;
    const bf16* p = QIB + (size_t)(row0 + ((r >> 2) & 1)) * 1024 + ((r >> 3) * 4 + (r & 3)) * 64 + 8 * hh;
#pragma unroll
    for (int ks = 0; ks < 4; ++ks) af[ks] = *(const bf16x8*)(p + 16 * ks);
}
__device__ __forceinline__ float idx_reduce(const f32x16& acc, const f32x4 (&w)[4]) {
    float v = 0.f;
#pragma unroll
    for (int j = 0; j < 16; ++j) v += w[j >> 2][j & 3] * fmaxf(acc[j], 0.f);
    return v;
}
__device__ __forceinline__ void d1_prompt_item(Frame& F, int item) {
    const int idx = item & 255, second = item >> 8, b = idx >> 6, qi = idx & 63, qt = second ? 127 - qi : qi;
    const int t0 = qt * 16 + 2 * F.wave, row0 = b * SEQ + t0;
    const int r = F.lane & 31, hh = F.lane >> 5;
    bf16x8 af[4]; idx_afrag(WSP(bf16, WS_QIB), row0, F.lane, af);
    f32x4 w[4];
#pragma unroll
    for (int j = 0; j < 4; ++j) w[j] = *(const f32x4*)(WSP(float, WS_WIS) + (size_t)(row0 + hh) * 16 + 4 * j);
    const int tq = t0 + hh;
    const bf16* KIB = WSP(bf16, WS_KIB) + (size_t)(b * SEQ) * 64;
    float* SC = WSP(float, WS_SC) + (size_t)(b * SEQ + tq) * SEQ;
    for (int s0 = 0; s0 <= t0 + 1; s0 += 32) {
        f32x16 acc;
#pragma unroll
        for (int j = 0; j < 16; ++j) acc[j] = 0.f;
#pragma unroll
        for (int ks = 0; ks < 4; ++ks) { const bf16x8 bfr = *(const bf16x8*)(KIB + (size_t)(s0 + r) * 64 + 16 * ks + 8 * hh);
            acc = __builtin_amdgcn_mfma_f32_32x32x16_bf16(af[ks], bfr, acc, 0, 0, 0); }
        SC[s0 + r] = idx_reduce(acc, w);
    }
}
__device__ __forceinline__ void d1_sample_item(Frame& F, int item) {
    const int r = F.lane & 31, hh = F.lane >> 5;
    int db, p = 0; bool newk = false;
    if (item < DB * NPAGES) { db = item >> 6; p = item & 63; } else { db = item - DB * NPAGES; newk = true; }
    const int row0 = NTOKP + db * DT;
    bf16x8 af0[4], af1[4]; idx_afrag(WSP(bf16, WS_QIB), row0, F.lane, af0); idx_afrag(WSP(bf16, WS_QIB), row0 + 2, F.lane, af1);
    f32x4 w0[4], w1[4];
#pragma unroll
    for (int j = 0; j < 4; ++j) { w0[j] = *(const f32x4*)(WSP(float, WS_WIS) + (size_t)(row0 + hh) * 16 + 4 * j); w1[j] = *(const f32x4*)(WSP(float, WS_WIS) + (size_t)(row0 + 2 + hh) * 16 + 4 * j); }
    float* SCS = WSP(float, WS_SCS);
    if (!newk) {
        const int page = ((const int*)F.in[I_PT])[db * NPAGES + p];
        const float* kp = F.in[I_CKI] + ((size_t)page * PAGE + r) * 64 + 8 * hh;
        f32x4 ka[4][4], kc[4][4];
#pragma unroll
        for (int kt = 0; kt < 4; ++kt)
#pragma unroll
            for (int ks = 0; ks < 4; ++ks) { ka[kt][ks] = *(const f32x4*)(kp + (size_t)kt * 32 * 64 + 16 * ks); kc[kt][ks] = *(const f32x4*)(kp + (size_t)kt * 32 * 64 + 16 * ks + 4); }
#pragma unroll
        for (int kt = 0; kt < 4; ++kt) {
            f32x16 acc0, acc1;
#pragma unroll
            for (int j = 0; j < 16; ++j) { acc0[j] = 0.f; acc1[j] = 0.f; }
#pragma unroll
            for (int ks = 0; ks < 4; ++ks) { const f32x4 a = ka[kt][ks], c = kc[kt][ks];
                v4u u; u.x = cvt_pk_bf16(a.x, a.y); u.y = cvt_pk_bf16(a.z, a.w); u.z = cvt_pk_bf16(c.x, c.y); u.w = cvt_pk_bf16(c.z, c.w);
                const bf16x8 bfr = __builtin_bit_cast(bf16x8, u);
                acc0 = __builtin_amdgcn_mfma_f32_32x32x16_bf16(af0[ks], bfr, acc0, 0, 0, 0); acc1 = __builtin_amdgcn_mfma_f32_32x32x16_bf16(af1[ks], bfr, acc1, 0, 0, 0); }
            SCS[(size_t)(db * DT + hh) * SCS_LD + p * PAGE + kt * 32 + r] = idx_reduce(acc0, w0);
            SCS[(size_t)(db * DT + 2 + hh) * SCS_LD + p * PAGE + kt * 32 + r] = idx_reduce(acc1, w1);
        }
    } else {
        f32x16 acc0, acc1;
#pragma unroll
        for (int j = 0; j < 16; ++j) { acc0[j] = 0.f; acc1[j] = 0.f; }
        const bf16* kp = WSP(bf16, WS_KIB) + (size_t)(row0 + (r & 3)) * 64 + 8 * hh;
#pragma unroll
        for (int ks = 0; ks < 4; ++ks) { bf16x8 bfr = *(const bf16x8*)(kp + 16 * ks);
            acc0 = __builtin_amdgcn_mfma_f32_32x32x16_bf16(af0[ks], bfr, acc0, 0, 0, 0); acc1 = __builtin_amdgcn_mfma_f32_32x32x16_bf16(af1[ks], bfr, acc1, 0, 0, 0); }
        if (r < 4) { SCS[(size_t)(db * DT + hh) * SCS_LD + PAST + r] = idx_reduce(acc0, w0); SCS[(size_t)(db * DT + 2 + hh) * SCS_LD + PAST + r] = idx_reduce(acc1, w1); }
    }
}
__device__ __forceinline__ void d2_sample_block(Frame& F, int q);
__device__ __forceinline__ void p4_phase(Frame& F) {
    const int gw = F.bid * NWAVES + F.wave, NGW = F.G * NWAVES;
    if (F.G >= 64) {
        for (int q = F.bid; q < NTOKS; q += F.G) d2_sample_block(F, q);
    } else {
        for (int it = gw; it < DB * NPAGES + DB; it += NGW) d1_sample_item(F, it);
    }
    for (int row = gw; row < NTOK; row += NGW) gn_row(F, row);
}

__device__ __forceinline__ unsigned wave_count(unsigned c) {
#pragma unroll
    for (int o = 1; o < 64; o <<= 1) c += __shfl_xor((int)c, o);
    return c;
}
template <int NV>
__device__ __forceinline__ void kth_select(const unsigned (&key)[NV * 4], unsigned xk, int xbase, int lane, unsigned& T_out, unsigned& cut_out) {
    unsigned T = 0u; bool exact = false;
    for (int bit = 31; bit >= 0; --bit) {
        const unsigned cand = T | (1u << bit);
        unsigned c = (xk >= cand) ? 1u : 0u;
#pragma unroll
        for (int i = 0; i < NV * 4; ++i) c += (key[i] >= cand) ? 1u : 0u;
        c = wave_count(c);
        if (c >= (unsigned)TOPK) T = cand;
        if (c == (unsigned)TOPK) { exact = true; break; }
    }
    unsigned cut = 0x7fffffffu;
    if (!exact) {
        unsigned cg = (xk > T) ? 1u : 0u, ce = (xk == T) ? 1u : 0u;
#pragma unroll
        for (int i = 0; i < NV * 4; ++i) { cg += (key[i] > T) ? 1u : 0u; ce += (key[i] == T) ? 1u : 0u; }
        cg = wave_count(cg); ce = wave_count(ce);
        const unsigned need = (unsigned)TOPK - cg;
        if (ce > need) {
            unsigned I = 0u;
            for (int bit = 14; bit >= 0; --bit) {
                const unsigned cand = I | (1u << bit);
                unsigned c = (xk == T && (unsigned)(xbase + lane) < cand && lane < 4) ? 1u : 0u;
#pragma unroll
                for (int i = 0; i < NV * 4; ++i) { const unsigned idx = 256u * (i >> 2) + 4u * lane + (i & 3); c += (key[i] == T && idx < cand) ? 1u : 0u; }
                c = wave_count(c);
                if (c < need) I = cand;
            }
            cut = I;
        }
    }
    T_out = T; cut_out = cut;
}
__device__ __forceinline__ void d2_prompt_row(Frame& F, int row) {
    const int t = row & 2047, lane = F.lane;
    unsigned* THR = WSP(unsigned, WS_THR) + (size_t)row * 2;
    if (t < TOPK) { if (lane == 0) { THR[0] = 0u; THR[1] = 0x7fffffffu; } return; }
    const float* SC = WSP(float, WS_SC) + (size_t)row * SEQ;
    unsigned key[32];
#pragma unroll
    for (int j = 0; j < 8; ++j) { const int i0 = 256 * j + 4 * lane;
        if (i0 <= t) { const f32x4 v = *(const f32x4*)(SC + i0);
            key[4 * j + 0] = sort_key(v.x); key[4 * j + 1] = (i0 + 1 <= t) ? sort_key(v.y) : 0u; key[4 * j + 2] = (i0 + 2 <= t) ? sort_key(v.z) : 0u; key[4 * j + 3] = (i0 + 3 <= t) ? sort_key(v.w) : 0u; }
        else { key[4 * j + 0] = 0u; key[4 * j + 1] = 0u; key[4 * j + 2] = 0u; key[4 * j + 3] = 0u; } }
    unsigned T, cut; kth_select<8>(key, 0u, 1 << 20, lane, T, cut);
    if (lane == 0) { THR[0] = T; THR[1] = cut; }
}
__device__ __forceinline__ void d2_sample_block(Frame& F, int q) {
    const int t = q & 3, tid = F.tid, lane = F.lane;
    const float* SCS = WSP(float, WS_SCS) + (size_t)q * SCS_LD;
    LAS unsigned* red = (LAS unsigned*)(F.lds + RING_OFF);
    unsigned key[16];
#pragma unroll
    for (int j = 0; j < 4; ++j) { const f32x4 v = *(const f32x4*)(SCS + 2048 * j + 4 * tid);
        key[4 * j + 0] = sort_key(v.x); key[4 * j + 1] = sort_key(v.y); key[4 * j + 2] = sort_key(v.z); key[4 * j + 3] = sort_key(v.w); }
    unsigned xk = 0u; if (tid <= t) xk = sort_key(SCS[PAST + tid]);
    if (tid == 0) red[16] = 0u;
    unsigned T = 0u; bool exact = false; int par = 0;
    for (int bit = 31; bit >= 0; --bit) {
        const unsigned cand = T | (1u << bit);
        unsigned c = (xk >= cand) ? 1u : 0u;
#pragma unroll
        for (int i = 0; i < 16; ++i) c += (key[i] >= cand) ? 1u : 0u;
        c = wave_count(c);
        if (lane == 0) red[par * 8 + F.wave] = c;
        __syncthreads();
        unsigned tot = 0u;
#pragma unroll
        for (int w = 0; w < 8; ++w) tot += red[par * 8 + w];
        par ^= 1;
        if (tot >= (unsigned)TOPK) T = cand;
        if (tot == (unsigned)TOPK) { exact = true; break; }
    }
    unsigned cut = 0x7fffffffu;
    if (!exact) {
        unsigned cg = (xk > T) ? 1u : 0u, ce = (xk == T) ? 1u : 0u;
#pragma unroll
        for (int i = 0; i < 16; ++i) { cg += (key[i] > T) ? 1u : 0u; ce += (key[i] == T) ? 1u : 0u; }
        cg = wave_count(cg); ce = wave_count(ce);
        if (lane == 0) red[par * 8 + F.wave] = (cg << 16) | ce;
        __syncthreads();
        unsigned tg = 0u, te = 0u;
#pragma unroll
        for (int w = 0; w < 8; ++w) { const unsigned v = red[par * 8 + w]; tg += v >> 16; te += v & 0xffffu; }
        par ^= 1;
        const unsigned need = (unsigned)TOPK - tg;
        if (te > need) {
            unsigned I = 0u;
            for (int bit = 14; bit >= 0; --bit) {
                const unsigned cand = I | (1u << bit);
                unsigned c = (xk == T && tid < 4 && (unsigned)(PAST + tid) < cand) ? 1u : 0u;
#pragma unroll
                for (int i = 0; i < 16; ++i) { const unsigned idx = 2048u * (i >> 2) + 4u * tid + (i & 3); c += (key[i] == T && idx < cand) ? 1u : 0u; }
                c = wave_count(c);
                if (lane == 0) red[par * 8 + F.wave] = c;
                __syncthreads();
                unsigned tot = 0u;
#pragma unroll
                for (int w = 0; w < 8; ++w) tot += red[par * 8 + w];
                par ^= 1;
                if (tot < need) I = cand;
            }
            cut = I;
        }
    }
    __syncthreads();
    int* IDX = WSP(int, WS_IDX) + (size_t)q * TOPK;
#pragma unroll
    for (int i = 0; i < 16; ++i) { const int idx = 2048 * (i >> 2) + 4 * tid + (i & 3);
        if (key[i] > T || (key[i] == T && (unsigned)idx <= cut)) { const unsigned pos = atomicAdd((unsigned*)&red[16], 1u); if (pos < (unsigned)TOPK) IDX[pos] = idx; } }
    if (tid <= t) { const int idx = PAST + tid; if (xk > T || (xk == T && (unsigned)idx <= cut)) { const unsigned pos = atomicAdd((unsigned*)&red[16], 1u); if (pos < (unsigned)TOPK) IDX[pos] = idx; } }
    __syncthreads();
}
__device__ __forceinline__ void p5_phase(Frame& F) {
    const int gw = F.bid * NWAVES + F.wave, NGW = F.G * NWAVES;
    for (int q = F.bid; q < NTOKS; q += F.G) d2_sample_block(F, q);
}

constexpr int DSA_MASK_OFF = RING_OFF;
constexpr int DSA_MERGE_OFF = RING_OFF + 8192;
__device__ __forceinline__ void cnt_ge(unsigned& c, unsigned k, unsigned cand) { asm volatile("v_cmp_ge_u32 vcc, %1, %2\n\tv_addc_co_u32 %0, vcc, 0, %0, vcc" : "+v"(c) : "v"(k), "v"(cand) : "vcc"); }
template <int CTRL> __device__ __forceinline__ unsigned dppu(unsigned x) { return (unsigned)__builtin_amdgcn_mov_dpp((int)x, CTRL, 0xf, 0xf, true); }
__device__ __forceinline__ unsigned half_sum_u(unsigned c) {
    c += dppu<0xB1>(c); c += dppu<0x4E>(c); c += dppu<0x141>(c); c += dppu<0x140>(c);
    auto s2 = __builtin_amdgcn_permlane16_swap(c, c, false, false);
    return s2[0] + s2[1];
}
template <bool MASKED>
__device__ __forceinline__ void attn_core(Frame& F, int row0, int nkt, int NT, const bf16* Qb, const bf16* Kf  , const bf16* Vf  , int gate_col, int out_col) {
    const int lane = F.lane, r = lane & 31, hh = lane >> 5, h = F.wave & 3, half = F.wave >> 2;
    const LAS unsigned* mask = (const LAS unsigned*)(F.lds + DSA_MASK_OFF) + r * 64;
    bf16x8 qf[8];
#pragma unroll
    for (int ks = 0; ks < 8; ++ks) qf[ks] = *(const bf16x8*)(Qb + (size_t)(row0 + r) * 512 + h * 128 + 16 * ks + 8 * hh);
    f32x16 o[4];
#pragma unroll
    for (int d = 0; d < 4; ++d)
#pragma unroll
        for (int j = 0; j < 16; ++j) o[d][j] = 0.f;
    float m = -INFINITY, lsum = 0.f;
    const bf16* kbase = Kf + (size_t)(h * NT) * 4096 + lane * 8;
    const bf16* vbase = Vf + (size_t)(h * NT) * 4096 + lane * 8;
    bf16x8 kf[8];
    if (half < nkt) {
#pragma unroll
        for (int ks = 0; ks < 8; ++ks) kf[ks] = *(const bf16x8*)(kbase + (size_t)half * 4096 + ks * 512);
    }
    for (int kt = half; kt < nkt; kt += 2) {
        bf16x8 vf[4][2];
#pragma unroll
        for (int d = 0; d < 4; ++d)
#pragma unroll
            for (int s = 0; s < 2; ++s) vf[d][s] = *(const bf16x8*)(vbase + (size_t)kt * 4096 + (d * 2 + s) * 512);
        f32x16 x;
#pragma unroll
        for (int j = 0; j < 16; ++j) x[j] = 0.f;
#pragma unroll
        for (int ks = 0; ks < 8; ++ks) x = __builtin_amdgcn_mfma_f32_32x32x16_bf16(kf[ks], qf[ks], x, 0, 0, 0);
        {
            const int ktn = (kt + 2 < nkt) ? kt + 2 : kt;
#pragma unroll
            for (int ks = 0; ks < 8; ++ks) kf[ks] = *(const bf16x8*)(kbase + (size_t)ktn * 4096 + ks * 512);
        }
        if (MASKED) {
            const unsigned m4 = mask[kt] >> (4 * hh);
#pragma unroll
            for (int g = 0; g < 4; ++g)
#pragma unroll
                for (int e = 0; e < 4; ++e) { const unsigned t = (unsigned)((int)(m4 << (31 - (8 * g + e))) >> 31);
                    x[4 * g + e] = __uint_as_float((__float_as_uint(x[4 * g + e]) & t) | (0xff800000u & ~t)); }
        }
        float mx = x[0];
#pragma unroll
        for (int j = 1; j < 16; ++j) mx = fmaxf(mx, x[j]);
        mx = xhalf_max(mx);
        const float mn = fmaxf(m, mx), mu = (mn == -INFINITY) ? 0.f : mn;
        const float alpha = __builtin_amdgcn_exp2f(m - mu);
        m = mn;
        float ls = 0.f;
#pragma unroll
        for (int j = 0; j < 16; ++j) { x[j] = __builtin_amdgcn_exp2f(x[j] - mu); ls += x[j]; }
        lsum = lsum * alpha + ls;
        if (__any(alpha != 1.f)) {
#pragma unroll
            for (int d = 0; d < 4; ++d)
#pragma unroll
                for (int j = 0; j < 16; ++j) o[d][j] *= alpha;
        }
        bf16x8 pf[2];
#pragma unroll
        for (int s = 0; s < 2; ++s) { v4u u; u.x = cvt_pk_bf16(x[8 * s + 0], x[8 * s + 1]); u.y = cvt_pk_bf16(x[8 * s + 2], x[8 * s + 3]); u.z = cvt_pk_bf16(x[8 * s + 4], x[8 * s + 5]); u.w = cvt_pk_bf16(x[8 * s + 6], x[8 * s + 7]);
            pf[s] = __builtin_bit_cast(bf16x8, u); }
#pragma unroll
        for (int d = 0; d < 4; ++d)
#pragma unroll
            for (int s = 0; s < 2; ++s) o[d] = __builtin_amdgcn_mfma_f32_32x32x16_bf16(vf[d][s], pf[s], o[d], 0, 0, 0);
    }
    lsum = xhalf_sum(lsum);
    LAS float* mg = (LAS float*)(F.lds + DSA_MERGE_OFF) + h * 66 * 64;
    if (half == 1) {
        mg[0 * 64 + lane] = m; mg[1 * 64 + lane] = lsum;
#pragma unroll
        for (int d = 0; d < 4; ++d)
#pragma unroll
            for (int j = 0; j < 16; ++j) mg[(2 + d * 16 + j) * 64 + lane] = o[d][j];
    }
    __syncthreads();
    if (half == 0) {
        const float m1 = mg[0 * 64 + lane], l1 = mg[1 * 64 + lane];
        const float mn = fmaxf(m, m1), mu = (mn == -INFINITY) ? 0.f : mn;
        const float a0 = __builtin_amdgcn_exp2f(m - mu), a1 = __builtin_amdgcn_exp2f(m1 - mu);
        const float l = lsum * a0 + l1 * a1; const float inv = l > 0.f ? 1.f / l : 0.f;
        const float* gp = WSP(float, WS_PROJ) + (size_t)(row0 + r) * INWP + gate_col + h * 128;
        bf16* op = WSP(bf16, WS_YMIX) + (size_t)(row0 + r) * DM + out_col + h * 128;
#pragma unroll
        for (int d = 0; d < 4; ++d)
#pragma unroll
            for (int g = 0; g < 4; ++g) { const int dd = d * 32 + 8 * g + 4 * hh; const f32x4 gv = *(const f32x4*)(gp + dd);
                float v[4];
#pragma unroll
                for (int e = 0; e < 4; ++e) v[e] = (o[d][4 * g + e] * a0 + mg[(2 + d * 16 + 4 * g + e) * 64 + lane] * a1) * inv * silu(gv[e]);
                v2u pk; pk.x = cvt_pk_bf16(v[0], v[1]); pk.y = cvt_pk_bf16(v[2], v[3]); *(v2u*)(op + dd) = pk; }
    }
    __syncthreads();
}
__device__ __forceinline__ void dsa_prompt_item(Frame& F, int b, int qt) {
    const int t0 = qt * 32, row0 = b * SEQ + t0, nkt = qt + 1;
    LAS unsigned* mask = (LAS unsigned*)(F.lds + DSA_MASK_OFF);
    if (t0 + 31 < TOPK) {
        for (int i = F.tid; i < 32 * 64; i += NTHR) { const int q = i >> 6, kt = i & 63; const int nb = t0 + q - 32 * kt + 1;
            mask[i] = nb >= 32 ? 0xffffffffu : (nb <= 0 ? 0u : ((1u << nb) - 1u)); }
    } else {
        const int lane = F.lane, r = lane & 31, hh = lane >> 5;
        int r4 = 4 * r; asm volatile("" : "+v"(r4));
        const bf16* KIB = WSP(bf16, WS_SC) + (size_t)(b * SEQ) * 64 + lane * 8;
        LAS unsigned* skl = (LAS unsigned*)(F.lds + DSA_MASK_OFF + 8192) + F.wave * 4096 + hh * 2048;
        for (int i = F.tid; i < 32 * 64; i += NTHR) mask[i] = 0u;
        __syncthreads();
        for (int pass = 0; pass < 2; ++pass) {
            const int q0 = 16 * pass + 2 * F.wave, tq = t0 + q0 + hh;
            {
                bf16x8 af[4]; idx_afrag(WSP(bf16, WS_QIB), row0 + q0, lane, af);
                f32x4 w[4];
#pragma unroll
                for (int j = 0; j < 4; ++j) w[j] = *(const f32x4*)(WSP(float, WS_WIS) + (size_t)(row0 + q0 + hh) * 16 + 4 * j);
                bf16x8 ring[4][4];
#pragma unroll
                for (int i = 0; i < 3; ++i) { const int ktc = i < nkt ? i : nkt - 1;
#pragma unroll
                    for (int ks = 0; ks < 4; ++ks) ring[i][ks] = *(const bf16x8*)(KIB + (size_t)ktc * 2048 + ks * 512); }
                for (int kt0 = 0; kt0 < nkt; kt0 += 4) {
#pragma unroll
                    for (int i = 0; i < 4; ++i) {
                        const int kt = kt0 + i, ktp = (kt + 3 < nkt) ? kt + 3 : nkt - 1;
#pragma unroll
                        for (int ks = 0; ks < 4; ++ks) ring[(i + 3) & 3][ks] = *(const bf16x8*)(KIB + (size_t)ktp * 2048 + ks * 512);
                        f32x16 acc;
#pragma unroll
                        for (int j = 0; j < 16; ++j) acc[j] = 0.f;
#pragma unroll
                        for (int ks = 0; ks < 4; ++ks) acc = __builtin_amdgcn_mfma_f32_32x32x16_bf16(af[ks], ring[i][ks], acc, 0, 0, 0);
                        if (kt < nkt) skl[kt * 32 + r] = sort_key(idx_reduce(acc, w));
                    }
                }
            }
            asm volatile("s_waitcnt lgkmcnt(0)" ::: "memory");
            unsigned sk[64];
            int tqr = tq - r4; asm volatile("" : "+v"(tqr));
#pragma unroll
            for (int i = 0; i < 16; ++i) { const v4u v = *(const LAS v4u*)(skl + 128 * i + r4);
                sk[4 * i + 0] = (128 * i + 0 <= tqr) ? v.x : 0u; sk[4 * i + 1] = (128 * i + 1 <= tqr) ? v.y : 0u; sk[4 * i + 2] = (128 * i + 2 <= tqr) ? v.z : 0u; sk[4 * i + 3] = (128 * i + 3 <= tqr) ? v.w : 0u; }
            unsigned T = 0u; bool exact = false;
            for (int bit = 31; bit >= 0; --bit) {
                const unsigned cand = T | (1u << bit);
                unsigned c = 0u;
#pragma unroll
                for (int i = 0; i < 64; ++i) cnt_ge(c, sk[i], cand);
                c = half_sum_u(c);
                if (!exact) { if (c >= (unsigned)TOPK) T = cand; if (c == (unsigned)TOPK) exact = true; }
                if (__all(exact)) break;
            }
            unsigned cut = 0x7fffffffu;
            if (__any(!exact)) {
                unsigned cg = 0u, ce = 0u;
                for (int i = 0; i < 16; ++i) { const v4u v = *(const LAS v4u*)(skl + 128 * i + r4); const int i0 = 128 * i + r4;
#pragma unroll
                    for (int e = 0; e < 4; ++e) { const unsigned k = (i0 + e <= tq) ? v[e] : 0u; cg += (k > T) ? 1u : 0u; ce += (k == T) ? 1u : 0u; } }
                cg = half_sum_u(cg); ce = half_sum_u(ce);
                const unsigned need = (unsigned)TOPK - cg;
                const bool tie = !exact && ce > need;
                unsigned I = 0u;
                for (int bit = 11; bit >= 0; --bit) {
                    const unsigned cand = I | (1u << bit);
                    unsigned c = 0u;
                    for (int i = 0; i < 16; ++i) { const v4u v = *(const LAS v4u*)(skl + 128 * i + r4); const int i0 = 128 * i + r4;
#pragma unroll
                        for (int e = 0; e < 4; ++e) { const unsigned k = (i0 + e <= tq) ? v[e] : 0u; c += (k == T && (unsigned)(i0 + e) < cand) ? 1u : 0u; } }
                    c = half_sum_u(c);
                    if (c < need) I = cand;
                }
                if (tie) cut = I;
            }
            int cutr = (int)cut - r4; asm volatile("" : "+v"(cutr));
#pragma unroll
            for (int i = 0; i < 16; ++i) {
                unsigned nib = 0u;
#pragma unroll
                for (int e = 0; e < 4; ++e) { const unsigned k = sk[4 * i + e]; const bool sel = k != 0u && (k > T || (k == T && (128 * i + e) <= cutr)); nib |= sel ? (1u << e) : 0u; }
                if (nib) __hip_atomic_fetch_or((LAS unsigned*)&mask[(q0 + hh) * 64 + 4 * i + (r >> 3)], nib << (4 * (r & 7)), __ATOMIC_RELAXED, __HIP_MEMORY_SCOPE_WORKGROUP);
            }
        }
    }
    __syncthreads();
#ifndef T_NOCORE
    attn_core<true>(F, row0, nkt, 64, WSP(bf16, WS_QB), WSP(bf16, WS_KB) + (size_t)b * SEQ * 512, WSP(bf16, WS_VT) + (size_t)b * 512 * SEQ, C_GA, 1024);
#endif
}
__device__ __forceinline__ void gather_attn_item(Frame& F, int q, bool dsa) {
    const int lane = F.lane, hd = lane >> 4, d0 = (lane & 15) * 8, db = q >> 2, row = NTOKP + q;
    LAS float* red = (LAS float*)(F.lds + RING_OFF);
    LAS float* racc = red + 64;
    const float* kptr; const float* vptr;
    {
        const int ki = F.wave * 32 + (lane & 31);
        if (dsa) { const int idx = WSP(int, WS_IDX)[(size_t)q * TOPK + ki];
            if (idx < PAST) { const size_t phys = (size_t)((const int*)F.in[I_PT])[db * NPAGES + (idx >> 7)] * PAGE + (idx & 127); kptr = F.in[I_CK] + phys * 512; vptr = F.in[I_CV] + phys * 512; }
            else { const int j = idx - PAST; kptr = F.out + O_KS + (size_t)(db * DT + j) * 512; vptr = F.out + O_VS + (size_t)(db * DT + j) * 512; } }
        else { kptr = F.in[I_CMK] + (size_t)(db * MEMT + ki) * 512; vptr = F.in[I_CMV] + (size_t)(db * MEMT + ki) * 512; }
    }
    const bf16* qb = (dsa ? WSP(bf16, WS_QB) : WSP(bf16, WS_QMB)) + (size_t)row * 512 + hd * 128 + d0;
    float qv[8];
    { const v4u u = *(const v4u*)qb; qv[0] = __uint_as_float(u.x << 16); qv[1] = __uint_as_float(u.x & 0xffff0000u); qv[2] = __uint_as_float(u.y << 16); qv[3] = __uint_as_float(u.y & 0xffff0000u);
      qv[4] = __uint_as_float(u.z << 16); qv[5] = __uint_as_float(u.z & 0xffff0000u); qv[6] = __uint_as_float(u.w << 16); qv[7] = __uint_as_float(u.w & 0xffff0000u); }
    LAS float* sl = racc + 8 * 8 * 64 + F.wave * 128;
    float mx = -INFINITY;
#pragma unroll 16
    for (int i = 0; i < 32; ++i) {
        const unsigned long long pk = (unsigned long long)kptr;
        const unsigned lo = __shfl((int)(unsigned)pk, i), hi = __shfl((int)(unsigned)(pk >> 32), i);
        const float* kr = (const float*)(((unsigned long long)hi << 32) | lo) + hd * 128 + d0;
        const f32x4 a = *(const f32x4*)kr, c = *(const f32x4*)(kr + 4);
        float s = (a.x * qv[0] + a.y * qv[1]) + (a.z * qv[2] + a.w * qv[3]) + (c.x * qv[4] + c.y * qv[5]) + (c.z * qv[6] + c.w * qv[7]);
        s = row16_sum(s); mx = fmaxf(mx, s);
        if ((lane & 15) == 0) sl[i * 4 + hd] = s;
    }
    if ((lane & 15) == 0) red[F.wave * 4 + hd] = mx;
    __syncthreads();
    float gm = red[hd];
#pragma unroll
    for (int w = 1; w < 8; ++w) gm = fmaxf(gm, red[w * 4 + hd]);
    __syncthreads();
    float acc[8]; float ls = 0.f;
#pragma unroll
    for (int e = 0; e < 8; ++e) acc[e] = 0.f;
#pragma unroll 16
    for (int i = 0; i < 32; ++i) {
        const unsigned long long pv = (unsigned long long)vptr;
        const unsigned lo = __shfl((int)(unsigned)pv, i), hi = __shfl((int)(unsigned)(pv >> 32), i);
        const float* vr = (const float*)(((unsigned long long)hi << 32) | lo) + hd * 128 + d0;
        const f32x4 a = *(const f32x4*)vr, c = *(const f32x4*)(vr + 4);
        const float p = exp2f(sl[i * 4 + hd] - gm); ls += p;
        acc[0] += p * a.x; acc[1] += p * a.y; acc[2] += p * a.z; acc[3] += p * a.w; acc[4] += p * c.x; acc[5] += p * c.y; acc[6] += p * c.z; acc[7] += p * c.w;
    }
    if ((lane & 15) == 0) red[F.wave * 4 + hd] = ls;
#pragma unroll
    for (int e = 0; e < 8; ++e) racc[(F.wave * 8 + e) * 64 + lane] = acc[e];
    __syncthreads();
    if (F.wave == 0) {
        float l = 0.f;
#pragma unroll
        for (int w = 0; w < 8; ++w) l += red[w * 4 + hd];
        const float inv = 1.f / l;
        const float* gp = WSP(float, WS_PROJ) + (size_t)row * INWP + (dsa ? C_GA : C_GM) + hd * 128 + d0;
        float v[8];
#pragma unroll
        for (int e = 0; e < 8; ++e) { float a = 0.f;
#pragma unroll
            for (int w = 0; w < 8; ++w) a += racc[(w * 8 + e) * 64 + lane];
            v[e] = a * inv * silu(gp[e]); }
        v4u pk; pk.x = cvt_pk_bf16(v[0], v[1]); pk.y = cvt_pk_bf16(v[2], v[3]); pk.z = cvt_pk_bf16(v[4], v[5]); pk.w = cvt_pk_bf16(v[6], v[7]);
        *(v4u*)(WSP(bf16, WS_YMIX) + (size_t)row * DM + (dsa ? 1024 : 1536) + hd * 128 + d0) = pk;
    }
    __syncthreads();
}
__device__ __forceinline__ void p6_phase(Frame& F) {
    { const int gt = F.bid * NTHR + F.tid, NGT = F.G * NTHR;
      for (int e = gt; e < NTOKS * DM / 4; e += NGT) *(f32x4*)(F.out + O_YS + (size_t)e * 4) = *(const f32x4*)(F.in[I_XS] + (size_t)e * 4); }
    if (F.G >= 64) { for (int it = F.bid; it < 256; it += F.G) { const int i = it & 127; gather_attn_item(F, (i & 31) * 4 + (i >> 5), it < 128); } return; }
    unsigned* qctr = (unsigned*)(F.ws + WS_CTL) + 8192;
    volatile LAS int* slot = (volatile LAS int*)(F.lds + LDSCTL_OFF + 64);
    for (;;) {
        if (F.tid == 0) *slot = (int)__hip_atomic_fetch_add(qctr, 1u, __ATOMIC_RELAXED, __HIP_MEMORY_SCOPE_AGENT);
        __syncthreads();
        const int it = *slot;
        __syncthreads();
        if (it >= 768) break;
        Frame Fi = F; asm volatile("" : "+v"(Fi.lane), "+v"(Fi.tid));
        if (it < 256) { const int b = it & 3, qt = 63 - (it >> 2); dsa_prompt_item(Fi, b, qt); }
        else if (it < 512) { const int j = it - 256; gather_attn_item(Fi, j & 127, j < 128); }
        else { const int j = it - 512, b = j >> 6, qt = j & 63;
            attn_core<false>(Fi, b * SEQ + qt * 32, 8, 8, WSP(bf16, WS_QMB), WSP(bf16, WS_MKB) + (size_t)b * MEMT * 512, WSP(bf16, WS_MVT) + (size_t)b * 512 * MEMT, C_GM, 1536); }
    }
}

constexpr int G4_RING_BYTES = 3 * (16 * 384 + 16 * 16) * 4;
constexpr int G4_MASK_OFF = 77824, G4_SKL_OFF = G4_MASK_OFF + 8192;
constexpr int G4_SLOT_OFF = LDSCTL_OFF + 128;
struct GBar { volatile LAS unsigned* cnt; unsigned target; };
template <bool SLEEP = true>
__device__ __forceinline__ void gbar(GBar& g, int lane) {
    g.target += 4u;
    asm volatile("s_waitcnt lgkmcnt(0)" ::: "memory");
    if (lane == 0) __hip_atomic_fetch_add((LAS unsigned*)g.cnt, 1u, __ATOMIC_RELAXED, __HIP_MEMORY_SCOPE_WORKGROUP);
    unsigned sp = 0; while (*g.cnt < g.target) { if (SLEEP) __builtin_amdgcn_s_sleep(1); if (++sp > (1u << 26)) break; }
    asm volatile("" ::: "memory");
}
constexpr int S4_TC = 16, S4_NB = 3, S4_BUF_FLOATS = S4_TC * 384 + S4_TC * 16, S4_NCH = SEQ / S4_TC;
__device__ __forceinline__ void scan4_issue(LAS unsigned char* lds, const float* sin, const float* scal, int c, int sw, int lane) {
    LAS float* buf = (LAS float*)(lds + RING_OFF) + (c % S4_NB) * S4_BUF_FLOATS;
    const float* src = sin + (size_t)c * S4_TC * 384;
#pragma unroll
    for (int i = 0; i < 6; ++i) { const int piece = sw + 4 * i;
        __builtin_amdgcn_global_load_lds((const unsigned*)(src + piece * 256 + lane * 4), (LAS unsigned*)(buf + piece * 256), 16, 0, 0); }
    __builtin_amdgcn_global_load_lds((const unsigned*)(scal + (size_t)c * S4_TC * 16 + lane * 4), (LAS unsigned*)(buf + S4_TC * 384), 16, 0, 0);
}
__device__ __forceinline__ void scan4_item(Frame& F, GBar& gb, int b, int h, int rg, float* s_out, float* y0) {
    const int bh = b * RH + h, lane = F.lane, sw = F.wave;
    const float* sin = WSP(float, WS_SCANIN) + (size_t)bh * SEQ * 384; const float* scal = WSP(float, WS_SCAL) + (size_t)bh * SEQ * 16;
    const int ri = lane >> 4, kq = lane & 15, vrow = rg * 16 + sw * 4 + ri;
    f32x2 s01 = (f32x2){0.f, 0.f}, s23 = (f32x2){0.f, 0.f};
    scan4_issue(F.lds, sin, scal, 0, sw, lane); scan4_issue(F.lds, sin, scal, 1, sw, lane);
    for (int c = 0; c < S4_NCH; ++c) {
        if (c < 2 || c + 2 >= S4_NCH) asm volatile("s_waitcnt vmcnt(0)" ::: "memory");
        else asm volatile("s_waitcnt vmcnt(9)" ::: "memory");
        gbar<false>(gb, lane);
        if (c + 2 < S4_NCH) scan4_issue(F.lds, sin, scal, c + 2, sw, lane);
        const LAS float* buf = (const LAS float*)(F.lds + RING_OFF) + (c % S4_NB) * S4_BUF_FLOATS;
        const LAS float* lb = buf + 4 * kq;
        const LAS float* vb = buf + 320 + vrow;
        const LAS float* sb = buf + S4_TC * 384;
        float yacc = 0.f;
#define S4_LOAD(ST, KK, W4, NB, KP, WR, TB) do { KK = *(const LAS f32x4*)(lb + (ST) * 384); W4 = *(const LAS f32x4*)(lb + (ST) * 384 + 64); NB = *(const LAS f32x4*)(lb + (ST) * 384 + 128); \
            KP = *(const LAS f32x4*)(lb + (ST) * 384 + 192); WR = *(const LAS f32x4*)(lb + (ST) * 384 + 256); const float _v = vb[(ST) * 384]; const f32x2 _s = *(const LAS f32x2*)(sb + (ST) * 16); \
            TB.x = _v; TB.y = _s.x; TB.z = _s.y; TB.w = 0.f; } while (0)
        f32x4 kkA, w4A, nbA, kpA, wrA, tbA, kkB, w4B, nbB, kpB, wrB, tbB;
        S4_LOAD(0, kkA, w4A, nbA, kpA, wrA, tbA); S4_LOAD(1, kkB, w4B, nbB, kpB, wrB, tbB);
#pragma unroll
        for (int st = 0; st < S4_TC; st += 2) {
            const int s2 = (st + 2 < S4_TC) ? st + 2 : st, s3 = (st + 3 < S4_TC) ? st + 3 : st + 1;
            float y;
            SCAN_STEP(kkA, w4A, nbA, kpA, wrA, tbA, y);
            yacc = (kq == st) ? y : yacc;
            S4_LOAD(s2, kkA, w4A, nbA, kpA, wrA, tbA);
            __builtin_amdgcn_sched_barrier(0);
            SCAN_STEP(kkB, w4B, nbB, kpB, wrB, tbB, y);
            yacc = (kq == st + 1) ? y : yacc;
            S4_LOAD(s3, kkB, w4B, nbB, kpB, wrB, tbB);
            __builtin_amdgcn_sched_barrier(0);
        }
#undef S4_LOAD
        y0[(size_t)(c * S4_TC + kq) * RW + vrow] = yacc;
    }
    *(f32x4*)(s_out + (size_t)vrow * 64 + 4 * kq) = (f32x4){s01.x, s01.y, s23.x, s23.y};
}
template <bool MASKED>
__device__ __forceinline__ void attn4(Frame& F, int gw, int row0, int nkt, int NT, const bf16* Qb, const bf16* Kf, const bf16* Vf, int gate_col, int out_col) {
    const int lane = F.lane, r = lane & 31, hh = lane >> 5, h = gw;
    const LAS unsigned* mask = (const LAS unsigned*)(F.lds + G4_MASK_OFF) + r * 64;
    bf16x8 qf[8];
#pragma unroll
    for (int ks = 0; ks < 8; ++ks) qf[ks] = *(const bf16x8*)(Qb + (size_t)(row0 + r) * 512 + h * 128 + 16 * ks + 8 * hh);
    f32x16 o[4];
#pragma unroll
    for (int d = 0; d < 4; ++d)
#pragma unroll
        for (int j = 0; j < 16; ++j) o[d][j] = 0.f;
    float m = -INFINITY, lsum = 0.f;
    const bf16* kbase = Kf + (size_t)(h * NT) * 4096 + lane * 8;
    const bf16* vbase = Vf + (size_t)(h * NT) * 4096 + lane * 8;
    bf16x8 kf[8];
#pragma unroll
    for (int ks = 0; ks < 8; ++ks) kf[ks] = *(const bf16x8*)(kbase + ks * 512);
#pragma unroll 1
    for (int kt = 0; kt < nkt; ++kt) {
        bf16x8 vf[4][2];
#pragma unroll
        for (int d = 0; d < 4; ++d)
#pragma unroll
            for (int s = 0; s < 2; ++s) vf[d][s] = *(const bf16x8*)(vbase + (size_t)kt * 4096 + (d * 2 + s) * 512);
        f32x16 x;
#pragma unroll
        for (int j = 0; j < 16; ++j) x[j] = 0.f;
#pragma unroll
        for (int ks = 0; ks < 8; ++ks) x = __builtin_amdgcn_mfma_f32_32x32x16_bf16(kf[ks], qf[ks], x, 0, 0, 0);
        {   const int ktn = (kt + 1 < nkt) ? kt + 1 : kt;
#pragma unroll
            for (int ks = 0; ks < 8; ++ks) kf[ks] = *(const bf16x8*)(kbase + (size_t)ktn * 4096 + ks * 512); }
        if (MASKED) {
            const unsigned m4 = mask[kt] >> (4 * hh);
#pragma unroll
            for (int g = 0; g < 4; ++g)
#pragma unroll
                for (int e = 0; e < 4; ++e) { const unsigned t = (unsigned)((int)(m4 << (31 - (8 * g + e))) >> 31);
                    x[4 * g + e] = __uint_as_float((__float_as_uint(x[4 * g + e]) & t) | (0xff800000u & ~t)); }
        }
        float mx = x[0];
#pragma unroll
        for (int j = 1; j < 16; ++j) mx = fmaxf(mx, x[j]);
        mx = xhalf_max(mx);
        const float mn = fmaxf(m, mx), mu = (mn == -INFINITY) ? 0.f : mn;
        const float alpha = __builtin_amdgcn_exp2f(m - mu);
        m = mn;
        float ls = 0.f;
#pragma unroll
        for (int j = 0; j < 16; ++j) { x[j] = __builtin_amdgcn_exp2f(x[j] - mu); ls += x[j]; }
        lsum = lsum * alpha + ls;
        if (__any(alpha != 1.f)) {
#pragma unroll
            for (int d = 0; d < 4; ++d)
#pragma unroll
                for (int j = 0; j < 16; ++j) o[d][j] *= alpha;
        }
        bf16x8 pf[2];
#pragma unroll
        for (int s = 0; s < 2; ++s) { v4u u; u.x = cvt_pk_bf16(x[8 * s + 0], x[8 * s + 1]); u.y = cvt_pk_bf16(x[8 * s + 2], x[8 * s + 3]); u.z = cvt_pk_bf16(x[8 * s + 4], x[8 * s + 5]); u.w = cvt_pk_bf16(x[8 * s + 6], x[8 * s + 7]);
            pf[s] = __builtin_bit_cast(bf16x8, u); }
#pragma unroll
        for (int d = 0; d < 4; ++d)
#pragma unroll
            for (int s = 0; s < 2; ++s) o[d] = __builtin_amdgcn_mfma_f32_32x32x16_bf16(vf[d][s], pf[s], o[d], 0, 0, 0);
    }
    lsum = xhalf_sum(lsum);
    const float inv = lsum > 0.f ? 1.f / lsum : 0.f;
    const float* gp = WSP(float, WS_PROJ) + (size_t)(row0 + r) * INWP + gate_col + h * 128;
    bf16* op = WSP(bf16, WS_YMIX) + (size_t)(row0 + r) * DM + out_col + h * 128;
#pragma unroll
    for (int d = 0; d < 4; ++d)
#pragma unroll
        for (int g = 0; g < 4; ++g) { const int dd = d * 32 + 8 * g + 4 * hh; const f32x4 gv = *(const f32x4*)(gp + dd);
            float v[4];
#pragma unroll
            for (int e = 0; e < 4; ++e) v[e] = o[d][4 * g + e] * inv * silu(gv[e]);
            v2u pk; pk.x = cvt_pk_bf16(v[0], v[1]); pk.y = cvt_pk_bf16(v[2], v[3]); *(v2u*)(op + dd) = pk; }
}
__device__ __forceinline__ void dsa4_item(Frame& F, GBar& gb, int gw, int b, int qt) {
    const int t0 = qt * 32, row0 = b * SEQ + t0, nkt = qt + 1, gt = gw * 64 + F.lane;
    LAS unsigned* mask = (LAS unsigned*)(F.lds + G4_MASK_OFF);
    if (t0 + 31 < TOPK) {
        for (int i = gt; i < 32 * 64; i += 256) { const int q = i >> 6, kt = i & 63; const int nb = t0 + q - 32 * kt + 1;
            mask[i] = nb >= 32 ? 0xffffffffu : (nb <= 0 ? 0u : ((1u << nb) - 1u)); }
    } else {
        const int lane = F.lane, r = lane & 31, hh = lane >> 5;
        int r4 = 4 * r; asm volatile("" : "+v"(r4));
        const bf16* KIB = WSP(bf16, WS_SC) + (size_t)(b * SEQ) * 64 + lane * 8;
        LAS unsigned* skl = (LAS unsigned*)(F.lds + G4_SKL_OFF) + gw * 4096 + hh * 2048;
        for (int i = gt; i < 32 * 64; i += 256) mask[i] = 0u;
        gbar(gb, lane);
        for (int pass = 0; pass < 4; ++pass) {
            const int q0 = 8 * pass + 2 * gw, tq = t0 + q0 + hh;
            {
                bf16x8 af[4]; idx_afrag(WSP(bf16, WS_QIB), row0 + q0, lane, af);
                f32x4 w[4];
#pragma unroll
                for (int j = 0; j < 4; ++j) w[j] = *(const f32x4*)(WSP(float, WS_WIS) + (size_t)(row0 + q0 + hh) * 16 + 4 * j);
                bf16x8 ring[4][4];
#pragma unroll
                for (int i = 0; i < 3; ++i) { const int ktc = i < nkt ? i : nkt - 1;
#pragma unroll
                    for (int ks = 0; ks < 4; ++ks) ring[i][ks] = *(const bf16x8*)(KIB + (size_t)ktc * 2048 + ks * 512); }
                for (int kt0 = 0; kt0 < nkt; kt0 += 4) {
#pragma unroll
                    for (int i = 0; i < 4; ++i) {
                        const int kt = kt0 + i, ktp = (kt + 3 < nkt) ? kt + 3 : nkt - 1;
#pragma unroll
                        for (int ks = 0; ks < 4; ++ks) ring[(i + 3) & 3][ks] = *(const bf16x8*)(KIB + (size_t)ktp * 2048 + ks * 512);
                        f32x16 acc;
#pragma unroll
                        for (int j = 0; j < 16; ++j) acc[j] = 0.f;
#pragma unroll
                        for (int ks = 0; ks < 4; ++ks) acc = __builtin_amdgcn_mfma_f32_32x32x16_bf16(af[ks], ring[i][ks], acc, 0, 0, 0);
                        if (kt < nkt) skl[kt * 32 + r] = sort_key(idx_reduce(acc, w));
                    }
                }
            }
            asm volatile("s_waitcnt lgkmcnt(0)" ::: "memory");
            unsigned sk[64];
            int tqr = tq - r4; asm volatile("" : "+v"(tqr));
#pragma unroll
            for (int i = 0; i < 16; ++i) { const v4u v = *(const LAS v4u*)(skl + 128 * i + r4);
                sk[4 * i + 0] = (128 * i + 0 <= tqr) ? v.x : 0u; sk[4 * i + 1] = (128 * i + 1 <= tqr) ? v.y : 0u; sk[4 * i + 2] = (128 * i + 2 <= tqr) ? v.z : 0u; sk[4 * i + 3] = (128 * i + 3 <= tqr) ? v.w : 0u; }
            unsigned T = 0u; bool exact = false;
            for (int bit = 31; bit >= 0; --bit) {
                const unsigned cand = T | (1u << bit);
                unsigned c = 0u;
#pragma unroll
                for (int i = 0; i < 64; ++i) cnt_ge(c, sk[i], cand);
                c = half_sum_u(c);
                if (!exact) { if (c >= (unsigned)TOPK) T = cand; if (c == (unsigned)TOPK) exact = true; }
                if (__all(exact)) break;
            }
            unsigned cut = 0x7fffffffu;
            if (__any(!exact)) {
                unsigned cg = 0u, ce = 0u;
                for (int i = 0; i < 16; ++i) { const v4u v = *(const LAS v4u*)(skl + 128 * i + r4); const int i0 = 128 * i + r4;
#pragma unroll
                    for (int e = 0; e < 4; ++e) { const unsigned k = (i0 + e <= tq) ? v[e] : 0u; cg += (k > T) ? 1u : 0u; ce += (k == T) ? 1u : 0u; } }
                cg = half_sum_u(cg); ce = half_sum_u(ce);
                const unsigned need = (unsigned)TOPK - cg;
                const bool tie = !exact && ce > need;
                unsigned I = 0u;
                for (int bit = 11; bit >= 0; --bit) {
                    const unsigned cand = I | (1u << bit);
                    unsigned c = 0u;
                    for (int i = 0; i < 16; ++i) { const v4u v = *(const LAS v4u*)(skl + 128 * i + r4); const int i0 = 128 * i + r4;
#pragma unroll
                        for (int e = 0; e < 4; ++e) { const unsigned k = (i0 + e <= tq) ? v[e] : 0u; c += (k == T && (unsigned)(i0 + e) < cand) ? 1u : 0u; } }
                    c = half_sum_u(c);
                    if (c < need) I = cand;
                }
                if (tie) cut = I;
            }
            int cutr = (int)cut - r4; asm volatile("" : "+v"(cutr));
#pragma unroll
            for (int i = 0; i < 16; ++i) {
                unsigned nib = 0u;
#pragma unroll
                for (int e = 0; e < 4; ++e) { const unsigned k = sk[4 * i + e]; const bool sel = k != 0u && (k > T || (k == T && (128 * i + e) <= cutr)); nib |= sel ? (1u << e) : 0u; }
                if (nib) __hip_atomic_fetch_or((LAS unsigned*)&mask[(q0 + hh) * 64 + 4 * i + (r >> 3)], nib << (4 * (r & 7)), __ATOMIC_RELAXED, __HIP_MEMORY_SCOPE_WORKGROUP);
            }
        }
    }
    gbar(gb, F.lane);
    attn4<true>(F, gw, row0, nkt, 64, WSP(bf16, WS_QB), WSP(bf16, WS_KB) + (size_t)b * SEQ * 512, WSP(bf16, WS_VT) + (size_t)b * 512 * SEQ, C_GA, 1024);
    gbar(gb, F.lane);
}
__device__ __forceinline__ void group_queue(Frame& F, GBar& gb, int gw) {
    unsigned* qctr = (unsigned*)(F.ws + WS_CTL) + 8192;
    volatile LAS int* slot = (volatile LAS int*)(F.lds + G4_SLOT_OFF);
    for (int n = 0;; ++n) {
        if (gw == 0 && F.lane == 0) slot[n & 1] = (int)__hip_atomic_fetch_add(qctr, 1u, __ATOMIC_RELAXED, __HIP_MEMORY_SCOPE_AGENT);
        gbar(gb, F.lane);
        const int it = slot[n & 1];
        if (it >= 512) break;
        Frame Fi = F; asm volatile("" : "+v"(Fi.lane), "+v"(Fi.tid));
        if (it < 256) dsa4_item(Fi, gb, gw, it & 3, 63 - (it >> 2));
        else { const int j = it - 256, b = j >> 6, qt = j & 63;
            attn4<false>(Fi, gw, b * SEQ + qt * 32, 8, 8, WSP(bf16, WS_QMB), WSP(bf16, WS_MKB) + (size_t)b * MEMT * 512, WSP(bf16, WS_MVT) + (size_t)b * 512 * MEMT, C_GM, 1536); }
    }
}
__device__ __forceinline__ bool overlap_mode(const Frame& F) { return F.G >= 64; }
__device__ __forceinline__ void p3_overlap(Frame& F) {
    volatile LAS unsigned* ctl = (volatile LAS unsigned*)(F.lds + G4_SLOT_OFF);
    const unsigned c_scan = ctl[4], c_att = ctl[8];
    __syncthreads();
    if (F.wave < 4) {
        GBar gb{ctl + 4, c_scan};
        for (int it0 = F.bid; it0 < 256; it0 += F.G) { const int it = (F.G == 256) ? ((it0 & 7) * 32 + (it0 >> 3)) : it0;
            const int bh = it >> 2, rg = it & 3, b = bh >> 4, h = bh & 15;
            scan4_item(F, gb, b, h, rg, F.out + O_WKVP + (size_t)bh * 4096, WSP(float, WS_Y) + (size_t)(b * SEQ) * RW + h * 64);
            asm volatile("s_waitcnt vmcnt(0)" ::: "memory"); gbar(gb, F.lane); }
    } else {
        GBar gb{ctl + 8, c_att};
        const int gw = F.wave - 4;
        const int gwi = F.bid * 4 + gw, NGW = F.G * 4;
        for (int it = gwi; it < DB * RH * 16; it += NGW) scan_sample_witem(F, it);
        for (int it = gwi; it < DB * NPAGES + DB; it += NGW) d1_sample_item(F, it);
        group_queue(F, gb, gw);
    }
    __syncthreads();
}
__device__ __forceinline__ void p8_phase(Frame& F) {
    const int gw = F.bid * NWAVES + F.wave, NGW = F.G * NWAVES;
    int t_ = threadIdx.x; asm volatile("" : "+v"(t_)); const int lane_ = t_ & 63;
    for (int row = gw; row < NTOK; row += NGW) {
        float* y = F.out + (row < NTOKP ? O_YP + (size_t)row * DM : O_YS + (size_t)(row - NTOKP) * DM);
        f32x4* xr = (f32x4*)y + lane_; const f32x4* wr = (const f32x4*)F.in[I_FNW] + lane_;
        f32x4 v[8]; float s = 0.f;
#pragma unroll
        for (int j = 0; j < 8; ++j) { v[j] = xr[64 * j]; s += (v[j].x * v[j].x + v[j].y * v[j].y) + (v[j].z * v[j].z + v[j].w * v[j].w); }
        const float rs = 1.f / sqrtf(wave_sum(s) * (1.f / DM) + RMS_EPS);
#pragma unroll
        for (int j = 0; j < 8; ++j) { const f32x4 ww = wr[64 * j]; xr[64 * j] = (f32x4){v[j].x * rs * ww.x, v[j].y * rs * ww.y, v[j].z * rs * ww.z, v[j].w * rs * ww.w}; }
    }
}

constexpr int N_PHASES = 9;
struct Args { const void* in[N_IN]; float* out; unsigned char* ws; int ph_lo, ph_hi; };
__global__ void __launch_bounds__(NTHR, 2) hymba_fwd(Args args) {
    extern __shared__ __attribute__((aligned(16))) unsigned char lds[];
    Frame F;
    F.lds = (LAS unsigned char*)lds;
    F.tid = threadIdx.x; F.lane = F.tid & 63; F.wave = __builtin_amdgcn_readfirstlane(F.tid >> 6);
    F.G = gridDim.x; F.bid = blockIdx.x;
#pragma unroll
    for (int i = 0; i < N_IN; ++i) F.in[i] = (const float*)args.in[i];
    F.out = args.out; F.ws = args.ws;
    for (int u = F.tid; u < (LDS_BYTES - LDSCTL_OFF) / 4; u += NTHR) ((LAS unsigned*)(F.lds + LDSCTL_OFF))[u] = 0u;
    __syncthreads();

#if MK_SPLIT
#define GRID_BAR() do { } while (0)
#else
    XcdBarrier bar = xcd_barrier_post((unsigned*)(F.ws + WS_CTL) + CW_BAR, (volatile LAS unsigned*)(F.lds + MISC_OFF) + 8);
#define GRID_BAR() xcd_barrier(bar)
#endif
    const int lo = args.ph_lo, hi = args.ph_hi;
#ifndef PH_MASK
#define PH_MASK 0x1FF
#endif
#define IN(k) (((PH_MASK >> (k)) & 1) && lo <= (k) && (k) < hi)
#define BOTH(k) (IN(k) && IN((k) + 1))

#define RUNPH(k, ...) do { if (IN(k)) { __VA_ARGS__; if (PROBE_REPEAT == (k)) { GRID_BAR(); __VA_ARGS__; } if (BOTH(k)) GRID_BAR(); } } while (0)
    RUNPH(0, p0_prologue(F));
    RUNPH(1, {
        { pg8::Gemm g{WSP(bf16, WS_XN), WSP(bf16, WS_WINT), MPAD, INWP, DM, DM}; pg8::StaticOrder S; S.init(MPAD, INWP, F.G, F.bid);
          EpiProjFused E{WSP(float, WS_PROJ), F.out, F.ws};
          pg8::gemm_phase<EpiProjFused, pg8::StaticOrder, true, true>(F.lds + RING_OFF, g, S, E); }
        { pg8::Gemm g{WSP(bf16, WS_XM), WSP(bf16, WS_WMEMT), 1024, 1024, DM, DM}; pg8::StaticOrder S; S.init(1024, 1024, F.G, F.G - 1 - F.bid);
          EpiMem E{F.out};
          pg8::gemm_phase<EpiMem, pg8::StaticOrder, true, true>(F.lds + RING_OFF, g, S, E); }
    });
    RUNPH(2, p2_phase(F));
    if (F.G >= 64) { RUNPH(3, p3_overlap(F)); } else { RUNPH(3, p3_scan_phase(F)); }
    RUNPH(4, p4_phase(F));
    if (F.G < 64) { RUNPH(5, p5_phase(F)); }
    RUNPH(6, p6_phase(F));
    RUNPH(7, {
        { pg8::Gemm g{WSP(bf16, WS_YMIX), WSP(bf16, WS_WOUTT), NTOKP, DM, DM, DM}; pg8::StaticOrder S; S.init(NTOKP, DM, F.G, F.bid);
          EpiOut E{F.in[I_XP], F.in[I_XS], F.out};
          pg8::gemm_phase<EpiOut, pg8::StaticOrder, true, true>(F.lds + RING_OFF, g, S, E); }
        { pg8::Gemm g{WSP(bf16, WS_YMIX), WSP(bf16, WS_WOUTT), MPAD, DM, 256, DM}; pg8::ListOrder S{F.G, F.bid, 2};
          EpiOutAtomic E{F.out};
          pg8::gemm_phase<EpiOutAtomic, pg8::ListOrder, true, true>(F.lds + RING_OFF, g, S, E); }
    });
    if (IN(8)) { p8_phase(F); }
#undef IN
#undef BOTH
}

extern "C" void kernel_launch(void* const* d_in, const int* in_sizes, int n_in, void* d_out, int out_size, void* d_ws, size_t ws_size, hipStream_t stream) {
    static int grid = 0;
    if (grid == 0) {
        if (n_in != N_IN || out_size != (int)O_END || ws_size < WS_END) { fprintf(stderr, "kernel_launch: unexpected shapes: n_in %d out %d ws %zu (need %zu)\n", n_in, out_size, ws_size, (size_t)WS_END); grid = -1; return; }
        int dev = 0, cus = 0, per_cu = 0;
        if (hipGetDevice(&dev) != hipSuccess || hipDeviceGetAttribute(&cus, hipDeviceAttributeMultiprocessorCount, dev) != hipSuccess) { grid = -1; return; }
        if (hipFuncSetAttribute((const void*)hymba_fwd, hipFuncAttributeMaxDynamicSharedMemorySize, LDS_BYTES) != hipSuccess) { fprintf(stderr, "kernel_launch: hipFuncSetAttribute failed\n"); grid = -1; return; }
        if (hipOccupancyMaxActiveBlocksPerMultiprocessor(&per_cu, (const void*)hymba_fwd, NTHR, LDS_BYTES) != hipSuccess || per_cu < 1) { fprintf(stderr, "kernel_launch: occupancy query says %d\n", per_cu); }
        (void)hipGetLastError();
        grid = cus;
    }
    if (grid < 0) return;
    if (hipMemsetAsync((char*)d_ws + WS_CTL, 0, CTL_ZERO_BYTES, stream) != hipSuccess) { fprintf(stderr, "kernel_launch: memset failed\n"); return; }
    Args a{};
    for (int i = 0; i < N_IN; ++i) a.in[i] = d_in[i];
    a.out = (float*)d_out; a.ws = (unsigned char*)d_ws;
#if MK_SPLIT
    for (int p = 0; p < N_PHASES; ++p) { a.ph_lo = p; a.ph_hi = p + 1; hipLaunchKernelGGL(hymba_fwd, dim3(grid), dim3(NTHR), LDS_BYTES, stream, a); }
#else
    a.ph_lo = 0; a.ph_hi = N_PHASES;
    hipLaunchKernelGGL(hymba_fwd, dim3(grid), dim3(NTHR), LDS_BYTES, stream, a);
#endif
    const hipError_t le = hipPeekAtLastError();
    if (le != hipSuccess) fprintf(stderr, "kernel_launch: launch failed: %s\n", hipGetErrorName(le));
}
```
